# Optimizing an MI355X kernel written in HIP

```python
import math
import jax, jax.numpy as jnp
from jax import lax
import numpy as np

D_MODEL = 1024
BATCH = 16
SEQ = 2048
DEPTH = 1

EPS = 1e-6
D_MIX = D_MODEL
HGRN_HEADS = 4
HGRN_EXPAND = 128
HGRN_DV = 128
HGRN_KEY_WIDTH = HGRN_HEADS * HGRN_EXPAND
HGRN_WIDTH = HGRN_HEADS * HGRN_DV
HGRN_CHUNK = 64
DIFF_HEADS = 4
DIFF_HALF = 64
DIFF_VDIM = 2 * DIFF_HALF
DIFF_WIDTH = DIFF_HEADS * DIFF_VDIM
Q_BLOCK = 128
REL_BUCKETS = 32
REL_MAX_DIST = 128
IN_SPLIT_SIZES = (HGRN_KEY_WIDTH, HGRN_KEY_WIDTH, HGRN_KEY_WIDTH, HGRN_WIDTH, HGRN_WIDTH,
                  DIFF_HEADS * 2 * DIFF_HALF, DIFF_HEADS * 2 * DIFF_HALF, DIFF_WIDTH)
D_IN_PROJ = 3 * HGRN_KEY_WIDTH + 2 * HGRN_WIDTH + 4 * DIFF_HEADS * DIFF_HALF + DIFF_WIDTH
PEER_HEADS = 8
PEER_NKEYS = 128
PEER_N_EXPERTS = PEER_NKEYS * PEER_NKEYS
PEER_DKEY = 128
PEER_TOPK = 16
PEER_TOKEN_BLOCK = 128

kernel_name = 'hymba_hgrn2_diffattn_peer_encoder'


def rms_norm(x, g):
    xf = x.astype(jnp.float32)
    y = xf * lax.rsqrt(jnp.mean(xf * xf, axis=-1, keepdims=True) + EPS)
    return (y * g.astype(jnp.float32)).astype(x.dtype)


def t5_bucket(rel):
    nb = REL_BUCKETS // 2
    ret = jnp.where(rel > 0, nb, 0)
    n = jnp.abs(rel)
    max_exact = nb // 2
    nf = jnp.maximum(n, 1).astype(jnp.float32)
    large = max_exact + (jnp.log(nf / max_exact) / math.log(REL_MAX_DIST / max_exact)
                         * (nb - max_exact)).astype(jnp.int32)
    large = jnp.minimum(large, nb - 1)
    return ret + jnp.where(n < max_exact, n, large)


def hgrn2_chunk_scan(q, k, v, log_f):
    B, H, L, DK = q.shape
    DV = v.shape[-1]
    C = HGRN_CHUNK
    n = L // C

    def to_chunks(t):
        return jnp.moveaxis(t.reshape(B, H, n, C, t.shape[-1]), 2, 0)

    qc, kc, vc, fc = to_chunks(q), to_chunks(k), to_chunks(v), to_chunks(log_f)
    mask = jnp.tril(jnp.ones((C, C), dtype=bool))[:, :, None]

    def step(S, inp):
        qi, ki, vi, fi = inp
        b = jnp.cumsum(fi, axis=2)
        o_inter = jnp.einsum('bhtk,bhkv->bhtv', qi * jnp.exp(b), S)
        rel = b[:, :, :, None, :] - b[:, :, None, :, :]
        decay = jnp.exp(jnp.where(mask, rel, -jnp.inf))
        A = jnp.einsum('bhtk,bhsk,bhtsk->bhts', qi, ki, decay)
        o_intra = jnp.einsum('bhts,bhsv->bhtv', A, vi)
        b_last = b[:, :, -1:, :]
        S_new = jnp.exp(b_last[:, :, 0, :])[..., None] * S + \
            jnp.einsum('bhsk,bhsv->bhkv', ki * jnp.exp(b_last - b), vi)
        return S_new, o_inter + o_intra

    S0 = jnp.zeros((B, H, DK, DV), jnp.float32)
    _, o = lax.scan(step, S0, (qc, kc, vc, fc))
    return jnp.moveaxis(o, 0, 2).reshape(B, H, L, DV)


def hgrn2_group(hq, hf_f, hf_b, hi, hg, lb_f_tab, lb_b_tab, out_g, layer):
    B, L, _ = hq.shape

    def heads(t, dh):
        return t.reshape(B, L, HGRN_HEADS, dh).transpose(0, 2, 1, 3).astype(jnp.float32)

    q = jax.nn.silu(heads(hq, HGRN_EXPAND))
    v = heads(hi, HGRN_DV)

    def gates(z, lb_tab):
        lb = jnp.cumsum(jax.nn.softmax(lb_tab.astype(jnp.float32), axis=0), axis=0)[layer]
        lb = lb.reshape(HGRN_HEADS, 1, HGRN_EXPAND)
        z = heads(z, HGRN_EXPAND)
        log_f = jnp.logaddexp(jnp.log(lb), jnp.log1p(-lb) + jax.nn.log_sigmoid(z))
        k = (1.0 - lb) * jax.nn.sigmoid(-z)
        return log_f, k

    lf_f, k_f = gates(hf_f, lb_f_tab)
    lf_b, k_b = gates(hf_b, lb_b_tab)
    flip = lambda t: jnp.flip(t, axis=2)
    o_f = hgrn2_chunk_scan(q, k_f, v, lf_f)
    o_b = flip(hgrn2_chunk_scan(flip(q), flip(k_b), flip(v), flip(lf_b)))
    o = rms_norm(o_f + o_b, out_g) * jax.nn.silu(heads(hg, HGRN_DV))
    return o.transpose(0, 2, 1, 3).reshape(B, L, HGRN_WIDTH).astype(hq.dtype)


def diff_attention(q, k, v, lam, rel_bias):
    B, H, L = q.shape[0], q.shape[1], q.shape[2]
    nb = L // Q_BLOCK
    scale = DIFF_HALF ** -0.5
    qb = jnp.moveaxis(q.reshape(B, H, nb, Q_BLOCK, 2, DIFF_HALF), 2, 0)
    key_pos = jnp.arange(L, dtype=jnp.int32)

    def block(args):
        q_blk, blk_idx = args
        q_pos = blk_idx * Q_BLOCK + jnp.arange(Q_BLOCK, dtype=jnp.int32)
        bucket = t5_bucket(key_pos[None, :] - q_pos[:, None])
        bias = jnp.moveaxis(rel_bias[bucket], -1, 0).astype(jnp.float32)
        s = jnp.einsum('bhqmd,bhkmd->bhmqk', q_blk, k).astype(jnp.float32) * scale
        p = jax.nn.softmax(s + bias[None, :, None], axis=-1)
        w = p[:, :, 0] - lam * p[:, :, 1]
        return jnp.einsum('bhqk,bhkv->bhqv', w.astype(v.dtype), v)

    o = lax.map(block, (qb, jnp.arange(nb, dtype=jnp.int32)))
    return jnp.moveaxis(o, 0, 2).reshape(B, H, L, DIFF_VDIM)


def diff_attn_group(dq, dk, dv, lq1, lk1, lq2, lk2, out_g, rel_bias, layer):
    B, L, _ = dq.shape
    q = dq.reshape(B, L, DIFF_HEADS, 2, DIFF_HALF).transpose(0, 2, 1, 3, 4)
    k = dk.reshape(B, L, DIFF_HEADS, 2, DIFF_HALF).transpose(0, 2, 1, 3, 4)
    v = dv.reshape(B, L, DIFF_HEADS, DIFF_VDIM).transpose(0, 2, 1, 3)
    lam_init = 0.8 - 0.6 * math.exp(-0.3 * layer)
    f32 = jnp.float32
    lam = jnp.exp(jnp.sum(lq1.astype(f32) * lk1.astype(f32))) - \
        jnp.exp(jnp.sum(lq2.astype(f32) * lk2.astype(f32))) + lam_init
    o = diff_attention(q, k, v, lam, rel_bias)
    o = rms_norm(o, out_g) * (1.0 - lam_init)
    return o.transpose(0, 2, 1, 3).reshape(B, L, DIFF_WIDTH).astype(dq.dtype)


def peer_ffn(x, w_q, sub_keys, expert_u, expert_v):
    B, L, D = x.shape
    T = B * L
    xt = x.reshape(T, D)
    q = jnp.einsum('td,dhe->the', xt, w_q).reshape(T, PEER_HEADS, 2, PEER_DKEY)
    s = jnp.einsum('thpe,hpne->thpn', q, sub_keys).astype(jnp.float32)
    s_top, i_top = lax.top_k(s, PEER_TOPK)
    cand_s = (s_top[:, :, 0, :, None] + s_top[:, :, 1, None, :]).reshape(T, PEER_HEADS, PEER_TOPK * PEER_TOPK)
    cand_i = (i_top[:, :, 0, :, None] * PEER_NKEYS + i_top[:, :, 1, None, :]).reshape(T, PEER_HEADS, PEER_TOPK * PEER_TOPK)
    best_s, pos = lax.top_k(cand_s, PEER_TOPK)
    idx = jnp.take_along_axis(cand_i, pos, axis=-1)
    gate = jax.nn.softmax(best_s, axis=-1).astype(x.dtype)
    nblk = T // PEER_TOKEN_BLOCK

    def block(args):
        xb, ib, gb = args
        u = expert_u[ib]
        hdn = jax.nn.gelu(jnp.einsum('cd,chkd->chk', xb, u), approximate=False)
        return jnp.einsum('chk,chkd->cd', gb * hdn, expert_v[ib])

    out = lax.map(block, (xt.reshape(nblk, PEER_TOKEN_BLOCK, D),
                          idx.reshape(nblk, PEER_TOKEN_BLOCK, PEER_HEADS, PEER_TOPK),
                          gate.reshape(nblk, PEER_TOKEN_BLOCK, PEER_HEADS, PEER_TOPK)))
    return out.reshape(B, L, D)


def setup_inputs(seed: int = 0) -> dict:
    key = jax.random.key(seed)
    ks = jax.random.split(key, 20)
    nrm = lambda k, shape, s: jax.random.normal(k, shape, jnp.float32) * s
    gain = lambda k, shape: 1.0 + nrm(k, shape, 0.02)
    return {
        'x': nrm(ks[0], (BATCH, SEQ, D_MODEL), 1.0),
        'norm1_g': gain(ks[1], (DEPTH, D_MODEL)),
        'w_in': nrm(ks[2], (DEPTH, D_MODEL, D_IN_PROJ), D_MODEL ** -0.5),
        'hgrn_lb_fwd': nrm(ks[3], (DEPTH + 1, HGRN_KEY_WIDTH), 0.5),
        'hgrn_lb_bwd': nrm(ks[4], (DEPTH + 1, HGRN_KEY_WIDTH), 0.5),
        'hgrn_out_g': gain(ks[5], (DEPTH, HGRN_DV)),
        'diff_lam_q1': nrm(ks[6], (DEPTH, DIFF_HALF), 0.1),
        'diff_lam_k1': nrm(ks[7], (DEPTH, DIFF_HALF), 0.1),
        'diff_lam_q2': nrm(ks[8], (DEPTH, DIFF_HALF), 0.1),
        'diff_lam_k2': nrm(ks[9], (DEPTH, DIFF_HALF), 0.1),
        'diff_out_g': gain(ks[10], (DEPTH, DIFF_VDIM)),
        'rel_bias': nrm(ks[11], (REL_BUCKETS, DIFF_HEADS), 0.3),
        'w_out': nrm(ks[12], (DEPTH, D_MIX, D_MODEL), D_MIX ** -0.5),
        'norm2_g': gain(ks[13], (DEPTH, D_MODEL)),
        'peer_w_q': nrm(ks[14], (DEPTH, D_MODEL, PEER_HEADS, 2 * PEER_DKEY), D_MODEL ** -0.5),
        'peer_sub_keys': nrm(ks[15], (DEPTH, PEER_HEADS, 2, PEER_NKEYS, PEER_DKEY), PEER_DKEY ** -0.5),
        'peer_u': nrm(ks[16], (DEPTH, PEER_N_EXPERTS, D_MODEL), D_MODEL ** -0.5),
        'peer_v': nrm(ks[17], (DEPTH, PEER_N_EXPERTS, D_MODEL), 0.5 * PEER_HEADS ** -0.5),
        'final_g': gain(ks[18], (D_MODEL,)),
    }


def reference(x, norm1_g, w_in, hgrn_lb_fwd, hgrn_lb_bwd, hgrn_out_g, diff_lam_q1, diff_lam_k1,
              diff_lam_q2, diff_lam_k2, diff_out_g, rel_bias, w_out, norm2_g, peer_w_q,
              peer_sub_keys, peer_u, peer_v, final_g):
    h = x
    split_at = [int(v) for v in np.cumsum(IN_SPLIT_SIZES)[:-1]]
    for layer in range(DEPTH):
        xn = rms_norm(h, norm1_g[layer])
        proj = jnp.einsum('bld,de->ble', xn, w_in[layer])
        hq, hf_f, hf_b, hi, hg, dq, dk, dv = jnp.split(proj, split_at, axis=-1)
        o_hgrn = hgrn2_group(hq, hf_f, hf_b, hi, hg, hgrn_lb_fwd, hgrn_lb_bwd,
                             hgrn_out_g[layer], layer)
        o_diff = diff_attn_group(dq, dk, dv, diff_lam_q1[layer], diff_lam_k1[layer],
                                 diff_lam_q2[layer], diff_lam_k2[layer], diff_out_g[layer],
                                 rel_bias, layer)
        mixed = jnp.concatenate([o_hgrn, o_diff], axis=-1)
        h = h + jnp.einsum('ble,ed->bld', mixed, w_out[layer])
        hn = rms_norm(h, norm2_g[layer])
        h = h + peer_ffn(hn, peer_w_q[layer], peer_sub_keys[layer], peer_u[layer], peer_v[layer])
    return rms_norm(h, final_g)
```

```cpp
#include <hip/hip_runtime.h>
#include <hip/hip_bf16.h>
#include <hip/hip_cooperative_groups.h>
#include <cstdio>
#include <cstdint>
#include <cmath>
namespace cg = cooperative_groups;
#ifndef MK_ONE_LAUNCH
#define MK_ONE_LAUNCH 1
#endif
namespace pg8 {
#define PG8_LAS __attribute__((address_space(3)))
typedef unsigned short bf16_t;
typedef short bf16x8 __attribute__((ext_vector_type(8)));
typedef float f32x4 __attribute__((ext_vector_type(4)));
typedef unsigned u32x4 __attribute__((ext_vector_type(4)));
constexpr int BM = 256, BK = 64, HALF = 128, HTB = HALF * BK * 2  , STAGE_BYTES = 8 * HTB, NXCD = 8, WGM = 8;

__host__ __device__ __forceinline__ int lds_byte(int r, int c) { const int st = (r >> 4) * 2 + (c >> 5), rr = r & 15, cc = c & 31, ob = rr * 64 + cc * 2; return st * 1024 + (ob ^ (((ob >> 9) & 1) << 5)); }
__host__ __device__ __forceinline__ void stage_rc(int b, int& R, int& C) { const int st = b / 1024, sb = b % 1024, swz = sb ^ (((sb >> 9) & 1) << 5); R = (st >> 1) * 16 + swz / 64; C = (st & 1) * 32 + (swz % 64) / 2; }
__host__ __device__ __forceinline__ int perm32(int rho) { const int n = rho >> 4, i = rho & 15; return 8 * (i >> 2) + 4 * n + (i & 3); }

struct Unit { int pm, pn; };
struct Gemm { const bf16_t* A; const bf16_t* Bt; int M, N, K; };

struct StaticOrder {
    int nM, nN, nwg, G, c;
    __host__ __device__ void init(int M, int N, int G_, int c_) { nM = M / BM; nN = N / BM; nwg = nM * nN; G = G_; c = c_; }
    __host__ __device__ bool next(int i, Unit& u) const {
        const long L = (long)i * G + c; if (L >= nwg) return false;
        int wgid = (int)L; { const int q = nwg / NXCD, r = nwg % NXCD, xcd = wgid % NXCD, off = wgid / NXCD; wgid = (xcd < r ? xcd * (q + 1) : r * (q + 1) + (xcd - r) * q) + off; }
        const int nig = WGM * nN, gid = wgid / nig, fm = gid * WGM, gsz = (nM - fm) < WGM ? (nM - fm) : WGM;
        u.pm = fm + ((wgid % nig) % gsz); u.pn = (wgid % nig) / gsz; return true;
    }
    __device__ __forceinline__ void a_ready(const Unit&) const {}
    __device__ __forceinline__ void done(const Unit&) const {}
};

__device__ __forceinline__ unsigned cvt_pk_bf16(float lo, float hi) { unsigned r; asm volatile("v_cvt_pk_bf16_f32 %0, %1, %2" : "=v"(r) : "v"(lo), "v"(hi)); return r; }
typedef float f32x2 __attribute__((ext_vector_type(2)));
template <class Epi, class Sched, bool ALIGN_EPI = false, bool SP2 = false>
__device__ __forceinline__ void gemm_phase(PG8_LAS unsigned char* lds, const Gemm g, const Sched& S, const Epi& E) {
    const int tid = threadIdx.x, wid = __builtin_amdgcn_readfirstlane(tid >> 6), lane = tid & 63, wr = wid >> 2, wc = wid & 3, fr = lane & 15, fq = lane >> 4;
    const int K = g.K, nt = K / BK;
    unsigned voffA[2], voffB[2];
#pragma unroll
    for (int i = 0; i < 2; ++i) { int R, C; stage_rc(tid * 16 + i * 8192, R, C); const int Rb = Epi::PERM ? ((R & ~31) + perm32(R & 31)) : R;
        voffA[i] = (unsigned)(R * K + C) * 2u; voffB[i] = (unsigned)(Rb * K + C) * 2u; }
    const size_t kstep = (size_t)(BK * 2);
    const size_t hstep = (size_t)HALF * K * 2;
    const size_t tstep = 2 * hstep;
    const unsigned ldsw = (unsigned)wid * 1024u;
    const int aoff = lds_byte(wr * 64 + fr, fq * 8), boff = lds_byte(wc * 32 + fr, fq * 8);
#define PG8_SA(b, h) (((b) * 2 + (h)) * HTB)
#define PG8_SB(b, h) ((4 + (b) * 2 + (h)) * HTB)
#define PG8_STAGE(bufoff, gbase, voff) do { _Pragma("unroll") for (int _i = 0; _i < 2; ++_i) \
        __builtin_amdgcn_global_load_lds((const unsigned*)((const char*)(gbase) + (voff)[_i]), (PG8_LAS unsigned*)(lds + (bufoff) + ldsw + _i * 8192), 16, 0, 0); } while (0)
#define PG8_LDA(dst, b, h) do { _Pragma("unroll") for (int m = 0; m < 4; ++m) _Pragma("unroll") for (int k = 0; k < 2; ++k) dst[m][k] = *(const PG8_LAS bf16x8*)(lds + PG8_SA(b, h) + aoff + m * 2048 + k * 1024); } while (0)
#define PG8_LDB(dst, b, h) do { _Pragma("unroll") for (int n = 0; n < 2; ++n) _Pragma("unroll") for (int k = 0; k < 2; ++k) dst[n][k] = *(const PG8_LAS bf16x8*)(lds + PG8_SB(b, h) + boff + n * 2048 + k * 1024); } while (0)
#define PG8_MMA(ai, bj, At, Bt) do { __builtin_amdgcn_s_setprio(1); _Pragma("unroll") for (int m = 0; m < 4; ++m) _Pragma("unroll") for (int n = 0; n < 2; ++n) _Pragma("unroll") for (int k = 0; k < 2; ++k) \
        acc[ai][bj][m][n] = __builtin_amdgcn_mfma_f32_16x16x32_bf16(Bt[n][k], At[m][k], acc[ai][bj][m][n], 0, 0, 0); __builtin_amdgcn_s_setprio(0); } while (0)
#define PG8_WAIT_V(n) asm volatile("s_waitcnt vmcnt(" #n ")" ::: "memory")
#define PG8_WAIT_L(n) asm volatile("s_waitcnt lgkmcnt(" #n ")" ::: "memory")
#define PG8_BAR __builtin_amdgcn_s_barrier()
#define PG8_SCHED __builtin_amdgcn_sched_barrier(0)
    Unit cur, nxt; int ui = 0;
    if (!S.next(0, cur)) return;
    f32x4 acc[2][2][4][2];
#pragma unroll
    for (int a = 0; a < 2; ++a)
#pragma unroll
        for (int b = 0; b < 2; ++b)
#pragma unroll
            for (int m = 0; m < 4; ++m)
#pragma unroll
                for (int n = 0; n < 2; ++n) acc[a][b][m][n] = (f32x4){0.f, 0.f, 0.f, 0.f};
    bf16x8 At[4][2], B0[2][2], B1[2][2];
    const char* cA = (const char*)g.A + (size_t)cur.pm * tstep; const char* cB = (const char*)g.Bt + (size_t)cur.pn * tstep;
    S.a_ready(cur);
    if constexpr (SP2) {
        PG8_STAGE(PG8_SB(0, 0), cB, voffB); PG8_STAGE(PG8_SB(0, 1), cB + hstep, voffB); PG8_STAGE(PG8_SA(0, 0), cA, voffA); PG8_STAGE(PG8_SA(0, 1), cA + hstep, voffA);
        if (wr == 1) PG8_BAR;
        PG8_WAIT_V(2); PG8_BAR;
        PG8_STAGE(PG8_SB(1, 0), cB + kstep, voffB); PG8_STAGE(PG8_SA(1, 0), cA + kstep, voffA); PG8_STAGE(PG8_SB(1, 1), cB + hstep + kstep, voffB);
        PG8_WAIT_V(6); PG8_BAR;
    } else {
        PG8_STAGE(PG8_SB(0, 0), cB, voffB); PG8_STAGE(PG8_SA(0, 0), cA, voffA); PG8_STAGE(PG8_SB(0, 1), cB + hstep, voffB); PG8_STAGE(PG8_SA(0, 1), cA + hstep, voffA);
        if (wr == 1) PG8_BAR;
        PG8_WAIT_V(4); PG8_BAR;
        PG8_STAGE(PG8_SB(1, 0), cB + kstep, voffB); PG8_STAGE(PG8_SA(1, 0), cA + kstep, voffA); PG8_STAGE(PG8_SB(1, 1), cB + hstep + kstep, voffB);
        PG8_WAIT_V(6); PG8_BAR;
    }
    for (;;) {
        const bool has_next = S.next(ui + 1, nxt);
        const char* nA = has_next ? (const char*)g.A + (size_t)nxt.pm * tstep : cA; const char* nB = has_next ? (const char*)g.Bt + (size_t)nxt.pn * tstep : cB;
        for (int t = 0; t < nt; t += 2) {
            const bool last = (t == nt - 2);
            const char* a1 = cA + (size_t)(t + 1) * kstep;
            const char* a2 = last ? nA : cA + (size_t)(t + 2) * kstep; const char* b2 = last ? nB : cB + (size_t)(t + 2) * kstep;
            const char* a3 = a2 + kstep; const char* b3 = b2 + kstep;
            if (last && has_next) S.a_ready(nxt);
            if constexpr (SP2) {
            PG8_LDB(B0, 0, 0); PG8_LDB(B1, 0, 1); PG8_SCHED; PG8_LDA(At, 0, 0); PG8_STAGE(PG8_SA(1, 1), a1 + hstep, voffA);
            PG8_WAIT_V(8); PG8_WAIT_L(0); PG8_BAR; PG8_MMA(0, 0, At, B0); PG8_MMA(0, 1, At, B1); PG8_BAR; PG8_SCHED;
            PG8_LDA(At, 0, 1); PG8_STAGE(PG8_SB(0, 0), b2, voffB); PG8_STAGE(PG8_SB(0, 1), b2 + hstep, voffB); PG8_STAGE(PG8_SA(0, 0), a2, voffA);
            PG8_WAIT_V(8); PG8_WAIT_L(0); PG8_BAR; PG8_MMA(1, 0, At, B0); PG8_MMA(1, 1, At, B1); PG8_BAR; PG8_SCHED;
            PG8_LDB(B0, 1, 0); PG8_LDB(B1, 1, 1); PG8_SCHED; PG8_LDA(At, 1, 0); PG8_STAGE(PG8_SA(0, 1), a2 + hstep, voffA);
            PG8_WAIT_V(8); PG8_WAIT_L(0); PG8_BAR; PG8_MMA(0, 0, At, B0); PG8_MMA(0, 1, At, B1); PG8_BAR; PG8_SCHED;
            PG8_LDA(At, 1, 1); PG8_STAGE(PG8_SB(1, 0), b3, voffB); PG8_STAGE(PG8_SB(1, 1), b3 + hstep, voffB); PG8_STAGE(PG8_SA(1, 0), a3, voffA);
            PG8_WAIT_V(8); PG8_WAIT_L(0); PG8_BAR; PG8_MMA(1, 0, At, B0); PG8_MMA(1, 1, At, B1); PG8_BAR; PG8_SCHED;
            } else {
            PG8_LDB(B0, 0, 0); PG8_SCHED; PG8_LDA(At, 0, 0); PG8_STAGE(PG8_SA(1, 1), a1 + hstep, voffA);
            PG8_WAIT_L(8); PG8_BAR; PG8_WAIT_L(0); PG8_MMA(0, 0, At, B0); PG8_BAR; PG8_SCHED;
            PG8_LDB(B1, 0, 1); PG8_STAGE(PG8_SB(0, 0), b2, voffB);
            PG8_BAR; PG8_WAIT_L(0); PG8_MMA(0, 1, At, B1); PG8_BAR;
            PG8_LDA(At, 0, 1); PG8_STAGE(PG8_SA(0, 0), a2, voffA);
            PG8_BAR; PG8_WAIT_L(0); PG8_MMA(1, 0, At, B0); PG8_BAR; PG8_SCHED;
            PG8_STAGE(PG8_SB(0, 1), b2 + hstep, voffB);
            PG8_WAIT_V(6); PG8_BAR; PG8_MMA(1, 1, At, B1); PG8_BAR;
            PG8_LDB(B0, 1, 0); PG8_SCHED; PG8_LDA(At, 1, 0); PG8_STAGE(PG8_SA(0, 1), a2 + hstep, voffA);
            PG8_WAIT_L(8); PG8_BAR; PG8_WAIT_L(0); PG8_MMA(0, 0, At, B0); PG8_BAR; PG8_SCHED;
            PG8_LDB(B1, 1, 1); PG8_STAGE(PG8_SB(1, 0), b3, voffB);
            PG8_BAR; PG8_WAIT_L(0); PG8_MMA(0, 1, At, B1); PG8_BAR;
            PG8_LDA(At, 1, 1); PG8_STAGE(PG8_SA(1, 0), a3, voffA);
            PG8_BAR; PG8_WAIT_L(0); PG8_MMA(1, 0, At, B0); PG8_BAR; PG8_SCHED;
            PG8_STAGE(PG8_SB(1, 1), b3 + hstep, voffB);
            PG8_WAIT_V(6); PG8_BAR; PG8_MMA(1, 1, At, B1); PG8_BAR;
            }
        }
        if constexpr (ALIGN_EPI) { if (wr == 0) PG8_BAR; }
        if constexpr (!Epi::AFTER_DRAIN) { E(acc, cur, wr, wc, fr, fq); S.done(cur); }
        if (!has_next) break;
#pragma unroll
        for (int a = 0; a < 2; ++a)
#pragma unroll
            for (int b = 0; b < 2; ++b)
#pragma unroll
                for (int m = 0; m < 4; ++m)
#pragma unroll
                    for (int n = 0; n < 2; ++n) acc[a][b][m][n] = (f32x4){0.f, 0.f, 0.f, 0.f};
        cur = nxt; cA = nA; cB = nB; ++ui;
        if constexpr (ALIGN_EPI) { if (wr == 1) PG8_BAR; }
    }
    PG8_WAIT_V(0);
    if constexpr (!ALIGN_EPI) { if (wr == 0) PG8_BAR; }
    PG8_BAR;
    if constexpr (Epi::AFTER_DRAIN) { E.fused(acc, cur, wr, wc, fr, fq, lds, wid, lane); S.done(cur); }
#undef PG8_SA
#undef PG8_SB
#undef PG8_STAGE
#undef PG8_LDA
#undef PG8_LDB
#undef PG8_MMA
#undef PG8_WAIT_V
#undef PG8_WAIT_L
#undef PG8_BAR
#undef PG8_SCHED
}
}

#define LAS __attribute__((address_space(3)))
typedef unsigned short bf16_t;
typedef short bf16x8 __attribute__((ext_vector_type(8)));
typedef short bf16x4 __attribute__((ext_vector_type(4)));
typedef float f32x4 __attribute__((ext_vector_type(4)));
typedef float f32x16 __attribute__((ext_vector_type(16)));
typedef unsigned u32x4 __attribute__((ext_vector_type(4)));
typedef unsigned u32x2 __attribute__((ext_vector_type(2)));
typedef __bf16 bf16x2_t __attribute__((ext_vector_type(2)));

constexpr int NB = 16, SEQ = 2048, T = NB * SEQ, D = 1024;
constexpr int PP = 4608;
constexpr int C_Q = 0, C_KF = 512, C_LFF = 1024, C_KB = 1536, C_LFB = 2048, C_V = 2560, C_G = 3072, C_DQ = 3584, C_DK = 4096;
constexpr float EPS = 1e-6f;
constexpr float LOG2E = 1.4426950408889634f;
constexpr int NWAVES = 8, NTHREADS = 512;
constexpr int NGRP = 8, GRP_SHIFT = 11, GRP_SIZE = 2048, VSL = 128, NVS = 4;
constexpr int LDS_BYTES = 147456;

constexpr size_t MiB = (size_t)1 << 20;
constexpr size_t WS_SM = 64 * 1024;
constexpr size_t WS_WINT = 2 * MiB, WS_WOT = 10 * MiB, WS_WQT = 12 * MiB, WS_KEYS = 16 * MiB;
constexpr size_t WS_UT = 32 * MiB, WS_USC = 48 * MiB, WS_VSC = 49 * MiB, WS_VE = 64 * MiB, WS_XN = 96 * MiB, WS_PROJ = 160 * MiB, WS_VT = 448 * MiB, WS_END = 480 * MiB;
constexpr size_t WS_H1B = 160 * MiB, WS_QP = 224 * MiB, WS_IDX = 360 * MiB, WS_GATE = 376 * MiB, WS_SS = 392 * MiB, WS_C = 394 * MiB;
constexpr int QPS = 2048 + 64;
constexpr size_t WS_US8 = 48 * MiB + 131072;
constexpr size_t WS_H1Q = 96 * MiB, WS_HSC = 128 * MiB;
constexpr int SM_LBF = 0, SM_LBB = 512, SM_LAM = 1024, SM_BT = 2048, BT_STRIDE = 260;

struct Params { const float* in[19]; float* out; unsigned char* ws; int ph_lo, ph_hi; };
enum { I_X = 0, I_G1, I_WIN, I_LBF, I_LBB, I_HOG, I_LQ1, I_LK1, I_LQ2, I_LK2, I_DOG, I_RB, I_WOUT, I_G2, I_WQ, I_KEYS, I_U, I_V, I_FG };

#define LDS_WAIT() asm volatile("s_waitcnt lgkmcnt(0)" ::: "memory")
__device__ __forceinline__ unsigned f2bf(float f) { unsigned u = __builtin_bit_cast(unsigned, f); return (u + 0x7fffu + ((u >> 16) & 1u)) >> 16; }
typedef float f32x2v_ __attribute__((ext_vector_type(2)));
__device__ __forceinline__ unsigned pk2(float lo, float hi) { const f32x2v_ v = {lo, hi}; return __builtin_bit_cast(unsigned, __builtin_convertvector(v, bf16x2_t)); }
__device__ __forceinline__ float bflo(unsigned w) { return __uint_as_float(w << 16); }
__device__ __forceinline__ float bfhi(unsigned w) { return __uint_as_float(w & 0xffff0000u); }
template <int CTRL> __device__ __forceinline__ float dpp_mov(float v) { return __builtin_bit_cast(float, __builtin_amdgcn_update_dpp(0, __builtin_bit_cast(int, v), CTRL, 0xF, 0xF, false)); }
__device__ __forceinline__ void swap16_(float& a, float& b) { asm volatile("s_nop 1\n\tv_permlane16_swap_b32 %0, %1\n\ts_nop 1" : "+v"(a), "+v"(b)); }
__device__ __forceinline__ void swap32_(float& a, float& b) { asm volatile("s_nop 1\n\tv_permlane32_swap_b32 %0, %1\n\ts_nop 1" : "+v"(a), "+v"(b)); }
__device__ __forceinline__ void swap16i_(int& a, int& b) { asm volatile("s_nop 1\n\tv_permlane16_swap_b32 %0, %1\n\ts_nop 1" : "+v"(a), "+v"(b)); }
__device__ __forceinline__ void swap32i_(int& a, int& b) { asm volatile("s_nop 1\n\tv_permlane32_swap_b32 %0, %1\n\ts_nop 1" : "+v"(a), "+v"(b)); }
__device__ __forceinline__ float swap16_sum(float v) { float a = v, b = v; swap16_(a, b); return a + b; }
__device__ __forceinline__ float swap32_sum(float v) { float a = v, b = v; swap32_(a, b); return a + b; }
__device__ __forceinline__ float swap16_max(float v) { float a = v, b = v; swap16_(a, b); return fmaxf(a, b); }
__device__ __forceinline__ float swap32_max(float v) { float a = v, b = v; swap32_(a, b); return fmaxf(a, b); }
__device__ __forceinline__ float xchg16(float v, int lane) { float a = v, b = v; swap16_(a, b); return (lane & 16) ? a : b; }
__device__ __forceinline__ float xchg32(float v, int lane) { float a = v, b = v; swap32_(a, b); return (lane & 32) ? a : b; }
__device__ __forceinline__ float wave_sum(float v) {
    v += dpp_mov<0xB1>(v); v += dpp_mov<0x4E>(v); v += dpp_mov<0x141>(v); v += dpp_mov<0x140>(v);
    return swap32_sum(swap16_sum(v));
}
__device__ __forceinline__ float wave_max(float v) {
    v = fmaxf(v, dpp_mov<0xB1>(v)); v = fmaxf(v, dpp_mov<0x4E>(v)); v = fmaxf(v, dpp_mov<0x141>(v)); v = fmaxf(v, dpp_mov<0x140>(v));
    return swap32_max(swap16_max(v));
}
__device__ __forceinline__ float sigmoidf_(float z) { return __builtin_amdgcn_rcpf(1.0f + __expf(-z)); }

__device__ __forceinline__ void p0_transpose_item(const float* W, int K, int N, bf16_t* WT, const float* kscale, LAS float* scr, int item, int lane) {
    const int nblk = N / 32, kb = item / nblk, nb = item % nblk, k0 = 64 * kb, n0 = 32 * nb;
#pragma unroll 8
    for (int i = 0; i < 32; ++i) { const int kk = 2 * i + (lane >> 5); float w = W[(size_t)(k0 + kk) * N + n0 + (lane & 31)]; if (kscale) w *= kscale[k0 + kk]; scr[kk * 33 + (lane & 31)] = w; }
    LDS_WAIT(); asm volatile("" ::: "memory");
    const int c = lane & 7;
#pragma unroll
    for (int j = 0; j < 4; ++j) { const int n = (lane >> 3) + 8 * j; const LAS float* s = scr + (8 * c) * 33 + n;
        u32x4 o; o.x = pk2(s[0 * 33], s[1 * 33]); o.y = pk2(s[2 * 33], s[3 * 33]); o.z = pk2(s[4 * 33], s[5 * 33]); o.w = pk2(s[6 * 33], s[7 * 33]);
        *(u32x4*)(WT + (size_t)(n0 + n) * K + k0 + 8 * c) = o; }
    LDS_WAIT(); asm volatile("" ::: "memory");
}
__device__ __forceinline__ int t5_bucket(int rel) {
    const int n = rel < 0 ? -rel : rel;
    const int v = n < 8 ? n : n < 12 ? 8 : n < 16 ? 9 : n < 23 ? 10 : n < 32 ? 11 : n < 46 ? 12 : n < 64 ? 13 : n < 91 ? 14 : 15;
    return (rel > 0 ? 16 : 0) + v;
}
__device__ __forceinline__ void phase_prep(const Params& p, LAS unsigned char* lds, int vcu, int G) {
    const int tid = threadIdx.x, lane = tid & 63, wave = __builtin_amdgcn_readfirstlane(tid >> 6);
    unsigned char* ws = p.ws;
    LAS float* scr = (LAS float*)(lds + wave * 16384);
    const int gw = vcu * NWAVES + wave, NGW = G * NWAVES;
    constexpr int I_IN = (D / 64) * (4096 / 32), I_OUT = (D / 64) * (D / 32), I_QW = (D / 64) * (2048 / 32);
    for (int it = gw; it < I_IN + I_OUT + I_QW; it += NGW) {
        int r = it;
        if (r < I_IN) { p0_transpose_item(p.in[I_WIN], D, 4096, (bf16_t*)(ws + WS_WINT), nullptr, scr, r, lane); continue; } r -= I_IN;
        if (r < I_OUT) { p0_transpose_item(p.in[I_WOUT], D, D, (bf16_t*)(ws + WS_WOT), nullptr, scr, r, lane); continue; } r -= I_OUT;
        p0_transpose_item(p.in[I_WQ], D, 2048, (bf16_t*)(ws + WS_WQT), p.in[I_G2], scr, r, lane);
    }
    for (int i = blockIdx.x * NTHREADS + tid; i < 8 * 2 * 128 * 128 / 4; i += G * NTHREADS) {
        const f32x4 v = ((const f32x4*)p.in[I_KEYS])[i];
        ((u32x2*)(ws + WS_KEYS))[i] = (u32x2){pk2(v.x, v.y), pk2(v.z, v.w)};
    }
#define PX_LOAD(dst, m0_) { _Pragma("unroll") for (int u = 0; u < 4; ++u) { const int m = ((m0_) + u * NGW) < T ? ((m0_) + u * NGW) : gw; const f32x4* xr = (const f32x4*)(p.in[I_X] + (size_t)m * D) + lane; \
            _Pragma("unroll") for (int j = 0; j < 4; ++j) dst[u][j] = xr[64 * j]; } }
#define PX_PROC(src, m0_) { _Pragma("unroll") for (int u = 0; u < 4; ++u) { const int m = (m0_) + u * NGW; if (m < T) { float ssq = 0.f; \
            _Pragma("unroll") for (int j = 0; j < 4; ++j) ssq += (src[u][j].x * src[u][j].x + src[u][j].y * src[u][j].y) + (src[u][j].z * src[u][j].z + src[u][j].w * src[u][j].w); \
            const float rs = rsqrtf(wave_sum(ssq) * (1.f / D) + EPS); unsigned long long* o8 = (unsigned long long*)((bf16_t*)(ws + WS_XN) + (size_t)m * D) + lane; \
            _Pragma("unroll") for (int j = 0; j < 4; ++j) { const f32x4 y = src[u][j] * rs * ((const f32x4*)p.in[I_G1])[64 * j + lane]; o8[64 * j] = (unsigned long long)pk2(y.x, y.y) | ((unsigned long long)pk2(y.z, y.w) << 32); } } } }
    {
        f32x4 va[4][4], vb[4][4];
        PX_LOAD(va, gw)
        for (int m0 = gw; m0 < T; m0 += 8 * NGW) {
            if (m0 + 4 * NGW < T) PX_LOAD(vb, m0 + 4 * NGW)
            PX_PROC(va, m0)
            if (m0 + 8 * NGW < T) PX_LOAD(va, m0 + 8 * NGW)
            PX_PROC(vb, m0 + 4 * NGW)
        }
    }
    if (blockIdx.x == 0) {
        float* sm = (float*)(ws + WS_SM);
        { const float* a = p.in[I_LBF]; sm[SM_LBF + tid] = 1.f / (1.f + __expf(a[512 + tid] - a[tid])); }
        { const float* a = p.in[I_LBB]; sm[SM_LBB + tid] = 1.f / (1.f + __expf(a[512 + tid] - a[tid])); }
        if (tid < 64) {
            float a = p.in[I_LQ1][tid] * p.in[I_LK1][tid], b = p.in[I_LQ2][tid] * p.in[I_LK2][tid];
            a = wave_sum(a); b = wave_sum(b);
            if (tid == 0) sm[SM_LAM] = __expf(a) - __expf(b) + 0.2f;
        }
        for (int i = tid; i < 4 * 257; i += NTHREADS) { const int h = i / 257, r = i % 257; sm[SM_BT + h * BT_STRIDE + r] = p.in[I_RB][t5_bucket(r - 128) * 4 + h] * LOG2E; }
    }
}

__device__ __forceinline__ float silu_(float x) { return x * __builtin_amdgcn_rcpf(1.0f + __expf(-x)); }
struct EpiInProj {
    static constexpr bool PERM = true, AFTER_DRAIN = false;
    bf16_t* P; const float* sm;
    __device__ __forceinline__ void st8(bf16_t* dst, const float (&y)[8]) const { u32x4 w; w.x = pk2(y[0], y[1]); w.y = pk2(y[2], y[3]); w.z = pk2(y[4], y[5]); w.w = pk2(y[6], y[7]); *(u32x4*)dst = w; }
    __device__ __forceinline__ void operator()(const f32x4 (&acc)[2][2][4][2], const pg8::Unit& u, int wr, int wc, int fr, int fq) const {
        const int seg = u.pn >> 1;
        const int row0 = u.pm * 256 + wr * 64 + fr;
        const int cs0 = (u.pn & 1) * 256 + wc * 32 + 8 * fq;
#pragma unroll
        for (int bj = 0; bj < 2; ++bj) {
            const int cs = cs0 + bj * 128;
            float lb[8] = {0.f, 0.f, 0.f, 0.f, 0.f, 0.f, 0.f, 0.f};
            if (seg == 1 || seg == 2) {
#pragma unroll
                for (int i = 0; i < 8; ++i) lb[i] = sm[(seg == 1 ? SM_LBF : SM_LBB) + cs + i];
            }
#pragma unroll
            for (int ai = 0; ai < 2; ++ai)
#pragma unroll
                for (int m = 0; m < 4; ++m) {
                    const size_t row = (size_t)(row0 + ai * 128 + m * 16);
                    bf16_t* rp = P + row * PP + cs;
                    float x[8];
#pragma unroll
                    for (int i = 0; i < 4; ++i) { x[i] = acc[ai][bj][m][0][i]; x[4 + i] = acc[ai][bj][m][1][i]; }
                    float y[8];
                    if (seg == 0 || seg == 4) {
#pragma unroll
                        for (int i = 0; i < 8; ++i) y[i] = silu_(x[i]);
                        st8(rp + (seg == 0 ? C_Q : C_G), y);
                    } else if (seg == 1 || seg == 2) {
                        float lf[8];
#pragma unroll
                        for (int i = 0; i < 8; ++i) { const float s = sigmoidf_(x[i]); const float k = (1.f - lb[i]) * (1.f - s); y[i] = k; lf[i] = __logf(1.f - k); }
                        st8(rp + (seg == 1 ? C_KF : C_KB), y);
                        st8(rp + (seg == 1 ? C_LFF : C_LFB), lf);
                    } else if (seg == 3) {
                        st8(rp + C_V, x);
                    } else if (seg == 5) {
#pragma unroll
                        for (int i = 0; i < 8; ++i) y[i] = x[i] * (0.125f * LOG2E);
                        st8(rp + C_DQ, y);
                    } else {
                        st8(rp + C_DK, x);
                    }
                }
        }
    }
};
struct EpiStore {
    static constexpr bool PERM = true, AFTER_DRAIN = false;
    bf16_t* O; int ldc;
    __device__ __forceinline__ void operator()(const f32x4 (&acc)[2][2][4][2], const pg8::Unit& u, int wr, int wc, int fr, int fq) const {
        const int row0 = u.pm * 256 + wr * 64 + fr, col0 = u.pn * 256 + wc * 32 + 8 * fq;
#pragma unroll
        for (int ai = 0; ai < 2; ++ai)
#pragma unroll
            for (int m = 0; m < 4; ++m)
#pragma unroll
                for (int bj = 0; bj < 2; ++bj) {
                    const f32x4 a = acc[ai][bj][m][0], b = acc[ai][bj][m][1];
                    u32x4 w; w.x = pk2(a[0], a[1]); w.y = pk2(a[2], a[3]); w.z = pk2(b[0], b[1]); w.w = pk2(b[2], b[3]);
                    *(u32x4*)(O + (size_t)(row0 + ai * 128 + m * 16) * ldc + col0 + bj * 128) = w;
                }
    }
};
struct EpiOutProj {
    static constexpr bool PERM = true, AFTER_DRAIN = false;
    const float* x; float* H1; bf16_t* H1B; float* SS;
    __device__ __forceinline__ void operator()(const f32x4 (&acc)[2][2][4][2], const pg8::Unit& u, int wr, int wc, int fr, int fq) const {
        const int row0 = u.pm * 256 + wr * 64 + fr, col0 = u.pn * 256 + wc * 32 + 8 * fq;
#pragma unroll
        for (int ai = 0; ai < 2; ++ai)
#pragma unroll
            for (int m = 0; m < 4; ++m) {
                const size_t row = (size_t)(row0 + ai * 128 + m * 16);
                float ss = 0.f;
#pragma unroll
                for (int bj = 0; bj < 2; ++bj) {
                    const size_t off = row * D + col0 + bj * 128;
                    const f32x4 a = *(const f32x4*)(x + off) + acc[ai][bj][m][0], b = *(const f32x4*)(x + off + 4) + acc[ai][bj][m][1];
                    u32x4 w; w.x = pk2(a[0], a[1]); w.y = pk2(a[2], a[3]); w.z = pk2(b[0], b[1]); w.w = pk2(b[2], b[3]);
                    *(u32x4*)(H1B + off) = w;
                    ss += (a[0] * a[0] + a[1] * a[1]) + (a[2] * a[2] + a[3] * a[3]) + (b[0] * b[0] + b[1] * b[1]) + (b[2] * b[2] + b[3] * b[3]);
                }
                ss += __shfl_xor(ss, 16); ss += __shfl_xor(ss, 32);
                if (fq == 0) SS[row * 16 + u.pn * 4 + wc] = ss;
            }
    }
};
__device__ __forceinline__ float row_rstd(const float* SS, size_t row) {
    const f32x4* s = (const f32x4*)(SS + row * 16);
    const f32x4 a = s[0], b = s[1], c = s[2], d = s[3];
    const float t = ((a[0] + a[1]) + (a[2] + a[3])) + ((b[0] + b[1]) + (b[2] + b[3])) + ((c[0] + c[1]) + (c[2] + c[3])) + ((d[0] + d[1]) + (d[2] + d[3]));
    return rsqrtf(t * (1.f / D) + EPS);
}
struct EpiQ {
    static constexpr bool PERM = true, AFTER_DRAIN = false;
    bf16_t* O; const float* SS; float* RSTD;
    __device__ __forceinline__ void operator()(const f32x4 (&acc)[2][2][4][2], const pg8::Unit& u, int wr, int wc, int fr, int fq) const {
        const int row0 = u.pm * 256 + wr * 64 + fr, col0 = u.pn * 256 + wc * 32 + 8 * fq;
#pragma unroll
        for (int ai = 0; ai < 2; ++ai)
#pragma unroll
            for (int m = 0; m < 4; ++m) {
                const size_t row = (size_t)(row0 + ai * 128 + m * 16);
                const float rs = row_rstd(SS, row);
                if (u.pn == 0 && wc == 0 && fq == 0) RSTD[row] = rs;
#pragma unroll
                for (int bj = 0; bj < 2; ++bj) {
                    const f32x4 a = acc[ai][bj][m][0] * rs, b = acc[ai][bj][m][1] * rs;
                    u32x4 w; w.x = pk2(a[0], a[1]); w.y = pk2(a[2], a[3]); w.z = pk2(b[0], b[1]); w.w = pk2(b[2], b[3]);
                    *(u32x4*)(O + row * QPS + col0 + bj * 128) = w;
                }
            }
    }
};

constexpr int HQ_STRIDE = 272, HT_STRIDE = 48;
constexpr int H_QA = 0, H_KD = 4352, H_KH = 8704, H_VT = 14848, H_DEC = 20992, H_OPER = 21504, H_RAW = 2 * H_OPER, H_RAWB = 16384;
__device__ __forceinline__ void phase_hgrn(const Params& p, LAS unsigned char* lds, int G) {
    const int tid = threadIdx.x, lane = tid & 63, wave = __builtin_amdgcn_readfirstlane(tid >> 6), fr = lane & 15, g = lane >> 4;
    const bf16_t* PROJ = (const bf16_t*)(p.ws + WS_PROJ);
    const int NCH = SEQ / 16;
    for (int item = blockIdx.x; item < 128; item += G) {
        const int dir = item & 1, h = (item >> 1) & 3, b = item >> 3;
        bf16_t* O = (bf16_t*)p.out + (size_t)dir * T * 512;
        const int ck = dir ? C_KB : C_KF, cl = dir ? C_LFB : C_LFF;
        const bool isv = tid >= 256; const int arow = (tid & 255) >> 4, ac8 = (tid & 15) * 8;
        u32x4 rq = (u32x4){0u, 0u, 0u, 0u}, rk = rq, rl = rq;
#define HG_GLOAD(ch) do { const int pos_ = (ch) * 16 + arow, tr_ = dir ? SEQ - 1 - pos_ : pos_; \
            const bf16_t* rp_ = PROJ + (size_t)(b * SEQ + tr_) * PP + h * 128 + ac8; \
            if (isv) { rq = *(const u32x4*)(rp_ + C_V); } else { rq = *(const u32x4*)(rp_ + C_Q); rk = *(const u32x4*)(rp_ + ck); rl = *(const u32x4*)(rp_ + cl); } } while (0)
#define HG_RAWSTORE(par) do { LAS unsigned char* R_ = lds + H_RAW + (par) * H_RAWB + arow * 256 + ac8 * 2; \
            if (isv) { *(LAS u32x4*)(R_ + 12288) = rq; } else { *(LAS u32x4*)R_ = rq; *(LAS u32x4*)(R_ + 4096) = rk; *(LAS u32x4*)(R_ + 8192) = rl; } } while (0)
        const int pc = tid & 127, part = tid >> 7;
        auto phaseB = [&](int par) {
            const LAS unsigned char* R = lds + H_RAW + par * H_RAWB; LAS unsigned char* OP = lds + par * H_OPER;
            float pre = 0.f, total = 0.f;
#pragma unroll
            for (int t = 0; t < 16; ++t) { const float v = __uint_as_float((unsigned)(*(const LAS unsigned short*)(R + 8192 + t * 256 + pc * 2)) << 16); total += v; pre += (t < 4 * part) ? v : 0.f; }
            float bb = pre; float kh[4], vv[4];
#pragma unroll
            for (int j = 0; j < 4; ++j) {
                const int t = 4 * part + j;
                const float lfv = __uint_as_float((unsigned)(*(const LAS unsigned short*)(R + 8192 + t * 256 + pc * 2)) << 16);
                const float qv = __uint_as_float((unsigned)(*(const LAS unsigned short*)(R + t * 256 + pc * 2)) << 16);
                const float kv = __uint_as_float((unsigned)(*(const LAS unsigned short*)(R + 4096 + t * 256 + pc * 2)) << 16);
                vv[j] = __uint_as_float((unsigned)(*(const LAS unsigned short*)(R + 12288 + t * 256 + pc * 2)) << 16);
                bb += lfv;
                *(LAS unsigned short*)(OP + H_QA + t * HQ_STRIDE + pc * 2) = (unsigned short)f2bf(qv * __expf(bb));
                *(LAS unsigned short*)(OP + H_KD + t * HQ_STRIDE + pc * 2) = (unsigned short)f2bf(kv * __expf(-bb));
                kh[j] = kv * __expf(total - bb);
            }
            *(LAS u32x2*)(OP + H_KH + pc * HT_STRIDE + part * 8) = (u32x2){pk2(kh[0], kh[1]), pk2(kh[2], kh[3])};
            *(LAS u32x2*)(OP + H_VT + pc * HT_STRIDE + part * 8) = (u32x2){pk2(vv[0], vv[1]), pk2(vv[2], vv[3])};
            if (part == 0) *(LAS float*)(OP + H_DEC + pc * 4) = __expf(total);
        };
        f32x4 S[8];
#pragma unroll
        for (int kt = 0; kt < 8; ++kt) S[kt] = (f32x4){0.f, 0.f, 0.f, 0.f};
        __syncthreads();
        HG_GLOAD(0); HG_RAWSTORE(0); HG_GLOAD(1);
        __syncthreads();
        phaseB(0); HG_RAWSTORE(1);
        __syncthreads();
        for (int i = 0; i < NCH; ++i) {
            if (i + 2 < NCH) HG_GLOAD(i + 2);
            if (i + 1 < NCH) phaseB((i + 1) & 1);
            {
                const LAS unsigned char* OP = lds + (i & 1) * H_OPER;
                f32x4 o = (f32x4){0.f, 0.f, 0.f, 0.f};
#pragma unroll
                for (int j = 0; j < 4; ++j) {
                    u32x4 w; w.x = pk2(S[2 * j][0], S[2 * j][1]); w.y = pk2(S[2 * j][2], S[2 * j][3]); w.z = pk2(S[2 * j + 1][0], S[2 * j + 1][1]); w.w = pk2(S[2 * j + 1][2], S[2 * j + 1][3]);
                    const u32x2 a0 = *(const LAS u32x2*)(OP + H_QA + fr * HQ_STRIDE + (32 * j + 4 * g) * 2), a1 = *(const LAS u32x2*)(OP + H_QA + fr * HQ_STRIDE + (32 * j + 16 + 4 * g) * 2);
                    o = __builtin_amdgcn_mfma_f32_16x16x32_bf16(__builtin_bit_cast(bf16x8, (u32x4){a0.x, a0.y, a1.x, a1.y}), __builtin_bit_cast(bf16x8, w), o, 0, 0, 0);
                }
                f32x4 X = (f32x4){0.f, 0.f, 0.f, 0.f};
#pragma unroll
                for (int j = 0; j < 4; ++j) {
                    const bf16x8 ak = *(const LAS bf16x8*)(OP + H_KD + fr * HQ_STRIDE + (32 * j + 8 * g) * 2), bq = *(const LAS bf16x8*)(OP + H_QA + fr * HQ_STRIDE + (32 * j + 8 * g) * 2);
                    X = __builtin_amdgcn_mfma_f32_16x16x32_bf16(ak, bq, X, 0, 0, 0);
                }
#pragma unroll
                for (int r = 0; r < 4; ++r) X[r] = (4 * g + r > fr) ? 0.f : X[r];
                const u32x2 vlo = *(const LAS u32x2*)(OP + H_VT + (16 * wave + fr) * HT_STRIDE + g * 8);
                const bf16x8 vb = __builtin_bit_cast(bf16x8, (u32x4){vlo.x, vlo.y, 0u, 0u});
                const bf16x8 pa = __builtin_bit_cast(bf16x8, (u32x4){pk2(X[0], X[1]), pk2(X[2], X[3]), 0u, 0u});
                o = __builtin_amdgcn_mfma_f32_16x16x32_bf16(pa, vb, o, 0, 0, 0);
#pragma unroll
                for (int r = 0; r < 4; ++r) { const int pos = i * 16 + 4 * g + r, tr = dir ? SEQ - 1 - pos : pos; O[(size_t)(b * SEQ + tr) * 512 + h * 128 + 16 * wave + fr] = (bf16_t)f2bf(o[r]); }
#pragma unroll
                for (int kt = 0; kt < 8; ++kt) {
                    const f32x4 dc = *(const LAS f32x4*)(OP + H_DEC + (16 * kt + 4 * g) * 4);
                    const u32x2 klo = *(const LAS u32x2*)(OP + H_KH + (16 * kt + fr) * HT_STRIDE + g * 8);
                    S[kt] = __builtin_amdgcn_mfma_f32_16x16x32_bf16(__builtin_bit_cast(bf16x8, (u32x4){klo.x, klo.y, 0u, 0u}), vb, S[kt] * dc, 0, 0, 0);
                }
            }
            if (i + 2 < NCH) HG_RAWSTORE(i & 1);
            __syncthreads();
        }
    }
}

constexpr int KT_STRIDE = 272, VT_STRIDE = 144;
constexpr int ATT_BUF = 64 * KT_STRIDE + 128 * VT_STRIDE;
constexpr int QUANT_ITEMS = 256;
__device__ __forceinline__ void quant_tables(const Params& p, int gw, int NGW, int lane) {
    unsigned char* ws = p.ws;
#define PQ_LOAD(dst, r0_) { _Pragma("unroll") for (int u = 0; u < 4; ++u) { const int r = ((r0_) + u * NGW) < 2 * 16384 ? ((r0_) + u * NGW) : gw; const bool isv = r >= 16384; const int e = isv ? r - 16384 : r; \
            const f32x4* xr = (const f32x4*)((isv ? p.in[I_V] : p.in[I_U]) + (size_t)e * D) + lane; _Pragma("unroll") for (int j = 0; j < 4; ++j) dst[u][j] = xr[64 * j]; } }
#define PQ_PROC(src, r0_) { _Pragma("unroll") for (int u = 0; u < 4; ++u) { const int r = (r0_) + u * NGW; if (r < 2 * 16384) { \
            const bool isv = r >= 16384; const int e = isv ? r - 16384 : r; f32x4 v[4]; float am = 0.f; \
            _Pragma("unroll") for (int j = 0; j < 4; ++j) { v[j] = src[u][j]; if (!isv) v[j] = v[j] * ((const f32x4*)p.in[I_G2])[64 * j + lane]; \
                am = fmaxf(am, fmaxf(fmaxf(fabsf(v[j].x), fabsf(v[j].y)), fmaxf(fabsf(v[j].z), fabsf(v[j].w)))); } \
            am = wave_max(am); const float sc = am > 0.f ? am * (1.f / 7.f) : 1.f, inv = 1.f / sc; unsigned pk[4]; int qs = 0; \
            _Pragma("unroll") for (int j = 0; j < 4; ++j) { \
                const int q0 = (int)rintf(v[j].x * inv), q1 = (int)rintf(v[j].y * inv), q2 = (int)rintf(v[j].z * inv), q3 = (int)rintf(v[j].w * inv); qs += (q0 + q1) + (q2 + q3); \
                pk[j] = (unsigned)((q0 & 0xFF) | ((q1 & 0xFF) << 8) | ((q2 & 0xFF) << 16) | ((q3 & 0xFF) << 24)); } \
            if (isv) {   \
                _Pragma("unroll") for (int j = 0; j < 4; ++j) { const unsigned k_ = pk[j]; \
                    *(unsigned short*)(ws + WS_VE + ((size_t)j * 16384 + e) * VSL + 2 * lane) = (unsigned short)(((k_ & 0xFu) ^ 8u) | ((k_ >> 4) & 0xF0u) | ((((k_ >> 16) & 0xFu) ^ 8u) << 8) | ((k_ >> 12) & 0xF000u)); } \
                if (lane == 0) ((float*)(ws + WS_VSC))[e] = sc; } \
            else {   \
                _Pragma("unroll") for (int j = 0; j < 2; ++j) *(unsigned*)(ws + WS_UT + (size_t)e * 512 + 256 * j + 4 * lane) = (pk[j] & 0x0F0F0F0Fu) | ((pk[j + 2] << 4) & 0xF0F0F0F0u); \
                const float qt = wave_sum((float)qs); if (lane == 0) { ((float*)(ws + WS_USC))[e] = sc; ((float*)(ws + WS_US8))[e] = 8.f * qt; } } } } }
    for (int r0 = gw; r0 < 2 * 16384; r0 += 4 * NGW) { f32x4 va[4][4]; PQ_LOAD(va, r0) PQ_PROC(va, r0) }
}
__device__ __forceinline__ void phase_attn(const Params& p, LAS unsigned char* lds, int G) {
    const int tid = threadIdx.x, lane = tid & 63, wave = __builtin_amdgcn_readfirstlane(tid >> 6), fr = lane & 15, fq = lane >> 4;
    const bf16_t* PROJ = (const bf16_t*)(p.ws + WS_PROJ);
    const bf16_t* VT = (const bf16_t*)(p.ws + WS_VT);
    bf16_t* MIXED = (bf16_t*)(p.ws + WS_XN);
    const float* sm = (const float*)(p.ws + WS_SM);
    LAS unsigned char* LK = lds; LAS unsigned char* LV = lds + 64 * KT_STRIDE; LAS float* LB = (LAS float*)(lds + 2 * ATT_BUF);
    const float lam = sm[SM_LAM];
    unsigned* qctr = (unsigned*)(p.ws + 32768);
    volatile LAS unsigned* qslot = (volatile LAS unsigned*)(lds + 131072 + 320 + 64);
    for (;;) {
        __syncthreads();
        if (tid == 0) qslot[0] = __hip_atomic_fetch_add(qctr, 1u, __ATOMIC_RELAXED, __HIP_MEMORY_SCOPE_AGENT);
        __syncthreads();
        const int item = (int)qslot[0];
        if (item >= 1024 + QUANT_ITEMS) break;
        if (item >= 1024) { quant_tables(p, (item - 1024) * NWAVES + wave, QUANT_ITEMS * NWAVES, lane); continue; }
        const int bh = item >> 4, qb = item & 15, b = bh >> 2, h = bh & 3;
        const int qabs = qb * 128 + wave * 16 + fr;
        const size_t qrow = (size_t)b * SEQ + qabs;
        __syncthreads();
        for (int i = tid; i < 257; i += NTHREADS) LB[i] = sm[SM_BT + h * BT_STRIDE + i];
        bf16x8 qf[2][2];
#pragma unroll
        for (int m = 0; m < 2; ++m)
#pragma unroll
            for (int kk = 0; kk < 2; ++kk) qf[m][kk] = *(const bf16x8*)(PROJ + qrow * PP + C_DQ + h * 128 + m * 64 + kk * 32 + fq * 8);
        float mrun[2] = {0.f, 0.f};
        f32x4 lacc[2] = {(f32x4){0.f, 0.f, 0.f, 0.f}, (f32x4){0.f, 0.f, 0.f, 0.f}};
        f32x4 o[2][8];
#pragma unroll
        for (int m = 0; m < 2; ++m)
#pragma unroll
            for (int dt = 0; dt < 8; ++dt) o[m][dt] = (f32x4){0.f, 0.f, 0.f, 0.f};
        u32x4 kreg[2], vreg[2];
        const bf16_t* kg[2]; const bf16_t* vg[2]; int koff[2], voff[2];
#pragma unroll
        for (int i = 0; i < 2; ++i) { const int c = tid + i * 512;
            const int kr = c >> 4, kc = (c & 15) * 8; kg[i] = PROJ + ((size_t)b * SEQ + kr) * PP + C_DK + h * 128 + kc; koff[i] = kr * KT_STRIDE + kc * 2;
            const int vr = c >> 3, vc = (c & 7) * 8; vg[i] = VT + (size_t)(h * 128 + vr) * T + (size_t)b * SEQ + vc; voff[i] = vr * VT_STRIDE + vc * 2; }
#pragma unroll
        for (int i = 0; i < 2; ++i) { kreg[i] = *(const u32x4*)kg[i]; vreg[i] = *(const u32x4*)vg[i]; }
#pragma unroll
        for (int i = 0; i < 2; ++i) { *(LAS u32x4*)(LK + koff[i]) = kreg[i]; *(LAS u32x4*)(LV + voff[i]) = vreg[i]; }
        __syncthreads();
        const int Qw = qb * 128 + wave * 16;
        for (int kt = 0; kt < SEQ / 64; ++kt) {
            const int pbuf = (kt & 1) * ATT_BUF;
            if (kt + 1 < SEQ / 64) {
#pragma unroll
                for (int i = 0; i < 2; ++i) { kreg[i] = *(const u32x4*)(kg[i] + (size_t)(kt + 1) * 64 * PP); vreg[i] = *(const u32x4*)(vg[i] + (kt + 1) * 64); }
            }
            const int k0 = kt * 64;
            const bool farl = (k0 + 63 - Qw) <= -91, farr = (k0 - (Qw + 15)) >= 91;
            const float binit = farl ? LB[0] : (farr ? LB[256] : 0.f);
            f32x4 s[2][4];
#pragma unroll
            for (int m = 0; m < 2; ++m) {
                const float ci = binit - mrun[m];
#pragma unroll
                for (int ks = 0; ks < 4; ++ks) {
                    f32x4 a = (f32x4){ci, ci, ci, ci};
#pragma unroll
                    for (int kk = 0; kk < 2; ++kk) {
                        const bf16x8 kf = *(const LAS bf16x8*)(LK + pbuf + (16 * ks + fr) * KT_STRIDE + (m * 64 + kk * 32 + fq * 8) * 2);
                        a = __builtin_amdgcn_mfma_f32_16x16x32_bf16(kf, qf[m][kk], a, 0, 0, 0);
                    }
                    s[m][ks] = a;
                }
            }
            if (!(farl || farr)) {
#pragma unroll
                for (int ks = 0; ks < 4; ++ks)
#pragma unroll
                    for (int r = 0; r < 4; ++r) {
                        int rel = k0 + 16 * ks + 4 * fq + r - qabs; rel = rel < -128 ? -128 : (rel > 128 ? 128 : rel);
                        const float bv = LB[rel + 128];
                        s[0][ks][r] += bv; s[1][ks][r] += bv;
                    }
            }
            bf16x8 pb[2][2];
#pragma unroll
            for (int m = 0; m < 2; ++m) {
#define MX2(a_, b_) __builtin_amdgcn_fmed3f((a_), (b_), __builtin_inff())
                float mx = MX2(MX2(s[m][0][0], s[m][0][1]), MX2(s[m][0][2], s[m][0][3]));
#pragma unroll
                for (int ks = 1; ks < 4; ++ks) mx = MX2(mx, MX2(MX2(s[m][ks][0], s[m][ks][1]), MX2(s[m][ks][2], s[m][ks][3])));
                { float a_ = mx, b_ = mx; swap16_(a_, b_); mx = MX2(a_, b_); }
                { float a_ = mx, b_ = mx; swap32_(a_, b_); mx = MX2(a_, b_); }
#undef MX2
                if (__any(fabsf(mx) > 8.0f)) {
                    const float dl = fabsf(mx) > 8.0f ? mx : 0.f, alpha = __builtin_amdgcn_exp2f(-dl);
                    mrun[m] += dl; lacc[m] *= alpha;
#pragma unroll
                    for (int ks = 0; ks < 4; ++ks) s[m][ks] = s[m][ks] - dl;
#pragma unroll
                    for (int dt = 0; dt < 8; ++dt) o[m][dt] *= alpha;
                }
#pragma unroll
                for (int ks = 0; ks < 4; ++ks)
#pragma unroll
                    for (int r = 0; r < 4; ++r) s[m][ks][r] = __builtin_amdgcn_exp2f(s[m][ks][r]);
#pragma unroll
                for (int k2 = 0; k2 < 2; ++k2) {
                    u32x4 w; w.x = pk2(s[m][2 * k2][0], s[m][2 * k2][1]); w.y = pk2(s[m][2 * k2][2], s[m][2 * k2][3]);
                    w.z = pk2(s[m][2 * k2 + 1][0], s[m][2 * k2 + 1][1]); w.w = pk2(s[m][2 * k2 + 1][2], s[m][2 * k2 + 1][3]);
                    pb[m][k2] = __builtin_bit_cast(bf16x8, w);
                }
            }
            const bf16x8 ones = __builtin_bit_cast(bf16x8, (u32x4){0x3F803F80u, 0x3F803F80u, 0x3F803F80u, 0x3F803F80u});
#pragma unroll
            for (int k2 = 0; k2 < 2; ++k2) {
                lacc[0] = __builtin_amdgcn_mfma_f32_16x16x32_bf16(ones, pb[0][k2], lacc[0], 0, 0, 0);
                lacc[1] = __builtin_amdgcn_mfma_f32_16x16x32_bf16(ones, pb[1][k2], lacc[1], 0, 0, 0);
#pragma unroll
                for (int dt = 0; dt < 8; ++dt) {
                    const u32x2 lo = *(const LAS u32x2*)(LV + pbuf + (16 * dt + fr) * VT_STRIDE + (32 * k2 + 4 * fq) * 2);
                    const u32x2 hi = *(const LAS u32x2*)(LV + pbuf + (16 * dt + fr) * VT_STRIDE + (32 * k2 + 16 + 4 * fq) * 2);
                    const bf16x8 vf = __builtin_bit_cast(bf16x8, (u32x4){lo.x, lo.y, hi.x, hi.y});
                    o[0][dt] = __builtin_amdgcn_mfma_f32_16x16x32_bf16(vf, pb[0][k2], o[0][dt], 0, 0, 0);
                    o[1][dt] = __builtin_amdgcn_mfma_f32_16x16x32_bf16(vf, pb[1][k2], o[1][dt], 0, 0, 0);
                }
            }
            if (kt + 1 < SEQ / 64) {
                const int nbuf = ((kt + 1) & 1) * ATT_BUF;
#pragma unroll
                for (int i = 0; i < 2; ++i) { *(LAS u32x4*)(LK + nbuf + koff[i]) = kreg[i]; *(LAS u32x4*)(LV + nbuf + voff[i]) = vreg[i]; }
            }
            __syncthreads();
        }
        float inv[2];
#pragma unroll
        for (int m = 0; m < 2; ++m) inv[m] = __builtin_amdgcn_rcpf(lacc[m][0]);
        float ssq = 0.f;
#pragma unroll
        for (int dt = 0; dt < 8; ++dt)
#pragma unroll
            for (int r = 0; r < 4; ++r) { const float ov = o[0][dt][r] * inv[0] - lam * (o[1][dt][r] * inv[1]); o[0][dt][r] = ov; ssq += ov * ov; }
        ssq += __shfl_xor(ssq, 16); ssq += __shfl_xor(ssq, 32);
        const float rs = rsqrtf(ssq * (1.f / 128.f) + EPS) * 0.8f;
        const float* og = p.in[I_DOG];
#pragma unroll
        for (int dt = 0; dt < 8; ++dt) {
            const f32x4 g = *(const f32x4*)(og + 16 * dt + 4 * fq);
            const f32x4 y = o[0][dt] * rs * g;
            *(u32x2*)(MIXED + qrow * D + 512 + h * 128 + 16 * dt + 4 * fq) = (u32x2){pk2(y[0], y[1]), pk2(y[2], y[3])};
        }
    }
}

__device__ __forceinline__ void phase_mix(const Params& p, int vcu, int G) {
    const int tid = threadIdx.x, lane = tid & 63, wave = __builtin_amdgcn_readfirstlane(tid >> 6);
    const bf16_t* PROJ = (const bf16_t*)(p.ws + WS_PROJ);
    const bf16_t* OF = (const bf16_t*)p.out; const bf16_t* OB = OF + (size_t)T * 512;
    bf16_t* MIXED = (bf16_t*)(p.ws + WS_XN);
    const float* hog = p.in[I_HOG];
    const f32x4 g0 = *(const f32x4*)(hog + (lane & 15) * 8), g1 = *(const f32x4*)(hog + (lane & 15) * 8 + 4);
    for (int m0 = vcu * NWAVES + wave; m0 < T; m0 += 4 * G * NWAVES) {
        u32x4 av[4], bv[4], gv[4];
#pragma unroll
        for (int u = 0; u < 4; ++u) { const int m = (m0 + u * G * NWAVES) < T ? (m0 + u * G * NWAVES) : m0;
            av[u] = *(const u32x4*)(OF + (size_t)m * 512 + 8 * lane); bv[u] = *(const u32x4*)(OB + (size_t)m * 512 + 8 * lane); gv[u] = *(const u32x4*)(PROJ + (size_t)m * PP + C_G + 8 * lane); }
#pragma unroll
        for (int u = 0; u < 4; ++u) {
            const int m = m0 + u * G * NWAVES; if (m >= T) break;
            const u32x4 a = av[u], bb = bv[u], gg = gv[u];
            float o[8]; float ss = 0.f;
#pragma unroll
            for (int i = 0; i < 4; ++i) { o[2 * i] = bflo(a[i]) + bflo(bb[i]); o[2 * i + 1] = bfhi(a[i]) + bfhi(bb[i]); ss += o[2 * i] * o[2 * i] + o[2 * i + 1] * o[2 * i + 1]; }
            ss += dpp_mov<0xB1>(ss); ss += dpp_mov<0x4E>(ss); ss += dpp_mov<0x141>(ss); ss += dpp_mov<0x140>(ss);
            const float rs = rsqrtf(ss * (1.f / 128.f) + EPS);
            float y[8];
#pragma unroll
            for (int i = 0; i < 4; ++i) { y[2 * i] = o[2 * i] * rs * (i < 2 ? g0[2 * i] : g1[2 * i - 4]) * bflo(gg[i]); y[2 * i + 1] = o[2 * i + 1] * rs * (i < 2 ? g0[2 * i + 1] : g1[2 * i - 3]) * bfhi(gg[i]); }
            *(u32x4*)(MIXED + (size_t)m * D + 8 * lane) = (u32x4){pk2(y[0], y[1]), pk2(y[2], y[3]), pk2(y[4], y[5]), pk2(y[6], y[7])};
        }
    }
}

__device__ __forceinline__ void phase_hquant(const Params& p, int vcu, int G) {
    const int tid = threadIdx.x, lane = tid & 63, wave = __builtin_amdgcn_readfirstlane(tid >> 6);
    const bf16_t* H1B = (const bf16_t*)(p.ws + WS_H1B); const float* SS = (const float*)(p.ws + WS_SS);
    for (int t0 = vcu * NWAVES + wave; t0 < T; t0 += 4 * G * NWAVES) {
        u32x4 ha[4], hb[4];
#pragma unroll
        for (int u = 0; u < 4; ++u) { const int t = (t0 + u * G * NWAVES) < T ? (t0 + u * G * NWAVES) : t0; ha[u] = *(const u32x4*)(H1B + (size_t)t * D + 8 * lane); hb[u] = *(const u32x4*)(H1B + (size_t)t * D + 512 + 8 * lane); }
#pragma unroll
        for (int u = 0; u < 4; ++u) {
            const int t = t0 + u * G * NWAVES; if (t >= T) break;
            const u32x4 h0 = ha[u], h1 = hb[u];
            float hf[16]; float am = 0.f;
#pragma unroll
            for (int k = 0; k < 4; ++k) { hf[2 * k] = bflo(h0[k]); hf[2 * k + 1] = bfhi(h0[k]); hf[8 + 2 * k] = bflo(h1[k]); hf[8 + 2 * k + 1] = bfhi(h1[k]); }
#pragma unroll
            for (int k = 0; k < 16; ++k) am = fmaxf(am, fabsf(hf[k]));
            am = wave_max(am);
            const float iv = am > 0.f ? 127.f / am : 0.f;
            u32x4 q;
#pragma unroll
            for (int w = 0; w < 4; ++w) { const int q0 = (int)rintf(hf[4 * w] * iv), q1 = (int)rintf(hf[4 * w + 1] * iv), q2 = (int)rintf(hf[4 * w + 2] * iv), q3 = (int)rintf(hf[4 * w + 3] * iv);
                q[w] = (unsigned)((q0 & 0xFF) | ((q1 & 0xFF) << 8) | ((q2 & 0xFF) << 16) | ((q3 & 0xFF) << 24)); }
            u32x2 ph, pl;
#pragma unroll
            for (int w = 0; w < 2; ++w) { ph[w] = ((q[w] >> 4) & 0x0F0F0F0Fu) | (q[2 + w] & 0xF0F0F0F0u); pl[w] = ((q[w] & 0x0F0F0F0Fu) | ((q[2 + w] << 4) & 0xF0F0F0F0u)) ^ 0x88888888u; }
            *(u32x2*)(p.ws + WS_H1Q + (size_t)t * D + 8 * lane) = ph; *(u32x2*)(p.ws + WS_H1Q + (size_t)t * D + 512 + 8 * lane) = pl;
            if (lane == 0) ((float*)(p.ws + WS_HSC))[t] = am * (1.f / 127.f) * row_rstd(SS, (size_t)t);
        }
    }
}
__device__ __forceinline__ unsigned ford(float f) { const unsigned u = __float_as_uint(f); return (u & 0x80000000u) ? ~u : (u | 0x80000000u); }
__device__ __forceinline__ float funord(unsigned u) { u = (u & 0x80000000u) ? (u & 0x7fffffffu) : ~u; return __uint_as_float(u); }
template <int N> __device__ __forceinline__ void bitonic_sort_desc(unsigned (&v)[N]) {
#pragma unroll
    for (int k = 2; k <= N; k <<= 1)
#pragma unroll
        for (int j = k >> 1; j > 0; j >>= 1)
#pragma unroll
            for (int i = 0; i < N; ++i) { const int l = i ^ j;
                if (l > i) { const unsigned a = v[i], b = v[l]; const unsigned mx = a > b ? a : b, mn = a > b ? b : a; if ((i & k) == 0) { v[i] = mx; v[l] = mn; } else { v[i] = mn; v[l] = mx; } } }
}
__device__ __forceinline__ void merge_top16(unsigned (&a)[16], const unsigned (&b)[16]) {
#pragma unroll
    for (int i = 0; i < 16; ++i) a[i] = a[i] > b[15 - i] ? a[i] : b[15 - i];
#pragma unroll
    for (int j = 8; j > 0; j >>= 1)
#pragma unroll
        for (int i = 0; i < 16; ++i) { const int l = i ^ j; if (l > i) { const unsigned x = a[i], y = a[l]; a[i] = x > y ? x : y; a[l] = x > y ? y : x; } }
}
__device__ __forceinline__ void top16_of64(const unsigned (&v)[64], unsigned (&out)[16]) {
    unsigned g1[16], g2[16], g3[16];
#pragma unroll
    for (int i = 0; i < 16; ++i) { out[i] = v[i]; g1[i] = v[16 + i]; g2[i] = v[32 + i]; g3[i] = v[48 + i]; }
    bitonic_sort_desc<16>(out); bitonic_sort_desc<16>(g1); bitonic_sort_desc<16>(g2); bitonic_sort_desc<16>(g3);
    merge_top16(out, g1); merge_top16(g2, g3); merge_top16(out, g2);
}
__device__ __forceinline__ unsigned xchg32u(unsigned v, int lane) { return __builtin_bit_cast(unsigned, xchg32(__builtin_bit_cast(float, v), lane)); }
constexpr int TK_KROW = 272, TK_TAB = 256 * TK_KROW;
__device__ __forceinline__ void phase_topk(const Params& p, LAS unsigned char* lds, int vcu, int G) {
    const int tid = threadIdx.x, lane = tid & 63, wave = __builtin_amdgcn_readfirstlane(tid >> 6), r32 = lane & 31, hi = lane >> 5;
    const bf16_t* QP = (const bf16_t*)(p.ws + WS_QP);
    const bf16_t* KEYS = (const bf16_t*)(p.ws + WS_KEYS);
    int* IDX = (int*)(p.ws + WS_IDX);
    LAS unsigned* tab = (LAS unsigned*)(lds + TK_TAB) + wave * 8 * 64 + lane;
    for (int item = blockIdx.x; item < (T / 256) * 2; item += G) {
        const int tg = item % (T / 256), hg = item / (T / 256);
        const size_t tok = (size_t)(tg * 8 + wave) * 32 + r32;
        for (int hh = 0; hh < 4; ++hh) {
            const int h = hg * 4 + hh;
            __syncthreads();
#pragma unroll
            for (int c8 = 0; c8 < 8; ++c8) { const int c = tid + c8 * NTHREADS, row = c >> 4, ch = c & 15;
                *(LAS u32x4*)(lds + row * TK_KROW + ch * 16) = *(const u32x4*)(KEYS + (size_t)(h * 256 + row) * 128 + ch * 8); }
            __syncthreads();
            unsigned lst[2][16];
#pragma unroll
            for (int pp = 0; pp < 2; ++pp) {
                f32x16 acc[4];
#pragma unroll
                for (int kt = 0; kt < 4; ++kt)
#pragma unroll
                    for (int r = 0; r < 16; ++r) acc[kt][r] = 0.f;
                const bf16_t* qrow = QP + tok * QPS + h * 256 + pp * 128 + 8 * hi;
                const LAS unsigned char* kb = lds + (pp * 128 + r32) * TK_KROW + 16 * hi;
#pragma unroll
                for (int s2 = 0; s2 < 8; ++s2) {
                    const bf16x8 bq = *(const bf16x8*)(qrow + 16 * s2);
#pragma unroll
                    for (int kt = 0; kt < 4; ++kt) {
                        const bf16x8 ak = *(const LAS bf16x8*)(kb + kt * 32 * TK_KROW + 32 * s2);
                        acc[kt] = __builtin_amdgcn_mfma_f32_32x32x16_bf16(ak, bq, acc[kt], 0, 0, 0);
                    }
                }
                unsigned v[64];
#pragma unroll
                for (int kt = 0; kt < 4; ++kt)
#pragma unroll
                    for (int r = 0; r < 16; ++r) { const int n = 32 * kt + (r & 3) + 8 * (r >> 2) + 4 * hi; v[kt * 16 + r] = (ford(acc[kt][r]) & ~0x7Fu) | (unsigned)(127 - n); }
                unsigned own[16], oth[16];
                top16_of64(v, own);
#pragma unroll
                for (int j = 0; j < 16; ++j) oth[j] = xchg32u(own[j], lane);
                merge_top16(own, oth);
#pragma unroll
                for (int j = 0; j < 16; ++j) lst[pp][j] = own[j];
            }
            float a[16], bs[16];
#pragma unroll
            for (int j = 0; j < 16; ++j) { a[j] = funord(lst[0][j] & ~0x7Fu); bs[j] = funord(lst[1][j] & ~0x7Fu); }
#pragma unroll
            for (int m = 0; m < 4; ++m) {
                tab[m * 64] = (127u - (lst[0][4 * m] & 0x7Fu)) | ((127u - (lst[0][4 * m + 1] & 0x7Fu)) << 8) | ((127u - (lst[0][4 * m + 2] & 0x7Fu)) << 16) | ((127u - (lst[0][4 * m + 3] & 0x7Fu)) << 24);
                tab[(4 + m) * 64] = (127u - (lst[1][4 * m] & 0x7Fu)) | ((127u - (lst[1][4 * m + 1] & 0x7Fu)) << 8) | ((127u - (lst[1][4 * m + 2] & 0x7Fu)) << 16) | ((127u - (lst[1][4 * m + 3] & 0x7Fu)) << 24);
            }
            unsigned cand[64];
            {
                int c = 0;
#pragma unroll
                for (int i = 0; i < 16; ++i)
#pragma unroll
                    for (int j = 0; j < 16; ++j)
                        if ((i + 1) * (j + 1) <= 16) { cand[c] = (ford(a[i] + bs[j]) & ~0xFFu) | (unsigned)(255 - (i * 16 + j)); ++c; }
#pragma unroll
                for (int q = 50; q < 64; ++q) cand[q] = 0u;
            }
            unsigned best[16], eidx[16];
            top16_of64(cand, best);
            LDS_WAIT();
#pragma unroll
            for (int r = 0; r < 16; ++r) { const unsigned code = 255u - (best[r] & 0xFFu), ci = code >> 4, cj = code & 15u;
                const unsigned wi = tab[(ci >> 2) * 64], wj = tab[(4 + (cj >> 2)) * 64];
                eidx[r] = ((wi >> (8 * (ci & 3u))) & 0x7Fu) * 128u + ((wj >> (8 * (cj & 3u))) & 0x7Fu); }
            LDS_WAIT();
            if (hi == 0) {
                float g[16]; const float mx = funord(best[0] & ~0xFFu); float tot = 0.f;
#pragma unroll
                for (int r = 0; r < 16; ++r) { g[r] = __expf(funord(best[r] & ~0xFFu) - mx); tot += g[r]; }
                const float it_ = 1.f / tot;
                unsigned* rp = (unsigned*)IDX + (tok * 8 + h) * 16;
#pragma unroll
                for (int q4 = 0; q4 < 4; ++q4)
                    *(u32x4*)(rp + 4 * q4) = (u32x4){eidx[4 * q4] | (f2bf(g[4 * q4] * it_) << 16), eidx[4 * q4 + 1] | (f2bf(g[4 * q4 + 1] * it_) << 16), eidx[4 * q4 + 2] | (f2bf(g[4 * q4 + 2] * it_) << 16), eidx[4 * q4 + 3] | (f2bf(g[4 * q4 + 3] * it_) << 16)};
            }
        }
    }
}

typedef float f32x2_ __attribute__((ext_vector_type(2)));
__device__ __forceinline__ float gelu_exact(float v) {
    const float av = fabsf(v), t = __builtin_amdgcn_rcpf(av * 0.2316418882f + 1.0f);
    float q = t * 0.5307027145f + (-0.7265760135f); q = q * t + 0.7107068705f; q = q * t + (-0.142248368f); q = q * t + 0.127414796f; q = q * t;
    const float e = __builtin_amdgcn_exp2f((v * v) * (-0.72134752044f));
    const float m = v * (q * e);
    return v < 0.f ? m : v - m;
}
typedef float f32x2_ __attribute__((ext_vector_type(2)));
__device__ __forceinline__ void phase_peer_u(const Params& p, LAS unsigned char* lds, int G, int mx, int mj) {
    const int tid = threadIdx.x, lane = tid & 63, wave = __builtin_amdgcn_readfirstlane(tid >> 6), bx = blockIdx.x;
    const bool xl = (G % 8 == 0);
    const int x = xl ? mx : 0, nx = xl ? 8 : 1, jb = xl ? mj : bx, nw = (xl ? G / 8 : G) * NWAVES, widx = jb * NWAVES + wave;
    const unsigned char* H1Q = (const unsigned char*)(p.ws + WS_H1Q); const unsigned char* UQ = (const unsigned char*)(p.ws + WS_UT);
    const unsigned* REC = (const unsigned*)(p.ws + WS_IDX); const float* HSC = (const float*)(p.ws + WS_HSC);
    const float* USC = (const float*)(p.ws + WS_USC); const float* VSC = (const float*)(p.ws + WS_VSC);
    unsigned* CI = (unsigned*)(p.ws + WS_C);
    LAS float* SU = (LAS float*)lds; LAS float* SV = SU + GRP_SIZE; LAS float* U8 = (LAS float*)(lds + 49152);
    LAS u32x2* slots = (LAS u32x2*)(lds + 16384 + wave * 2048);
    LAS u32x4* hbuf = (LAS u32x4*)(lds + 32768 + wave * 2048);
    const int K = (T - widx + nw - 1) / nw;
    const int lrow = lane >> 4, lcol = lane & 15, lc16 = 16 * lcol;
    for (int g = x; g < NGRP; g += nx) {
        __syncthreads();
        for (int i = tid; i < GRP_SIZE; i += NTHREADS) { SU[i] = USC[g * GRP_SIZE + i]; SV[i] = VSC[g * GRP_SIZE + i]; U8[i] = ((const float*)(p.ws + WS_US8))[g * GRP_SIZE + i]; }
        __syncthreads();
#define PU_R(S, k_) { const int kk_ = (k_) < K ? (k_) : K - 1; const size_t tt_ = (size_t)(widx + nw * kk_); \
            rq##S = *(const u32x2*)(REC + tt_ * 128 + 2 * lane); rr##S = HSC[tt_]; hr##S = *(const u32x4*)(H1Q + tt_ * D + 16 * lane); }
#define PU_C(S, k_) { LAS u32x2* sl_ = slots + S * 128; const bool ok_ = (k_) < K; tk##S = widx + nw * ((k_) < K ? (k_) : K - 1); rs##S = rr##S; \
            hbuf[S * 64 + lane] = hr##S; const unsigned rl##S = rq##S.x, rh##S = rq##S.y; \
            { const bool f0 = ((rl##S & 0x3FFFu) >> GRP_SHIFT) == (unsigned)g, f1 = ((rh##S & 0x3FFFu) >> GRP_SHIFT) == (unsigned)g; const unsigned long long m0 = __ballot(f0), m1 = __ballot(f1); const int n0 = __popcll(m0); \
              if (f0) sl_[(int)__builtin_amdgcn_mbcnt_hi((unsigned)(m0 >> 32), __builtin_amdgcn_mbcnt_lo((unsigned)m0, 0u))] = (u32x2){((rl##S & 0x3FFFu) << 9) | ((unsigned)(2 * lane) << 24), rl##S & 0xffff0000u}; \
              if (f1) sl_[n0 + (int)__builtin_amdgcn_mbcnt_hi((unsigned)(m1 >> 32), __builtin_amdgcn_mbcnt_lo((unsigned)m1, 0u))] = (u32x2){((rh##S & 0x3FFFu) << 9) | ((unsigned)(2 * lane + 1) << 24), rh##S & 0xffff0000u}; \
              nn##S = ok_ ? n0 + __popcll(m1) : 0; } \
            LDS_WAIT(); \
            _Pragma("unroll") for (int q = 0; q < 6; ++q) sr##S[q] = sl_[4 * q + lrow]; \
            _Pragma("unroll") for (int i = 0; i < 4; ++i) hq##S[i] = hbuf[S * 64 + 16 * i + lcol]; }
#define PU_ISSUE(R, SR, n_) { \
            _Pragma("unroll") for (int q = 0; q < 6; ++q) if (q < 4 || (n_) > 4 * q) { const bool v_ = (4 * q + lrow) < (n_); const unsigned char* a_ = UQ + (v_ ? (size_t)((SR[q].x & 0x7FFFFFu) + lc16) : (size_t)0); \
                row##R[2 * q] = *(const u32x4*)a_; row##R[2 * q + 1] = *(const u32x4*)(a_ + 256); } }
#define PU_DOT(R, HQ, ACC, n_) { _Pragma("unroll") for (int q = 0; q < 6; ++q) if (q < 4 || (n_) > 4 * q) { int a1_ = 0, a2_ = 0; \
                _Pragma("unroll") for (int i = 0; i < 2; ++i) _Pragma("unroll") for (int w = 0; w < 4; ++w) { a1_ = __builtin_amdgcn_sdot8((int)row##R[2 * q + i][w], (int)HQ[i][w], a1_, false); a2_ = __builtin_amdgcn_sdot8((int)row##R[2 * q + i][w], (int)HQ[2 + i][w], a2_, false); } \
                ACC[q] = (a1_ << 4) + a2_; } }
#define PU_EPI(S, SR, ACC, n_) { float rt_[6]; \
            _Pragma("unroll") for (int q = 0; q < 6; ++q) { rt_[q] = 0.f; if (q < 4 || (n_) > 4 * q) { float f_ = (float)ACC[q]; f_ += dpp_mov<0xB1>(f_); f_ += dpp_mov<0x4E>(f_); f_ += dpp_mov<0x141>(f_); f_ += dpp_mov<0x140>(f_); rt_[q] = f_; } } \
            float tot_ = rt_[0]; unsigned rx_ = SR[0].x, ry_ = SR[0].y; \
            _Pragma("unroll") for (int q = 1; q < 6; ++q) { const bool e_ = lcol == q; tot_ = e_ ? rt_[q] : tot_; rx_ = e_ ? SR[q].x : rx_; ry_ = e_ ? SR[q].y : ry_; } \
            if (lcol < 6 && (4 * lcol + lrow) < (n_)) { const unsigned idx_ = (rx_ >> 9) & 0x3FFFu; const int li_ = (int)(idx_ & (GRP_SIZE - 1)); \
                const float c_ = __uint_as_float(ry_) * gelu_exact((tot_ + U8[li_]) * SU[li_] * rs##S) * SV[li_]; CI[(size_t)tk##S * 128 + (rx_ >> 24)] = (f2bf(c_) << 16) | idx_; } }
#define PU_OVF(S, R) if (nn##S > 24) { for (int b1_ = 24; b1_ < nn##S; b1_ += 24) { u32x2 so2_[6]; _Pragma("unroll") for (int q = 0; q < 6; ++q) so2_[q] = slots[S * 128 + ((b1_ + 4 * q + lrow) & 127)]; \
            const int n2_ = nn##S - b1_; int ac2_[6]; PU_ISSUE(R, so2_, n2_) PU_DOT(R, hq##S, ac2_, n2_) PU_EPI(S, so2_, ac2_, n2_) } }
        u32x2 rq0, rq1; u32x4 hr0, hr1, hq0[4], hq1[4]; float rr0, rr1, rs0 = 0.f, rs1 = 0.f; int tk0 = 0, tk1 = 0, nn0 = 0, nn1 = 0;
        u32x4 rowA[12], rowB[12]; u32x2 sr0[6], sr1[6]; int acc0[6], acc1[6];
#pragma unroll
        for (int q = 0; q < 4; ++q) { hq0[q] = (u32x4){0u, 0u, 0u, 0u}; hq1[q] = hq0[q]; }
#pragma unroll
        for (int q = 0; q < 6; ++q) { sr0[q] = (u32x2){0u, 0u}; sr1[q] = sr0[q]; acc0[q] = 0; acc1[q] = 0; }
        PU_R(0, 0) PU_R(1, 1)
        PU_C(0, 0)
        PU_ISSUE(A, sr0, nn0)
        PU_R(0, 2)
        for (int k = 0; k < K; k += 2) {
            PU_C(1, k + 1)
            PU_ISSUE(B, sr1, nn1)
            PU_R(1, k + 3)
            PU_DOT(A, hq0, acc0, nn0) PU_EPI(0, sr0, acc0, nn0) PU_OVF(0, A)
            PU_C(0, k + 2)
            PU_ISSUE(A, sr0, nn0)
            PU_R(0, k + 4)
            PU_DOT(B, hq1, acc1, nn1) PU_EPI(1, sr1, acc1, nn1) PU_OVF(1, B)
        }
    }
    __syncthreads();
}
__device__ __forceinline__ void phase_peer_v(const Params& p, LAS unsigned char* lds, int G, int mx, int mj) {
    const int tid = threadIdx.x, lane = tid & 63, wave = __builtin_amdgcn_readfirstlane(tid >> 6), bx = blockIdx.x;
    const bool xl = (G % 8 == 0);
    const int x = xl ? (mx & 3) : 0, nx = xl ? 4 : 1, jb = xl ? (mx >> 2) * (G / 8) + mj : bx, nw = (xl ? G / 4 : G) * NWAVES, widx = jb * NWAVES + wave;
    const unsigned char* VQ = (const unsigned char*)(p.ws + WS_VE);
    const unsigned* CI = (const unsigned*)(p.ws + WS_C);
    bf16_t* H1B = (bf16_t*)(p.ws + WS_H1B);
    const int sub = lane & 7, es = lane >> 3;
    const int K = (T - widx + nw - 1) / nw, NB4 = (K + 3) / 4;
    LAS unsigned* RL = (LAS unsigned*)(lds + wave * 4096);
    for (int s = x; s < NVS; s += nx) {
        const unsigned char* VQs = VQ + (size_t)s * 16384 * VSL + 16 * sub;
#define PV_TOK(k_) ((size_t)(widx + nw * ((k_) < K ? (k_) : K - 1)))
#define PV_RQLOAD(blk_) { _Pragma("unroll") for (int j = 0; j < 4; ++j) rq[j] = *(const u32x2*)(CI + PV_TOK(4 * (blk_) + j) * 128 + 2 * lane); }
#define PV_RQSTORE(blk_) { _Pragma("unroll") for (int j = 0; j < 4; ++j) *(LAS u32x2*)(RL + (((blk_) & 1) * 4 + j) * 128 + 2 * lane) = rq[j]; }
#define PV_REC(blkpar_, j_, hf_, i_) RL[((blkpar_) * 4 + (j_)) * 128 + 64 * (hf_) + 8 * (i_) + es]
#define PV_GATHER8(vb, rg_, hf_) { _Pragma("unroll") for (int i = 0; i < 8; ++i) vb[i] = *(const u32x4*)(VQs + (size_t)(rg_[8 * (hf_) + i] & 0x3FFFu) * VSL); }
#define PV_PREP(blkpar_, j_, sl_, k_) { float cf_[16]; float am_ = 0.f; hvs[sl_] = *(const u32x2*)(H1B + PV_TOK(k_) * D + hoff); \
            _Pragma("unroll") for (int i = 0; i < 16; ++i) rg[i] = PV_REC(blkpar_, j_, (i >> 3), (i & 7)); \
            _Pragma("unroll") for (int i = 0; i < 16; ++i) { cf_[i] = __uint_as_float(rg[i] & 0xffff0000u); am_ = fmaxf(am_, fabsf(cf_[i])); } \
            am_ = fmaxf(am_, dpp_mov<0x128>(am_)); am_ = swap16_max(am_); am_ = swap32_max(am_); \
            const float iv_ = am_ > 0.f ? 127.f / am_ : 0.f; csc[sl_] = am_ * (1.f / 127.f); int cs_ = 0; \
            _Pragma("unroll") for (int m = 0; m < 4; ++m) { const int q0 = (int)rintf(cf_[4 * m] * iv_), q1 = (int)rintf(cf_[4 * m + 1] * iv_), q2 = (int)rintf(cf_[4 * m + 2] * iv_), q3 = (int)rintf(cf_[4 * m + 3] * iv_); \
                cqs[sl_][m] = (q0 & 0xFF) | ((q1 & 0xFF) << 8) | ((q2 & 0xFF) << 16) | ((q3 & 0xFF) << 24); cs_ = __builtin_amdgcn_sdot4(cqs[sl_][m], 0x01010101, cs_, false); } \
            float ct_ = (float)cs_; ct_ += dpp_mov<0x128>(ct_); ct_ = swap16_sum(ct_); ct_ = swap32_sum(ct_); cto[sl_] = -8.f * ct_; }
#define PV_T4(r0, r1, r2, r3, w, cqw) { const unsigned x0_ = __builtin_amdgcn_perm(r1[w], r0[w], 0x05010400u), x1_ = __builtin_amdgcn_perm(r1[w], r0[w], 0x07030602u), \
                y0_ = __builtin_amdgcn_perm(r3[w], r2[w], 0x05010400u), y1_ = __builtin_amdgcn_perm(r3[w], r2[w], 0x07030602u); \
            const unsigned t0_ = __builtin_amdgcn_perm(y0_, x0_, 0x05040100u), t1_ = __builtin_amdgcn_perm(y0_, x0_, 0x07060302u), t2_ = __builtin_amdgcn_perm(y1_, x1_, 0x05040100u), t3_ = __builtin_amdgcn_perm(y1_, x1_, 0x07060302u); \
            acci[8 * (w)] = __builtin_amdgcn_sdot4((int)(t0_ & 0x0F0F0F0Fu), cqw, acci[8 * (w)], false); acci[8 * (w) + 1] = __builtin_amdgcn_sdot4((int)(t0_ & 0xF0F0F0F0u), cqw, acci[8 * (w) + 1], false); \
            acci[8 * (w) + 2] = __builtin_amdgcn_sdot4((int)(t1_ & 0x0F0F0F0Fu), cqw, acci[8 * (w) + 2], false); acci[8 * (w) + 3] = __builtin_amdgcn_sdot4((int)(t1_ & 0xF0F0F0F0u), cqw, acci[8 * (w) + 3], false); \
            acci[8 * (w) + 4] = __builtin_amdgcn_sdot4((int)(t2_ & 0x0F0F0F0Fu), cqw, acci[8 * (w) + 4], false); acci[8 * (w) + 5] = __builtin_amdgcn_sdot4((int)(t2_ & 0xF0F0F0F0u), cqw, acci[8 * (w) + 5], false); \
            acci[8 * (w) + 6] = __builtin_amdgcn_sdot4((int)(t3_ & 0x0F0F0F0Fu), cqw, acci[8 * (w) + 6], false); acci[8 * (w) + 7] = __builtin_amdgcn_sdot4((int)(t3_ & 0xF0F0F0F0u), cqw, acci[8 * (w) + 7], false); }
#define PV_ACC8(vb, sl_, hf_) { _Pragma("unroll") for (int w = 0; w < 4; ++w) { PV_T4(vb[0], vb[1], vb[2], vb[3], w, cqs[sl_][2 * (hf_)]) PV_T4(vb[4], vb[5], vb[6], vb[7], w, cqs[sl_][2 * (hf_) + 1]) } }
#define PV_FIN(k_, sl_) { int r16[16], r8[8], r4[4]; \
            { const bool bt = lane & 8; _Pragma("unroll") for (int q = 0; q < 16; ++q) { const int keep = bt ? acci[q + 16] : acci[q], send = bt ? acci[q] : acci[q + 16]; r16[q] = keep + __builtin_amdgcn_update_dpp(0, send, 0x128, 0xF, 0xF, false); } } \
            _Pragma("unroll") for (int q = 0; q < 8; ++q) { int a_ = r16[q], b_ = r16[q + 8]; swap16i_(a_, b_); r8[q] = a_ + b_; } \
            _Pragma("unroll") for (int q = 0; q < 4; ++q) { int a_ = r8[q], b_ = r8[q + 4]; swap32i_(a_, b_); r4[q] = a_ + b_; } \
            _Pragma("unroll") for (int q = 0; q < 32; ++q) acci[q] = 0; \
            if ((k_) < K) { const u32x2 hw = hvs[sl_]; const float sc_ = csc[sl_], sh_ = sc_ * (1.f / 16.f), co_ = cto[sl_]; \
                *(u32x2*)(H1B + (size_t)(widx + nw * (k_)) * D + hoff) = (u32x2){pk2(bflo(hw.x) + ((float)r4[0] + co_) * sc_, bfhi(hw.x) + (float)r4[1] * sh_), pk2(bflo(hw.y) + ((float)r4[2] + co_) * sc_, bfhi(hw.y) + (float)r4[3] * sh_)}; } }
#define PV_STEP(vb, B_, j_, hf_) { PV_ACC8(vb, ((j_) & 3), hf_) if ((hf_) == 1) PV_FIN(4 * (B_) + (j_), ((j_) & 3)) \
            if ((hf_) == 0) PV_PREP((((j_) + 2) < 4) ? ((B_) & 1) : (((B_) + 1) & 1), (((j_) + 2) & 3), (((j_) + 2) & 3), 4 * (B_) + (j_) + 2) \
            PV_GATHER8(vb, rg, hf_) }
        u32x2 rq[4]; u32x4 v0[8], v1[8], v2[8], v3[8]; int acci[32]; int cqs[4][4]; float csc[4], cto[4]; unsigned rg[16]; u32x2 hvs[4];
        const int hoff = s * 256 + 32 * sub + 16 * (es & 1) + 8 * ((es >> 1) & 1) + 4 * (es >> 2);
#pragma unroll
        for (int q = 0; q < 32; ++q) acci[q] = 0;
        PV_RQLOAD(0) PV_RQSTORE(0) PV_RQLOAD(1) PV_RQSTORE(1)
        LDS_WAIT();
        PV_PREP(0, 0, 0, 0) PV_GATHER8(v0, rg, 0) PV_GATHER8(v1, rg, 1)
        PV_PREP(0, 1, 1, 1) PV_GATHER8(v2, rg, 0) PV_GATHER8(v3, rg, 1)
        for (int B = 0; B < NB4; ++B) {
            if (B > 0) { PV_RQSTORE(B + 1) LDS_WAIT(); }
            PV_STEP(v0, B, 0, 0) PV_STEP(v1, B, 0, 1)
            PV_STEP(v2, B, 1, 0) PV_STEP(v3, B, 1, 1)
            PV_RQLOAD(B + 2)
            PV_STEP(v0, B, 2, 0) PV_STEP(v1, B, 2, 1)
            PV_STEP(v2, B, 3, 0) PV_STEP(v3, B, 3, 1)
        }
    }
}
__device__ __forceinline__ void phase_final(const Params& p, int vcu, int G) {
    const int tid = threadIdx.x, lane = tid & 63, wave = __builtin_amdgcn_readfirstlane(tid >> 6);
    const bf16_t* H2B = (const bf16_t*)(p.ws + WS_H1B); float* Y = p.out; const float* fg = p.in[I_FG];
    const int w0 = vcu * NWAVES + wave, WS_ = G * NWAVES;
    const f32x4 g0 = ((const f32x4*)fg)[2 * lane], g1 = ((const f32x4*)fg)[2 * lane + 1], g2 = ((const f32x4*)fg)[128 + 2 * lane], g3 = ((const f32x4*)fg)[128 + 2 * lane + 1];
#define PF_LOAD(dst, t0_) { _Pragma("unroll") for (int u = 0; u < 4; ++u) { const int tok = ((t0_) + u * WS_) < T ? ((t0_) + u * WS_) : w0; \
            dst[u][0] = *(const u32x4*)(H2B + (size_t)tok * D + 8 * lane); dst[u][1] = *(const u32x4*)(H2B + (size_t)tok * D + 512 + 8 * lane); } }
#define PF_PROC(src, t0_) { _Pragma("unroll") for (int u = 0; u < 4; ++u) { const int tok = (t0_) + u * WS_; if (tok < T) { float f[16]; float ss = 0.f; \
            _Pragma("unroll") for (int k = 0; k < 4; ++k) { f[2 * k] = bflo(src[u][0][k]); f[2 * k + 1] = bfhi(src[u][0][k]); f[8 + 2 * k] = bflo(src[u][1][k]); f[8 + 2 * k + 1] = bfhi(src[u][1][k]); } \
            _Pragma("unroll") for (int k = 0; k < 16; ++k) ss += f[k] * f[k]; \
            const float rs = rsqrtf(wave_sum(ss) * (1.f / D) + EPS); f32x4* yr = (f32x4*)(Y + (size_t)tok * D); \
            yr[2 * lane] = (f32x4){f[0], f[1], f[2], f[3]} * rs * g0; yr[2 * lane + 1] = (f32x4){f[4], f[5], f[6], f[7]} * rs * g1; \
            yr[128 + 2 * lane] = (f32x4){f[8], f[9], f[10], f[11]} * rs * g2; yr[128 + 2 * lane + 1] = (f32x4){f[12], f[13], f[14], f[15]} * rs * g3; } } }
    u32x4 va[4][2], vb[4][2];
    PF_LOAD(va, w0)
    for (int t0 = w0; t0 < T; t0 += 8 * WS_) {
        if (t0 + 4 * WS_ < T) PF_LOAD(vb, t0 + 4 * WS_)
        PF_PROC(va, t0)
        if (t0 + 8 * WS_ < T) PF_LOAD(va, t0 + 8 * WS_)
        PF_PROC(vb, t0 + 4 * WS_)
    }
}
#define XB_TMO      128
#define XB_XCNT(j)  (256  + 64 * (j))
#define XB_XSUB(j)  (1280 + 64 * (j))
#define XB_XGEN(j)  (2304 + 64 * (j))
#define XB_TOP      3328
#define XB_TOPGEN   3392
#define XCD_BAR_WORDS 3456
#define XB_SPIN_CAP (1u << 18)

__device__ __forceinline__ unsigned xb_ld(unsigned* p)              { return __hip_atomic_load(p, __ATOMIC_RELAXED, __HIP_MEMORY_SCOPE_AGENT); }
__device__ __forceinline__ unsigned xb_add(unsigned* p, unsigned v) { return __hip_atomic_fetch_add(p, v, __ATOMIC_RELAXED, __HIP_MEMORY_SCOPE_AGENT); }
__device__ __forceinline__ unsigned xb_xcc_id() { return (unsigned)__builtin_amdgcn_s_getreg((3 << 11) | 20) & 0xFu; }
#define XB_SPIN(cond, bar) do { unsigned _sp = 0; while (cond) { __builtin_amdgcn_s_sleep(1); \
    if ((++_sp & 255u) == 0u) { if (xb_ld(&(bar)[XB_TMO])) break; if (_sp > XB_SPIN_CAP) { atomicAdd(&(bar)[XB_TMO], 1u); break; } } } } while (0)

struct XcdBarrier {
    unsigned* bar; unsigned x;
    volatile LAS unsigned* st;
};

__device__ __forceinline__ XcdBarrier xcd_barrier_post(unsigned* bar, volatile LAS unsigned* st) {
    XcdBarrier b; b.bar = bar; b.x = xb_xcc_id(); b.st = st;
    if (threadIdx.x == 0) (void)xb_add(&bar[XB_XCNT(b.x)], 1u);
    return b;
}
__device__ __forceinline__ void xcd_barrier_complete(unsigned* bar, unsigned x, unsigned& nloc, unsigned& nx) {
    const unsigned G = gridDim.x * gridDim.y * gridDim.z;
    unsigned sum, cnt, mine, sp = 0u;
    for (;;) {
        sum = 0u; cnt = 0u; mine = 0u;
#pragma unroll
        for (unsigned j = 0; j < 16; ++j) { const unsigned c = xb_ld(&bar[XB_XCNT(j)]); sum += c; cnt += (c > 0u) ? 1u : 0u; mine = (j == x) ? c : mine; }
        if (sum == G) break;
        __builtin_amdgcn_s_sleep(1);
        if ((++sp & 255u) == 0u) { if (xb_ld(&bar[XB_TMO])) break; if (sp > XB_SPIN_CAP) { atomicAdd(&bar[XB_TMO], 1u); break; } }
    }
    nloc = mine > 0u ? mine : 1u; nx = cnt > 0u ? cnt : 1u;
}

__device__ __forceinline__ void xcd_barrier(const XcdBarrier& b) {
    asm volatile("s_waitcnt vmcnt(0)" ::: "memory");
    __syncthreads();
    if (threadIdx.x == 0) {
        unsigned* bar = b.bar;
        __builtin_amdgcn_s_waitcnt(0);
        unsigned nloc = b.st[0], nx = b.st[1];
        if (nloc == 0u) { xcd_barrier_complete(bar, b.x, nloc, nx); b.st[0] = nloc; b.st[1] = nx; }
        const unsigned old = xb_add(&bar[XB_XSUB(b.x)], 1u);
        const unsigned gen = old / nloc;
        if (old + 1u == (gen + 1u) * nloc) {
            __builtin_amdgcn_fence(__ATOMIC_RELEASE, "agent");
            asm volatile("s_waitcnt vmcnt(0)" ::: "memory");
            const unsigned og = xb_add(&bar[XB_TOP], 1u);
            const unsigned tg = og / nx;
            if (og + 1u == (tg + 1u) * nx) xb_add(&bar[XB_TOPGEN], 1u);
            else XB_SPIN(xb_ld(&bar[XB_TOPGEN]) == tg, bar);
            __builtin_amdgcn_fence(__ATOMIC_ACQUIRE, "agent");
            xb_add(&bar[XB_XGEN(b.x)], 1u);
            asm volatile("s_waitcnt vmcnt(0)" ::: "memory");
        } else {
            XB_SPIN(xb_ld(&bar[XB_XGEN(b.x)]) == gen, bar);
            __builtin_amdgcn_fence(__ATOMIC_ACQUIRE, "agent");
            asm volatile("s_waitcnt vmcnt(0)" ::: "memory");
        }
    }
    __syncthreads();
}

constexpr int N_PHASES = 11;
__global__ void __launch_bounds__(NTHREADS, 2) hymba_fwd(Params p) {
    extern __shared__ __attribute__((aligned(16))) unsigned char lds_raw[];
    LAS unsigned char* lds = (LAS unsigned char*)lds_raw;
    cg::grid_group grid = cg::this_grid();
    const int G = gridDim.x; const int bx = blockIdx.x;
    const int vcu = (G % 8 == 0) ? (bx % 8) * (G / 8) + bx / 8 : bx;
    unsigned char* ws = p.ws;
    const int lo = p.ph_lo, hi = p.ph_hi;
    volatile LAS unsigned* MISC = (volatile LAS unsigned*)(lds + 131072 + 320);
    if (threadIdx.x < 32) MISC[threadIdx.x] = 0u;
    __syncthreads();
    XcdBarrier bar; bar.bar = (unsigned*)ws; bar.x = xb_xcc_id(); bar.st = MISC + 8;
    if (threadIdx.x == 0) { MISC[20] = xb_add(&bar.bar[XB_XCNT(bar.x)], 1u); MISC[21] = bar.x; MISC[22] = 0u; }
#define IN(k) (lo <= (k) && (k) < hi)
#define SEAM(k) do { if ((k) + 1 < hi) { if ((k) == 0) grid.sync(); else xcd_barrier(bar); } } while (0)
    if (IN(0)) { phase_prep(p, lds, vcu, G); SEAM(0); }
    {
        if (threadIdx.x == 0 && lo == 0 && hi > 1 && (G % 8) == 0) { bool ok = true; for (unsigned j = 0; j < 8; ++j) ok = ok && (xb_ld(&bar.bar[XB_XCNT(j)]) == (unsigned)(G / 8)); MISC[22] = ok ? 1u : 0u; }
        __syncthreads();
    }
    const bool xcc_ok = MISC[22] != 0u; const int xcc_x = xcc_ok ? (int)MISC[21] : (bx & 7), xcc_j = xcc_ok ? (int)MISC[20] : (bx >> 3);
    if (IN(1)) {
        { pg8::Gemm g{(const bf16_t*)(ws + WS_XN), (const bf16_t*)(ws + WS_WINT), T, 3584, D}; pg8::StaticOrder S; S.init(T, 3584, G, bx);
          EpiInProj E{(bf16_t*)(ws + WS_PROJ), (const float*)(ws + WS_SM)};
          pg8::gemm_phase<EpiInProj, pg8::StaticOrder, true, true>(lds, g, S, E); }
        { pg8::Gemm g{(const bf16_t*)(ws + WS_WINT) + (size_t)3584 * D, (const bf16_t*)(ws + WS_XN), 512, T, D}; pg8::StaticOrder S; S.init(512, T, G, bx);
          EpiStore E{(bf16_t*)(ws + WS_VT), T};
          pg8::gemm_phase<EpiStore, pg8::StaticOrder, true, true>(lds, g, S, E); }
        SEAM(1);
    }
    if (IN(2)) { phase_hgrn(p, lds, G); }
    if (IN(3)) { phase_attn(p, lds, G); SEAM(3); }
    if (IN(4)) { phase_mix(p, vcu, G); SEAM(4); }
    if (IN(5)) {
        pg8::Gemm g{(const bf16_t*)(ws + WS_XN), (const bf16_t*)(ws + WS_WOT), T, D, D}; pg8::StaticOrder S; S.init(T, D, G, bx);
        EpiOutProj E{p.in[I_X], p.out, (bf16_t*)(ws + WS_H1B), (float*)(ws + WS_SS)};
        pg8::gemm_phase<EpiOutProj, pg8::StaticOrder, true, true>(lds, g, S, E);
        SEAM(5);
    }
    if (IN(6)) {
        phase_hquant(p, vcu, G);
        pg8::Gemm g{(const bf16_t*)(ws + WS_H1B), (const bf16_t*)(ws + WS_WQT), T, 2048, D}; pg8::StaticOrder S; S.init(T, 2048, G, bx);
        EpiQ E{(bf16_t*)(ws + WS_QP), (const float*)(ws + WS_SS), (float*)(ws + WS_GATE)};
        pg8::gemm_phase<EpiQ, pg8::StaticOrder, true, true>(lds, g, S, E);
        SEAM(6);
    }
    if (IN(7)) { phase_topk(p, lds, vcu, G); SEAM(7); }
    if (IN(8)) { phase_peer_u(p, lds, G, xcc_x, xcc_j); SEAM(8); }
    if (IN(9)) { phase_peer_v(p, lds, G, xcc_x, xcc_j); SEAM(9); }
    if (IN(10)) { phase_final(p, vcu, G); }
#undef IN
#undef SEAM
}

extern "C" void kernel_launch(void* const* d_in, const int* in_sizes, int n_in, void* d_out, int out_size, void* d_ws, size_t ws_size, hipStream_t stream) {
    static int grid = 0;
    if (grid == 0) {
        if (n_in != 19 || out_size != T * D || ws_size < WS_END) { fprintf(stderr, "kernel_launch: unexpected sizes (n_in %d out %d ws %zu)\n", n_in, out_size, ws_size); grid = -1; return; }
        int dev = 0, cus = 0, per_cu = 0;
        hipGetDevice(&dev); hipDeviceGetAttribute(&cus, hipDeviceAttributeMultiprocessorCount, dev);
        hipFuncSetAttribute((const void*)hymba_fwd, hipFuncAttributeMaxDynamicSharedMemorySize, LDS_BYTES);
        hipOccupancyMaxActiveBlocksPerMultiprocessor(&per_cu, (const void*)hymba_fwd, NTHREADS, LDS_BYTES);
        (void)hipGetLastError();
        if (per_cu < 1) { fprintf(stderr, "kernel_launch: occupancy query says %d blocks/CU\n", per_cu); per_cu = 1; }
        grid = cus;
    }
    if (grid < 0) return;
    if (hipMemsetAsync(d_ws, 0, 65536, stream) != hipSuccess) { fprintf(stderr, "kernel_launch: memset of the barrier words failed\n"); return; }
    Params p{};
    for (int i = 0; i < 19; ++i) p.in[i] = (const float*)d_in[i];
    p.out = (float*)d_out; p.ws = (unsigned char*)d_ws;
#if MK_ONE_LAUNCH
    p.ph_lo = 0; p.ph_hi = N_PHASES;
    void* args[] = {&p};
    hipError_t e = hipLaunchCooperativeKernel((const void*)hymba_fwd, dim3(grid), dim3(NTHREADS), args, LDS_BYTES, stream);
    if (e != hipSuccess) fprintf(stderr, "cooperative launch failed: %s (grid %d)\n", hipGetErrorString(e), grid);
#else
    for (int ph = 0; ph < N_PHASES; ++ph) { p.ph_lo = ph; p.ph_hi = ph + 1; hipLaunchKernelGGL(hymba_fwd, dim3(grid), dim3(NTHREADS), LDS_BYTES, stream, p); }
#endif
}
```

```cpp
#include <hip/hip_runtime.h>
#include <hip/hip_bf16.h>
#include <hip/hip_cooperative_groups.h>
#include <cstdio>
#include <cstdint>
#include <cmath>
namespace cg = cooperative_groups;
#ifndef MK_ONE_LAUNCH
#define MK_ONE_LAUNCH 1
#endif
namespace pg8 {
#define PG8_LAS __attribute__((address_space(3)))
typedef unsigned short bf16_t;
typedef short bf16x8 __attribute__((ext_vector_type(8)));
typedef float f32x4 __attribute__((ext_vector_type(4)));
typedef unsigned u32x4 __attribute__((ext_vector_type(4)));
constexpr int BM = 256, BK = 64, HALF = 128, HTB = HALF * BK * 2  , STAGE_BYTES = 8 * HTB, NXCD = 8, WGM = 8;

__host__ __device__ __forceinline__ int lds_byte(int r, int c) { const int st = (r >> 4) * 2 + (c >> 5), rr = r & 15, cc = c & 31, ob = rr * 64 + cc * 2; return st * 1024 + (ob ^ (((ob >> 9) & 1) << 5)); }
__host__ __device__ __forceinline__ void stage_rc(int b, int& R, int& C) { const int st = b / 1024, sb = b % 1024, swz = sb ^ (((sb >> 9) & 1) << 5); R = (st >> 1) * 16 + swz / 64; C = (st & 1) * 32 + (swz % 64) / 2; }
__host__ __device__ __forceinline__ int perm32(int rho) { const int n = rho >> 4, i = rho & 15; return 8 * (i >> 2) + 4 * n + (i & 3); }

struct Unit { int pm, pn; };
struct Gemm { const bf16_t* A; const bf16_t* Bt; int M, N, K; };

struct StaticOrder {
    int nM, nN, nwg, G, c;
    __host__ __device__ void init(int M, int N, int G_, int c_) { nM = M / BM; nN = N / BM; nwg = nM * nN; G = G_; c = c_; }
    __host__ __device__ bool next(int i, Unit& u) const {
        const long L = (long)i * G + c; if (L >= nwg) return false;
        int wgid = (int)L; { const int q = nwg / NXCD, r = nwg % NXCD, xcd = wgid % NXCD, off = wgid / NXCD; wgid = (xcd < r ? xcd * (q + 1) : r * (q + 1) + (xcd - r) * q) + off; }
        const int nig = WGM * nN, gid = wgid / nig, fm = gid * WGM, gsz = (nM - fm) < WGM ? (nM - fm) : WGM;
        u.pm = fm + ((wgid % nig) % gsz); u.pn = (wgid % nig) / gsz; return true;
    }
    __device__ __forceinline__ void a_ready(const Unit&) const {}
    __device__ __forceinline__ void done(const Unit&) const {}
};

__device__ __forceinline__ unsigned cvt_pk_bf16(float lo, float hi) { unsigned r; asm volatile("v_cvt_pk_bf16_f32 %0, %1, %2" : "=v"(r) : "v"(lo), "v"(hi)); return r; }
typedef float f32x2 __attribute__((ext_vector_type(2)));
template <class Epi, class Sched, bool ALIGN_EPI = false, bool SP2 = false>
__device__ __forceinline__ void gemm_phase(PG8_LAS unsigned char* lds, const Gemm g, const Sched& S, const Epi& E) {
    const int tid = threadIdx.x, wid = __builtin_amdgcn_readfirstlane(tid >> 6), lane = tid & 63, wr = wid >> 2, wc = wid & 3, fr = lane & 15, fq = lane >> 4;
    const int K = g.K, nt = K / BK;
    unsigned voffA[2], voffB[2];
#pragma unroll
    for (int i = 0; i < 2; ++i) { int R, C; stage_rc(tid * 16 + i * 8192, R, C); const int Rb = Epi::PERM ? ((R & ~31) + perm32(R & 31)) : R;
        voffA[i] = (unsigned)(R * K + C) * 2u; voffB[i] = (unsigned)(Rb * K + C) * 2u; }
    const size_t kstep = (size_t)(BK * 2);
    const size_t hstep = (size_t)HALF * K * 2;
    const size_t tstep = 2 * hstep;
    const unsigned ldsw = (unsigned)wid * 1024u;
    const int aoff = lds_byte(wr * 64 + fr, fq * 8), boff = lds_byte(wc * 32 + fr, fq * 8);
#define PG8_SA(b, h) (((b) * 2 + (h)) * HTB)
#define PG8_SB(b, h) ((4 + (b) * 2 + (h)) * HTB)
#define PG8_STAGE(bufoff, gbase, voff) do { _Pragma("unroll") for (int _i = 0; _i < 2; ++_i) \
        __builtin_amdgcn_global_load_lds((const unsigned*)((const char*)(gbase) + (voff)[_i]), (PG8_LAS unsigned*)(lds + (bufoff) + ldsw + _i * 8192), 16, 0, 0); } while (0)
#define PG8_LDA(dst, b, h) do { _Pragma("unroll") for (int m = 0; m < 4; ++m) _Pragma("unroll") for (int k = 0; k < 2; ++k) dst[m][k] = *(const PG8_LAS bf16x8*)(lds + PG8_SA(b, h) + aoff + m * 2048 + k * 1024); } while (0)
#define PG8_LDB(dst, b, h) do { _Pragma("unroll") for (int n = 0; n < 2; ++n) _Pragma("unroll") for (int k = 0; k < 2; ++k) dst[n][k] = *(const PG8_LAS bf16x8*)(lds + PG8_SB(b, h) + boff + n * 2048 + k * 1024); } while (0)
#define PG8_MMA(ai, bj, At, Bt) do { __builtin_amdgcn_s_setprio(1); _Pragma("unroll") for (int m = 0; m < 4; ++m) _Pragma("unroll") for (int n = 0; n < 2; ++n) _Pragma("unroll") for (int k = 0; k < 2; ++k) \
        acc[ai][bj][m][n] = __builtin_amdgcn_mfma_f32_16x16x32_bf16(Bt[n][k], At[m][k], acc[ai][bj][m][n], 0, 0, 0); __builtin_amdgcn_s_setprio(0); } while (0)
#define PG8_WAIT_V(n) asm volatile("s_waitcnt vmcnt(" #n ")" ::: "memory")
#define PG8_WAIT_L(n) asm volatile("s_waitcnt lgkmcnt(" #n ")" ::: "memory")
#define PG8_BAR __builtin_amdgcn_s_barrier()
#define PG8_SCHED __builtin_amdgcn_sched_barrier(0)
    Unit cur, nxt; int ui = 0;
    if (!S.next(0, cur)) return;
    f32x4 acc[2][2][4][2];
#pragma unroll
    for (int a = 0; a < 2; ++a)
#pragma unroll
        for (int b = 0; b < 2; ++b)
#pragma unroll
            for (int m = 0; m < 4; ++m)
#pragma unroll
                for (int n = 0; n < 2; ++n) acc[a][b][m][n] = (f32x4){0.f, 0.f, 0.f, 0.f};
    bf16x8 At[4][2], B0[2][2], B1[2][2];
    const char* cA = (const char*)g.A + (size_t)cur.pm * tstep; const char* cB = (const char*)g.Bt + (size_t)cur.pn * tstep;
    S.a_ready(cur);
    if constexpr (SP2) {
        PG8_STAGE(PG8_SB(0, 0), cB, voffB); PG8_STAGE(PG8_SB(0, 1), cB + hstep, voffB); PG8_STAGE(PG8_SA(0, 0), cA, voffA); PG8_STAGE(PG8_SA(0, 1), cA + hstep, voffA);
        if (wr == 1) PG8_BAR;
        PG8_WAIT_V(2); PG8_BAR;
        PG8_STAGE(PG8_SB(1, 0), cB + kstep, voffB); PG8_STAGE(PG8_SA(1, 0), cA + kstep, voffA); PG8_STAGE(PG8_SB(1, 1), cB + hstep + kstep, voffB);
        PG8_WAIT_V(6); PG8_BAR;
    } else {
        PG8_STAGE(PG8_SB(0, 0), cB, voffB); PG8_STAGE(PG8_SA(0, 0), cA, voffA); PG8_STAGE(PG8_SB(0, 1), cB + hstep, voffB); PG8_STAGE(PG8_SA(0, 1), cA + hstep, voffA);
        if (wr == 1) PG8_BAR;
        PG8_WAIT_V(4); PG8_BAR;
        PG8_STAGE(PG8_SB(1, 0), cB + kstep, voffB); PG8_STAGE(PG8_SA(1, 0), cA + kstep, voffA); PG8_STAGE(PG8_SB(1, 1), cB + hstep + kstep, voffB);
        PG8_WAIT_V(6); PG8_BAR;
    }
    for (;;) {
        const bool has_next = S.next(ui + 1, nxt);
        const char* nA = has_next ? (const char*)g.A + (size_t)nxt.pm * tstep : cA; const char* nB = has_next ? (const char*)g.Bt + (size_t)nxt.pn * tstep : cB;
        for (int t = 0; t < nt; t += 2) {
            const bool last = (t == nt - 2);
            const char* a1 = cA + (size_t)(t + 1) * kstep;
            const char* a2 = last ? nA : cA + (size_t)(t + 2) * kstep; const char* b2 = last ? nB : cB + (size_t)(t + 2) * kstep;
            const char* a3 = a2 + kstep; const char* b3 = b2 + kstep;
            if (last && has_next) S.a_ready(nxt);
            if constexpr (SP2) {
            PG8_LDB(B0, 0, 0); PG8_LDB(B1, 0, 1); PG8_SCHED; PG8_LDA(At, 0, 0); PG8_STAGE(PG8_SA(1, 1), a1 + hstep, voffA);
            PG8_WAIT_V(8); PG8_WAIT_L(0); PG8_BAR; PG8_MMA(0, 0, At, B0); PG8_MMA(0, 1, At, B1); PG8_BAR; PG8_SCHED;
            PG8_LDA(At, 0, 1); PG8_STAGE(PG8_SB(0, 0), b2, voffB); PG8_STAGE(PG8_SB(0, 1), b2 + hstep, voffB); PG8_STAGE(PG8_SA(0, 0), a2, voffA);
            PG8_WAIT_V(8); PG8_WAIT_L(0); PG8_BAR; PG8_MMA(1, 0, At, B0); PG8_MMA(1, 1, At, B1); PG8_BAR; PG8_SCHED;
            PG8_LDB(B0, 1, 0); PG8_LDB(B1, 1, 1); PG8_SCHED; PG8_LDA(At, 1, 0); PG8_STAGE(PG8_SA(0, 1), a2 + hstep, voffA);
            PG8_WAIT_V(8); PG8_WAIT_L(0); PG8_BAR; PG8_MMA(0, 0, At, B0); PG8_MMA(0, 1, At, B1); PG8_BAR; PG8_SCHED;
            PG8_LDA(At, 1, 1); PG8_STAGE(PG8_SB(1, 0), b3, voffB); PG8_STAGE(PG8_SB(1, 1), b3 + hstep, voffB); PG8_STAGE(PG8_SA(1, 0), a3, voffA);
            PG8_WAIT_V(8); PG8_WAIT_L(0); PG8_BAR; PG8_MMA(1, 0, At, B0); PG8_MMA(1, 1, At, B1); PG8_BAR; PG8_SCHED;
            } else {
            PG8_LDB(B0, 0, 0); PG8_SCHED; PG8_LDA(At, 0, 0); PG8_STAGE(PG8_SA(1, 1), a1 + hstep, voffA);
            PG8_WAIT_L(8); PG8_BAR; PG8_WAIT_L(0); PG8_MMA(0, 0, At, B0); PG8_BAR; PG8_SCHED;
            PG8_LDB(B1, 0, 1); PG8_STAGE(PG8_SB(0, 0), b2, voffB);
            PG8_BAR; PG8_WAIT_L(0); PG8_MMA(0, 1, At, B1); PG8_BAR;
            PG8_LDA(At, 0, 1); PG8_STAGE(PG8_SA(0, 0), a2, voffA);
            PG8_BAR; PG8_WAIT_L(0); PG8_MMA(1, 0, At, B0); PG8_BAR; PG8_SCHED;
            PG8_STAGE(PG8_SB(0, 1), b2 + hstep, voffB);
            PG8_WAIT_V(6); PG8_BAR; PG8_MMA(1, 1, At, B1); PG8_BAR;
            PG8_LDB(B0, 1, 0); PG8_SCHED; PG8_LDA(At, 1, 0); PG8_STAGE(PG8_SA(0, 1), a2 + hstep, voffA);
            PG8_WAIT_L(8); PG8_BAR; PG8_WAIT_L(0); PG8_MMA(0, 0, At, B0); PG8_BAR; PG8_SCHED;
            PG8_LDB(B1, 1, 1); PG8_STAGE(PG8_SB(1, 0), b3, voffB);
            PG8_BAR; PG8_WAIT_L(0); PG8_MMA(0, 1, At, B1); PG8_BAR;
            PG8_LDA(At, 1, 1); PG8_STAGE(PG8_SA(1, 0), a3, voffA);
            PG8_BAR; PG8_WAIT_L(0); PG8_MMA(1, 0, At, B0); PG8_BAR; PG8_SCHED;
            PG8_STAGE(PG8_SB(1, 1), b3 + hstep, voffB);
            PG8_WAIT_V(6); PG8_BAR; PG8_MMA(1, 1, At, B1); PG8_BAR;
            }
        }
        if constexpr (ALIGN_EPI) { if (wr == 0) PG8_BAR; }
        if constexpr (!Epi::AFTER_DRAIN) { E(acc, cur, wr, wc, fr, fq); S.done(cur); }
        if (!has_next) break;
#pragma unroll
        for (int a = 0; a < 2; ++a)
#pragma unroll
            for (int b = 0; b < 2; ++b)
#pragma unroll
                for (int m = 0; m < 4; ++m)
#pragma unroll
                    for (int n = 0; n < 2; ++n) acc[a][b][m][n] = (f32x4){0.f, 0.f, 0.f, 0.f};
        cur = nxt; cA = nA; cB = nB; ++ui;
        if constexpr (ALIGN_EPI) { if (wr == 1) PG8_BAR; }
    }
    PG8_WAIT_V(0);
    if constexpr (!ALIGN_EPI) { if (wr == 0) PG8_BAR; }
    PG8_BAR;
    if constexpr (Epi::AFTER_DRAIN) { E.fused(acc, cur, wr, wc, fr, fq, lds, wid, lane); S.done(cur); }
#undef PG8_SA
#undef PG8_SB
#undef PG8_STAGE
#undef PG8_LDA
#undef PG8_LDB
#undef PG8_MMA
#undef PG8_WAIT_V
#undef PG8_WAIT_L
#undef PG8_BAR
#undef PG8_SCHED
}
}

#define LAS __attribute__((address_space(3)))
typedef unsigned short bf16_t;
typedef short bf16x8 __attribute__((ext_vector_type(8)));
typedef short bf16x4 __attribute__((ext_vector_type(4)));
typedef float f32x4 __attribute__((ext_vector_type(4)));
typedef float f32x16 __attribute__((ext_vector_type(16)));
typedef unsigned u32x4 __attribute__((ext_vector_type(4)));
typedef unsigned u32x2 __attribute__((ext_vector_type(2)));
typedef __bf16 bf16x2_t __attribute__((ext_vector_type(2)));

constexpr int NB = 16, SEQ = 2048, T = NB * SEQ, D = 1024;
constexpr int PP = 4608;
constexpr int C_Q = 0, C_KF = 512, C_LFF = 1024, C_KB = 1536, C_LFB = 2048, C_V = 2560, C_G = 3072, C_DQ = 3584, C_DK = 4096;
constexpr float EPS = 1e-6f;
constexpr float LOG2E = 1.4426950408889634f;
constexpr int NWAVES = 8, NTHREADS = 512;
constexpr int NGRP = 8, GRP_SHIFT = 11, GRP_SIZE = 2048, VSL = 128, NVS = 4;
constexpr int LDS_BYTES = 147456;

constexpr size_t MiB = (size_t)1 << 20;
constexpr size_t WS_SM = 64 * 1024;
constexpr size_t WS_WINT = 2 * MiB, WS_WOT = 10 * MiB, WS_WQT = 12 * MiB, WS_KEYS = 16 * MiB;
constexpr size_t WS_UT = 32 * MiB, WS_USC = 48 * MiB, WS_VSC = 49 * MiB, WS_VE = 64 * MiB, WS_XN = 96 * MiB, WS_PROJ = 160 * MiB, WS_VT = 448 * MiB, WS_END = 480 * MiB;
constexpr size_t WS_H1B = 160 * MiB, WS_QP = 224 * MiB, WS_IDX = 360 * MiB, WS_GATE = 376 * MiB, WS_SS = 392 * MiB, WS_C = 394 * MiB;
constexpr int QPS = 2048 + 64;
constexpr size_t WS_US8 = 48 * MiB + 131072;
constexpr size_t WS_H1Q = 96 * MiB, WS_HSC = 128 * MiB;
constexpr int SM_LBF = 0, SM_LBB = 512, SM_LAM = 1024, SM_BT = 2048, BT_STRIDE = 260;

struct Params { const float* in[19]; float* out; unsigned char* ws; int ph_lo, ph_hi; };
enum { I_X = 0, I_G1, I_WIN, I_LBF, I_LBB, I_HOG, I_LQ1, I_LK1, I_LQ2, I_LK2, I_DOG, I_RB, I_WOUT, I_G2, I_WQ, I_KEYS, I_U, I_V, I_FG };

#define LDS_WAIT() asm volatile("s_waitcnt lgkmcnt(0)" ::: "memory")
__device__ __forceinline__ unsigned f2bf(float f) { unsigned u = __builtin_bit_cast(unsigned, f); return (u + 0x7fffu + ((u >> 16) & 1u)) >> 16; }
typedef float f32x2v_ __attribute__((ext_vector_type(2)));
__device__ __forceinline__ unsigned pk2(float lo, float hi) { const f32x2v_ v = {lo, hi}; return __builtin_bit_cast(unsigned, __builtin_convertvector(v, bf16x2_t)); }
__device__ __forceinline__ float bflo(unsigned w) { return __uint_as_float(w << 16); }
__device__ __forceinline__ float bfhi(unsigned w) { return __uint_as_float(w & 0xffff0000u); }
template <int CTRL> __device__ __forceinline__ float dpp_mov(float v) { return __builtin_bit_cast(float, __builtin_amdgcn_update_dpp(0, __builtin_bit_cast(int, v), CTRL, 0xF, 0xF, false)); }
__device__ __forceinline__ void swap16_(float& a, float& b) { asm volatile("s_nop 1\n\tv_permlane16_swap_b32 %0, %1\n\ts_nop 1" : "+v"(a), "+v"(b)); }
__device__ __forceinline__ void swap32_(float& a, float& b) { asm volatile("s_nop 1\n\tv_permlane32_swap_b32 %0, %1\n\ts_nop 1" : "+v"(a), "+v"(b)); }
__device__ __forceinline__ void swap16i_(int& a, int& b) { asm volatile("s_nop 1\n\tv_permlane16_swap_b32 %0, %1\n\ts_nop 1" : "+v"(a), "+v"(b)); }
__device__ __forceinline__ void swap32i_(int& a, int& b) { asm volatile("s_nop 1\n\tv_permlane32_swap_b32 %0, %1\n\ts_nop 1" : "+v"(a), "+v"(b)); }
__device__ __forceinline__ float swap16_sum(float v) { float a = v, b = v; swap16_(a, b); return a + b; }
__device__ __forceinline__ float swap32_sum(float v) { float a = v, b = v; swap32_(a, b); return a + b; }
__device__ __forceinline__ float swap16_max(float v) { float a = v, b = v; swap16_(a, b); return fmaxf(a, b); }
__device__ __forceinline__ float swap32_max(float v) { float a = v, b = v; swap32_(a, b); return fmaxf(a, b); }
__device__ __forceinline__ float xchg16(float v, int lane) { float a = v, b = v; swap16_(a, b); return (lane & 16) ? a : b; }
__device__ __forceinline__ float xchg32(float v, int lane) { float a = v, b = v; swap32_(a, b); return (lane & 32) ? a : b; }
__device__ __forceinline__ float wave_sum(float v) {
    v += dpp_mov<0xB1>(v); v += dpp_mov<0x4E>(v); v += dpp_mov<0x141>(v); v += dpp_mov<0x140>(v);
    return swap32_sum(swap16_sum(v));
}
__device__ __forceinline__ float wave_max(float v) {
    v = fmaxf(v, dpp_mov<0xB1>(v)); v = fmaxf(v, dpp_mov<0x4E>(v)); v = fmaxf(v, dpp_mov<0x141>(v)); v = fmaxf(v, dpp_mov<0x140>(v));
    return swap32_max(swap16_max(v));
}
__device__ __forceinline__ float sigmoidf_(float z) { return __builtin_amdgcn_rcpf(1.0f + __expf(-z)); }

__device__ __forceinline__ void p0_transpose_item(const float* W, int K, int N, bf16_t* WT, const float* kscale, LAS float* scr, int item, int lane) {
    const int nblk = N / 32, kb = item / nblk, nb = item % nblk, k0 = 64 * kb, n0 = 32 * nb;
#pragma unroll 8
    for (int i = 0; i < 32; ++i) { const int kk = 2 * i + (lane >> 5); float w = W[(size_t)(k0 + kk) * N + n0 + (lane & 31)]; if (kscale) w *= kscale[k0 + kk]; scr[kk * 33 + (lane & 31)] = w; }
    LDS_WAIT(); asm volatile("" ::: "memory");
    const int c = lane & 7;
#pragma unroll
    for (int j = 0; j < 4; ++j) { const int n = (lane >> 3) + 8 * j; const LAS float* s = scr + (8 * c) * 33 + n;
        u32x4 o; o.x = pk2(s[0 * 33], s[1 * 33]); o.y = pk2(s[2 * 33], s[3 * 33]); o.z = pk2(s[4 * 33], s[5 * 33]); o.w = pk2(s[6 * 33], s[7 * 33]);
        *(u32x4*)(WT + (size_t)(n0 + n) * K + k0 + 8 * c) = o; }
    LDS_WAIT(); asm volatile("" ::: "memory");
}
__device__ __forceinline__ int t5_bucket(int rel) {
    const int n = rel < 0 ? -rel : rel;
    const int v = n < 8 ? n : n < 12 ? 8 : n < 16 ? 9 : n < 23 ? 10 : n < 32 ? 11 : n < 46 ? 12 : n < 64 ? 13 : n < 91 ? 14 : 15;
    return (rel > 0 ? 16 : 0) + v;
}
__device__ __forceinline__ void phase_prep(const Params& p, LAS unsigned char* lds, int vcu, int G) {
    const int tid = threadIdx.x, lane = tid & 63, wave = __builtin_amdgcn_readfirstlane(tid >> 6);
    unsigned char* ws = p.ws;
    LAS float* scr = (LAS float*)(lds + wave * 16384);
    const int gw = vcu * NWAVES + wave, NGW = G * NWAVES;
    constexpr int I_IN = (D / 64) * (4096 / 32), I_OUT = (D / 64) * (D / 32), I_QW = (D / 64) * (2048 / 32);
    for (int it = gw; it < I_IN + I_OUT + I_QW; it += NGW) {
        int r = it;
        if (r < I_IN) { p0_transpose_item(p.in[I_WIN], D, 4096, (bf16_t*)(ws + WS_WINT), nullptr, scr, r, lane); continue; } r -= I_IN;
        if (r < I_OUT) { p0_transpose_item(p.in[I_WOUT], D, D, (bf16_t*)(ws + WS_WOT), nullptr, scr, r, lane); continue; } r -= I_OUT;
        p0_transpose_item(p.in[I_WQ], D, 2048, (bf16_t*)(ws + WS_WQT), p.in[I_G2], scr, r, lane);
    }
    for (int i = blockIdx.x * NTHREADS + tid; i < 8 * 2 * 128 * 128 / 4; i += G * NTHREADS) {
        const f32x4 v = ((const f32x4*)p.in[I_KEYS])[i];
        ((u32x2*)(ws + WS_KEYS))[i] = (u32x2){pk2(v.x, v.y), pk2(v.z, v.w)};
    }
#define PX_LOAD(dst, m0_) { _Pragma("unroll") for (int u = 0; u < 4; ++u) { const int m = ((m0_) + u * NGW) < T ? ((m0_) + u * NGW) : gw; const f32x4* xr = (const f32x4*)(p.in[I_X] + (size_t)m * D) + lane; \
            _Pragma("unroll") for (int j = 0; j < 4; ++j) dst[u][j] = xr[64 * j]; } }
#define PX_PROC(src, m0_) { _Pragma("unroll") for (int u = 0; u < 4; ++u) { const int m = (m0_) + u * NGW; if (m < T) { float ssq = 0.f; \
            _Pragma("unroll") for (int j = 0; j < 4; ++j) ssq += (src[u][j].x * src[u][j].x + src[u][j].y * src[u][j].y) + (src[u][j].z * src[u][j].z + src[u][j].w * src[u][j].w); \
            const float rs = rsqrtf(wave_sum(ssq) * (1.f / D) + EPS); unsigned long long* o8 = (unsigned long long*)((bf16_t*)(ws + WS_XN) + (size_t)m * D) + lane; \
            _Pragma("unroll") for (int j = 0; j < 4; ++j) { const f32x4 y = src[u][j] * rs * ((const f32x4*)p.in[I_G1])[64 * j + lane]; o8[64 * j] = (unsigned long long)pk2(y.x, y.y) | ((unsigned long long)pk2(y.z, y.w) << 32); } } } }
    {
        f32x4 va[4][4], vb[4][4];
        PX_LOAD(va, gw)
        for (int m0 = gw; m0 < T; m0 += 8 * NGW) {
            if (m0 + 4 * NGW < T) PX_LOAD(vb, m0 + 4 * NGW)
            PX_PROC(va, m0)
            if (m0 + 8 * NGW < T) PX_LOAD(va, m0 + 8 * NGW)
            PX_PROC(vb, m0 + 4 * NGW)
        }
    }
    if (blockIdx.x == 0) {
        float* sm = (float*)(ws + WS_SM);
        { const float* a = p.in[I_LBF]; sm[SM_LBF + tid] = 1.f / (1.f + __expf(a[512 + tid] - a[tid])); }
        { const float* a = p.in[I_LBB]; sm[SM_LBB + tid] = 1.f / (1.f + __expf(a[512 + tid] - a[tid])); }
        if (tid < 64) {
            float a = p.in[I_LQ1][tid] * p.in[I_LK1][tid], b = p.in[I_LQ2][tid] * p.in[I_LK2][tid];
            a = wave_sum(a); b = wave_sum(b);
            if (tid == 0) sm[SM_LAM] = __expf(a) - __expf(b) + 0.2f;
        }
        for (int i = tid; i < 4 * 257; i += NTHREADS) { const int h = i / 257, r = i % 257; sm[SM_BT + h * BT_STRIDE + r] = p.in[I_RB][t5_bucket(r - 128) * 4 + h] * LOG2E; }
    }
}

__device__ __forceinline__ float silu_(float x) { return x * __builtin_amdgcn_rcpf(1.0f + __expf(-x)); }
struct EpiInProj {
    static constexpr bool PERM = true, AFTER_DRAIN = false;
    bf16_t* P; const float* sm;
    __device__ __forceinline__ void st8(bf16_t* dst, const float (&y)[8]) const { u32x4 w; w.x = pk2(y[0], y[1]); w.y = pk2(y[2], y[3]); w.z = pk2(y[4], y[5]); w.w = pk2(y[6], y[7]); *(u32x4*)dst = w; }
    __device__ __forceinline__ void operator()(const f32x4 (&acc)[2][2][4][2], const pg8::Unit& u, int wr, int wc, int fr, int fq) const {
        const int seg = u.pn >> 1;
        const int row0 = u.pm * 256 + wr * 64 + fr;
        const int cs0 = (u.pn & 1) * 256 + wc * 32 + 8 * fq;
#pragma unroll
        for (int bj = 0; bj < 2; ++bj) {
            const int cs = cs0 + bj * 128;
            float lb[8] = {0.f, 0.f, 0.f, 0.f, 0.f, 0.f, 0.f, 0.f};
            if (seg == 1 || seg == 2) {
#pragma unroll
                for (int i = 0; i < 8; ++i) lb[i] = sm[(seg == 1 ? SM_LBF : SM_LBB) + cs + i];
            }
#pragma unroll
            for (int ai = 0; ai < 2; ++ai)
#pragma unroll
                for (int m = 0; m < 4; ++m) {
                    const size_t row = (size_t)(row0 + ai * 128 + m * 16);
                    bf16_t* rp = P + row * PP + cs;
                    float x[8];
#pragma unroll
                    for (int i = 0; i < 4; ++i) { x[i] = acc[ai][bj][m][0][i]; x[4 + i] = acc[ai][bj][m][1][i]; }
                    float y[8];
                    if (seg == 0 || seg == 4) {
#pragma unroll
                        for (int i = 0; i < 8; ++i) y[i] = silu_(x[i]);
                        st8(rp + (seg == 0 ? C_Q : C_G), y);
                    } else if (seg == 1 || seg == 2) {
                        float lf[8];
#pragma unroll
                        for (int i = 0; i < 8; ++i) { const float s = sigmoidf_(x[i]); const float k = (1.f - lb[i]) * (1.f - s); y[i] = k; lf[i] = __logf(1.f - k); }
                        st8(rp + (seg == 1 ? C_KF : C_KB), y);
                        st8(rp + (seg == 1 ? C_LFF : C_LFB), lf);
                    } else if (seg == 3) {
                        st8(rp + C_V, x);
                    } else if (seg == 5) {
#pragma unroll
                        for (int i = 0; i < 8; ++i) y[i] = x[i] * (0.125f * LOG2E);
                        st8(rp + C_DQ, y);
                    } else {
                        st8(rp + C_DK, x);
                    }
                }
        }
    }
};
struct EpiStore {
    static constexpr bool PERM = true, AFTER_DRAIN = false;
    bf16_t* O; int ldc;
    __device__ __forceinline__ void operator()(const f32x4 (&acc)[2][2][4][2], const pg8::Unit& u, int wr, int wc, int fr, int fq) const {
        const int row0 = u.pm * 256 + wr * 64 + fr, col0 = u.pn * 256 + wc * 32 + 8 * fq;
#pragma unroll
        for (int ai = 0; ai < 2; ++ai)
#pragma unroll
            for (int m = 0; m < 4; ++m)
#pragma unroll
                for (int bj = 0; bj < 2; ++bj) {
                    const f32x4 a = acc[ai][bj][m][0], b = acc[ai][bj][m][1];
                    u32x4 w; w.x = pk2(a[0], a[1]); w.y = pk2(a[2], a[3]); w.z = pk2(b[0], b[1]); w.w = pk2(b[2], b[3]);
                    *(u32x4*)(O + (size_t)(row0 + ai * 128 + m * 16) * ldc + col0 + bj * 128) = w;
                }
    }
};
struct EpiOutProj {
    static constexpr bool PERM = true, AFTER_DRAIN = false;
    const float* x; float* H1; bf16_t* H1B; float* SS;
    __device__ __forceinline__ void operator()(const f32x4 (&acc)[2][2][4][2], const pg8::Unit& u, int wr, int wc, int fr, int fq) const {
        const int row0 = u.pm * 256 + wr * 64 + fr, col0 = u.pn * 256 + wc * 32 + 8 * fq;
#pragma unroll
        for (int ai = 0; ai < 2; ++ai)
#pragma unroll
            for (int m = 0; m < 4; ++m) {
                const size_t row = (size_t)(row0 + ai * 128 + m * 16);
                float ss = 0.f;
#pragma unroll
                for (int bj = 0; bj < 2; ++bj) {
                    const size_t off = row * D + col0 + bj * 128;
                    const f32x4 a = *(const f32x4*)(x + off) + acc[ai][bj][m][0], b = *(const f32x4*)(x + off + 4) + acc[ai][bj][m][1];
                    u32x4 w; w.x = pk2(a[0], a[1]); w.y = pk2(a[2], a[3]); w.z = pk2(b[0], b[1]); w.w = pk2(b[2], b[3]);
                    *(u32x4*)(H1B + off) = w;
                    ss += (a[0] * a[0] + a[1] * a[1]) + (a[2] * a[2] + a[3] * a[3]) + (b[0] * b[0] + b[1] * b[1]) + (b[2] * b[2] + b[3] * b[3]);
                }
                ss += __shfl_xor(ss, 16); ss += __shfl_xor(ss, 32);
                if (fq == 0) SS[row * 16 + u.pn * 4 + wc] = ss;
            }
    }
};
__device__ __forceinline__ float row_rstd(const float* SS, size_t row) {
    const f32x4* s = (const f32x4*)(SS + row * 16);
    const f32x4 a = s[0], b = s[1], c = s[2], d = s[3];
    const float t = ((a[0] + a[1]) + (a[2] + a[3])) + ((b[0] + b[1]) + (b[2] + b[3])) + ((c[0] + c[1]) + (c[2] + c[3])) + ((d[0] + d[1]) + (d[2] + d[3]));
    return rsqrtf(t * (1.f / D) + EPS);
}
struct EpiQ {
    static constexpr bool PERM = true, AFTER_DRAIN = false;
    bf16_t* O; const float* SS; float* RSTD;
    __device__ __forceinline__ void operator()(const f32x4 (&acc)[2][2][4][2], const pg8::Unit& u, int wr, int wc, int fr, int fq) const {
        const int row0 = u.pm * 256 + wr * 64 + fr, col0 = u.pn * 256 + wc * 32 + 8 * fq;
#pragma unroll
        for (int ai = 0; ai < 2; ++ai)
#pragma unroll
            for (int m = 0; m < 4; ++m) {
                const size_t row = (size_t)(row0 + ai * 128 + m * 16);
                const float rs = row_rstd(SS, row);
                if (u.pn == 0 && wc == 0 && fq == 0) RSTD[row] = rs;
#pragma unroll
                for (int bj = 0; bj < 2; ++bj) {
                    const f32x4 a = acc[ai][bj][m][0] * rs, b = acc[ai][bj][m][1] * rs;
                    u32x4 w; w.x = pk2(a[0], a[1]); w.y = pk2(a[2], a[3]); w.z = pk2(b[0], b[1]); w.w = pk2(b[2], b[3]);
                    *(u32x4*)(O + row * QPS + col0 + bj * 128) = w;
                }
            }
    }
};

constexpr int HQ_STRIDE = 272, HT_STRIDE = 48;
constexpr int H_QA = 0, H_KD = 4352, H_KH = 8704, H_VT = 14848, H_DEC = 20992, H_OPER = 21504, H_RAW = 2 * H_OPER, H_RAWB = 16384;
__device__ __forceinline__ void phase_hgrn(const Params& p, LAS unsigned char* lds, int G) {
    const int tid = threadIdx.x, lane = tid & 63, wave = __builtin_amdgcn_readfirstlane(tid >> 6), fr = lane & 15, g = lane >> 4;
    const bf16_t* PROJ = (const bf16_t*)(p.ws + WS_PROJ);
    const int NCH = SEQ / 16;
    for (int item = blockIdx.x; item < 128; item += G) {
        const int dir = item & 1, h = (item >> 1) & 3, b = item >> 3;
        bf16_t* O = (bf16_t*)p.out + (size_t)dir * T * 512;
        const int ck = dir ? C_KB : C_KF, cl = dir ? C_LFB : C_LFF;
        const bool isv = tid >= 256; const int arow = (tid & 255) >> 4, ac8 = (tid & 15) * 8;
        u32x4 rq = (u32x4){0u, 0u, 0u, 0u}, rk = rq, rl = rq;
#define HG_GLOAD(ch) do { const int pos_ = (ch) * 16 + arow, tr_ = dir ? SEQ - 1 - pos_ : pos_; \
            const bf16_t* rp_ = PROJ + (size_t)(b * SEQ + tr_) * PP + h * 128 + ac8; \
            if (isv) { rq = *(const u32x4*)(rp_ + C_V); } else { rq = *(const u32x4*)(rp_ + C_Q); rk = *(const u32x4*)(rp_ + ck); rl = *(const u32x4*)(rp_ + cl); } } while (0)
#define HG_RAWSTORE(par) do { LAS unsigned char* R_ = lds + H_RAW + (par) * H_RAWB + arow * 256 + ac8 * 2; \
            if (isv) { *(LAS u32x4*)(R_ + 12288) = rq; } else { *(LAS u32x4*)R_ = rq; *(LAS u32x4*)(R_ + 4096) = rk; *(LAS u32x4*)(R_ + 8192) = rl; } } while (0)
        const int pc = tid & 127, part = tid >> 7;
        auto phaseB = [&](int par) {
            const LAS unsigned char* R = lds + H_RAW + par * H_RAWB; LAS unsigned char* OP = lds + par * H_OPER;
            float pre = 0.f, total = 0.f;
#pragma unroll
            for (int t = 0; t < 16; ++t) { const float v = __uint_as_float((unsigned)(*(const LAS unsigned short*)(R + 8192 + t * 256 + pc * 2)) << 16); total += v; pre += (t < 4 * part) ? v : 0.f; }
            float bb = pre; float kh[4], vv[4];
#pragma unroll
            for (int j = 0; j < 4; ++j) {
                const int t = 4 * part + j;
                const float lfv = __uint_as_float((unsigned)(*(const LAS unsigned short*)(R + 8192 + t * 256 + pc * 2)) << 16);
                const float qv = __uint_as_float((unsigned)(*(const LAS unsigned short*)(R + t * 256 + pc * 2)) << 16);
                const float kv = __uint_as_float((unsigned)(*(const LAS unsigned short*)(R + 4096 + t * 256 + pc * 2)) << 16);
                vv[j] = __uint_as_float((unsigned)(*(const LAS unsigned short*)(R + 12288 + t * 256 + pc * 2)) << 16);
                bb += lfv;
                *(LAS unsigned short*)(OP + H_QA + t * HQ_STRIDE + pc * 2) = (unsigned short)f2bf(qv * __expf(bb));
                *(LAS unsigned short*)(OP + H_KD + t * HQ_STRIDE + pc * 2) = (unsigned short)f2bf(kv * __expf(-bb));
                kh[j] = kv * __expf(total - bb);
            }
            *(LAS u32x2*)(OP + H_KH + pc * HT_STRIDE + part * 8) = (u32x2){pk2(kh[0], kh[1]), pk2(kh[2], kh[3])};
            *(LAS u32x2*)(OP + H_VT + pc * HT_STRIDE + part * 8) = (u32x2){pk2(vv[0], vv[1]), pk2(vv[2], vv[3])};
            if (part == 0) *(LAS float*)(OP + H_DEC + pc * 4) = __expf(total);
        };
        f32x4 S[8];
#pragma unroll
        for (int kt = 0; kt < 8; ++kt) S[kt] = (f32x4){0.f, 0.f, 0.f, 0.f};
        __syncthreads();
        HG_GLOAD(0); HG_RAWSTORE(0); HG_GLOAD(1);
        __syncthreads();
        phaseB(0); HG_RAWSTORE(1);
        __syncthreads();
        for (int i = 0; i < NCH; ++i) {
            if (i + 2 < NCH) HG_GLOAD(i + 2);
            if (i + 1 < NCH) phaseB((i + 1) & 1);
            {
                const LAS unsigned char* OP = lds + (i & 1) * H_OPER;
                f32x4 o = (f32x4){0.f, 0.f, 0.f, 0.f};
#pragma unroll
                for (int j = 0; j < 4; ++j) {
                    u32x4 w; w.x = pk2(S[2 * j][0], S[2 * j][1]); w.y = pk2(S[2 * j][2], S[2 * j][3]); w.z = pk2(S[2 * j + 1][0], S[2 * j + 1][1]); w.w = pk2(S[2 * j + 1][2], S[2 * j + 1][3]);
                    const u32x2 a0 = *(const LAS u32x2*)(OP + H_QA + fr * HQ_STRIDE + (32 * j + 4 * g) * 2), a1 = *(const LAS u32x2*)(OP + H_QA + fr * HQ_STRIDE + (32 * j + 16 + 4 * g) * 2);
                    o = __builtin_amdgcn_mfma_f32_16x16x32_bf16(__builtin_bit_cast(bf16x8, (u32x4){a0.x, a0.y, a1.x, a1.y}), __builtin_bit_cast(bf16x8, w), o, 0, 0, 0);
                }
                f32x4 X = (f32x4){0.f, 0.f, 0.f, 0.f};
#pragma unroll
                for (int j = 0; j < 4; ++j) {
                    const bf16x8 ak = *(const LAS bf16x8*)(OP + H_KD + fr * HQ_STRIDE + (32 * j + 8 * g) * 2), bq = *(const LAS bf16x8*)(OP + H_QA + fr * HQ_STRIDE + (32 * j + 8 * g) * 2);
                    X = __builtin_amdgcn_mfma_f32_16x16x32_bf16(ak, bq, X, 0, 0, 0);
                }
#pragma unroll
                for (int r = 0; r < 4; ++r) X[r] = (4 * g + r > fr) ? 0.f : X[r];
                const u32x2 vlo = *(const LAS u32x2*)(OP + H_VT + (16 * wave + fr) * HT_STRIDE + g * 8);
                const bf16x8 vb = __builtin_bit_cast(bf16x8, (u32x4){vlo.x, vlo.y, 0u, 0u});
                const bf16x8 pa = __builtin_bit_cast(bf16x8, (u32x4){pk2(X[0], X[1]), pk2(X[2], X[3]), 0u, 0u});
                o = __builtin_amdgcn_mfma_f32_16x16x32_bf16(pa, vb, o, 0, 0, 0);
#pragma unroll
                for (int r = 0; r < 4; ++r) { const int pos = i * 16 + 4 * g + r, tr = dir ? SEQ - 1 - pos : pos; O[(size_t)(b * SEQ + tr) * 512 + h * 128 + 16 * wave + fr] = (bf16_t)f2bf(o[r]); }
#pragma unroll
                for (int kt = 0; kt < 8; ++kt) {
                    const f32x4 dc = *(const LAS f32x4*)(OP + H_DEC + (16 * kt + 4 * g) * 4);
                    const u32x2 klo = *(const LAS u32x2*)(OP + H_KH + (16 * kt + fr) * HT_STRIDE + g * 8);
                    S[kt] = __builtin_amdgcn_mfma_f32_16x16x32_bf16(__builtin_bit_cast(bf16x8, (u32x4){klo.x, klo.y, 0u, 0u}), vb, S[kt] * dc, 0, 0, 0);
                }
            }
            if (i + 2 < NCH) HG_RAWSTORE(i & 1);
            __syncthreads();
        }
    }
}

constexpr int KT_STRIDE = 272, VT_STRIDE = 144;
constexpr int ATT_BUF = 64 * KT_STRIDE + 128 * VT_STRIDE;
constexpr int QUANT_ITEMS = 256;
__device__ __forceinline__ void quant_tables(const Params& p, int gw, int NGW, int lane) {
    unsigned char* ws = p.ws;
#define PQ_LOAD(dst, r0_) { _Pragma("unroll") for (int u = 0; u < 4; ++u) { const int r = ((r0_) + u * NGW) < 2 * 16384 ? ((r0_) + u * NGW) : gw; const bool isv = r >= 16384; const int e = isv ? r - 16384 : r; \
            const f32x4* xr = (const f32x4*)((isv ? p.in[I_V] : p.in[I_U]) + (size_t)e * D) + lane; _Pragma("unroll") for (int j = 0; j < 4; ++j) dst[u][j] = xr[64 * j]; } }
#define PQ_PROC(src, r0_) { _Pragma("unroll") for (int u = 0; u < 4; ++u) { const int r = (r0_) + u * NGW; if (r < 2 * 16384) { \
            const bool isv = r >= 16384; const int e = isv ? r - 16384 : r; f32x4 v[4]; float am = 0.f; \
            _Pragma("unroll") for (int j = 0; j < 4; ++j) { v[j] = src[u][j]; if (!isv) v[j] = v[j] * ((const f32x4*)p.in[I_G2])[64 * j + lane]; \
                am = fmaxf(am, fmaxf(fmaxf(fabsf(v[j].x), fabsf(v[j].y)), fmaxf(fabsf(v[j].z), fabsf(v[j].w)))); } \
            am = wave_max(am); const float sc = am > 0.f ? am * (1.f / 7.f) : 1.f, inv = 1.f / sc; unsigned pk[4]; int qs = 0; \
            _Pragma("unroll") for (int j = 0; j < 4; ++j) { \
                const int q0 = (int)rintf(v[j].x * inv), q1 = (int)rintf(v[j].y * inv), q2 = (int)rintf(v[j].z * inv), q3 = (int)rintf(v[j].w * inv); qs += (q0 + q1) + (q2 + q3); \
                pk[j] = (unsigned)((q0 & 0xFF) | ((q1 & 0xFF) << 8) | ((q2 & 0xFF) << 16) | ((q3 & 0xFF) << 24)); } \
            if (isv) {   \
                _Pragma("unroll") for (int j = 0; j < 4; ++j) { const unsigned k_ = pk[j]; \
                    *(unsigned short*)(ws + WS_VE + ((size_t)j * 16384 + e) * VSL + 2 * lane) = (unsigned short)(((k_ & 0xFu) ^ 8u) | ((k_ >> 4) & 0xF0u) | ((((k_ >> 16) & 0xFu) ^ 8u) << 8) | ((k_ >> 12) & 0xF000u)); } \
                if (lane == 0) ((float*)(ws + WS_VSC))[e] = sc; } \
            else {   \
                _Pragma("unroll") for (int j = 0; j < 2; ++j) *(unsigned*)(ws + WS_UT + (size_t)e * 512 + 256 * j + 4 * lane) = (pk[j] & 0x0F0F0F0Fu) | ((pk[j + 2] << 4) & 0xF0F0F0F0u); \
                const float qt = wave_sum((float)qs); if (lane == 0) { ((float*)(ws + WS_USC))[e] = sc; ((float*)(ws + WS_US8))[e] = 8.f * qt; } } } } }
    for (int r0 = gw; r0 < 2 * 16384; r0 += 4 * NGW) { f32x4 va[4][4]; PQ_LOAD(va, r0) PQ_PROC(va, r0) }
}
__device__ __forceinline__ float MAX3_(float a, float b, float c) { float r; asm("v_max3_f32 %0, %1, %2, %3" : "=v"(r) : "v"(a), "v"(b), "v"(c)); return r; }
__device__ __forceinline__ void phase_attn(const Params& p, LAS unsigned char* lds, int G) {
    const int tid = threadIdx.x, lane = tid & 63, wave = __builtin_amdgcn_readfirstlane(tid >> 6), fr = lane & 15, fq = lane >> 4;
    const bf16_t* PROJ = (const bf16_t*)(p.ws + WS_PROJ);
    const bf16_t* VT = (const bf16_t*)(p.ws + WS_VT);
    bf16_t* MIXED = (bf16_t*)(p.ws + WS_XN);
    const float* sm = (const float*)(p.ws + WS_SM);
    LAS unsigned char* LK = lds; LAS unsigned char* LV = lds + 64 * KT_STRIDE; LAS float* LB = (LAS float*)(lds + 2 * ATT_BUF);
    const float lam = sm[SM_LAM];
    float vinf = __builtin_inff(); asm volatile("" : "+v"(vinf));
    unsigned* qctr = (unsigned*)(p.ws + 32768);
    volatile LAS unsigned* qslot = (volatile LAS unsigned*)(lds + 131072 + 320 + 64);
    for (;;) {
        __syncthreads();
        if (tid == 0) qslot[0] = __hip_atomic_fetch_add(qctr, 1u, __ATOMIC_RELAXED, __HIP_MEMORY_SCOPE_AGENT);
        __syncthreads();
        const int item = (int)qslot[0];
        if (item >= 1024 + QUANT_ITEMS) break;
        if (item >= 1024) { quant_tables(p, (item - 1024) * NWAVES + wave, QUANT_ITEMS * NWAVES, lane); continue; }
        const int bh = item >> 4, qb = item & 15, b = bh >> 2, h = bh & 3;
        const int qabs = qb * 128 + wave * 16 + fr;
        const size_t qrow = (size_t)b * SEQ + qabs;
        __syncthreads();
        for (int i = tid; i < 257; i += NTHREADS) LB[i] = sm[SM_BT + h * BT_STRIDE + i];
        bf16x8 qf[2][2];
#pragma unroll
        for (int m = 0; m < 2; ++m)
#pragma unroll
            for (int kk = 0; kk < 2; ++kk) qf[m][kk] = *(const bf16x8*)(PROJ + qrow * PP + C_DQ + h * 128 + m * 64 + kk * 32 + fq * 8);
        float mrun[2] = {0.f, 0.f};
        f32x4 lacc[2] = {(f32x4){0.f, 0.f, 0.f, 0.f}, (f32x4){0.f, 0.f, 0.f, 0.f}};
        f32x4 o[2][8];
#pragma unroll
        for (int m = 0; m < 2; ++m)
#pragma unroll
            for (int dt = 0; dt < 8; ++dt) o[m][dt] = (f32x4){0.f, 0.f, 0.f, 0.f};
        u32x4 kreg[2], vreg[2];
        const bf16_t* kg[2]; const bf16_t* vg[2]; int koff[2], voff[2];
#pragma unroll
        for (int i = 0; i < 2; ++i) { const int c = tid + i * 512;
            const int kr = c >> 4, kc = (c & 15) * 8; kg[i] = PROJ + ((size_t)b * SEQ + kr) * PP + C_DK + h * 128 + kc; koff[i] = kr * KT_STRIDE + kc * 2;
            const int vr = c >> 3, vc = (c & 7) * 8; vg[i] = VT + (size_t)(h * 128 + vr) * T + (size_t)b * SEQ + vc; voff[i] = vr * VT_STRIDE + vc * 2; }
#pragma unroll
        for (int i = 0; i < 2; ++i) { kreg[i] = *(const u32x4*)kg[i]; vreg[i] = *(const u32x4*)vg[i]; }
#pragma unroll
        for (int i = 0; i < 2; ++i) { *(LAS u32x4*)(LK + koff[i]) = kreg[i]; *(LAS u32x4*)(LV + voff[i]) = vreg[i]; }
        __syncthreads();
        const int Qw = qb * 128 + wave * 16;
        for (int kt = 0; kt < SEQ / 64; ++kt) {
            const int pbuf = (kt & 1) * ATT_BUF;
            if (kt + 1 < SEQ / 64) {
#pragma unroll
                for (int i = 0; i < 2; ++i) { kreg[i] = *(const u32x4*)(kg[i] + (size_t)(kt + 1) * 64 * PP); vreg[i] = *(const u32x4*)(vg[i] + (kt + 1) * 64); }
            }
            const int k0 = kt * 64;
            const bool farl = (k0 + 63 - Qw) <= -91, farr = (k0 - (Qw + 15)) >= 91;
            const float binit = farl ? LB[0] : (farr ? LB[256] : 0.f);
            f32x4 s[2][4];
#pragma unroll
            for (int m = 0; m < 2; ++m) {
                const float ci = binit - mrun[m];
#pragma unroll
                for (int ks = 0; ks < 4; ++ks) {
                    f32x4 a = (f32x4){ci, ci, ci, ci};
#pragma unroll
                    for (int kk = 0; kk < 2; ++kk) {
                        const bf16x8 kf = *(const LAS bf16x8*)(LK + pbuf + (16 * ks + fr) * KT_STRIDE + (m * 64 + kk * 32 + fq * 8) * 2);
                        a = __builtin_amdgcn_mfma_f32_16x16x32_bf16(kf, qf[m][kk], a, 0, 0, 0);
                    }
                    s[m][ks] = a;
                }
            }
            if (!(farl || farr)) {
#pragma unroll
                for (int ks = 0; ks < 4; ++ks)
#pragma unroll
                    for (int r = 0; r < 4; ++r) {
                        int rel = k0 + 16 * ks + 4 * fq + r - qabs; rel = rel < -128 ? -128 : (rel > 128 ? 128 : rel);
                        const float bv = LB[rel + 128];
                        s[0][ks][r] += bv; s[1][ks][r] += bv;
                    }
            }
            bf16x8 pb[2][2];
#pragma unroll
            for (int m = 0; m < 2; ++m) {
                float mx = MAX3_(__builtin_amdgcn_fmed3f(s[m][0][0], s[m][1][0], vinf), __builtin_amdgcn_fmed3f(s[m][2][0], s[m][3][0], vinf), s[m][0][1]);
                mx = MAX3_(mx, s[m][0][2], s[m][0][3]); mx = MAX3_(mx, s[m][1][1], s[m][1][2]); mx = MAX3_(mx, s[m][1][3], s[m][2][1]);
                mx = MAX3_(mx, s[m][2][2], s[m][2][3]); mx = MAX3_(mx, s[m][3][1], s[m][3][2]); mx = MAX3_(mx, mx, s[m][3][3]);
                { float a_ = mx, b_ = mx; swap16_(a_, b_); mx = MAX3_(a_, b_, b_); }
                { float a_ = mx, b_ = mx; swap32_(a_, b_); mx = MAX3_(a_, b_, b_); }
                if (__any(fabsf(mx) > 8.0f)) {
                    const float dl = fabsf(mx) > 8.0f ? mx : 0.f, alpha = __builtin_amdgcn_exp2f(-dl);
                    mrun[m] += dl; lacc[m] *= alpha;
#pragma unroll
                    for (int ks = 0; ks < 4; ++ks) s[m][ks] = s[m][ks] - dl;
#pragma unroll
                    for (int dt = 0; dt < 8; ++dt) o[m][dt] *= alpha;
                }
#pragma unroll
                for (int ks = 0; ks < 4; ++ks)
#pragma unroll
                    for (int r = 0; r < 4; ++r) s[m][ks][r] = __builtin_amdgcn_exp2f(s[m][ks][r]);
#pragma unroll
                for (int k2 = 0; k2 < 2; ++k2) {
                    u32x4 w; w.x = pk2(s[m][2 * k2][0], s[m][2 * k2][1]); w.y = pk2(s[m][2 * k2][2], s[m][2 * k2][3]);
                    w.z = pk2(s[m][2 * k2 + 1][0], s[m][2 * k2 + 1][1]); w.w = pk2(s[m][2 * k2 + 1][2], s[m][2 * k2 + 1][3]);
                    pb[m][k2] = __builtin_bit_cast(bf16x8, w);
                }
            }
            const bf16x8 ones = __builtin_bit_cast(bf16x8, (u32x4){0x3F803F80u, 0x3F803F80u, 0x3F803F80u, 0x3F803F80u});
#pragma unroll
            for (int k2 = 0; k2 < 2; ++k2) {
                lacc[0] = __builtin_amdgcn_mfma_f32_16x16x32_bf16(ones, pb[0][k2], lacc[0], 0, 0, 0);
                lacc[1] = __builtin_amdgcn_mfma_f32_16x16x32_bf16(ones, pb[1][k2], lacc[1], 0, 0, 0);
#pragma unroll
                for (int dt = 0; dt < 8; ++dt) {
                    const u32x2 lo = *(const LAS u32x2*)(LV + pbuf + (16 * dt + fr) * VT_STRIDE + (32 * k2 + 4 * fq) * 2);
                    const u32x2 hi = *(const LAS u32x2*)(LV + pbuf + (16 * dt + fr) * VT_STRIDE + (32 * k2 + 16 + 4 * fq) * 2);
                    const bf16x8 vf = __builtin_bit_cast(bf16x8, (u32x4){lo.x, lo.y, hi.x, hi.y});
                    o[0][dt] = __builtin_amdgcn_mfma_f32_16x16x32_bf16(vf, pb[0][k2], o[0][dt], 0, 0, 0);
                    o[1][dt] = __builtin_amdgcn_mfma_f32_16x16x32_bf16(vf, pb[1][k2], o[1][dt], 0, 0, 0);
                }
            }
            if (kt + 1 < SEQ / 64) {
                const int nbuf = ((kt + 1) & 1) * ATT_BUF;
#pragma unroll
                for (int i = 0; i < 2; ++i) { *(LAS u32x4*)(LK + nbuf + koff[i]) = kreg[i]; *(LAS u32x4*)(LV + nbuf + voff[i]) = vreg[i]; }
            }
            __syncthreads();
        }
        float inv[2];
#pragma unroll
        for (int m = 0; m < 2; ++m) inv[m] = __builtin_amdgcn_rcpf(lacc[m][0]);
        float ssq = 0.f;
#pragma unroll
        for (int dt = 0; dt < 8; ++dt)
#pragma unroll
            for (int r = 0; r < 4; ++r) { const float ov = o[0][dt][r] * inv[0] - lam * (o[1][dt][r] * inv[1]); o[0][dt][r] = ov; ssq += ov * ov; }
        ssq += __shfl_xor(ssq, 16); ssq += __shfl_xor(ssq, 32);
        const float rs = rsqrtf(ssq * (1.f / 128.f) + EPS) * 0.8f;
        const float* og = p.in[I_DOG];
#pragma unroll
        for (int dt = 0; dt < 8; ++dt) {
            const f32x4 g = *(const f32x4*)(og + 16 * dt + 4 * fq);
            const f32x4 y = o[0][dt] * rs * g;
            *(u32x2*)(MIXED + qrow * D + 512 + h * 128 + 16 * dt + 4 * fq) = (u32x2){pk2(y[0], y[1]), pk2(y[2], y[3])};
        }
    }
}

__device__ __forceinline__ void phase_mix(const Params& p, int vcu, int G) {
    const int tid = threadIdx.x, lane = tid & 63, wave = __builtin_amdgcn_readfirstlane(tid >> 6);
    const bf16_t* PROJ = (const bf16_t*)(p.ws + WS_PROJ);
    const bf16_t* OF = (const bf16_t*)p.out; const bf16_t* OB = OF + (size_t)T * 512;
    bf16_t* MIXED = (bf16_t*)(p.ws + WS_XN);
    const float* hog = p.in[I_HOG];
    const f32x4 g0 = *(const f32x4*)(hog + (lane & 15) * 8), g1 = *(const f32x4*)(hog + (lane & 15) * 8 + 4);
    for (int m0 = vcu * NWAVES + wave; m0 < T; m0 += 4 * G * NWAVES) {
        u32x4 av[4], bv[4], gv[4];
#pragma unroll
        for (int u = 0; u < 4; ++u) { const int m = (m0 + u * G * NWAVES) < T ? (m0 + u * G * NWAVES) : m0;
            av[u] = *(const u32x4*)(OF + (size_t)m * 512 + 8 * lane); bv[u] = *(const u32x4*)(OB + (size_t)m * 512 + 8 * lane); gv[u] = *(const u32x4*)(PROJ + (size_t)m * PP + C_G + 8 * lane); }
#pragma unroll
        for (int u = 0; u < 4; ++u) {
            const int m = m0 + u * G * NWAVES; if (m >= T) break;
            const u32x4 a = av[u], bb = bv[u], gg = gv[u];
            float o[8]; float ss = 0.f;
#pragma unroll
            for (int i = 0; i < 4; ++i) { o[2 * i] = bflo(a[i]) + bflo(bb[i]); o[2 * i + 1] = bfhi(a[i]) + bfhi(bb[i]); ss += o[2 * i] * o[2 * i] + o[2 * i + 1] * o[2 * i + 1]; }
            ss += dpp_mov<0xB1>(ss); ss += dpp_mov<0x4E>(ss); ss += dpp_mov<0x141>(ss); ss += dpp_mov<0x140>(ss);
            const float rs = rsqrtf(ss * (1.f / 128.f) + EPS);
            float y[8];
#pragma unroll
            for (int i = 0; i < 4; ++i) { y[2 * i] = o[2 * i] * rs * (i < 2 ? g0[2 * i] : g1[2 * i - 4]) * bflo(gg[i]); y[2 * i + 1] = o[2 * i + 1] * rs * (i < 2 ? g0[2 * i + 1] : g1[2 * i - 3]) * bfhi(gg[i]); }
            *(u32x4*)(MIXED + (size_t)m * D + 8 * lane) = (u32x4){pk2(y[0], y[1]), pk2(y[2], y[3]), pk2(y[4], y[5]), pk2(y[6], y[7])};
        }
    }
}

__device__ __forceinline__ void phase_hquant(const Params& p, int vcu, int G) {
    const int tid = threadIdx.x, lane = tid & 63, wave = __builtin_amdgcn_readfirstlane(tid >> 6);
    const bf16_t* H1B = (const bf16_t*)(p.ws + WS_H1B); const float* SS = (const float*)(p.ws + WS_SS);
    for (int t0 = vcu * NWAVES + wave; t0 < T; t0 += 4 * G * NWAVES) {
        u32x4 ha[4], hb[4];
#pragma unroll
        for (int u = 0; u < 4; ++u) { const int t = (t0 + u * G * NWAVES) < T ? (t0 + u * G * NWAVES) : t0; ha[u] = *(const u32x4*)(H1B + (size_t)t * D + 8 * lane); hb[u] = *(const u32x4*)(H1B + (size_t)t * D + 512 + 8 * lane); }
#pragma unroll
        for (int u = 0; u < 4; ++u) {
            const int t = t0 + u * G * NWAVES; if (t >= T) break;
            const u32x4 h0 = ha[u], h1 = hb[u];
            float hf[16]; float am = 0.f;
#pragma unroll
            for (int k = 0; k < 4; ++k) { hf[2 * k] = bflo(h0[k]); hf[2 * k + 1] = bfhi(h0[k]); hf[8 + 2 * k] = bflo(h1[k]); hf[8 + 2 * k + 1] = bfhi(h1[k]); }
#pragma unroll
            for (int k = 0; k < 16; ++k) am = fmaxf(am, fabsf(hf[k]));
            am = wave_max(am);
            const float iv = am > 0.f ? 127.f / am : 0.f;
            u32x4 q;
#pragma unroll
            for (int w = 0; w < 4; ++w) { const int q0 = (int)rintf(hf[4 * w] * iv), q1 = (int)rintf(hf[4 * w + 1] * iv), q2 = (int)rintf(hf[4 * w + 2] * iv), q3 = (int)rintf(hf[4 * w + 3] * iv);
                q[w] = (unsigned)((q0 & 0xFF) | ((q1 & 0xFF) << 8) | ((q2 & 0xFF) << 16) | ((q3 & 0xFF) << 24)); }
            u32x2 ph, pl;
#pragma unroll
            for (int w = 0; w < 2; ++w) { ph[w] = ((q[w] >> 4) & 0x0F0F0F0Fu) | (q[2 + w] & 0xF0F0F0F0u); pl[w] = ((q[w] & 0x0F0F0F0Fu) | ((q[2 + w] << 4) & 0xF0F0F0F0u)) ^ 0x88888888u; }
            *(u32x2*)(p.ws + WS_H1Q + (size_t)t * D + 8 * lane) = ph; *(u32x2*)(p.ws + WS_H1Q + (size_t)t * D + 512 + 8 * lane) = pl;
            if (lane == 0) ((float*)(p.ws + WS_HSC))[t] = am * (1.f / 127.f) * row_rstd(SS, (size_t)t);
        }
    }
}
__device__ __forceinline__ unsigned ford(float f) { const unsigned u = __float_as_uint(f); return (u & 0x80000000u) ? ~u : (u | 0x80000000u); }
__device__ __forceinline__ float funord(unsigned u) { u = (u & 0x80000000u) ? (u & 0x7fffffffu) : ~u; return __uint_as_float(u); }
template <int N> __device__ __forceinline__ void bitonic_sort_desc(unsigned (&v)[N]) {
#pragma unroll
    for (int k = 2; k <= N; k <<= 1)
#pragma unroll
        for (int j = k >> 1; j > 0; j >>= 1)
#pragma unroll
            for (int i = 0; i < N; ++i) { const int l = i ^ j;
                if (l > i) { const unsigned a = v[i], b = v[l]; const unsigned mx = a > b ? a : b, mn = a > b ? b : a; if ((i & k) == 0) { v[i] = mx; v[l] = mn; } else { v[i] = mn; v[l] = mx; } } }
}
__device__ __forceinline__ void merge_top16(unsigned (&a)[16], const unsigned (&b)[16]) {
#pragma unroll
    for (int i = 0; i < 16; ++i) a[i] = a[i] > b[15 - i] ? a[i] : b[15 - i];
#pragma unroll
    for (int j = 8; j > 0; j >>= 1)
#pragma unroll
        for (int i = 0; i < 16; ++i) { const int l = i ^ j; if (l > i) { const unsigned x = a[i], y = a[l]; a[i] = x > y ? x : y; a[l] = x > y ? y : x; } }
}
__device__ __forceinline__ void top16_of64(const unsigned (&v)[64], unsigned (&out)[16]) {
    unsigned g1[16], g2[16], g3[16];
#pragma unroll
    for (int i = 0; i < 16; ++i) { out[i] = v[i]; g1[i] = v[16 + i]; g2[i] = v[32 + i]; g3[i] = v[48 + i]; }
    bitonic_sort_desc<16>(out); bitonic_sort_desc<16>(g1); bitonic_sort_desc<16>(g2); bitonic_sort_desc<16>(g3);
    merge_top16(out, g1); merge_top16(g2, g3); merge_top16(out, g2);
}
__device__ __forceinline__ unsigned xchg32u(unsigned v, int lane) { return __builtin_bit_cast(unsigned, xchg32(__builtin_bit_cast(float, v), lane)); }
constexpr int TK_KROW = 272, TK_TAB = 256 * TK_KROW;
__device__ __forceinline__ void phase_topk(const Params& p, LAS unsigned char* lds, int vcu, int G) {
    const int tid = threadIdx.x, lane = tid & 63, wave = __builtin_amdgcn_readfirstlane(tid >> 6), r32 = lane & 31, hi = lane >> 5;
    const bf16_t* QP = (const bf16_t*)(p.ws + WS_QP);
    const bf16_t* KEYS = (const bf16_t*)(p.ws + WS_KEYS);
    int* IDX = (int*)(p.ws + WS_IDX);
    LAS unsigned* tab = (LAS unsigned*)(lds + TK_TAB) + wave * 8 * 64 + lane;
    for (int item = blockIdx.x; item < (T / 256) * 2; item += G) {
        const int tg = item % (T / 256), hg = item / (T / 256);
        const size_t tok = (size_t)(tg * 8 + wave) * 32 + r32;
        for (int hh = 0; hh < 4; ++hh) {
            const int h = hg * 4 + hh;
            __syncthreads();
#pragma unroll
            for (int c8 = 0; c8 < 8; ++c8) { const int c = tid + c8 * NTHREADS, row = c >> 4, ch = c & 15;
                *(LAS u32x4*)(lds + row * TK_KROW + ch * 16) = *(const u32x4*)(KEYS + (size_t)(h * 256 + row) * 128 + ch * 8); }
            __syncthreads();
            unsigned lst[2][16];
#pragma unroll
            for (int pp = 0; pp < 2; ++pp) {
                f32x16 acc[4];
#pragma unroll
                for (int kt = 0; kt < 4; ++kt)
#pragma unroll
                    for (int r = 0; r < 16; ++r) acc[kt][r] = 0.f;
                const bf16_t* qrow = QP + tok * QPS + h * 256 + pp * 128 + 8 * hi;
                const LAS unsigned char* kb = lds + (pp * 128 + r32) * TK_KROW + 16 * hi;
#pragma unroll
                for (int s2 = 0; s2 < 8; ++s2) {
                    const bf16x8 bq = *(const bf16x8*)(qrow + 16 * s2);
#pragma unroll
                    for (int kt = 0; kt < 4; ++kt) {
                        const bf16x8 ak = *(const LAS bf16x8*)(kb + kt * 32 * TK_KROW + 32 * s2);
                        acc[kt] = __builtin_amdgcn_mfma_f32_32x32x16_bf16(ak, bq, acc[kt], 0, 0, 0);
                    }
                }
                unsigned v[64];
#pragma unroll
                for (int kt = 0; kt < 4; ++kt)
#pragma unroll
                    for (int r = 0; r < 16; ++r) { const int n = 32 * kt + (r & 3) + 8 * (r >> 2) + 4 * hi; v[kt * 16 + r] = (ford(acc[kt][r]) & ~0x7Fu) | (unsigned)(127 - n); }
                unsigned own[16], oth[16];
                top16_of64(v, own);
#pragma unroll
                for (int j = 0; j < 16; ++j) oth[j] = xchg32u(own[j], lane);
                merge_top16(own, oth);
#pragma unroll
                for (int j = 0; j < 16; ++j) lst[pp][j] = own[j];
            }
            float a[16], bs[16];
#pragma unroll
            for (int j = 0; j < 16; ++j) { a[j] = funord(lst[0][j] & ~0x7Fu); bs[j] = funord(lst[1][j] & ~0x7Fu); }
#pragma unroll
            for (int m = 0; m < 4; ++m) {
                tab[m * 64] = (127u - (lst[0][4 * m] & 0x7Fu)) | ((127u - (lst[0][4 * m + 1] & 0x7Fu)) << 8) | ((127u - (lst[0][4 * m + 2] & 0x7Fu)) << 16) | ((127u - (lst[0][4 * m + 3] & 0x7Fu)) << 24);
                tab[(4 + m) * 64] = (127u - (lst[1][4 * m] & 0x7Fu)) | ((127u - (lst[1][4 * m + 1] & 0x7Fu)) << 8) | ((127u - (lst[1][4 * m + 2] & 0x7Fu)) << 16) | ((127u - (lst[1][4 * m + 3] & 0x7Fu)) << 24);
            }
            unsigned cand[64];
            {
                int c = 0;
#pragma unroll
                for (int i = 0; i < 16; ++i)
#pragma unroll
                    for (int j = 0; j < 16; ++j)
                        if ((i + 1) * (j + 1) <= 16) { cand[c] = (ford(a[i] + bs[j]) & ~0xFFu) | (unsigned)(255 - (i * 16 + j)); ++c; }
#pragma unroll
                for (int q = 50; q < 64; ++q) cand[q] = 0u;
            }
            unsigned best[16], eidx[16];
            top16_of64(cand, best);
            LDS_WAIT();
#pragma unroll
            for (int r = 0; r < 16; ++r) { const unsigned code = 255u - (best[r] & 0xFFu), ci = code >> 4, cj = code & 15u;
                const unsigned wi = tab[(ci >> 2) * 64], wj = tab[(4 + (cj >> 2)) * 64];
                eidx[r] = ((wi >> (8 * (ci & 3u))) & 0x7Fu) * 128u + ((wj >> (8 * (cj & 3u))) & 0x7Fu); }
            LDS_WAIT();
            if (hi == 0) {
                float g[16]; const float mx = funord(best[0] & ~0xFFu); float tot = 0.f;
#pragma unroll
                for (int r = 0; r < 16; ++r) { g[r] = __expf(funord(best[r] & ~0xFFu) - mx); tot += g[r]; }
                const float it_ = 1.f / tot;
                unsigned* rp = (unsigned*)IDX + (tok * 8 + h) * 16;
#pragma unroll
                for (int q4 = 0; q4 < 4; ++q4)
                    *(u32x4*)(rp + 4 * q4) = (u32x4){eidx[4 * q4] | (f2bf(g[4 * q4] * it_) << 16), eidx[4 * q4 + 1] | (f2bf(g[4 * q4 + 1] * it_) << 16), eidx[4 * q4 + 2] | (f2bf(g[4 * q4 + 2] * it_) << 16), eidx[4 * q4 + 3] | (f2bf(g[4 * q4 + 3] * it_) << 16)};
            }
        }
    }
}

typedef float f32x2_ __attribute__((ext_vector_type(2)));
__device__ __forceinline__ float gelu_exact(float v) {
    const float av = fabsf(v), t = __builtin_amdgcn_rcpf(av * 0.2316418882f + 1.0f);
    float q = t * 0.5307027145f + (-0.7265760135f); q = q * t + 0.7107068705f; q = q * t + (-0.142248368f); q = q * t + 0.127414796f; q = q * t;
    const float e = __builtin_amdgcn_exp2f((v * v) * (-0.72134752044f));
    const float m = v * (q * e);
    return v < 0.f ? m : v - m;
}
typedef float f32x2_ __attribute__((ext_vector_type(2)));
__device__ __forceinline__ void phase_peer_u(const Params& p, LAS unsigned char* lds, int G, int mx, int mj) {
    const int tid = threadIdx.x, lane = tid & 63, wave = __builtin_amdgcn_readfirstlane(tid >> 6), bx = blockIdx.x;
    const bool xl = (G % 8 == 0);
    const int x = xl ? mx : 0, nx = xl ? 8 : 1, jb = xl ? mj : bx, nw = (xl ? G / 8 : G) * NWAVES, widx = jb * NWAVES + wave;
    const unsigned char* H1Q = (const unsigned char*)(p.ws + WS_H1Q); const unsigned char* UQ = (const unsigned char*)(p.ws + WS_UT);
    const unsigned* REC = (const unsigned*)(p.ws + WS_IDX); const float* HSC = (const float*)(p.ws + WS_HSC);
    const float* USC = (const float*)(p.ws + WS_USC); const float* VSC = (const float*)(p.ws + WS_VSC);
    unsigned* CI = (unsigned*)(p.ws + WS_C);
    LAS float* SU = (LAS float*)lds; LAS float* SV = SU + GRP_SIZE; LAS float* U8 = (LAS float*)(lds + 49152);
    LAS u32x2* slots = (LAS u32x2*)(lds + 16384 + wave * 2048);
    LAS u32x4* hbuf = (LAS u32x4*)(lds + 32768 + wave * 2048);
    const int K = (T - widx + nw - 1) / nw;
    const int lrow = lane >> 4, lcol = lane & 15, lc16 = 16 * lcol;
    for (int g = x; g < NGRP; g += nx) {
        __syncthreads();
        for (int i = tid; i < GRP_SIZE; i += NTHREADS) { SU[i] = USC[g * GRP_SIZE + i]; SV[i] = VSC[g * GRP_SIZE + i]; U8[i] = ((const float*)(p.ws + WS_US8))[g * GRP_SIZE + i]; }
        __syncthreads();
#define PU_R(S, k_) { const int kk_ = (k_) < K ? (k_) : K - 1; const size_t tt_ = (size_t)(widx + nw * kk_); \
            rq##S = *(const u32x2*)(REC + tt_ * 128 + 2 * lane); rr##S = HSC[tt_]; hr##S = *(const u32x4*)(H1Q + tt_ * D + 16 * lane); }
#define PU_C(S, k_) { LAS u32x2* sl_ = slots + S * 128; const bool ok_ = (k_) < K; tk##S = widx + nw * ((k_) < K ? (k_) : K - 1); rs##S = rr##S; \
            hbuf[S * 64 + lane] = hr##S; const unsigned rl##S = rq##S.x, rh##S = rq##S.y; \
            { const bool f0 = ((rl##S & 0x3FFFu) >> GRP_SHIFT) == (unsigned)g, f1 = ((rh##S & 0x3FFFu) >> GRP_SHIFT) == (unsigned)g; const unsigned long long m0 = __ballot(f0), m1 = __ballot(f1); const int n0 = __popcll(m0); \
              if (f0) sl_[(int)__builtin_amdgcn_mbcnt_hi((unsigned)(m0 >> 32), __builtin_amdgcn_mbcnt_lo((unsigned)m0, 0u))] = (u32x2){((rl##S & 0x3FFFu) << 9) | ((unsigned)(2 * lane) << 24), rl##S & 0xffff0000u}; \
              if (f1) sl_[n0 + (int)__builtin_amdgcn_mbcnt_hi((unsigned)(m1 >> 32), __builtin_amdgcn_mbcnt_lo((unsigned)m1, 0u))] = (u32x2){((rh##S & 0x3FFFu) << 9) | ((unsigned)(2 * lane + 1) << 24), rh##S & 0xffff0000u}; \
              nn##S = ok_ ? n0 + __popcll(m1) : 0; } \
            LDS_WAIT(); \
            _Pragma("unroll") for (int q = 0; q < 6; ++q) sr##S[q] = sl_[4 * q + lrow]; \
            _Pragma("unroll") for (int i = 0; i < 4; ++i) hq##S[i] = hbuf[S * 64 + 16 * i + lcol]; }
#define PU_ISSUE(R, SR, n_) { \
            _Pragma("unroll") for (int q = 0; q < 6; ++q) if (q < 4 || (n_) > 4 * q) { const bool v_ = (4 * q + lrow) < (n_); const unsigned char* a_ = UQ + (v_ ? (size_t)((SR[q].x & 0x7FFFFFu) + lc16) : (size_t)0); \
                row##R[2 * q] = *(const u32x4*)a_; row##R[2 * q + 1] = *(const u32x4*)(a_ + 256); } }
#define PU_DOT(R, HQ, ACC, n_) { _Pragma("unroll") for (int q = 0; q < 6; ++q) if (q < 4 || (n_) > 4 * q) { int a1_ = 0, a2_ = 0; \
                _Pragma("unroll") for (int i = 0; i < 2; ++i) _Pragma("unroll") for (int w = 0; w < 4; ++w) { a1_ = __builtin_amdgcn_sdot8((int)row##R[2 * q + i][w], (int)HQ[i][w], a1_, false); a2_ = __builtin_amdgcn_sdot8((int)row##R[2 * q + i][w], (int)HQ[2 + i][w], a2_, false); } \
                ACC[q] = (a1_ << 4) + a2_; } }
#define PU_EPI(S, SR, ACC, n_) { float rt_[6]; \
            _Pragma("unroll") for (int q = 0; q < 6; ++q) { rt_[q] = 0.f; if (q < 4 || (n_) > 4 * q) { float f_ = (float)ACC[q]; f_ += dpp_mov<0xB1>(f_); f_ += dpp_mov<0x4E>(f_); f_ += dpp_mov<0x141>(f_); f_ += dpp_mov<0x140>(f_); rt_[q] = f_; } } \
            float tot_ = rt_[0]; unsigned rx_ = SR[0].x, ry_ = SR[0].y; \
            _Pragma("unroll") for (int q = 1; q < 6; ++q) { const bool e_ = lcol == q; tot_ = e_ ? rt_[q] : tot_; rx_ = e_ ? SR[q].x : rx_; ry_ = e_ ? SR[q].y : ry_; } \
            if (lcol < 6 && (4 * lcol + lrow) < (n_)) { const unsigned idx_ = (rx_ >> 9) & 0x3FFFu; const int li_ = (int)(idx_ & (GRP_SIZE - 1)); \
                const float c_ = __uint_as_float(ry_) * gelu_exact((tot_ + U8[li_]) * SU[li_] * rs##S) * SV[li_]; CI[(size_t)tk##S * 128 + (rx_ >> 24)] = (f2bf(c_) << 16) | idx_; } }
#define PU_OVF(S, R) if (nn##S > 24) { for (int b1_ = 24; b1_ < nn##S; b1_ += 24) { u32x2 so2_[6]; _Pragma("unroll") for (int q = 0; q < 6; ++q) so2_[q] = slots[S * 128 + ((b1_ + 4 * q + lrow) & 127)]; \
            const int n2_ = nn##S - b1_; int ac2_[6]; PU_ISSUE(R, so2_, n2_) PU_DOT(R, hq##S, ac2_, n2_) PU_EPI(S, so2_, ac2_, n2_) } }
        u32x2 rq0, rq1; u32x4 hr0, hr1, hq0[4], hq1[4]; float rr0, rr1, rs0 = 0.f, rs1 = 0.f; int tk0 = 0, tk1 = 0, nn0 = 0, nn1 = 0;
        u32x4 rowA[12], rowB[12]; u32x2 sr0[6], sr1[6]; int acc0[6], acc1[6];
#pragma unroll
        for (int q = 0; q < 4; ++q) { hq0[q] = (u32x4){0u, 0u, 0u, 0u}; hq1[q] = hq0[q]; }
#pragma unroll
        for (int q = 0; q < 6; ++q) { sr0[q] = (u32x2){0u, 0u}; sr1[q] = sr0[q]; acc0[q] = 0; acc1[q] = 0; }
        PU_R(0, 0) PU_R(1, 1)
        PU_C(0, 0)
        PU_ISSUE(A, sr0, nn0)
        PU_R(0, 2)
        for (int k = 0; k < K; k += 2) {
            PU_C(1, k + 1)
            PU_ISSUE(B, sr1, nn1)
            PU_R(1, k + 3)
            PU_DOT(A, hq0, acc0, nn0) PU_EPI(0, sr0, acc0, nn0) PU_OVF(0, A)
            PU_C(0, k + 2)
            PU_ISSUE(A, sr0, nn0)
            PU_R(0, k + 4)
            PU_DOT(B, hq1, acc1, nn1) PU_EPI(1, sr1, acc1, nn1) PU_OVF(1, B)
        }
    }
    __syncthreads();
}
__device__ __forceinline__ void phase_peer_v(const Params& p, LAS unsigned char* lds, int G, int mx, int mj) {
    const int tid = threadIdx.x, lane = tid & 63, wave = __builtin_amdgcn_readfirstlane(tid >> 6), bx = blockIdx.x;
    const bool xl = (G % 8 == 0);
    const int x = xl ? (mx & 3) : 0, nx = xl ? 4 : 1, jb = xl ? (mx >> 2) * (G / 8) + mj : bx, nw = (xl ? G / 4 : G) * NWAVES, widx = jb * NWAVES + wave;
    const unsigned char* VQ = (const unsigned char*)(p.ws + WS_VE);
    const unsigned* CI = (const unsigned*)(p.ws + WS_C);
    bf16_t* H1B = (bf16_t*)(p.ws + WS_H1B);
    const int sub = lane & 7, es = lane >> 3;
    const int K = (T - widx + nw - 1) / nw, NB4 = (K + 3) / 4;
    LAS unsigned* RL = (LAS unsigned*)(lds + wave * 4096);
    for (int s = x; s < NVS; s += nx) {
        const unsigned char* VQs = VQ + (size_t)s * 16384 * VSL + 16 * sub;
#define PV_TOK(k_) ((size_t)(widx + nw * ((k_) < K ? (k_) : K - 1)))
#define PV_RQLOAD(blk_) { _Pragma("unroll") for (int j = 0; j < 4; ++j) rq[j] = *(const u32x2*)(CI + PV_TOK(4 * (blk_) + j) * 128 + 2 * lane); }
#define PV_RQSTORE(blk_) { _Pragma("unroll") for (int j = 0; j < 4; ++j) *(LAS u32x2*)(RL + (((blk_) & 1) * 4 + j) * 128 + 2 * lane) = rq[j]; }
#define PV_REC(blkpar_, j_, hf_, i_) RL[((blkpar_) * 4 + (j_)) * 128 + 64 * (hf_) + 8 * (i_) + es]
#define PV_GATHER8(vb, rg_, hf_) { _Pragma("unroll") for (int i = 0; i < 8; ++i) vb[i] = *(const u32x4*)(VQs + (size_t)(rg_[8 * (hf_) + i] & 0x3FFFu) * VSL); }
#define PV_PREP(blkpar_, j_, sl_, k_) { float cf_[16]; float am_ = 0.f; hvs[sl_] = *(const u32x2*)(H1B + PV_TOK(k_) * D + hoff); \
            _Pragma("unroll") for (int i = 0; i < 16; ++i) rg[i] = PV_REC(blkpar_, j_, (i >> 3), (i & 7)); \
            _Pragma("unroll") for (int i = 0; i < 16; ++i) { cf_[i] = __uint_as_float(rg[i] & 0xffff0000u); am_ = fmaxf(am_, fabsf(cf_[i])); } \
            am_ = fmaxf(am_, dpp_mov<0x128>(am_)); am_ = swap16_max(am_); am_ = swap32_max(am_); \
            const float iv_ = am_ > 0.f ? 127.f / am_ : 0.f; csc[sl_] = am_ * (1.f / 127.f); int cs_ = 0; \
            _Pragma("unroll") for (int m = 0; m < 4; ++m) { const int q0 = (int)rintf(cf_[4 * m] * iv_), q1 = (int)rintf(cf_[4 * m + 1] * iv_), q2 = (int)rintf(cf_[4 * m + 2] * iv_), q3 = (int)rintf(cf_[4 * m + 3] * iv_); \
                cqs[sl_][m] = (q0 & 0xFF) | ((q1 & 0xFF) << 8) | ((q2 & 0xFF) << 16) | ((q3 & 0xFF) << 24); cs_ = __builtin_amdgcn_sdot4(cqs[sl_][m], 0x01010101, cs_, false); } \
            float ct_ = (float)cs_; ct_ += dpp_mov<0x128>(ct_); ct_ = swap16_sum(ct_); ct_ = swap32_sum(ct_); cto[sl_] = -8.f * ct_; }
#define PV_T4(r0, r1, r2, r3, w, cqw) { const unsigned x0_ = __builtin_amdgcn_perm(r1[w], r0[w], 0x05010400u), x1_ = __builtin_amdgcn_perm(r1[w], r0[w], 0x07030602u), \
                y0_ = __builtin_amdgcn_perm(r3[w], r2[w], 0x05010400u), y1_ = __builtin_amdgcn_perm(r3[w], r2[w], 0x07030602u); \
            const unsigned t0_ = __builtin_amdgcn_perm(y0_, x0_, 0x05040100u), t1_ = __builtin_amdgcn_perm(y0_, x0_, 0x07060302u), t2_ = __builtin_amdgcn_perm(y1_, x1_, 0x05040100u), t3_ = __builtin_amdgcn_perm(y1_, x1_, 0x07060302u); \
            acci[8 * (w)] = __builtin_amdgcn_sdot4((int)(t0_ & 0x0F0F0F0Fu), cqw, acci[8 * (w)], false); acci[8 * (w) + 1] = __builtin_amdgcn_sdot4((int)(t0_ & 0xF0F0F0F0u), cqw, acci[8 * (w) + 1], false); \
            acci[8 * (w) + 2] = __builtin_amdgcn_sdot4((int)(t1_ & 0x0F0F0F0Fu), cqw, acci[8 * (w) + 2], false); acci[8 * (w) + 3] = __builtin_amdgcn_sdot4((int)(t1_ & 0xF0F0F0F0u), cqw, acci[8 * (w) + 3], false); \
            acci[8 * (w) + 4] = __builtin_amdgcn_sdot4((int)(t2_ & 0x0F0F0F0Fu), cqw, acci[8 * (w) + 4], false); acci[8 * (w) + 5] = __builtin_amdgcn_sdot4((int)(t2_ & 0xF0F0F0F0u), cqw, acci[8 * (w) + 5], false); \
            acci[8 * (w) + 6] = __builtin_amdgcn_sdot4((int)(t3_ & 0x0F0F0F0Fu), cqw, acci[8 * (w) + 6], false); acci[8 * (w) + 7] = __builtin_amdgcn_sdot4((int)(t3_ & 0xF0F0F0F0u), cqw, acci[8 * (w) + 7], false); }
#define PV_ACC8(vb, sl_, hf_) { _Pragma("unroll") for (int w = 0; w < 4; ++w) { PV_T4(vb[0], vb[1], vb[2], vb[3], w, cqs[sl_][2 * (hf_)]) PV_T4(vb[4], vb[5], vb[6], vb[7], w, cqs[sl_][2 * (hf_) + 1]) } }
#define PV_FIN(k_, sl_) { int r16[16], r8[8], r4[4]; \
            { const bool bt = lane & 8; _Pragma("unroll") for (int q = 0; q < 16; ++q) { const int keep = bt ? acci[q + 16] : acci[q], send = bt ? acci[q] : acci[q + 16]; r16[q] = keep + __builtin_amdgcn_update_dpp(0, send, 0x128, 0xF, 0xF, false); } } \
            _Pragma("unroll") for (int q = 0; q < 8; ++q) { int a_ = r16[q], b_ = r16[q + 8]; swap16i_(a_, b_); r8[q] = a_ + b_; } \
            _Pragma("unroll") for (int q = 0; q < 4; ++q) { int a_ = r8[q], b_ = r8[q + 4]; swap32i_(a_, b_); r4[q] = a_ + b_; } \
            _Pragma("unroll") for (int q = 0; q < 32; ++q) acci[q] = 0; \
            if ((k_) < K) { const u32x2 hw = hvs[sl_]; const float sc_ = csc[sl_], sh_ = sc_ * (1.f / 16.f), co_ = cto[sl_]; \
                *(u32x2*)(H1B + (size_t)(widx + nw * (k_)) * D + hoff) = (u32x2){pk2(bflo(hw.x) + ((float)r4[0] + co_) * sc_, bfhi(hw.x) + (float)r4[1] * sh_), pk2(bflo(hw.y) + ((float)r4[2] + co_) * sc_, bfhi(hw.y) + (float)r4[3] * sh_)}; } }
#define PV_STEP(vb, B_, j_, hf_) { PV_ACC8(vb, ((j_) & 3), hf_) if ((hf_) == 1) PV_FIN(4 * (B_) + (j_), ((j_) & 3)) \
            if ((hf_) == 0) PV_PREP((((j_) + 2) < 4) ? ((B_) & 1) : (((B_) + 1) & 1), (((j_) + 2) & 3), (((j_) + 2) & 3), 4 * (B_) + (j_) + 2) \
            PV_GATHER8(vb, rg, hf_) }
        u32x2 rq[4]; u32x4 v0[8], v1[8], v2[8], v3[8]; int acci[32]; int cqs[4][4]; float csc[4], cto[4]; unsigned rg[16]; u32x2 hvs[4];
        const int hoff = s * 256 + 32 * sub + 16 * (es & 1) + 8 * ((es >> 1) & 1) + 4 * (es >> 2);
#pragma unroll
        for (int q = 0; q < 32; ++q) acci[q] = 0;
        PV_RQLOAD(0) PV_RQSTORE(0) PV_RQLOAD(1) PV_RQSTORE(1)
        LDS_WAIT();
        PV_PREP(0, 0, 0, 0) PV_GATHER8(v0, rg, 0) PV_GATHER8(v1, rg, 1)
        PV_PREP(0, 1, 1, 1) PV_GATHER8(v2, rg, 0) PV_GATHER8(v3, rg, 1)
        for (int B = 0; B < NB4; ++B) {
            if (B > 0) { PV_RQSTORE(B + 1) LDS_WAIT(); }
            PV_STEP(v0, B, 0, 0) PV_STEP(v1, B, 0, 1)
            PV_STEP(v2, B, 1, 0) PV_STEP(v3, B, 1, 1)
            PV_RQLOAD(B + 2)
            PV_STEP(v0, B, 2, 0) PV_STEP(v1, B, 2, 1)
            PV_STEP(v2, B, 3, 0) PV_STEP(v3, B, 3, 1)
        }
    }
}
__device__ __forceinline__ void phase_final(const Params& p, int vcu, int G) {
    const int tid = threadIdx.x, lane = tid & 63, wave = __builtin_amdgcn_readfirstlane(tid >> 6);
    const bf16_t* H2B = (const bf16_t*)(p.ws + WS_H1B); float* Y = p.out; const float* fg = p.in[I_FG];
    const int w0 = vcu * NWAVES + wave, WS_ = G * NWAVES;
    const f32x4 g0 = ((const f32x4*)fg)[2 * lane], g1 = ((const f32x4*)fg)[2 * lane + 1], g2 = ((const f32x4*)fg)[128 + 2 * lane], g3 = ((const f32x4*)fg)[128 + 2 * lane + 1];
#define PF_LOAD(dst, t0_) { _Pragma("unroll") for (int u = 0; u < 4; ++u) { const int tok = ((t0_) + u * WS_) < T ? ((t0_) + u * WS_) : w0; \
            dst[u][0] = *(const u32x4*)(H2B + (size_t)tok * D + 8 * lane); dst[u][1] = *(const u32x4*)(H2B + (size_t)tok * D + 512 + 8 * lane); } }
#define PF_PROC(src, t0_) { _Pragma("unroll") for (int u = 0; u < 4; ++u) { const int tok = (t0_) + u * WS_; if (tok < T) { float f[16]; float ss = 0.f; \
            _Pragma("unroll") for (int k = 0; k < 4; ++k) { f[2 * k] = bflo(src[u][0][k]); f[2 * k + 1] = bfhi(src[u][0][k]); f[8 + 2 * k] = bflo(src[u][1][k]); f[8 + 2 * k + 1] = bfhi(src[u][1][k]); } \
            _Pragma("unroll") for (int k = 0; k < 16; ++k) ss += f[k] * f[k]; \
            const float rs = rsqrtf(wave_sum(ss) * (1.f / D) + EPS); f32x4* yr = (f32x4*)(Y + (size_t)tok * D); \
            yr[2 * lane] = (f32x4){f[0], f[1], f[2], f[3]} * rs * g0; yr[2 * lane + 1] = (f32x4){f[4], f[5], f[6], f[7]} * rs * g1; \
            yr[128 + 2 * lane] = (f32x4){f[8], f[9], f[10], f[11]} * rs * g2; yr[128 + 2 * lane + 1] = (f32x4){f[12], f[13], f[14], f[15]} * rs * g3; } } }
    u32x4 va[4][2], vb[4][2];
    PF_LOAD(va, w0)
    for (int t0 = w0; t0 < T; t0 += 8 * WS_) {
        if (t0 + 4 * WS_ < T) PF_LOAD(vb, t0 + 4 * WS_)
        PF_PROC(va, t0)
        if (t0 + 8 * WS_ < T) PF_LOAD(va, t0 + 8 * WS_)
        PF_PROC(vb, t0 + 4 * WS_)
    }
}
#define XB_TMO      128
#define XB_XCNT(j)  (256  + 64 * (j))
#define XB_XSUB(j)  (1280 + 64 * (j))
#define XB_XGEN(j)  (2304 + 64 * (j))
#define XB_TOP      3328
#define XB_TOPGEN   3392
#define XCD_BAR_WORDS 3456
#define XB_SPIN_CAP (1u << 18)

__device__ __forceinline__ unsigned xb_ld(unsigned* p)              { return __hip_atomic_load(p, __ATOMIC_RELAXED, __HIP_MEMORY_SCOPE_AGENT); }
__device__ __forceinline__ unsigned xb_add(unsigned* p, unsigned v) { return __hip_atomic_fetch_add(p, v, __ATOMIC_RELAXED, __HIP_MEMORY_SCOPE_AGENT); }
__device__ __forceinline__ unsigned xb_xcc_id() { return (unsigned)__builtin_amdgcn_s_getreg((3 << 11) | 20) & 0xFu; }
#define XB_SPIN(cond, bar) do { unsigned _sp = 0; while (cond) { __builtin_amdgcn_s_sleep(1); \
    if ((++_sp & 255u) == 0u) { if (xb_ld(&(bar)[XB_TMO])) break; if (_sp > XB_SPIN_CAP) { atomicAdd(&(bar)[XB_TMO], 1u); break; } } } } while (0)

struct XcdBarrier {
    unsigned* bar; unsigned x;
    volatile LAS unsigned* st;
};

__device__ __forceinline__ XcdBarrier xcd_barrier_post(unsigned* bar, volatile LAS unsigned* st) {
    XcdBarrier b; b.bar = bar; b.x = xb_xcc_id(); b.st = st;
    if (threadIdx.x == 0) (void)xb_add(&bar[XB_XCNT(b.x)], 1u);
    return b;
}
__device__ __forceinline__ void xcd_barrier_complete(unsigned* bar, unsigned x, unsigned& nloc, unsigned& nx) {
    const unsigned G = gridDim.x * gridDim.y * gridDim.z;
    unsigned sum, cnt, mine, sp = 0u;
    for (;;) {
        sum = 0u; cnt = 0u; mine = 0u;
#pragma unroll
        for (unsigned j = 0; j < 16; ++j) { const unsigned c = xb_ld(&bar[XB_XCNT(j)]); sum += c; cnt += (c > 0u) ? 1u : 0u; mine = (j == x) ? c : mine; }
        if (sum == G) break;
        __builtin_amdgcn_s_sleep(1);
        if ((++sp & 255u) == 0u) { if (xb_ld(&bar[XB_TMO])) break; if (sp > XB_SPIN_CAP) { atomicAdd(&bar[XB_TMO], 1u); break; } }
    }
    nloc = mine > 0u ? mine : 1u; nx = cnt > 0u ? cnt : 1u;
}

__device__ __forceinline__ void xcd_barrier(const XcdBarrier& b) {
    asm volatile("s_waitcnt vmcnt(0)" ::: "memory");
    __syncthreads();
    if (threadIdx.x == 0) {
        unsigned* bar = b.bar;
        __builtin_amdgcn_s_waitcnt(0);
        unsigned nloc = b.st[0], nx = b.st[1];
        if (nloc == 0u) { xcd_barrier_complete(bar, b.x, nloc, nx); b.st[0] = nloc; b.st[1] = nx; }
        const unsigned old = xb_add(&bar[XB_XSUB(b.x)], 1u);
        const unsigned gen = old / nloc;
        if (old + 1u == (gen + 1u) * nloc) {
            __builtin_amdgcn_fence(__ATOMIC_RELEASE, "agent");
            asm volatile("s_waitcnt vmcnt(0)" ::: "memory");
            const unsigned og = xb_add(&bar[XB_TOP], 1u);
            const unsigned tg = og / nx;
            if (og + 1u == (tg + 1u) * nx) xb_add(&bar[XB_TOPGEN], 1u);
            else XB_SPIN(xb_ld(&bar[XB_TOPGEN]) == tg, bar);
            __builtin_amdgcn_fence(__ATOMIC_ACQUIRE, "agent");
            xb_add(&bar[XB_XGEN(b.x)], 1u);
            asm volatile("s_waitcnt vmcnt(0)" ::: "memory");
        } else {
            XB_SPIN(xb_ld(&bar[XB_XGEN(b.x)]) == gen, bar);
            __builtin_amdgcn_fence(__ATOMIC_ACQUIRE, "agent");
            asm volatile("s_waitcnt vmcnt(0)" ::: "memory");
        }
    }
    __syncthreads();
}

constexpr int N_PHASES = 11;
__global__ void __launch_bounds__(NTHREADS, 2) hymba_fwd(Params p) {
    extern __shared__ __attribute__((aligned(16))) unsigned char lds_raw[];
    LAS unsigned char* lds = (LAS unsigned char*)lds_raw;
    cg::grid_group grid = cg::this_grid();
    const int G = gridDim.x; const int bx = blockIdx.x;
    const int vcu = (G % 8 == 0) ? (bx % 8) * (G / 8) + bx / 8 : bx;
    unsigned char* ws = p.ws;
    const int lo = p.ph_lo, hi = p.ph_hi;
    volatile LAS unsigned* MISC = (volatile LAS unsigned*)(lds + 131072 + 320);
    if (threadIdx.x < 32) MISC[threadIdx.x] = 0u;
    __syncthreads();
    XcdBarrier bar; bar.bar = (unsigned*)ws; bar.x = xb_xcc_id(); bar.st = MISC + 8;
    if (threadIdx.x == 0) { MISC[20] = xb_add(&bar.bar[XB_XCNT(bar.x)], 1u); MISC[21] = bar.x; MISC[22] = 0u; }
#define IN(k) (lo <= (k) && (k) < hi)
#define SEAM(k) do { if ((k) + 1 < hi) { if ((k) == 0) grid.sync(); else xcd_barrier(bar); } } while (0)
    if (IN(0)) { phase_prep(p, lds, vcu, G); SEAM(0); }
    {
        if (threadIdx.x == 0 && lo == 0 && hi > 1 && (G % 8) == 0) { bool ok = true; for (unsigned j = 0; j < 8; ++j) ok = ok && (xb_ld(&bar.bar[XB_XCNT(j)]) == (unsigned)(G / 8)); MISC[22] = ok ? 1u : 0u; }
        __syncthreads();
    }
    const bool xcc_ok = MISC[22] != 0u; const int xcc_x = xcc_ok ? (int)MISC[21] : (bx & 7), xcc_j = xcc_ok ? (int)MISC[20] : (bx >> 3);
    if (IN(1)) {
        { pg8::Gemm g{(const bf16_t*)(ws + WS_XN), (const bf16_t*)(ws + WS_WINT), T, 3584, D}; pg8::StaticOrder S; S.init(T, 3584, G, bx);
          EpiInProj E{(bf16_t*)(ws + WS_PROJ), (const float*)(ws + WS_SM)};
          pg8::gemm_phase<EpiInProj, pg8::StaticOrder, true, true>(lds, g, S, E); }
        { pg8::Gemm g{(const bf16_t*)(ws + WS_WINT) + (size_t)3584 * D, (const bf16_t*)(ws + WS_XN), 512, T, D}; pg8::StaticOrder S; S.init(512, T, G, bx);
          EpiStore E{(bf16_t*)(ws + WS_VT), T};
          pg8::gemm_phase<EpiStore, pg8::StaticOrder, true, true>(lds, g, S, E); }
        SEAM(1);
    }
    if (IN(2)) { phase_hgrn(p, lds, G); }
    if (IN(3)) { phase_attn(p, lds, G); SEAM(3); }
    if (IN(4)) { phase_mix(p, vcu, G); SEAM(4); }
    if (IN(5)) {
        pg8::Gemm g{(const bf16_t*)(ws + WS_XN), (const bf16_t*)(ws + WS_WOT), T, D, D}; pg8::StaticOrder S; S.init(T, D, G, bx);
        EpiOutProj E{p.in[I_X], p.out, (bf16_t*)(ws + WS_H1B), (float*)(ws + WS_SS)};
        pg8::gemm_phase<EpiOutProj, pg8::StaticOrder, true, true>(lds, g, S, E);
        SEAM(5);
    }
    if (IN(6)) {
        phase_hquant(p, vcu, G);
        pg8::Gemm g{(const bf16_t*)(ws + WS_H1B), (const bf16_t*)(ws + WS_WQT), T, 2048, D}; pg8::StaticOrder S; S.init(T, 2048, G, bx);
        EpiQ E{(bf16_t*)(ws + WS_QP), (const float*)(ws + WS_SS), (float*)(ws + WS_GATE)};
        pg8::gemm_phase<EpiQ, pg8::StaticOrder, true, true>(lds, g, S, E);
        SEAM(6);
    }
    if (IN(7)) { phase_topk(p, lds, vcu, G); SEAM(7); }
    if (IN(8)) { phase_peer_u(p, lds, G, xcc_x, xcc_j); SEAM(8); }
    if (IN(9)) { phase_peer_v(p, lds, G, xcc_x, xcc_j); SEAM(9); }
    if (IN(10)) { phase_final(p, vcu, G); }
#undef IN
#undef SEAM
}

extern "C" void kernel_launch(void* const* d_in, const int* in_sizes, int n_in, void* d_out, int out_size, void* d_ws, size_t ws_size, hipStream_t stream) {
    static int grid = 0;
    if (grid == 0) {
        if (n_in != 19 || out_size != T * D || ws_size < WS_END) { fprintf(stderr, "kernel_launch: unexpected sizes (n_in %d out %d ws %zu)\n", n_in, out_size, ws_size); grid = -1; return; }
        int dev = 0, cus = 0, per_cu = 0;
        hipGetDevice(&dev); hipDeviceGetAttribute(&cus, hipDeviceAttributeMultiprocessorCount, dev);
        hipFuncSetAttribute((const void*)hymba_fwd, hipFuncAttributeMaxDynamicSharedMemorySize, LDS_BYTES);
        hipOccupancyMaxActiveBlocksPerMultiprocessor(&per_cu, (const void*)hymba_fwd, NTHREADS, LDS_BYTES);
        (void)hipGetLastError();
        if (per_cu < 1) { fprintf(stderr, "kernel_launch: occupancy query says %d blocks/CU\n", per_cu); per_cu = 1; }
        grid = cus;
    }
    if (grid < 0) return;
    if (hipMemsetAsync(d_ws, 0, 65536, stream) != hipSuccess) { fprintf(stderr, "kernel_launch: memset of the barrier words failed\n"); return; }
    Params p{};
    for (int i = 0; i < 19; ++i) p.in[i] = (const float*)d_in[i];
    p.out = (float*)d_out; p.ws = (unsigned char*)d_ws;
#if MK_ONE_LAUNCH
    p.ph_lo = 0; p.ph_hi = N_PHASES;
    void* args[] = {&p};
    hipError_t e = hipLaunchCooperativeKernel((const void*)hymba_fwd, dim3(grid), dim3(NTHREADS), args, LDS_BYTES, stream);
    if (e != hipSuccess) fprintf(stderr, "cooperative launch failed: %s (grid %d)\n", hipGetErrorString(e), grid);
#else
    for (int ph = 0; ph < N_PHASES; ++ph) { p.ph_lo = ph; p.ph_hi = ph + 1; hipLaunchKernelGGL(hymba_fwd, dim3(grid), dim3(NTHREADS), LDS_BYTES, stream, p); }
#endif
}
```

```cpp
#include <hip/hip_runtime.h>
#include <hip/hip_bf16.h>
#include <hip/hip_cooperative_groups.h>
#include <cstdio>
#include <cstdint>
#include <cmath>
namespace cg = cooperative_groups;
#ifndef MK_ONE_LAUNCH
#define MK_ONE_LAUNCH 1
#endif
namespace pg8 {
#define PG8_LAS __attribute__((address_space(3)))
typedef unsigned short bf16_t;
typedef short bf16x8 __attribute__((ext_vector_type(8)));
typedef float f32x4 __attribute__((ext_vector_type(4)));
typedef unsigned u32x4 __attribute__((ext_vector_type(4)));
constexpr int BM = 256, BK = 64, HALF = 128, HTB = HALF * BK * 2  , STAGE_BYTES = 8 * HTB, NXCD = 8, WGM = 8;

__host__ __device__ __forceinline__ int lds_byte(int r, int c) { const int st = (r >> 4) * 2 + (c >> 5), rr = r & 15, cc = c & 31, ob = rr * 64 + cc * 2; return st * 1024 + (ob ^ (((ob >> 9) & 1) << 5)); }
__host__ __device__ __forceinline__ void stage_rc(int b, int& R, int& C) { const int st = b / 1024, sb = b % 1024, swz = sb ^ (((sb >> 9) & 1) << 5); R = (st >> 1) * 16 + swz / 64; C = (st & 1) * 32 + (swz % 64) / 2; }
__host__ __device__ __forceinline__ int perm32(int rho) { const int n = rho >> 4, i = rho & 15; return 8 * (i >> 2) + 4 * n + (i & 3); }

struct Unit { int pm, pn; };
struct Gemm { const bf16_t* A; const bf16_t* Bt; int M, N, K; };

struct StaticOrder {
    int nM, nN, nwg, G, c;
    __host__ __device__ void init(int M, int N, int G_, int c_) { nM = M / BM; nN = N / BM; nwg = nM * nN; G = G_; c = c_; }
    __host__ __device__ bool next(int i, Unit& u) const {
        const long L = (long)i * G + c; if (L >= nwg) return false;
        int wgid = (int)L; { const int q = nwg / NXCD, r = nwg % NXCD, xcd = wgid % NXCD, off = wgid / NXCD; wgid = (xcd < r ? xcd * (q + 1) : r * (q + 1) + (xcd - r) * q) + off; }
        const int nig = WGM * nN, gid = wgid / nig, fm = gid * WGM, gsz = (nM - fm) < WGM ? (nM - fm) : WGM;
        u.pm = fm + ((wgid % nig) % gsz); u.pn = (wgid % nig) / gsz; return true;
    }
    __device__ __forceinline__ void a_ready(const Unit&) const {}
    __device__ __forceinline__ void done(const Unit&) const {}
};

__device__ __forceinline__ unsigned cvt_pk_bf16(float lo, float hi) { unsigned r; asm volatile("v_cvt_pk_bf16_f32 %0, %1, %2" : "=v"(r) : "v"(lo), "v"(hi)); return r; }
typedef float f32x2 __attribute__((ext_vector_type(2)));
template <class Epi, class Sched, bool ALIGN_EPI = false, bool SP2 = false>
__device__ __forceinline__ void gemm_phase(PG8_LAS unsigned char* lds, const Gemm g, const Sched& S, const Epi& E) {
    const int tid = threadIdx.x, wid = __builtin_amdgcn_readfirstlane(tid >> 6), lane = tid & 63, wr = wid >> 2, wc = wid & 3, fr = lane & 15, fq = lane >> 4;
    const int K = g.K, nt = K / BK;
    unsigned voffA[2], voffB[2];
#pragma unroll
    for (int i = 0; i < 2; ++i) { int R, C; stage_rc(tid * 16 + i * 8192, R, C); const int Rb = Epi::PERM ? ((R & ~31) + perm32(R & 31)) : R;
        voffA[i] = (unsigned)(R * K + C) * 2u; voffB[i] = (unsigned)(Rb * K + C) * 2u; }
    const size_t kstep = (size_t)(BK * 2);
    const size_t hstep = (size_t)HALF * K * 2;
    const size_t tstep = 2 * hstep;
    const unsigned ldsw = (unsigned)wid * 1024u;
    const int aoff = lds_byte(wr * 64 + fr, fq * 8), boff = lds_byte(wc * 32 + fr, fq * 8);
#define PG8_SA(b, h) (((b) * 2 + (h)) * HTB)
#define PG8_SB(b, h) ((4 + (b) * 2 + (h)) * HTB)
#define PG8_STAGE(bufoff, gbase, voff) do { _Pragma("unroll") for (int _i = 0; _i < 2; ++_i) \
        __builtin_amdgcn_global_load_lds((const unsigned*)((const char*)(gbase) + (voff)[_i]), (PG8_LAS unsigned*)(lds + (bufoff) + ldsw + _i * 8192), 16, 0, 0); } while (0)
#define PG8_LDA(dst, b, h) do { _Pragma("unroll") for (int m = 0; m < 4; ++m) _Pragma("unroll") for (int k = 0; k < 2; ++k) dst[m][k] = *(const PG8_LAS bf16x8*)(lds + PG8_SA(b, h) + aoff + m * 2048 + k * 1024); } while (0)
#define PG8_LDB(dst, b, h) do { _Pragma("unroll") for (int n = 0; n < 2; ++n) _Pragma("unroll") for (int k = 0; k < 2; ++k) dst[n][k] = *(const PG8_LAS bf16x8*)(lds + PG8_SB(b, h) + boff + n * 2048 + k * 1024); } while (0)
#define PG8_MMA(ai, bj, At, Bt) do { __builtin_amdgcn_s_setprio(1); _Pragma("unroll") for (int m = 0; m < 4; ++m) _Pragma("unroll") for (int n = 0; n < 2; ++n) _Pragma("unroll") for (int k = 0; k < 2; ++k) \
        acc[ai][bj][m][n] = __builtin_amdgcn_mfma_f32_16x16x32_bf16(Bt[n][k], At[m][k], acc[ai][bj][m][n], 0, 0, 0); __builtin_amdgcn_s_setprio(0); } while (0)
#define PG8_WAIT_V(n) asm volatile("s_waitcnt vmcnt(" #n ")" ::: "memory")
#define PG8_WAIT_L(n) asm volatile("s_waitcnt lgkmcnt(" #n ")" ::: "memory")
#define PG8_BAR __builtin_amdgcn_s_barrier()
#define PG8_SCHED __builtin_amdgcn_sched_barrier(0)
    Unit cur, nxt; int ui = 0;
    if (!S.next(0, cur)) return;
    f32x4 acc[2][2][4][2];
#pragma unroll
    for (int a = 0; a < 2; ++a)
#pragma unroll
        for (int b = 0; b < 2; ++b)
#pragma unroll
            for (int m = 0; m < 4; ++m)
#pragma unroll
                for (int n = 0; n < 2; ++n) acc[a][b][m][n] = (f32x4){0.f, 0.f, 0.f, 0.f};
    bf16x8 At[4][2], B0[2][2], B1[2][2];
    const char* cA = (const char*)g.A + (size_t)cur.pm * tstep; const char* cB = (const char*)g.Bt + (size_t)cur.pn * tstep;
    S.a_ready(cur);
    if constexpr (SP2) {
        PG8_STAGE(PG8_SB(0, 0), cB, voffB); PG8_STAGE(PG8_SB(0, 1), cB + hstep, voffB); PG8_STAGE(PG8_SA(0, 0), cA, voffA); PG8_STAGE(PG8_SA(0, 1), cA + hstep, voffA);
        if (wr == 1) PG8_BAR;
        PG8_WAIT_V(2); PG8_BAR;
        PG8_STAGE(PG8_SB(1, 0), cB + kstep, voffB); PG8_STAGE(PG8_SA(1, 0), cA + kstep, voffA); PG8_STAGE(PG8_SB(1, 1), cB + hstep + kstep, voffB);
        PG8_WAIT_V(6); PG8_BAR;
    } else {
        PG8_STAGE(PG8_SB(0, 0), cB, voffB); PG8_STAGE(PG8_SA(0, 0), cA, voffA); PG8_STAGE(PG8_SB(0, 1), cB + hstep, voffB); PG8_STAGE(PG8_SA(0, 1), cA + hstep, voffA);
        if (wr == 1) PG8_BAR;
        PG8_WAIT_V(4); PG8_BAR;
        PG8_STAGE(PG8_SB(1, 0), cB + kstep, voffB); PG8_STAGE(PG8_SA(1, 0), cA + kstep, voffA); PG8_STAGE(PG8_SB(1, 1), cB + hstep + kstep, voffB);
        PG8_WAIT_V(6); PG8_BAR;
    }
    for (;;) {
        const bool has_next = S.next(ui + 1, nxt);
        const char* nA = has_next ? (const char*)g.A + (size_t)nxt.pm * tstep : cA; const char* nB = has_next ? (const char*)g.Bt + (size_t)nxt.pn * tstep : cB;
        for (int t = 0; t < nt; t += 2) {
            const bool last = (t == nt - 2);
            const char* a1 = cA + (size_t)(t + 1) * kstep;
            const char* a2 = last ? nA : cA + (size_t)(t + 2) * kstep; const char* b2 = last ? nB : cB + (size_t)(t + 2) * kstep;
            const char* a3 = a2 + kstep; const char* b3 = b2 + kstep;
            if (last && has_next) S.a_ready(nxt);
            if constexpr (SP2) {
            PG8_LDB(B0, 0, 0); PG8_LDB(B1, 0, 1); PG8_SCHED; PG8_LDA(At, 0, 0); PG8_STAGE(PG8_SA(1, 1), a1 + hstep, voffA);
            PG8_WAIT_V(8); PG8_WAIT_L(0); PG8_BAR; PG8_MMA(0, 0, At, B0); PG8_MMA(0, 1, At, B1); PG8_BAR; PG8_SCHED;
            PG8_LDA(At, 0, 1); PG8_STAGE(PG8_SB(0, 0), b2, voffB); PG8_STAGE(PG8_SB(0, 1), b2 + hstep, voffB); PG8_STAGE(PG8_SA(0, 0), a2, voffA);
            PG8_WAIT_V(8); PG8_WAIT_L(0); PG8_BAR; PG8_MMA(1, 0, At, B0); PG8_MMA(1, 1, At, B1); PG8_BAR; PG8_SCHED;
            PG8_LDB(B0, 1, 0); PG8_LDB(B1, 1, 1); PG8_SCHED; PG8_LDA(At, 1, 0); PG8_STAGE(PG8_SA(0, 1), a2 + hstep, voffA);
            PG8_WAIT_V(8); PG8_WAIT_L(0); PG8_BAR; PG8_MMA(0, 0, At, B0); PG8_MMA(0, 1, At, B1); PG8_BAR; PG8_SCHED;
            PG8_LDA(At, 1, 1); PG8_STAGE(PG8_SB(1, 0), b3, voffB); PG8_STAGE(PG8_SB(1, 1), b3 + hstep, voffB); PG8_STAGE(PG8_SA(1, 0), a3, voffA);
            PG8_WAIT_V(8); PG8_WAIT_L(0); PG8_BAR; PG8_MMA(1, 0, At, B0); PG8_MMA(1, 1, At, B1); PG8_BAR; PG8_SCHED;
            } else {
            PG8_LDB(B0, 0, 0); PG8_SCHED; PG8_LDA(At, 0, 0); PG8_STAGE(PG8_SA(1, 1), a1 + hstep, voffA);
            PG8_WAIT_L(8); PG8_BAR; PG8_WAIT_L(0); PG8_MMA(0, 0, At, B0); PG8_BAR; PG8_SCHED;
            PG8_LDB(B1, 0, 1); PG8_STAGE(PG8_SB(0, 0), b2, voffB);
            PG8_BAR; PG8_WAIT_L(0); PG8_MMA(0, 1, At, B1); PG8_BAR;
            PG8_LDA(At, 0, 1); PG8_STAGE(PG8_SA(0, 0), a2, voffA);
            PG8_BAR; PG8_WAIT_L(0); PG8_MMA(1, 0, At, B0); PG8_BAR; PG8_SCHED;
            PG8_STAGE(PG8_SB(0, 1), b2 + hstep, voffB);
            PG8_WAIT_V(6); PG8_BAR; PG8_MMA(1, 1, At, B1); PG8_BAR;
            PG8_LDB(B0, 1, 0); PG8_SCHED; PG8_LDA(At, 1, 0); PG8_STAGE(PG8_SA(0, 1), a2 + hstep, voffA);
            PG8_WAIT_L(8); PG8_BAR; PG8_WAIT_L(0); PG8_MMA(0, 0, At, B0); PG8_BAR; PG8_SCHED;
            PG8_LDB(B1, 1, 1); PG8_STAGE(PG8_SB(1, 0), b3, voffB);
            PG8_BAR; PG8_WAIT_L(0); PG8_MMA(0, 1, At, B1); PG8_BAR;
            PG8_LDA(At, 1, 1); PG8_STAGE(PG8_SA(1, 0), a3, voffA);
            PG8_BAR; PG8_WAIT_L(0); PG8_MMA(1, 0, At, B0); PG8_BAR; PG8_SCHED;
            PG8_STAGE(PG8_SB(1, 1), b3 + hstep, voffB);
            PG8_WAIT_V(6); PG8_BAR; PG8_MMA(1, 1, At, B1); PG8_BAR;
            }
        }
        if constexpr (ALIGN_EPI) { if (wr == 0) PG8_BAR; }
        if constexpr (!Epi::AFTER_DRAIN) { E(acc, cur, wr, wc, fr, fq); S.done(cur); }
        if (!has_next) break;
#pragma unroll
        for (int a = 0; a < 2; ++a)
#pragma unroll
            for (int b = 0; b < 2; ++b)
#pragma unroll
                for (int m = 0; m < 4; ++m)
#pragma unroll
                    for (int n = 0; n < 2; ++n) acc[a][b][m][n] = (f32x4){0.f, 0.f, 0.f, 0.f};
        cur = nxt; cA = nA; cB = nB; ++ui;
        if constexpr (ALIGN_EPI) { if (wr == 1) PG8_BAR; }
    }
    PG8_WAIT_V(0);
    if constexpr (!ALIGN_EPI) { if (wr == 0) PG8_BAR; }
    PG8_BAR;
    if constexpr (Epi::AFTER_DRAIN) { E.fused(acc, cur, wr, wc, fr, fq, lds, wid, lane); S.done(cur); }
#undef PG8_SA
#undef PG8_SB
#undef PG8_STAGE
#undef PG8_LDA
#undef PG8_LDB
#undef PG8_MMA
#undef PG8_WAIT_V
#undef PG8_WAIT_L
#undef PG8_BAR
#undef PG8_SCHED
}
}

#define LAS __attribute__((address_space(3)))
typedef unsigned short bf16_t;
typedef short bf16x8 __attribute__((ext_vector_type(8)));
typedef short bf16x4 __attribute__((ext_vector_type(4)));
typedef float f32x4 __attribute__((ext_vector_type(4)));
typedef float f32x16 __attribute__((ext_vector_type(16)));
typedef unsigned u32x4 __attribute__((ext_vector_type(4)));
typedef unsigned u32x2 __attribute__((ext_vector_type(2)));
typedef __bf16 bf16x2_t __attribute__((ext_vector_type(2)));

constexpr int NB = 16, SEQ = 2048, T = NB * SEQ, D = 1024;
constexpr int PP = 4608;
constexpr int C_Q = 0, C_KF = 512, C_LFF = 1024, C_KB = 1536, C_LFB = 2048, C_V = 2560, C_G = 3072, C_DQ = 3584, C_DK = 4096;
constexpr float EPS = 1e-6f;
constexpr float LOG2E = 1.4426950408889634f;
constexpr int NWAVES = 8, NTHREADS = 512;
constexpr int NGRP = 8, GRP_SHIFT = 11, GRP_SIZE = 2048, VSL = 128, NVS = 4;
constexpr int LDS_BYTES = 147456;

constexpr size_t MiB = (size_t)1 << 20;
constexpr size_t WS_SM = 64 * 1024;
constexpr size_t WS_WINT = 2 * MiB, WS_WOT = 10 * MiB, WS_WQT = 12 * MiB, WS_KEYS = 16 * MiB;
constexpr size_t WS_UT = 32 * MiB, WS_USC = 48 * MiB, WS_VSC = 49 * MiB, WS_VE = 64 * MiB, WS_XN = 96 * MiB, WS_PROJ = 160 * MiB, WS_VT = 448 * MiB, WS_END = 480 * MiB;
constexpr size_t WS_H1B = 160 * MiB, WS_QP = 224 * MiB, WS_IDX = 360 * MiB, WS_GATE = 376 * MiB, WS_SS = 392 * MiB, WS_C = 394 * MiB;
constexpr int QPS = 2048 + 64;
constexpr size_t WS_US8 = 48 * MiB + 131072;
constexpr size_t WS_H1Q = 96 * MiB, WS_HSC = 128 * MiB;
constexpr int SM_LBF = 0, SM_LBB = 512, SM_LAM = 1024, SM_BT = 2048, BT_STRIDE = 260;

struct Params { const float* in[19]; float* out; unsigned char* ws; int ph_lo, ph_hi; };
enum { I_X = 0, I_G1, I_WIN, I_LBF, I_LBB, I_HOG, I_LQ1, I_LK1, I_LQ2, I_LK2, I_DOG, I_RB, I_WOUT, I_G2, I_WQ, I_KEYS, I_U, I_V, I_FG };

#define LDS_WAIT() asm volatile("s_waitcnt lgkmcnt(0)" ::: "memory")
__device__ __forceinline__ unsigned f2bf(float f) { unsigned u = __builtin_bit_cast(unsigned, f); return (u + 0x7fffu + ((u >> 16) & 1u)) >> 16; }
typedef float f32x2v_ __attribute__((ext_vector_type(2)));
__device__ __forceinline__ unsigned pk2(float lo, float hi) { const f32x2v_ v = {lo, hi}; return __builtin_bit_cast(unsigned, __builtin_convertvector(v, bf16x2_t)); }
__device__ __forceinline__ float bflo(unsigned w) { return __uint_as_float(w << 16); }
__device__ __forceinline__ float bfhi(unsigned w) { return __uint_as_float(w & 0xffff0000u); }
template <int CTRL> __device__ __forceinline__ float dpp_mov(float v) { return __builtin_bit_cast(float, __builtin_amdgcn_update_dpp(0, __builtin_bit_cast(int, v), CTRL, 0xF, 0xF, false)); }
__device__ __forceinline__ void swap16_(float& a, float& b) { asm volatile("s_nop 1\n\tv_permlane16_swap_b32 %0, %1\n\ts_nop 1" : "+v"(a), "+v"(b)); }
__device__ __forceinline__ void swap32_(float& a, float& b) { asm volatile("s_nop 1\n\tv_permlane32_swap_b32 %0, %1\n\ts_nop 1" : "+v"(a), "+v"(b)); }
__device__ __forceinline__ void swap16i_(int& a, int& b) { asm volatile("s_nop 1\n\tv_permlane16_swap_b32 %0, %1\n\ts_nop 1" : "+v"(a), "+v"(b)); }
__device__ __forceinline__ void swap32i_(int& a, int& b) { asm volatile("s_nop 1\n\tv_permlane32_swap_b32 %0, %1\n\ts_nop 1" : "+v"(a), "+v"(b)); }
__device__ __forceinline__ float swap16_sum(float v) { float a = v, b = v; swap16_(a, b); return a + b; }
__device__ __forceinline__ float swap32_sum(float v) { float a = v, b = v; swap32_(a, b); return a + b; }
__device__ __forceinline__ float swap16_max(float v) { float a = v, b = v; swap16_(a, b); return fmaxf(a, b); }
__device__ __forceinline__ float swap32_max(float v) { float a = v, b = v; swap32_(a, b); return fmaxf(a, b); }
__device__ __forceinline__ float xchg16(float v, int lane) { float a = v, b = v; swap16_(a, b); return (lane & 16) ? a : b; }
__device__ __forceinline__ float xchg32(float v, int lane) { float a = v, b = v; swap32_(a, b); return (lane & 32) ? a : b; }
__device__ __forceinline__ float wave_sum(float v) {
    v += dpp_mov<0xB1>(v); v += dpp_mov<0x4E>(v); v += dpp_mov<0x141>(v); v += dpp_mov<0x140>(v);
    return swap32_sum(swap16_sum(v));
}
__device__ __forceinline__ float wave_max(float v) {
    v = fmaxf(v, dpp_mov<0xB1>(v)); v = fmaxf(v, dpp_mov<0x4E>(v)); v = fmaxf(v, dpp_mov<0x141>(v)); v = fmaxf(v, dpp_mov<0x140>(v));
    return swap32_max(swap16_max(v));
}
__device__ __forceinline__ float sigmoidf_(float z) { return __builtin_amdgcn_rcpf(1.0f + __expf(-z)); }

__device__ __forceinline__ void p0_transpose_item(const float* W, int K, int N, bf16_t* WT, const float* kscale, LAS float* scr, int item, int lane) {
    const int nblk = N / 32, kb = item / nblk, nb = item % nblk, k0 = 64 * kb, n0 = 32 * nb;
#pragma unroll 8
    for (int i = 0; i < 32; ++i) { const int kk = 2 * i + (lane >> 5); float w = W[(size_t)(k0 + kk) * N + n0 + (lane & 31)]; if (kscale) w *= kscale[k0 + kk]; scr[kk * 33 + (lane & 31)] = w; }
    LDS_WAIT(); asm volatile("" ::: "memory");
    const int c = lane & 7;
#pragma unroll
    for (int j = 0; j < 4; ++j) { const int n = (lane >> 3) + 8 * j; const LAS float* s = scr + (8 * c) * 33 + n;
        u32x4 o; o.x = pk2(s[0 * 33], s[1 * 33]); o.y = pk2(s[2 * 33], s[3 * 33]); o.z = pk2(s[4 * 33], s[5 * 33]); o.w = pk2(s[6 * 33], s[7 * 33]);
        *(u32x4*)(WT + (size_t)(n0 + n) * K + k0 + 8 * c) = o; }
    LDS_WAIT(); asm volatile("" ::: "memory");
}
__device__ __forceinline__ int t5_bucket(int rel) {
    const int n = rel < 0 ? -rel : rel;
    const int v = n < 8 ? n : n < 12 ? 8 : n < 16 ? 9 : n < 23 ? 10 : n < 32 ? 11 : n < 46 ? 12 : n < 64 ? 13 : n < 91 ? 14 : 15;
    return (rel > 0 ? 16 : 0) + v;
}
__device__ __forceinline__ void phase_prep(const Params& p, LAS unsigned char* lds, int vcu, int G) {
    const int tid = threadIdx.x, lane = tid & 63, wave = __builtin_amdgcn_readfirstlane(tid >> 6);
    unsigned char* ws = p.ws;
    LAS float* scr = (LAS float*)(lds + wave * 16384);
    const int gw = vcu * NWAVES + wave, NGW = G * NWAVES;
    constexpr int I_IN = (D / 64) * (4096 / 32), I_OUT = (D / 64) * (D / 32), I_QW = (D / 64) * (2048 / 32);
    for (int it = gw; it < I_IN + I_OUT + I_QW; it += NGW) {
        int r = it;
        if (r < I_IN) { p0_transpose_item(p.in[I_WIN], D, 4096, (bf16_t*)(ws + WS_WINT), nullptr, scr, r, lane); continue; } r -= I_IN;
        if (r < I_OUT) { p0_transpose_item(p.in[I_WOUT], D, D, (bf16_t*)(ws + WS_WOT), nullptr, scr, r, lane); continue; } r -= I_OUT;
        p0_transpose_item(p.in[I_WQ], D, 2048, (bf16_t*)(ws + WS_WQT), p.in[I_G2], scr, r, lane);
    }
    for (int i = blockIdx.x * NTHREADS + tid; i < 8 * 2 * 128 * 128 / 4; i += G * NTHREADS) {
        const f32x4 v = ((const f32x4*)p.in[I_KEYS])[i];
        ((u32x2*)(ws + WS_KEYS))[i] = (u32x2){pk2(v.x, v.y), pk2(v.z, v.w)};
    }
#define PX_LOAD(dst, m0_) { _Pragma("unroll") for (int u = 0; u < 4; ++u) { const int m = ((m0_) + u * NGW) < T ? ((m0_) + u * NGW) : gw; const f32x4* xr = (const f32x4*)(p.in[I_X] + (size_t)m * D) + lane; \
            _Pragma("unroll") for (int j = 0; j < 4; ++j) dst[u][j] = xr[64 * j]; } }
#define PX_PROC(src, m0_) { _Pragma("unroll") for (int u = 0; u < 4; ++u) { const int m = (m0_) + u * NGW; if (m < T) { float ssq = 0.f; \
            _Pragma("unroll") for (int j = 0; j < 4; ++j) ssq += (src[u][j].x * src[u][j].x + src[u][j].y * src[u][j].y) + (src[u][j].z * src[u][j].z + src[u][j].w * src[u][j].w); \
            const float rs = rsqrtf(wave_sum(ssq) * (1.f / D) + EPS); unsigned long long* o8 = (unsigned long long*)((bf16_t*)(ws + WS_XN) + (size_t)m * D) + lane; \
            _Pragma("unroll") for (int j = 0; j < 4; ++j) { const f32x4 y = src[u][j] * rs * ((const f32x4*)p.in[I_G1])[64 * j + lane]; o8[64 * j] = (unsigned long long)pk2(y.x, y.y) | ((unsigned long long)pk2(y.z, y.w) << 32); } } } }
    {
        f32x4 va[4][4], vb[4][4];
        PX_LOAD(va, gw)
        for (int m0 = gw; m0 < T; m0 += 8 * NGW) {
            if (m0 + 4 * NGW < T) PX_LOAD(vb, m0 + 4 * NGW)
            PX_PROC(va, m0)
            if (m0 + 8 * NGW < T) PX_LOAD(va, m0 + 8 * NGW)
            PX_PROC(vb, m0 + 4 * NGW)
        }
    }
    if (blockIdx.x == 0) {
        float* sm = (float*)(ws + WS_SM);
        { const float* a = p.in[I_LBF]; sm[SM_LBF + tid] = 1.f / (1.f + __expf(a[512 + tid] - a[tid])); }
        { const float* a = p.in[I_LBB]; sm[SM_LBB + tid] = 1.f / (1.f + __expf(a[512 + tid] - a[tid])); }
        if (tid < 64) {
            float a = p.in[I_LQ1][tid] * p.in[I_LK1][tid], b = p.in[I_LQ2][tid] * p.in[I_LK2][tid];
            a = wave_sum(a); b = wave_sum(b);
            if (tid == 0) sm[SM_LAM] = __expf(a) - __expf(b) + 0.2f;
        }
        for (int i = tid; i < 4 * 257; i += NTHREADS) { const int h = i / 257, r = i % 257; sm[SM_BT + h * BT_STRIDE + r] = p.in[I_RB][t5_bucket(r - 128) * 4 + h] * LOG2E; }
    }
}

__device__ __forceinline__ float silu_(float x) { return x * __builtin_amdgcn_rcpf(1.0f + __expf(-x)); }
struct EpiInProj {
    static constexpr bool PERM = true, AFTER_DRAIN = false;
    bf16_t* P; const float* sm;
    __device__ __forceinline__ void st8(bf16_t* dst, const float (&y)[8]) const { u32x4 w; w.x = pk2(y[0], y[1]); w.y = pk2(y[2], y[3]); w.z = pk2(y[4], y[5]); w.w = pk2(y[6], y[7]); *(u32x4*)dst = w; }
    __device__ __forceinline__ void operator()(const f32x4 (&acc)[2][2][4][2], const pg8::Unit& u, int wr, int wc, int fr, int fq) const {
        const int seg = u.pn >> 1;
        const int row0 = u.pm * 256 + wr * 64 + fr;
        const int cs0 = (u.pn & 1) * 256 + wc * 32 + 8 * fq;
#pragma unroll
        for (int bj = 0; bj < 2; ++bj) {
            const int cs = cs0 + bj * 128;
            float lb[8] = {0.f, 0.f, 0.f, 0.f, 0.f, 0.f, 0.f, 0.f};
            if (seg == 1 || seg == 2) {
#pragma unroll
                for (int i = 0; i < 8; ++i) lb[i] = sm[(seg == 1 ? SM_LBF : SM_LBB) + cs + i];
            }
#pragma unroll
            for (int ai = 0; ai < 2; ++ai)
#pragma unroll
                for (int m = 0; m < 4; ++m) {
                    const size_t row = (size_t)(row0 + ai * 128 + m * 16);
                    bf16_t* rp = P + row * PP + cs;
                    float x[8];
#pragma unroll
                    for (int i = 0; i < 4; ++i) { x[i] = acc[ai][bj][m][0][i]; x[4 + i] = acc[ai][bj][m][1][i]; }
                    float y[8];
                    if (seg == 0 || seg == 4) {
#pragma unroll
                        for (int i = 0; i < 8; ++i) y[i] = silu_(x[i]);
                        st8(rp + (seg == 0 ? C_Q : C_G), y);
                    } else if (seg == 1 || seg == 2) {
                        float lf[8];
#pragma unroll
                        for (int i = 0; i < 8; ++i) { const float s = sigmoidf_(x[i]); const float k = (1.f - lb[i]) * (1.f - s); y[i] = k; lf[i] = __logf(1.f - k); }
                        st8(rp + (seg == 1 ? C_KF : C_KB), y);
                        st8(rp + (seg == 1 ? C_LFF : C_LFB), lf);
                    } else if (seg == 3) {
                        st8(rp + C_V, x);
                    } else if (seg == 5) {
#pragma unroll
                        for (int i = 0; i < 8; ++i) y[i] = x[i] * (0.125f * LOG2E);
                        st8(rp + C_DQ, y);
                    } else {
                        st8(rp + C_DK, x);
                    }
                }
        }
    }
};
struct EpiStore {
    static constexpr bool PERM = true, AFTER_DRAIN = false;
    bf16_t* O; int ldc;
    __device__ __forceinline__ void operator()(const f32x4 (&acc)[2][2][4][2], const pg8::Unit& u, int wr, int wc, int fr, int fq) const {
        const int row0 = u.pm * 256 + wr * 64 + fr, col0 = u.pn * 256 + wc * 32 + 8 * fq;
#pragma unroll
        for (int ai = 0; ai < 2; ++ai)
#pragma unroll
            for (int m = 0; m < 4; ++m)
#pragma unroll
                for (int bj = 0; bj < 2; ++bj) {
                    const f32x4 a = acc[ai][bj][m][0], b = acc[ai][bj][m][1];
                    u32x4 w; w.x = pk2(a[0], a[1]); w.y = pk2(a[2], a[3]); w.z = pk2(b[0], b[1]); w.w = pk2(b[2], b[3]);
                    *(u32x4*)(O + (size_t)(row0 + ai * 128 + m * 16) * ldc + col0 + bj * 128) = w;
                }
    }
};
struct EpiOutProj {
    static constexpr bool PERM = true, AFTER_DRAIN = false;
    const float* x; float* H1; bf16_t* H1B; float* SS;
    __device__ __forceinline__ void operator()(const f32x4 (&acc)[2][2][4][2], const pg8::Unit& u, int wr, int wc, int fr, int fq) const {
        const int row0 = u.pm * 256 + wr * 64 + fr, col0 = u.pn * 256 + wc * 32 + 8 * fq;
#pragma unroll
        for (int ai = 0; ai < 2; ++ai)
#pragma unroll
            for (int m = 0; m < 4; ++m) {
                const size_t row = (size_t)(row0 + ai * 128 + m * 16);
                float ss = 0.f;
#pragma unroll
                for (int bj = 0; bj < 2; ++bj) {
                    const size_t off = row * D + col0 + bj * 128;
                    const f32x4 a = *(const f32x4*)(x + off) + acc[ai][bj][m][0], b = *(const f32x4*)(x + off + 4) + acc[ai][bj][m][1];
                    u32x4 w; w.x = pk2(a[0], a[1]); w.y = pk2(a[2], a[3]); w.z = pk2(b[0], b[1]); w.w = pk2(b[2], b[3]);
                    *(u32x4*)(H1B + off) = w;
                    ss += (a[0] * a[0] + a[1] * a[1]) + (a[2] * a[2] + a[3] * a[3]) + (b[0] * b[0] + b[1] * b[1]) + (b[2] * b[2] + b[3] * b[3]);
                }
                ss += __shfl_xor(ss, 16); ss += __shfl_xor(ss, 32);
                if (fq == 0) SS[row * 16 + u.pn * 4 + wc] = ss;
            }
    }
};
__device__ __forceinline__ float row_rstd(const float* SS, size_t row) {
    const f32x4* s = (const f32x4*)(SS + row * 16);
    const f32x4 a = s[0], b = s[1], c = s[2], d = s[3];
    const float t = ((a[0] + a[1]) + (a[2] + a[3])) + ((b[0] + b[1]) + (b[2] + b[3])) + ((c[0] + c[1]) + (c[2] + c[3])) + ((d[0] + d[1]) + (d[2] + d[3]));
    return rsqrtf(t * (1.f / D) + EPS);
}
struct EpiQ {
    static constexpr bool PERM = true, AFTER_DRAIN = false;
    bf16_t* O; const float* SS; float* RSTD;
    __device__ __forceinline__ void operator()(const f32x4 (&acc)[2][2][4][2], const pg8::Unit& u, int wr, int wc, int fr, int fq) const {
        const int row0 = u.pm * 256 + wr * 64 + fr, col0 = u.pn * 256 + wc * 32 + 8 * fq;
#pragma unroll
        for (int ai = 0; ai < 2; ++ai)
#pragma unroll
            for (int m = 0; m < 4; ++m) {
                const size_t row = (size_t)(row0 + ai * 128 + m * 16);
                const float rs = row_rstd(SS, row);
                if (u.pn == 0 && wc == 0 && fq == 0) RSTD[row] = rs;
#pragma unroll
                for (int bj = 0; bj < 2; ++bj) {
                    const f32x4 a = acc[ai][bj][m][0] * rs, b = acc[ai][bj][m][1] * rs;
                    u32x4 w; w.x = pk2(a[0], a[1]); w.y = pk2(a[2], a[3]); w.z = pk2(b[0], b[1]); w.w = pk2(b[2], b[3]);
                    *(u32x4*)(O + row * QPS + col0 + bj * 128) = w;
                }
            }
    }
};

constexpr int HQ_STRIDE = 272, HT_STRIDE = 48;
constexpr int H_QA = 0, H_KD = 4352, H_KH = 8704, H_VT = 14848, H_DEC = 20992, H_OPER = 21504, H_RAW = 2 * H_OPER, H_RAWB = 16384;
constexpr size_t HG_DONE_OFF = 32768 + 256;
__device__ __forceinline__ void phase_hgrn(const Params& p, LAS unsigned char* lds, int G) {
    const int tid = threadIdx.x, lane = tid & 63, wave = __builtin_amdgcn_readfirstlane(tid >> 6), fr = lane & 15, g = lane >> 4;
    const bf16_t* PROJ = (const bf16_t*)(p.ws + WS_PROJ);
    const int NCH = SEQ / 16;
    for (int item = blockIdx.x; item < 128; item += G) {
        const int dir = item & 1, h = (item >> 1) & 3, b = item >> 3;
        bf16_t* O = (bf16_t*)p.out + (size_t)dir * T * 512;
        const int ck = dir ? C_KB : C_KF, cl = dir ? C_LFB : C_LFF;
        const bool isv = tid >= 256; const int arow = (tid & 255) >> 4, ac8 = (tid & 15) * 8;
        u32x4 rq = (u32x4){0u, 0u, 0u, 0u}, rk = rq, rl = rq;
#define HG_GLOAD(ch) do { const int pos_ = (ch) * 16 + arow, tr_ = dir ? SEQ - 1 - pos_ : pos_; \
            const bf16_t* rp_ = PROJ + (size_t)(b * SEQ + tr_) * PP + h * 128 + ac8; \
            if (isv) { rq = *(const u32x4*)(rp_ + C_V); } else { rq = *(const u32x4*)(rp_ + C_Q); rk = *(const u32x4*)(rp_ + ck); rl = *(const u32x4*)(rp_ + cl); } } while (0)
#define HG_RAWSTORE(par) do { LAS unsigned char* R_ = lds + H_RAW + (par) * H_RAWB + arow * 256 + ac8 * 2; \
            if (isv) { *(LAS u32x4*)(R_ + 12288) = rq; } else { *(LAS u32x4*)R_ = rq; *(LAS u32x4*)(R_ + 4096) = rk; *(LAS u32x4*)(R_ + 8192) = rl; } } while (0)
        const int pc = tid & 127, part = tid >> 7;
        auto phaseB = [&](int par) {
            const LAS unsigned char* R = lds + H_RAW + par * H_RAWB; LAS unsigned char* OP = lds + par * H_OPER;
            float pre = 0.f, total = 0.f;
#pragma unroll
            for (int t = 0; t < 16; ++t) { const float v = __uint_as_float((unsigned)(*(const LAS unsigned short*)(R + 8192 + t * 256 + pc * 2)) << 16); total += v; pre += (t < 4 * part) ? v : 0.f; }
            float bb = pre; float kh[4], vv[4];
#pragma unroll
            for (int j = 0; j < 4; ++j) {
                const int t = 4 * part + j;
                const float lfv = __uint_as_float((unsigned)(*(const LAS unsigned short*)(R + 8192 + t * 256 + pc * 2)) << 16);
                const float qv = __uint_as_float((unsigned)(*(const LAS unsigned short*)(R + t * 256 + pc * 2)) << 16);
                const float kv = __uint_as_float((unsigned)(*(const LAS unsigned short*)(R + 4096 + t * 256 + pc * 2)) << 16);
                vv[j] = __uint_as_float((unsigned)(*(const LAS unsigned short*)(R + 12288 + t * 256 + pc * 2)) << 16);
                bb += lfv;
                *(LAS unsigned short*)(OP + H_QA + t * HQ_STRIDE + pc * 2) = (unsigned short)f2bf(qv * __expf(bb));
                *(LAS unsigned short*)(OP + H_KD + t * HQ_STRIDE + pc * 2) = (unsigned short)f2bf(kv * __expf(-bb));
                kh[j] = kv * __expf(total - bb);
            }
            *(LAS u32x2*)(OP + H_KH + pc * HT_STRIDE + part * 8) = (u32x2){pk2(kh[0], kh[1]), pk2(kh[2], kh[3])};
            *(LAS u32x2*)(OP + H_VT + pc * HT_STRIDE + part * 8) = (u32x2){pk2(vv[0], vv[1]), pk2(vv[2], vv[3])};
            if (part == 0) *(LAS float*)(OP + H_DEC + pc * 4) = __expf(total);
        };
        f32x4 S[8];
#pragma unroll
        for (int kt = 0; kt < 8; ++kt) S[kt] = (f32x4){0.f, 0.f, 0.f, 0.f};
        __syncthreads();
        HG_GLOAD(0); HG_RAWSTORE(0); HG_GLOAD(1);
        __syncthreads();
        phaseB(0); HG_RAWSTORE(1);
        __syncthreads();
        for (int i = 0; i < NCH; ++i) {
            if (i + 2 < NCH) HG_GLOAD(i + 2);
            if (i + 1 < NCH) phaseB((i + 1) & 1);
            {
                const LAS unsigned char* OP = lds + (i & 1) * H_OPER;
                f32x4 o = (f32x4){0.f, 0.f, 0.f, 0.f};
#pragma unroll
                for (int j = 0; j < 4; ++j) {
                    u32x4 w; w.x = pk2(S[2 * j][0], S[2 * j][1]); w.y = pk2(S[2 * j][2], S[2 * j][3]); w.z = pk2(S[2 * j + 1][0], S[2 * j + 1][1]); w.w = pk2(S[2 * j + 1][2], S[2 * j + 1][3]);
                    const u32x2 a0 = *(const LAS u32x2*)(OP + H_QA + fr * HQ_STRIDE + (32 * j + 4 * g) * 2), a1 = *(const LAS u32x2*)(OP + H_QA + fr * HQ_STRIDE + (32 * j + 16 + 4 * g) * 2);
                    o = __builtin_amdgcn_mfma_f32_16x16x32_bf16(__builtin_bit_cast(bf16x8, (u32x4){a0.x, a0.y, a1.x, a1.y}), __builtin_bit_cast(bf16x8, w), o, 0, 0, 0);
                }
                f32x4 X = (f32x4){0.f, 0.f, 0.f, 0.f};
#pragma unroll
                for (int j = 0; j < 4; ++j) {
                    const bf16x8 ak = *(const LAS bf16x8*)(OP + H_KD + fr * HQ_STRIDE + (32 * j + 8 * g) * 2), bq = *(const LAS bf16x8*)(OP + H_QA + fr * HQ_STRIDE + (32 * j + 8 * g) * 2);
                    X = __builtin_amdgcn_mfma_f32_16x16x32_bf16(ak, bq, X, 0, 0, 0);
                }
#pragma unroll
                for (int r = 0; r < 4; ++r) X[r] = (4 * g + r > fr) ? 0.f : X[r];
                const u32x2 vlo = *(const LAS u32x2*)(OP + H_VT + (16 * wave + fr) * HT_STRIDE + g * 8);
                const bf16x8 vb = __builtin_bit_cast(bf16x8, (u32x4){vlo.x, vlo.y, 0u, 0u});
                const bf16x8 pa = __builtin_bit_cast(bf16x8, (u32x4){pk2(X[0], X[1]), pk2(X[2], X[3]), 0u, 0u});
                o = __builtin_amdgcn_mfma_f32_16x16x32_bf16(pa, vb, o, 0, 0, 0);
#pragma unroll
                for (int r = 0; r < 4; ++r) { const int pos = i * 16 + 4 * g + r, tr = dir ? SEQ - 1 - pos : pos; O[(size_t)(b * SEQ + tr) * 512 + h * 128 + 16 * wave + fr] = (bf16_t)f2bf(o[r]); }
#pragma unroll
                for (int kt = 0; kt < 8; ++kt) {
                    const f32x4 dc = *(const LAS f32x4*)(OP + H_DEC + (16 * kt + 4 * g) * 4);
                    const u32x2 klo = *(const LAS u32x2*)(OP + H_KH + (16 * kt + fr) * HT_STRIDE + g * 8);
                    S[kt] = __builtin_amdgcn_mfma_f32_16x16x32_bf16(__builtin_bit_cast(bf16x8, (u32x4){klo.x, klo.y, 0u, 0u}), vb, S[kt] * dc, 0, 0, 0);
                }
            }
            if (i + 2 < NCH) HG_RAWSTORE(i & 1);
            __syncthreads();
        }
        asm volatile("s_waitcnt vmcnt(0)" ::: "memory");
        __syncthreads();
        if (tid == 0) { __builtin_amdgcn_fence(__ATOMIC_RELEASE, "agent"); asm volatile("s_waitcnt vmcnt(0)" ::: "memory");
            (void)__hip_atomic_fetch_add((unsigned*)(p.ws + HG_DONE_OFF), 1u, __ATOMIC_RELAXED, __HIP_MEMORY_SCOPE_AGENT); }
    }
}

constexpr int KT_STRIDE = 272, VT_STRIDE = 144;
constexpr int ATT_BUF = 64 * KT_STRIDE + 128 * VT_STRIDE;
constexpr int QUANT_ITEMS = 256;
__device__ __forceinline__ void quant_tables(const Params& p, int gw, int NGW, int lane) {
    unsigned char* ws = p.ws;
#define PQ_LOAD(dst, r0_) { _Pragma("unroll") for (int u = 0; u < 4; ++u) { const int r = ((r0_) + u * NGW) < 2 * 16384 ? ((r0_) + u * NGW) : gw; const bool isv = r >= 16384; const int e = isv ? r - 16384 : r; \
            const f32x4* xr = (const f32x4*)((isv ? p.in[I_V] : p.in[I_U]) + (size_t)e * D) + lane; _Pragma("unroll") for (int j = 0; j < 4; ++j) dst[u][j] = xr[64 * j]; } }
#define PQ_PROC(src, r0_) { _Pragma("unroll") for (int u = 0; u < 4; ++u) { const int r = (r0_) + u * NGW; if (r < 2 * 16384) { \
            const bool isv = r >= 16384; const int e = isv ? r - 16384 : r; f32x4 v[4]; float am = 0.f; \
            _Pragma("unroll") for (int j = 0; j < 4; ++j) { v[j] = src[u][j]; if (!isv) v[j] = v[j] * ((const f32x4*)p.in[I_G2])[64 * j + lane]; \
                am = fmaxf(am, fmaxf(fmaxf(fabsf(v[j].x), fabsf(v[j].y)), fmaxf(fabsf(v[j].z), fabsf(v[j].w)))); } \
            am = wave_max(am); const float sc = am > 0.f ? am * (1.f / 7.f) : 1.f, inv = 1.f / sc; unsigned pk[4]; int qs = 0; \
            _Pragma("unroll") for (int j = 0; j < 4; ++j) { \
                const int q0 = (int)rintf(v[j].x * inv), q1 = (int)rintf(v[j].y * inv), q2 = (int)rintf(v[j].z * inv), q3 = (int)rintf(v[j].w * inv); qs += (q0 + q1) + (q2 + q3); \
                pk[j] = (unsigned)((q0 & 0xFF) | ((q1 & 0xFF) << 8) | ((q2 & 0xFF) << 16) | ((q3 & 0xFF) << 24)); } \
            if (isv) {   \
                _Pragma("unroll") for (int j = 0; j < 4; ++j) { const unsigned k_ = pk[j]; \
                    *(unsigned short*)(ws + WS_VE + ((size_t)j * 16384 + e) * VSL + 2 * lane) = (unsigned short)(((k_ & 0xFu) ^ 8u) | ((k_ >> 4) & 0xF0u) | ((((k_ >> 16) & 0xFu) ^ 8u) << 8) | ((k_ >> 12) & 0xF000u)); } \
                if (lane == 0) ((float*)(ws + WS_VSC))[e] = sc; } \
            else {   \
                _Pragma("unroll") for (int j = 0; j < 2; ++j) *(unsigned*)(ws + WS_UT + (size_t)e * 512 + 256 * j + 4 * lane) = (pk[j] & 0x0F0F0F0Fu) | ((pk[j + 2] << 4) & 0xF0F0F0F0u); \
                const float qt = wave_sum((float)qs); if (lane == 0) { ((float*)(ws + WS_USC))[e] = sc; ((float*)(ws + WS_US8))[e] = 8.f * qt; } } } } }
    for (int r0 = gw; r0 < 2 * 16384; r0 += 4 * NGW) { f32x4 va[4][4]; PQ_LOAD(va, r0) PQ_PROC(va, r0) }
}
constexpr int MIX_ITEMS = 256;
__device__ __forceinline__ void mix_rows(const Params& p, int gw, int NGW, int lane) {
    const bf16_t* PROJ = (const bf16_t*)(p.ws + WS_PROJ);
    const bf16_t* OF = (const bf16_t*)p.out; const bf16_t* OB = OF + (size_t)T * 512;
    bf16_t* MIXED = (bf16_t*)(p.ws + WS_XN);
    const float* hog = p.in[I_HOG];
    const f32x4 g0 = *(const f32x4*)(hog + (lane & 15) * 8), g1 = *(const f32x4*)(hog + (lane & 15) * 8 + 4);
    for (int m0 = gw; m0 < T; m0 += 4 * NGW) {
        u32x4 av[4], bv[4], gv[4];
#pragma unroll
        for (int u = 0; u < 4; ++u) { const int m = (m0 + u * NGW) < T ? (m0 + u * NGW) : m0;
            av[u] = *(const u32x4*)(OF + (size_t)m * 512 + 8 * lane); bv[u] = *(const u32x4*)(OB + (size_t)m * 512 + 8 * lane); gv[u] = *(const u32x4*)(PROJ + (size_t)m * PP + C_G + 8 * lane); }
#pragma unroll
        for (int u = 0; u < 4; ++u) {
            const int m = m0 + u * NGW; if (m >= T) break;
            const u32x4 a = av[u], bb = bv[u], gg = gv[u];
            float o[8]; float ss = 0.f;
#pragma unroll
            for (int i = 0; i < 4; ++i) { o[2 * i] = bflo(a[i]) + bflo(bb[i]); o[2 * i + 1] = bfhi(a[i]) + bfhi(bb[i]); ss += o[2 * i] * o[2 * i] + o[2 * i + 1] * o[2 * i + 1]; }
            ss += dpp_mov<0xB1>(ss); ss += dpp_mov<0x4E>(ss); ss += dpp_mov<0x141>(ss); ss += dpp_mov<0x140>(ss);
            const float rs = rsqrtf(ss * (1.f / 128.f) + EPS);
            float y[8];
#pragma unroll
            for (int i = 0; i < 4; ++i) { y[2 * i] = o[2 * i] * rs * (i < 2 ? g0[2 * i] : g1[2 * i - 4]) * bflo(gg[i]); y[2 * i + 1] = o[2 * i + 1] * rs * (i < 2 ? g0[2 * i + 1] : g1[2 * i - 3]) * bfhi(gg[i]); }
            *(u32x4*)(MIXED + (size_t)m * D + 8 * lane) = (u32x4){pk2(y[0], y[1]), pk2(y[2], y[3]), pk2(y[4], y[5]), pk2(y[6], y[7])};
        }
    }
}

__device__ __forceinline__ float MAX3_(float a, float b, float c) { float r; asm("v_max3_f32 %0, %1, %2, %3" : "=v"(r) : "v"(a), "v"(b), "v"(c)); return r; }
__device__ __forceinline__ void phase_attn(const Params& p, LAS unsigned char* lds, int G) {
    const int tid = threadIdx.x, lane = tid & 63, wave = __builtin_amdgcn_readfirstlane(tid >> 6), fr = lane & 15, fq = lane >> 4;
    const bf16_t* PROJ = (const bf16_t*)(p.ws + WS_PROJ);
    const bf16_t* VT = (const bf16_t*)(p.ws + WS_VT);
    bf16_t* MIXED = (bf16_t*)(p.ws + WS_XN);
    const float* sm = (const float*)(p.ws + WS_SM);
    LAS unsigned char* LK = lds; LAS unsigned char* LV = lds + 64 * KT_STRIDE; LAS float* LB = (LAS float*)(lds + 2 * ATT_BUF);
    const float lam = sm[SM_LAM];
    float vinf = __builtin_inff(); asm volatile("" : "+v"(vinf));
    unsigned* qctr = (unsigned*)(p.ws + 32768);
    volatile LAS unsigned* qslot = (volatile LAS unsigned*)(lds + 131072 + 320 + 64);
    for (;;) {
        __syncthreads();
        if (tid == 0) qslot[0] = __hip_atomic_fetch_add(qctr, 1u, __ATOMIC_RELAXED, __HIP_MEMORY_SCOPE_AGENT);
        __syncthreads();
        const int item = (int)qslot[0];
        if (item >= 1024 + QUANT_ITEMS + MIX_ITEMS) break;
        if (item >= 1024 + QUANT_ITEMS) {
            if (tid == 0) { unsigned sp_ = 0; while (__hip_atomic_load((unsigned*)(p.ws + HG_DONE_OFF), __ATOMIC_RELAXED, __HIP_MEMORY_SCOPE_AGENT) < 128u && ++sp_ < (1u << 24)) __builtin_amdgcn_s_sleep(2);
                __builtin_amdgcn_fence(__ATOMIC_ACQUIRE, "agent"); asm volatile("s_waitcnt vmcnt(0)" ::: "memory"); }
            __syncthreads();
            mix_rows(p, (item - 1024 - QUANT_ITEMS) * NWAVES + wave, MIX_ITEMS * NWAVES, lane); continue;
        }
        if (item >= 1024) { quant_tables(p, (item - 1024) * NWAVES + wave, QUANT_ITEMS * NWAVES, lane); continue; }
        const int bh = item >> 4, qb = item & 15, b = bh >> 2, h = bh & 3;
        const int qabs = qb * 128 + wave * 16 + fr;
        const size_t qrow = (size_t)b * SEQ + qabs;
        __syncthreads();
        for (int i = tid; i < 257; i += NTHREADS) LB[i] = sm[SM_BT + h * BT_STRIDE + i];
        bf16x8 qf[2][2];
#pragma unroll
        for (int m = 0; m < 2; ++m)
#pragma unroll
            for (int kk = 0; kk < 2; ++kk) qf[m][kk] = *(const bf16x8*)(PROJ + qrow * PP + C_DQ + h * 128 + m * 64 + kk * 32 + fq * 8);
        float mrun[2] = {0.f, 0.f};
        f32x4 lacc[2] = {(f32x4){0.f, 0.f, 0.f, 0.f}, (f32x4){0.f, 0.f, 0.f, 0.f}};
        f32x4 o[2][8];
#pragma unroll
        for (int m = 0; m < 2; ++m)
#pragma unroll
            for (int dt = 0; dt < 8; ++dt) o[m][dt] = (f32x4){0.f, 0.f, 0.f, 0.f};
        u32x4 kreg[2], vreg[2];
        const bf16_t* kg[2]; const bf16_t* vg[2]; int koff[2], voff[2];
#pragma unroll
        for (int i = 0; i < 2; ++i) { const int c = tid + i * 512;
            const int kr = c >> 4, kc = (c & 15) * 8; kg[i] = PROJ + ((size_t)b * SEQ + kr) * PP + C_DK + h * 128 + kc; koff[i] = kr * KT_STRIDE + kc * 2;
            const int vr = c >> 3, vc = (c & 7) * 8; vg[i] = VT + (size_t)(h * 128 + vr) * T + (size_t)b * SEQ + vc; voff[i] = vr * VT_STRIDE + vc * 2; }
#pragma unroll
        for (int i = 0; i < 2; ++i) { kreg[i] = *(const u32x4*)kg[i]; vreg[i] = *(const u32x4*)vg[i]; }
#pragma unroll
        for (int i = 0; i < 2; ++i) { *(LAS u32x4*)(LK + koff[i]) = kreg[i]; *(LAS u32x4*)(LV + voff[i]) = vreg[i]; }
        __syncthreads();
        const int Qw = qb * 128 + wave * 16;
        for (int kt = 0; kt < SEQ / 64; ++kt) {
            const int pbuf = (kt & 1) * ATT_BUF;
            if (kt + 1 < SEQ / 64) {
#pragma unroll
                for (int i = 0; i < 2; ++i) { kreg[i] = *(const u32x4*)(kg[i] + (size_t)(kt + 1) * 64 * PP); vreg[i] = *(const u32x4*)(vg[i] + (kt + 1) * 64); }
            }
            const int k0 = kt * 64;
            const bool farl = (k0 + 63 - Qw) <= -91, farr = (k0 - (Qw + 15)) >= 91;
            const float binit = farl ? LB[0] : (farr ? LB[256] : 0.f);
            f32x4 s[2][4];
#pragma unroll
            for (int m = 0; m < 2; ++m) {
                const float ci = binit - mrun[m];
#pragma unroll
                for (int ks = 0; ks < 4; ++ks) {
                    f32x4 a = (f32x4){ci, ci, ci, ci};
#pragma unroll
                    for (int kk = 0; kk < 2; ++kk) {
                        const bf16x8 kf = *(const LAS bf16x8*)(LK + pbuf + (16 * ks + fr) * KT_STRIDE + (m * 64 + kk * 32 + fq * 8) * 2);
                        a = __builtin_amdgcn_mfma_f32_16x16x32_bf16(kf, qf[m][kk], a, 0, 0, 0);
                    }
                    s[m][ks] = a;
                }
            }
            if (!(farl || farr)) {
#pragma unroll
                for (int ks = 0; ks < 4; ++ks)
#pragma unroll
                    for (int r = 0; r < 4; ++r) {
                        int rel = k0 + 16 * ks + 4 * fq + r - qabs; rel = rel < -128 ? -128 : (rel > 128 ? 128 : rel);
                        const float bv = LB[rel + 128];
                        s[0][ks][r] += bv; s[1][ks][r] += bv;
                    }
            }
            bf16x8 pb[2][2];
#pragma unroll
            for (int m = 0; m < 2; ++m) {
                float mx = MAX3_(__builtin_amdgcn_fmed3f(s[m][0][0], s[m][1][0], vinf), __builtin_amdgcn_fmed3f(s[m][2][0], s[m][3][0], vinf), s[m][0][1]);
                mx = MAX3_(mx, s[m][0][2], s[m][0][3]); mx = MAX3_(mx, s[m][1][1], s[m][1][2]); mx = MAX3_(mx, s[m][1][3], s[m][2][1]);
                mx = MAX3_(mx, s[m][2][2], s[m][2][3]); mx = MAX3_(mx, s[m][3][1], s[m][3][2]); mx = MAX3_(mx, mx, s[m][3][3]);
                { float a_ = mx, b_ = mx; swap16_(a_, b_); mx = MAX3_(a_, b_, b_); }
                { float a_ = mx, b_ = mx; swap32_(a_, b_); mx = MAX3_(a_, b_, b_); }
                if (__any(fabsf(mx) > 8.0f)) {
                    const float dl = fabsf(mx) > 8.0f ? mx : 0.f, alpha = __builtin_amdgcn_exp2f(-dl);
                    mrun[m] += dl; lacc[m] *= alpha;
#pragma unroll
                    for (int ks = 0; ks < 4; ++ks) s[m][ks] = s[m][ks] - dl;
#pragma unroll
                    for (int dt = 0; dt < 8; ++dt) o[m][dt] *= alpha;
                }
#pragma unroll
                for (int ks = 0; ks < 4; ++ks)
#pragma unroll
                    for (int r = 0; r < 4; ++r) s[m][ks][r] = __builtin_amdgcn_exp2f(s[m][ks][r]);
#pragma unroll
                for (int k2 = 0; k2 < 2; ++k2) {
                    u32x4 w; w.x = pk2(s[m][2 * k2][0], s[m][2 * k2][1]); w.y = pk2(s[m][2 * k2][2], s[m][2 * k2][3]);
                    w.z = pk2(s[m][2 * k2 + 1][0], s[m][2 * k2 + 1][1]); w.w = pk2(s[m][2 * k2 + 1][2], s[m][2 * k2 + 1][3]);
                    pb[m][k2] = __builtin_bit_cast(bf16x8, w);
                }
            }
            const bf16x8 ones = __builtin_bit_cast(bf16x8, (u32x4){0x3F803F80u, 0x3F803F80u, 0x3F803F80u, 0x3F803F80u});
#pragma unroll
            for (int k2 = 0; k2 < 2; ++k2) {
                lacc[0] = __builtin_amdgcn_mfma_f32_16x16x32_bf16(ones, pb[0][k2], lacc[0], 0, 0, 0);
                lacc[1] = __builtin_amdgcn_mfma_f32_16x16x32_bf16(ones, pb[1][k2], lacc[1], 0, 0, 0);
#pragma unroll
                for (int dt = 0; dt < 8; ++dt) {
                    const u32x2 lo = *(const LAS u32x2*)(LV + pbuf + (16 * dt + fr) * VT_STRIDE + (32 * k2 + 4 * fq) * 2);
                    const u32x2 hi = *(const LAS u32x2*)(LV + pbuf + (16 * dt + fr) * VT_STRIDE + (32 * k2 + 16 + 4 * fq) * 2);
                    const bf16x8 vf = __builtin_bit_cast(bf16x8, (u32x4){lo.x, lo.y, hi.x, hi.y});
                    o[0][dt] = __builtin_amdgcn_mfma_f32_16x16x32_bf16(vf, pb[0][k2], o[0][dt], 0, 0, 0);
                    o[1][dt] = __builtin_amdgcn_mfma_f32_16x16x32_bf16(vf, pb[1][k2], o[1][dt], 0, 0, 0);
                }
            }
            if (kt + 1 < SEQ / 64) {
                const int nbuf = ((kt + 1) & 1) * ATT_BUF;
#pragma unroll
                for (int i = 0; i < 2; ++i) { *(LAS u32x4*)(LK + nbuf + koff[i]) = kreg[i]; *(LAS u32x4*)(LV + nbuf + voff[i]) = vreg[i]; }
            }
            __syncthreads();
        }
        float inv[2];
#pragma unroll
        for (int m = 0; m < 2; ++m) inv[m] = __builtin_amdgcn_rcpf(lacc[m][0]);
        float ssq = 0.f;
#pragma unroll
        for (int dt = 0; dt < 8; ++dt)
#pragma unroll
            for (int r = 0; r < 4; ++r) { const float ov = o[0][dt][r] * inv[0] - lam * (o[1][dt][r] * inv[1]); o[0][dt][r] = ov; ssq += ov * ov; }
        ssq += __shfl_xor(ssq, 16); ssq += __shfl_xor(ssq, 32);
        const float rs = rsqrtf(ssq * (1.f / 128.f) + EPS) * 0.8f;
        const float* og = p.in[I_DOG];
#pragma unroll
        for (int dt = 0; dt < 8; ++dt) {
            const f32x4 g = *(const f32x4*)(og + 16 * dt + 4 * fq);
            const f32x4 y = o[0][dt] * rs * g;
            *(u32x2*)(MIXED + qrow * D + 512 + h * 128 + 16 * dt + 4 * fq) = (u32x2){pk2(y[0], y[1]), pk2(y[2], y[3])};
        }
    }
}

__device__ __forceinline__ void phase_hquant(const Params& p, int vcu, int G) {
    const int tid = threadIdx.x, lane = tid & 63, wave = __builtin_amdgcn_readfirstlane(tid >> 6);
    const bf16_t* H1B = (const bf16_t*)(p.ws + WS_H1B); const float* SS = (const float*)(p.ws + WS_SS);
    for (int t0 = vcu * NWAVES + wave; t0 < T; t0 += 4 * G * NWAVES) {
        u32x4 ha[4], hb[4];
#pragma unroll
        for (int u = 0; u < 4; ++u) { const int t = (t0 + u * G * NWAVES) < T ? (t0 + u * G * NWAVES) : t0; ha[u] = *(const u32x4*)(H1B + (size_t)t * D + 8 * lane); hb[u] = *(const u32x4*)(H1B + (size_t)t * D + 512 + 8 * lane); }
#pragma unroll
        for (int u = 0; u < 4; ++u) {
            const int t = t0 + u * G * NWAVES; if (t >= T) break;
            const u32x4 h0 = ha[u], h1 = hb[u];
            float hf[16]; float am = 0.f;
#pragma unroll
            for (int k = 0; k < 4; ++k) { hf[2 * k] = bflo(h0[k]); hf[2 * k + 1] = bfhi(h0[k]); hf[8 + 2 * k] = bflo(h1[k]); hf[8 + 2 * k + 1] = bfhi(h1[k]); }
#pragma unroll
            for (int k = 0; k < 16; ++k) am = fmaxf(am, fabsf(hf[k]));
            am = wave_max(am);
            const float iv = am > 0.f ? 127.f / am : 0.f;
            u32x4 q;
#pragma unroll
            for (int w = 0; w < 4; ++w) { const int q0 = (int)rintf(hf[4 * w] * iv), q1 = (int)rintf(hf[4 * w + 1] * iv), q2 = (int)rintf(hf[4 * w + 2] * iv), q3 = (int)rintf(hf[4 * w + 3] * iv);
                q[w] = (unsigned)((q0 & 0xFF) | ((q1 & 0xFF) << 8) | ((q2 & 0xFF) << 16) | ((q3 & 0xFF) << 24)); }
            u32x2 ph, pl;
#pragma unroll
            for (int w = 0; w < 2; ++w) { ph[w] = ((q[w] >> 4) & 0x0F0F0F0Fu) | (q[2 + w] & 0xF0F0F0F0u); pl[w] = ((q[w] & 0x0F0F0F0Fu) | ((q[2 + w] << 4) & 0xF0F0F0F0u)) ^ 0x88888888u; }
            *(u32x2*)(p.ws + WS_H1Q + (size_t)t * D + 8 * lane) = ph; *(u32x2*)(p.ws + WS_H1Q + (size_t)t * D + 512 + 8 * lane) = pl;
            if (lane == 0) ((float*)(p.ws + WS_HSC))[t] = am * (1.f / 127.f) * row_rstd(SS, (size_t)t);
        }
    }
}
__device__ __forceinline__ unsigned ford(float f) { const unsigned u = __float_as_uint(f); return (u & 0x80000000u) ? ~u : (u | 0x80000000u); }
__device__ __forceinline__ float funord(unsigned u) { u = (u & 0x80000000u) ? (u & 0x7fffffffu) : ~u; return __uint_as_float(u); }
template <int N> __device__ __forceinline__ void bitonic_sort_desc(unsigned (&v)[N]) {
#pragma unroll
    for (int k = 2; k <= N; k <<= 1)
#pragma unroll
        for (int j = k >> 1; j > 0; j >>= 1)
#pragma unroll
            for (int i = 0; i < N; ++i) { const int l = i ^ j;
                if (l > i) { const unsigned a = v[i], b = v[l]; const unsigned mx = a > b ? a : b, mn = a > b ? b : a; if ((i & k) == 0) { v[i] = mx; v[l] = mn; } else { v[i] = mn; v[l] = mx; } } }
}
__device__ __forceinline__ void merge_top16(unsigned (&a)[16], const unsigned (&b)[16]) {
#pragma unroll
    for (int i = 0; i < 16; ++i) a[i] = a[i] > b[15 - i] ? a[i] : b[15 - i];
#pragma unroll
    for (int j = 8; j > 0; j >>= 1)
#pragma unroll
        for (int i = 0; i < 16; ++i) { const int l = i ^ j; if (l > i) { const unsigned x = a[i], y = a[l]; a[i] = x > y ? x : y; a[l] = x > y ? y : x; } }
}
__device__ __forceinline__ void top16_of64(const unsigned (&v)[64], unsigned (&out)[16]) {
    unsigned g1[16], g2[16], g3[16];
#pragma unroll
    for (int i = 0; i < 16; ++i) { out[i] = v[i]; g1[i] = v[16 + i]; g2[i] = v[32 + i]; g3[i] = v[48 + i]; }
    bitonic_sort_desc<16>(out); bitonic_sort_desc<16>(g1); bitonic_sort_desc<16>(g2); bitonic_sort_desc<16>(g3);
    merge_top16(out, g1); merge_top16(g2, g3); merge_top16(out, g2);
}
__device__ __forceinline__ unsigned xchg32u(unsigned v, int lane) { return __builtin_bit_cast(unsigned, xchg32(__builtin_bit_cast(float, v), lane)); }
constexpr int TK_KROW = 272, TK_TAB = 256 * TK_KROW;
__device__ __forceinline__ void phase_topk(const Params& p, LAS unsigned char* lds, int vcu, int G) {
    const int tid = threadIdx.x, lane = tid & 63, wave = __builtin_amdgcn_readfirstlane(tid >> 6), r32 = lane & 31, hi = lane >> 5;
    const bf16_t* QP = (const bf16_t*)(p.ws + WS_QP);
    const bf16_t* KEYS = (const bf16_t*)(p.ws + WS_KEYS);
    int* IDX = (int*)(p.ws + WS_IDX);
    LAS unsigned* tab = (LAS unsigned*)(lds + TK_TAB) + wave * 8 * 64 + lane;
    for (int item = blockIdx.x; item < (T / 256) * 2; item += G) {
        const int tg = item % (T / 256), hg = item / (T / 256);
        const size_t tok = (size_t)(tg * 8 + wave) * 32 + r32;
        for (int hh = 0; hh < 4; ++hh) {
            const int h = hg * 4 + hh;
            __syncthreads();
#pragma unroll
            for (int c8 = 0; c8 < 8; ++c8) { const int c = tid + c8 * NTHREADS, row = c >> 4, ch = c & 15;
                *(LAS u32x4*)(lds + row * TK_KROW + ch * 16) = *(const u32x4*)(KEYS + (size_t)(h * 256 + row) * 128 + ch * 8); }
            __syncthreads();
            unsigned lst[2][16];
#pragma unroll
            for (int pp = 0; pp < 2; ++pp) {
                f32x16 acc[4];
#pragma unroll
                for (int kt = 0; kt < 4; ++kt)
#pragma unroll
                    for (int r = 0; r < 16; ++r) acc[kt][r] = 0.f;
                const bf16_t* qrow = QP + tok * QPS + h * 256 + pp * 128 + 8 * hi;
                const LAS unsigned char* kb = lds + (pp * 128 + r32) * TK_KROW + 16 * hi;
#pragma unroll
                for (int s2 = 0; s2 < 8; ++s2) {
                    const bf16x8 bq = *(const bf16x8*)(qrow + 16 * s2);
#pragma unroll
                    for (int kt = 0; kt < 4; ++kt) {
                        const bf16x8 ak = *(const LAS bf16x8*)(kb + kt * 32 * TK_KROW + 32 * s2);
                        acc[kt] = __builtin_amdgcn_mfma_f32_32x32x16_bf16(ak, bq, acc[kt], 0, 0, 0);
                    }
                }
                unsigned v[64];
#pragma unroll
                for (int kt = 0; kt < 4; ++kt)
#pragma unroll
                    for (int r = 0; r < 16; ++r) { const int n = 32 * kt + (r & 3) + 8 * (r >> 2) + 4 * hi; v[kt * 16 + r] = (ford(acc[kt][r]) & ~0x7Fu) | (unsigned)(127 - n); }
                unsigned own[16], oth[16];
                top16_of64(v, own);
#pragma unroll
                for (int j = 0; j < 16; ++j) oth[j] = xchg32u(own[j], lane);
                merge_top16(own, oth);
#pragma unroll
                for (int j = 0; j < 16; ++j) lst[pp][j] = own[j];
            }
            float a[16], bs[16];
#pragma unroll
            for (int j = 0; j < 16; ++j) { a[j] = funord(lst[0][j] & ~0x7Fu); bs[j] = funord(lst[1][j] & ~0x7Fu); }
#pragma unroll
            for (int m = 0; m < 4; ++m) {
                tab[m * 64] = (127u - (lst[0][4 * m] & 0x7Fu)) | ((127u - (lst[0][4 * m + 1] & 0x7Fu)) << 8) | ((127u - (lst[0][4 * m + 2] & 0x7Fu)) << 16) | ((127u - (lst[0][4 * m + 3] & 0x7Fu)) << 24);
                tab[(4 + m) * 64] = (127u - (lst[1][4 * m] & 0x7Fu)) | ((127u - (lst[1][4 * m + 1] & 0x7Fu)) << 8) | ((127u - (lst[1][4 * m + 2] & 0x7Fu)) << 16) | ((127u - (lst[1][4 * m + 3] & 0x7Fu)) << 24);
            }
            unsigned cand[64];
            {
                int c = 0;
#pragma unroll
                for (int i = 0; i < 16; ++i)
#pragma unroll
                    for (int j = 0; j < 16; ++j)
                        if ((i + 1) * (j + 1) <= 16) { cand[c] = (ford(a[i] + bs[j]) & ~0xFFu) | (unsigned)(255 - (i * 16 + j)); ++c; }
#pragma unroll
                for (int q = 50; q < 64; ++q) cand[q] = 0u;
            }
            unsigned best[16], eidx[16];
            top16_of64(cand, best);
            LDS_WAIT();
#pragma unroll
            for (int r = 0; r < 16; ++r) { const unsigned code = 255u - (best[r] & 0xFFu), ci = code >> 4, cj = code & 15u;
                const unsigned wi = tab[(ci >> 2) * 64], wj = tab[(4 + (cj >> 2)) * 64];
                eidx[r] = ((wi >> (8 * (ci & 3u))) & 0x7Fu) * 128u + ((wj >> (8 * (cj & 3u))) & 0x7Fu); }
            LDS_WAIT();
            if (hi == 0) {
                float g[16]; const float mx = funord(best[0] & ~0xFFu); float tot = 0.f;
#pragma unroll
                for (int r = 0; r < 16; ++r) { g[r] = __expf(funord(best[r] & ~0xFFu) - mx); tot += g[r]; }
                const float it_ = 1.f / tot;
                unsigned* rp = (unsigned*)IDX + (tok * 8 + h) * 16;
#pragma unroll
                for (int q4 = 0; q4 < 4; ++q4)
                    *(u32x4*)(rp + 4 * q4) = (u32x4){eidx[4 * q4] | (f2bf(g[4 * q4] * it_) << 16), eidx[4 * q4 + 1] | (f2bf(g[4 * q4 + 1] * it_) << 16), eidx[4 * q4 + 2] | (f2bf(g[4 * q4 + 2] * it_) << 16), eidx[4 * q4 + 3] | (f2bf(g[4 * q4 + 3] * it_) << 16)};
            }
        }
    }
}

typedef float f32x2_ __attribute__((ext_vector_type(2)));
__device__ __forceinline__ float gelu_exact(float v) {
    const float av = fabsf(v), t = __builtin_amdgcn_rcpf(av * 0.2316418882f + 1.0f);
    float q = t * 0.5307027145f + (-0.7265760135f); q = q * t + 0.7107068705f; q = q * t + (-0.142248368f); q = q * t + 0.127414796f; q = q * t;
    const float e = __builtin_amdgcn_exp2f((v * v) * (-0.72134752044f));
    const float m = v * (q * e);
    return v < 0.f ? m : v - m;
}
typedef float f32x2_ __attribute__((ext_vector_type(2)));
__device__ __forceinline__ void phase_peer_u(const Params& p, LAS unsigned char* lds, int G, int mx, int mj) {
    const int tid = threadIdx.x, lane = tid & 63, wave = __builtin_amdgcn_readfirstlane(tid >> 6), bx = blockIdx.x;
    const bool xl = (G % 8 == 0);
    const int x = xl ? mx : 0, nx = xl ? 8 : 1, jb = xl ? mj : bx, nw = (xl ? G / 8 : G) * NWAVES, widx = jb * NWAVES + wave;
    const unsigned char* H1Q = (const unsigned char*)(p.ws + WS_H1Q); const unsigned char* UQ = (const unsigned char*)(p.ws + WS_UT);
    const unsigned* REC = (const unsigned*)(p.ws + WS_IDX); const float* HSC = (const float*)(p.ws + WS_HSC);
    const float* USC = (const float*)(p.ws + WS_USC); const float* VSC = (const float*)(p.ws + WS_VSC);
    unsigned* CI = (unsigned*)(p.ws + WS_C);
    LAS float* SU = (LAS float*)lds; LAS float* SV = SU + GRP_SIZE; LAS float* U8 = (LAS float*)(lds + 49152);
    LAS u32x2* slots = (LAS u32x2*)(lds + 16384 + wave * 2048);
    LAS u32x4* hbuf = (LAS u32x4*)(lds + 32768 + wave * 2048);
    const int K = (T - widx + nw - 1) / nw;
    const int lrow = lane >> 4, lcol = lane & 15, lc16 = 16 * lcol;
    for (int g = x; g < NGRP; g += nx) {
        __syncthreads();
        for (int i = tid; i < GRP_SIZE; i += NTHREADS) { SU[i] = USC[g * GRP_SIZE + i]; SV[i] = VSC[g * GRP_SIZE + i]; U8[i] = ((const float*)(p.ws + WS_US8))[g * GRP_SIZE + i]; }
        __syncthreads();
#define PU_R(S, k_) { const int kk_ = (k_) < K ? (k_) : K - 1; const size_t tt_ = (size_t)(widx + nw * kk_); \
            rq##S = *(const u32x2*)(REC + tt_ * 128 + 2 * lane); rr##S = HSC[tt_]; hr##S = *(const u32x4*)(H1Q + tt_ * D + 16 * lane); }
#define PU_C(S, k_) { LAS u32x2* sl_ = slots + S * 128; const bool ok_ = (k_) < K; tk##S = widx + nw * ((k_) < K ? (k_) : K - 1); rs##S = rr##S; \
            hbuf[S * 64 + lane] = hr##S; const unsigned rl##S = rq##S.x, rh##S = rq##S.y; \
            { const bool f0 = ((rl##S & 0x3FFFu) >> GRP_SHIFT) == (unsigned)g, f1 = ((rh##S & 0x3FFFu) >> GRP_SHIFT) == (unsigned)g; const unsigned long long m0 = __ballot(f0), m1 = __ballot(f1); const int n0 = __popcll(m0); \
              if (f0) sl_[(int)__builtin_amdgcn_mbcnt_hi((unsigned)(m0 >> 32), __builtin_amdgcn_mbcnt_lo((unsigned)m0, 0u))] = (u32x2){((rl##S & 0x3FFFu) << 9) | ((unsigned)(2 * lane) << 24), rl##S & 0xffff0000u}; \
              if (f1) sl_[n0 + (int)__builtin_amdgcn_mbcnt_hi((unsigned)(m1 >> 32), __builtin_amdgcn_mbcnt_lo((unsigned)m1, 0u))] = (u32x2){((rh##S & 0x3FFFu) << 9) | ((unsigned)(2 * lane + 1) << 24), rh##S & 0xffff0000u}; \
              nn##S = ok_ ? n0 + __popcll(m1) : 0; } \
            LDS_WAIT(); \
            _Pragma("unroll") for (int q = 0; q < 6; ++q) sr##S[q] = sl_[4 * q + lrow]; \
            _Pragma("unroll") for (int i = 0; i < 4; ++i) hq##S[i] = hbuf[S * 64 + 16 * i + lcol]; }
#define PU_ISSUE(R, SR, n_) { \
            _Pragma("unroll") for (int q = 0; q < 6; ++q) if (q < 4 || (n_) > 4 * q) { const bool v_ = (4 * q + lrow) < (n_); const unsigned char* a_ = UQ + (v_ ? (size_t)((SR[q].x & 0x7FFFFFu) + lc16) : (size_t)0); \
                row##R[2 * q] = *(const u32x4*)a_; row##R[2 * q + 1] = *(const u32x4*)(a_ + 256); } }
#define PU_DOT(R, HQ, ACC, n_) { _Pragma("unroll") for (int q = 0; q < 6; ++q) if (q < 4 || (n_) > 4 * q) { int a1_ = 0, a2_ = 0; \
                _Pragma("unroll") for (int i = 0; i < 2; ++i) _Pragma("unroll") for (int w = 0; w < 4; ++w) { a1_ = __builtin_amdgcn_sdot8((int)row##R[2 * q + i][w], (int)HQ[i][w], a1_, false); a2_ = __builtin_amdgcn_sdot8((int)row##R[2 * q + i][w], (int)HQ[2 + i][w], a2_, false); } \
                ACC[q] = (a1_ << 4) + a2_; } }
#define PU_EPI(S, SR, ACC, n_) { float rt_[6]; \
            _Pragma("unroll") for (int q = 0; q < 6; ++q) { rt_[q] = 0.f; if (q < 4 || (n_) > 4 * q) { float f_ = (float)ACC[q]; f_ += dpp_mov<0xB1>(f_); f_ += dpp_mov<0x4E>(f_); f_ += dpp_mov<0x141>(f_); f_ += dpp_mov<0x140>(f_); rt_[q] = f_; } } \
            float tot_ = rt_[0]; unsigned rx_ = SR[0].x, ry_ = SR[0].y; \
            _Pragma("unroll") for (int q = 1; q < 6; ++q) { const bool e_ = lcol == q; tot_ = e_ ? rt_[q] : tot_; rx_ = e_ ? SR[q].x : rx_; ry_ = e_ ? SR[q].y : ry_; } \
            if (lcol < 6 && (4 * lcol + lrow) < (n_)) { const unsigned idx_ = (rx_ >> 9) & 0x3FFFu; const int li_ = (int)(idx_ & (GRP_SIZE - 1)); \
                const float c_ = __uint_as_float(ry_) * gelu_exact((tot_ + U8[li_]) * SU[li_] * rs##S) * SV[li_]; CI[(size_t)tk##S * 128 + (rx_ >> 24)] = (f2bf(c_) << 16) | idx_; } }
#define PU_OVF(S, R) if (nn##S > 24) { for (int b1_ = 24; b1_ < nn##S; b1_ += 24) { u32x2 so2_[6]; _Pragma("unroll") for (int q = 0; q < 6; ++q) so2_[q] = slots[S * 128 + ((b1_ + 4 * q + lrow) & 127)]; \
            const int n2_ = nn##S - b1_; int ac2_[6]; PU_ISSUE(R, so2_, n2_) PU_DOT(R, hq##S, ac2_, n2_) PU_EPI(S, so2_, ac2_, n2_) } }
        u32x2 rq0, rq1; u32x4 hr0, hr1, hq0[4], hq1[4]; float rr0, rr1, rs0 = 0.f, rs1 = 0.f; int tk0 = 0, tk1 = 0, nn0 = 0, nn1 = 0;
        u32x4 rowA[12], rowB[12]; u32x2 sr0[6], sr1[6]; int acc0[6], acc1[6];
#pragma unroll
        for (int q = 0; q < 4; ++q) { hq0[q] = (u32x4){0u, 0u, 0u, 0u}; hq1[q] = hq0[q]; }
#pragma unroll
        for (int q = 0; q < 6; ++q) { sr0[q] = (u32x2){0u, 0u}; sr1[q] = sr0[q]; acc0[q] = 0; acc1[q] = 0; }
        PU_R(0, 0) PU_R(1, 1)
        PU_C(0, 0)
        PU_ISSUE(A, sr0, nn0)
        PU_R(0, 2)
        for (int k = 0; k < K; k += 2) {
            PU_C(1, k + 1)
            PU_ISSUE(B, sr1, nn1)
            PU_R(1, k + 3)
            PU_DOT(A, hq0, acc0, nn0) PU_EPI(0, sr0, acc0, nn0) PU_OVF(0, A)
            PU_C(0, k + 2)
            PU_ISSUE(A, sr0, nn0)
            PU_R(0, k + 4)
            PU_DOT(B, hq1, acc1, nn1) PU_EPI(1, sr1, acc1, nn1) PU_OVF(1, B)
        }
    }
    __syncthreads();
}
__device__ __forceinline__ void phase_peer_v(const Params& p, LAS unsigned char* lds, int G, int mx, int mj) {
    const int tid = threadIdx.x, lane = tid & 63, wave = __builtin_amdgcn_readfirstlane(tid >> 6), bx = blockIdx.x;
    const bool xl = (G % 8 == 0);
    const int x = xl ? (mx & 3) : 0, nx = xl ? 4 : 1, jb = xl ? (mx >> 2) * (G / 8) + mj : bx, nw = (xl ? G / 4 : G) * NWAVES, widx = jb * NWAVES + wave;
    const unsigned char* VQ = (const unsigned char*)(p.ws + WS_VE);
    const unsigned* CI = (const unsigned*)(p.ws + WS_C);
    bf16_t* H1B = (bf16_t*)(p.ws + WS_H1B);
    const int sub = lane & 7, es = lane >> 3;
    const int K = (T - widx + nw - 1) / nw, NB4 = (K + 3) / 4;
    LAS unsigned* RL = (LAS unsigned*)(lds + wave * 4096);
    for (int s = x; s < NVS; s += nx) {
        const unsigned char* VQs = VQ + (size_t)s * 16384 * VSL + 16 * sub;
#define PV_TOK(k_) ((size_t)(widx + nw * ((k_) < K ? (k_) : K - 1)))
#define PV_RQLOAD(blk_) { _Pragma("unroll") for (int j = 0; j < 4; ++j) rq[j] = *(const u32x2*)(CI + PV_TOK(4 * (blk_) + j) * 128 + 2 * lane); }
#define PV_RQSTORE(blk_) { _Pragma("unroll") for (int j = 0; j < 4; ++j) *(LAS u32x2*)(RL + (((blk_) & 1) * 4 + j) * 128 + 2 * lane) = rq[j]; }
#define PV_REC(blkpar_, j_, hf_, i_) RL[((blkpar_) * 4 + (j_)) * 128 + 64 * (hf_) + 8 * (i_) + es]
#define PV_GATHER8(vb, rg_, hf_) { _Pragma("unroll") for (int i = 0; i < 8; ++i) vb[i] = *(const u32x4*)(VQs + (size_t)(rg_[8 * (hf_) + i] & 0x3FFFu) * VSL); }
#define PV_PREP(blkpar_, j_, sl_, k_) { float cf_[16]; float am_ = 0.f; hvs[sl_] = *(const u32x2*)(H1B + PV_TOK(k_) * D + hoff); \
            _Pragma("unroll") for (int i = 0; i < 16; ++i) rg[i] = PV_REC(blkpar_, j_, (i >> 3), (i & 7)); \
            _Pragma("unroll") for (int i = 0; i < 16; ++i) { cf_[i] = __uint_as_float(rg[i] & 0xffff0000u); am_ = fmaxf(am_, fabsf(cf_[i])); } \
            am_ = fmaxf(am_, dpp_mov<0x128>(am_)); am_ = swap16_max(am_); am_ = swap32_max(am_); \
            const float iv_ = am_ > 0.f ? 127.f / am_ : 0.f; csc[sl_] = am_ * (1.f / 127.f); int cs_ = 0; \
            _Pragma("unroll") for (int m = 0; m < 4; ++m) { const int q0 = (int)rintf(cf_[4 * m] * iv_), q1 = (int)rintf(cf_[4 * m + 1] * iv_), q2 = (int)rintf(cf_[4 * m + 2] * iv_), q3 = (int)rintf(cf_[4 * m + 3] * iv_); \
                cqs[sl_][m] = (q0 & 0xFF) | ((q1 & 0xFF) << 8) | ((q2 & 0xFF) << 16) | ((q3 & 0xFF) << 24); cs_ = __builtin_amdgcn_sdot4(cqs[sl_][m], 0x01010101, cs_, false); } \
            float ct_ = (float)cs_; ct_ += dpp_mov<0x128>(ct_); ct_ = swap16_sum(ct_); ct_ = swap32_sum(ct_); cto[sl_] = -8.f * ct_; }
#define PV_T4(r0, r1, r2, r3, w, cqw) { const unsigned x0_ = __builtin_amdgcn_perm(r1[w], r0[w], 0x05010400u), x1_ = __builtin_amdgcn_perm(r1[w], r0[w], 0x07030602u), \
                y0_ = __builtin_amdgcn_perm(r3[w], r2[w], 0x05010400u), y1_ = __builtin_amdgcn_perm(r3[w], r2[w], 0x07030602u); \
            const unsigned t0_ = __builtin_amdgcn_perm(y0_, x0_, 0x05040100u), t1_ = __builtin_amdgcn_perm(y0_, x0_, 0x07060302u), t2_ = __builtin_amdgcn_perm(y1_, x1_, 0x05040100u), t3_ = __builtin_amdgcn_perm(y1_, x1_, 0x07060302u); \
            acci[8 * (w)] = __builtin_amdgcn_sdot4((int)(t0_ & 0x0F0F0F0Fu), cqw, acci[8 * (w)], false); acci[8 * (w) + 1] = __builtin_amdgcn_sdot4((int)(t0_ & 0xF0F0F0F0u), cqw, acci[8 * (w) + 1], false); \
            acci[8 * (w) + 2] = __builtin_amdgcn_sdot4((int)(t1_ & 0x0F0F0F0Fu), cqw, acci[8 * (w) + 2], false); acci[8 * (w) + 3] = __builtin_amdgcn_sdot4((int)(t1_ & 0xF0F0F0F0u), cqw, acci[8 * (w) + 3], false); \
            acci[8 * (w) + 4] = __builtin_amdgcn_sdot4((int)(t2_ & 0x0F0F0F0Fu), cqw, acci[8 * (w) + 4], false); acci[8 * (w) + 5] = __builtin_amdgcn_sdot4((int)(t2_ & 0xF0F0F0F0u), cqw, acci[8 * (w) + 5], false); \
            acci[8 * (w) + 6] = __builtin_amdgcn_sdot4((int)(t3_ & 0x0F0F0F0Fu), cqw, acci[8 * (w) + 6], false); acci[8 * (w) + 7] = __builtin_amdgcn_sdot4((int)(t3_ & 0xF0F0F0F0u), cqw, acci[8 * (w) + 7], false); }
#define PV_ACC8(vb, sl_, hf_) { _Pragma("unroll") for (int w = 0; w < 4; ++w) { PV_T4(vb[0], vb[1], vb[2], vb[3], w, cqs[sl_][2 * (hf_)]) PV_T4(vb[4], vb[5], vb[6], vb[7], w, cqs[sl_][2 * (hf_) + 1]) } }
#define PV_FIN(k_, sl_) { int r16[16], r8[8], r4[4]; \
            { const bool bt = lane & 8; _Pragma("unroll") for (int q = 0; q < 16; ++q) { const int keep = bt ? acci[q + 16] : acci[q], send = bt ? acci[q] : acci[q + 16]; r16[q] = keep + __builtin_amdgcn_update_dpp(0, send, 0x128, 0xF, 0xF, false); } } \
            _Pragma("unroll") for (int q = 0; q < 8; ++q) { int a_ = r16[q], b_ = r16[q + 8]; swap16i_(a_, b_); r8[q] = a_ + b_; } \
            _Pragma("unroll") for (int q = 0; q < 4; ++q) { int a_ = r8[q], b_ = r8[q + 4]; swap32i_(a_, b_); r4[q] = a_ + b_; } \
            _Pragma("unroll") for (int q = 0; q < 32; ++q) acci[q] = 0; \
            if ((k_) < K) { const u32x2 hw = hvs[sl_]; const float sc_ = csc[sl_], sh_ = sc_ * (1.f / 16.f), co_ = cto[sl_]; \
                *(u32x2*)(H1B + (size_t)(widx + nw * (k_)) * D + hoff) = (u32x2){pk2(bflo(hw.x) + ((float)r4[0] + co_) * sc_, bfhi(hw.x) + (float)r4[1] * sh_), pk2(bflo(hw.y) + ((float)r4[2] + co_) * sc_, bfhi(hw.y) + (float)r4[3] * sh_)}; } }
#define PV_STEP(vb, B_, j_, hf_) { PV_ACC8(vb, ((j_) & 3), hf_) if ((hf_) == 1) PV_FIN(4 * (B_) + (j_), ((j_) & 3)) \
            if ((hf_) == 0) PV_PREP((((j_) + 2) < 4) ? ((B_) & 1) : (((B_) + 1) & 1), (((j_) + 2) & 3), (((j_) + 2) & 3), 4 * (B_) + (j_) + 2) \
            PV_GATHER8(vb, rg, hf_) }
        u32x2 rq[4]; u32x4 v0[8], v1[8], v2[8], v3[8]; int acci[32]; int cqs[4][4]; float csc[4], cto[4]; unsigned rg[16]; u32x2 hvs[4];
        const int hoff = s * 256 + 32 * sub + 16 * (es & 1) + 8 * ((es >> 1) & 1) + 4 * (es >> 2);
#pragma unroll
        for (int q = 0; q < 32; ++q) acci[q] = 0;
        PV_RQLOAD(0) PV_RQSTORE(0) PV_RQLOAD(1) PV_RQSTORE(1)
        LDS_WAIT();
        PV_PREP(0, 0, 0, 0) PV_GATHER8(v0, rg, 0) PV_GATHER8(v1, rg, 1)
        PV_PREP(0, 1, 1, 1) PV_GATHER8(v2, rg, 0) PV_GATHER8(v3, rg, 1)
        for (int B = 0; B < NB4; ++B) {
            if (B > 0) { PV_RQSTORE(B + 1) LDS_WAIT(); }
            PV_STEP(v0, B, 0, 0) PV_STEP(v1, B, 0, 1)
            PV_STEP(v2, B, 1, 0) PV_STEP(v3, B, 1, 1)
            PV_RQLOAD(B + 2)
            PV_STEP(v0, B, 2, 0) PV_STEP(v1, B, 2, 1)
            PV_STEP(v2, B, 3, 0) PV_STEP(v3, B, 3, 1)
        }
    }
}
__device__ __forceinline__ void phase_final(const Params& p, int vcu, int G) {
    const int tid = threadIdx.x, lane = tid & 63, wave = __builtin_amdgcn_readfirstlane(tid >> 6);
    const bf16_t* H2B = (const bf16_t*)(p.ws + WS_H1B); float* Y = p.out; const float* fg = p.in[I_FG];
    const int w0 = vcu * NWAVES + wave, WS_ = G * NWAVES;
    const f32x4 g0 = ((const f32x4*)fg)[2 * lane], g1 = ((const f32x4*)fg)[2 * lane + 1], g2 = ((const f32x4*)fg)[128 + 2 * lane], g3 = ((const f32x4*)fg)[128 + 2 * lane + 1];
#define PF_LOAD(dst, t0_) { _Pragma("unroll") for (int u = 0; u < 4; ++u) { const int tok = ((t0_) + u * WS_) < T ? ((t0_) + u * WS_) : w0; \
            dst[u][0] = *(const u32x4*)(H2B + (size_t)tok * D + 8 * lane); dst[u][1] = *(const u32x4*)(H2B + (size_t)tok * D + 512 + 8 * lane); } }
#define PF_PROC(src, t0_) { _Pragma("unroll") for (int u = 0; u < 4; ++u) { const int tok = (t0_) + u * WS_; if (tok < T) { float f[16]; float ss = 0.f; \
            _Pragma("unroll") for (int k = 0; k < 4; ++k) { f[2 * k] = bflo(src[u][0][k]); f[2 * k + 1] = bfhi(src[u][0][k]); f[8 + 2 * k] = bflo(src[u][1][k]); f[8 + 2 * k + 1] = bfhi(src[u][1][k]); } \
            _Pragma("unroll") for (int k = 0; k < 16; ++k) ss += f[k] * f[k]; \
            const float rs = rsqrtf(wave_sum(ss) * (1.f / D) + EPS); f32x4* yr = (f32x4*)(Y + (size_t)tok * D); \
            yr[2 * lane] = (f32x4){f[0], f[1], f[2], f[3]} * rs * g0; yr[2 * lane + 1] = (f32x4){f[4], f[5], f[6], f[7]} * rs * g1; \
            yr[128 + 2 * lane] = (f32x4){f[8], f[9], f[10], f[11]} * rs * g2; yr[128 + 2 * lane + 1] = (f32x4){f[12], f[13], f[14], f[15]} * rs * g3; } } }
    u32x4 va[4][2], vb[4][2];
    PF_LOAD(va, w0)
    for (int t0 = w0; t0 < T; t0 += 8 * WS_) {
        if (t0 + 4 * WS_ < T) PF_LOAD(vb, t0 + 4 * WS_)
        PF_PROC(va, t0)
        if (t0 + 8 * WS_ < T) PF_LOAD(va, t0 + 8 * WS_)
        PF_PROC(vb, t0 + 4 * WS_)
    }
}
#define XB_TMO      128
#define XB_XCNT(j)  (256  + 64 * (j))
#define XB_XSUB(j)  (1280 + 64 * (j))
#define XB_XGEN(j)  (2304 + 64 * (j))
#define XB_TOP      3328
#define XB_TOPGEN   3392
#define XCD_BAR_WORDS 3456
#define XB_SPIN_CAP (1u << 18)

__device__ __forceinline__ unsigned xb_ld(unsigned* p)              { return __hip_atomic_load(p, __ATOMIC_RELAXED, __HIP_MEMORY_SCOPE_AGENT); }
__device__ __forceinline__ unsigned xb_add(unsigned* p, unsigned v) { return __hip_atomic_fetch_add(p, v, __ATOMIC_RELAXED, __HIP_MEMORY_SCOPE_AGENT); }
__device__ __forceinline__ unsigned xb_xcc_id() { return (unsigned)__builtin_amdgcn_s_getreg((3 << 11) | 20) & 0xFu; }
#define XB_SPIN(cond, bar) do { unsigned _sp = 0; while (cond) { __builtin_amdgcn_s_sleep(1); \
    if ((++_sp & 255u) == 0u) { if (xb_ld(&(bar)[XB_TMO])) break; if (_sp > XB_SPIN_CAP) { atomicAdd(&(bar)[XB_TMO], 1u); break; } } } } while (0)

struct XcdBarrier {
    unsigned* bar; unsigned x;
    volatile LAS unsigned* st;
};

__device__ __forceinline__ XcdBarrier xcd_barrier_post(unsigned* bar, volatile LAS unsigned* st) {
    XcdBarrier b; b.bar = bar; b.x = xb_xcc_id(); b.st = st;
    if (threadIdx.x == 0) (void)xb_add(&bar[XB_XCNT(b.x)], 1u);
    return b;
}
__device__ __forceinline__ void xcd_barrier_complete(unsigned* bar, unsigned x, unsigned& nloc, unsigned& nx) {
    const unsigned G = gridDim.x * gridDim.y * gridDim.z;
    unsigned sum, cnt, mine, sp = 0u;
    for (;;) {
        sum = 0u; cnt = 0u; mine = 0u;
#pragma unroll
        for (unsigned j = 0; j < 16; ++j) { const unsigned c = xb_ld(&bar[XB_XCNT(j)]); sum += c; cnt += (c > 0u) ? 1u : 0u; mine = (j == x) ? c : mine; }
        if (sum == G) break;
        __builtin_amdgcn_s_sleep(1);
        if ((++sp & 255u) == 0u) { if (xb_ld(&bar[XB_TMO])) break; if (sp > XB_SPIN_CAP) { atomicAdd(&bar[XB_TMO], 1u); break; } }
    }
    nloc = mine > 0u ? mine : 1u; nx = cnt > 0u ? cnt : 1u;
}

__device__ __forceinline__ void xcd_barrier(const XcdBarrier& b) {
    asm volatile("s_waitcnt vmcnt(0)" ::: "memory");
    __syncthreads();
    if (threadIdx.x == 0) {
        unsigned* bar = b.bar;
        __builtin_amdgcn_s_waitcnt(0);
        unsigned nloc = b.st[0], nx = b.st[1];
        if (nloc == 0u) { xcd_barrier_complete(bar, b.x, nloc, nx); b.st[0] = nloc; b.st[1] = nx; }
        const unsigned old = xb_add(&bar[XB_XSUB(b.x)], 1u);
        const unsigned gen = old / nloc;
        if (old + 1u == (gen + 1u) * nloc) {
            __builtin_amdgcn_fence(__ATOMIC_RELEASE, "agent");
            asm volatile("s_waitcnt vmcnt(0)" ::: "memory");
            const unsigned og = xb_add(&bar[XB_TOP], 1u);
            const unsigned tg = og / nx;
            if (og + 1u == (tg + 1u) * nx) xb_add(&bar[XB_TOPGEN], 1u);
            else XB_SPIN(xb_ld(&bar[XB_TOPGEN]) == tg, bar);
            __builtin_amdgcn_fence(__ATOMIC_ACQUIRE, "agent");
            xb_add(&bar[XB_XGEN(b.x)], 1u);
            asm volatile("s_waitcnt vmcnt(0)" ::: "memory");
        } else {
            XB_SPIN(xb_ld(&bar[XB_XGEN(b.x)]) == gen, bar);
            __builtin_amdgcn_fence(__ATOMIC_ACQUIRE, "agent");
            asm volatile("s_waitcnt vmcnt(0)" ::: "memory");
        }
    }
    __syncthreads();
}

constexpr int N_PHASES = 11;
__global__ void __launch_bounds__(NTHREADS, 2) hymba_fwd(Params p) {
    extern __shared__ __attribute__((aligned(16))) unsigned char lds_raw[];
    LAS unsigned char* lds = (LAS unsigned char*)lds_raw;
    cg::grid_group grid = cg::this_grid();
    const int G = gridDim.x; const int bx = blockIdx.x;
    const int vcu = (G % 8 == 0) ? (bx % 8) * (G / 8) + bx / 8 : bx;
    unsigned char* ws = p.ws;
    const int lo = p.ph_lo, hi = p.ph_hi;
    volatile LAS unsigned* MISC = (volatile LAS unsigned*)(lds + 131072 + 320);
    if (threadIdx.x < 32) MISC[threadIdx.x] = 0u;
    __syncthreads();
    XcdBarrier bar; bar.bar = (unsigned*)ws; bar.x = xb_xcc_id(); bar.st = MISC + 8;
    if (threadIdx.x == 0) { MISC[20] = xb_add(&bar.bar[XB_XCNT(bar.x)], 1u); MISC[21] = bar.x; MISC[22] = 0u; }
#define IN(k) (lo <= (k) && (k) < hi)
#define SEAM(k) do { if ((k) + 1 < hi) { if ((k) == 0) grid.sync(); else xcd_barrier(bar); } } while (0)
    if (IN(0)) { phase_prep(p, lds, vcu, G); SEAM(0); }
    {
        if (threadIdx.x == 0 && lo == 0 && hi > 1 && (G % 8) == 0) { bool ok = true; for (unsigned j = 0; j < 8; ++j) ok = ok && (xb_ld(&bar.bar[XB_XCNT(j)]) == (unsigned)(G / 8)); MISC[22] = ok ? 1u : 0u; }
        __syncthreads();
    }
    const bool xcc_ok = MISC[22] != 0u; const int xcc_x = xcc_ok ? (int)MISC[21] : (bx & 7), xcc_j = xcc_ok ? (int)MISC[20] : (bx >> 3);
    if (IN(1)) {
        { pg8::Gemm g{(const bf16_t*)(ws + WS_XN), (const bf16_t*)(ws + WS_WINT), T, 3584, D}; pg8::StaticOrder S; S.init(T, 3584, G, bx);
          EpiInProj E{(bf16_t*)(ws + WS_PROJ), (const float*)(ws + WS_SM)};
          pg8::gemm_phase<EpiInProj, pg8::StaticOrder, true, true>(lds, g, S, E); }
        { pg8::Gemm g{(const bf16_t*)(ws + WS_WINT) + (size_t)3584 * D, (const bf16_t*)(ws + WS_XN), 512, T, D}; pg8::StaticOrder S; S.init(512, T, G, bx);
          EpiStore E{(bf16_t*)(ws + WS_VT), T};
          pg8::gemm_phase<EpiStore, pg8::StaticOrder, true, true>(lds, g, S, E); }
        SEAM(1);
    }
    if (IN(2)) { phase_hgrn(p, lds, G); }
    if (IN(3)) { phase_attn(p, lds, G); SEAM(3); }
    if (IN(5)) {
        pg8::Gemm g{(const bf16_t*)(ws + WS_XN), (const bf16_t*)(ws + WS_WOT), T, D, D}; pg8::StaticOrder S; S.init(T, D, G, bx);
        EpiOutProj E{p.in[I_X], p.out, (bf16_t*)(ws + WS_H1B), (float*)(ws + WS_SS)};
        pg8::gemm_phase<EpiOutProj, pg8::StaticOrder, true, true>(lds, g, S, E);
        SEAM(5);
    }
    if (IN(6)) {
        phase_hquant(p, vcu, G);
        pg8::Gemm g{(const bf16_t*)(ws + WS_H1B), (const bf16_t*)(ws + WS_WQT), T, 2048, D}; pg8::StaticOrder S; S.init(T, 2048, G, bx);
        EpiQ E{(bf16_t*)(ws + WS_QP), (const float*)(ws + WS_SS), (float*)(ws + WS_GATE)};
        pg8::gemm_phase<EpiQ, pg8::StaticOrder, true, true>(lds, g, S, E);
        SEAM(6);
    }
    if (IN(7)) { phase_topk(p, lds, vcu, G); SEAM(7); }
    if (IN(8)) { phase_peer_u(p, lds, G, xcc_x, xcc_j); SEAM(8); }
    if (IN(9)) { phase_peer_v(p, lds, G, xcc_x, xcc_j); SEAM(9); }
    if (IN(10)) { phase_final(p, vcu, G); }
#undef IN
#undef SEAM
}

extern "C" void kernel_launch(void* const* d_in, const int* in_sizes, int n_in, void* d_out, int out_size, void* d_ws, size_t ws_size, hipStream_t stream) {
    static int grid = 0;
    if (grid == 0) {
        if (n_in != 19 || out_size != T * D || ws_size < WS_END) { fprintf(stderr, "kernel_launch: unexpected sizes (n_in %d out %d ws %zu)\n", n_in, out_size, ws_size); grid = -1; return; }
        int dev = 0, cus = 0, per_cu = 0;
        hipGetDevice(&dev); hipDeviceGetAttribute(&cus, hipDeviceAttributeMultiprocessorCount, dev);
        hipFuncSetAttribute((const void*)hymba_fwd, hipFuncAttributeMaxDynamicSharedMemorySize, LDS_BYTES);
        hipOccupancyMaxActiveBlocksPerMultiprocessor(&per_cu, (const void*)hymba_fwd, NTHREADS, LDS_BYTES);
        (void)hipGetLastError();
        if (per_cu < 1) { fprintf(stderr, "kernel_launch: occupancy query says %d blocks/CU\n", per_cu); per_cu = 1; }
        grid = cus;
    }
    if (grid < 0) return;
    if (hipMemsetAsync(d_ws, 0, 65536, stream) != hipSuccess) { fprintf(stderr, "kernel_launch: memset of the barrier words failed\n"); return; }
    Params p{};
    for (int i = 0; i < 19; ++i) p.in[i] = (const float*)d_in[i];
    p.out = (float*)d_out; p.ws = (unsigned char*)d_ws;
#if MK_ONE_LAUNCH
    p.ph_lo = 0; p.ph_hi = N_PHASES;
    void* args[] = {&p};
    hipError_t e = hipLaunchCooperativeKernel((const void*)hymba_fwd, dim3(grid), dim3(NTHREADS), args, LDS_BYTES, stream);
    if (e != hipSuccess) fprintf(stderr, "cooperative launch failed: %s (grid %d)\n", hipGetErrorString(e), grid);
#else
    for (int ph = 0; ph < N_PHASES; ++ph) { p.ph_lo = ph; p.ph_hi = ph + 1; hipLaunchKernelGGL(hymba_fwd, dim3(grid), dim3(NTHREADS), LDS_BYTES, stream, p); }
#endif
}
```

```cpp
#include <hip/hip_runtime.h>
#include <hip/hip_bf16.h>
#include <hip/hip_cooperative_groups.h>
#include <cstdio>
#include <cstdint>
#include <cmath>
namespace cg = cooperative_groups;
#ifndef MK_ONE_LAUNCH
#define MK_ONE_LAUNCH 1
#endif
namespace pg8 {
#define PG8_LAS __attribute__((address_space(3)))
typedef unsigned short bf16_t;
typedef short bf16x8 __attribute__((ext_vector_type(8)));
typedef float f32x4 __attribute__((ext_vector_type(4)));
typedef unsigned u32x4 __attribute__((ext_vector_type(4)));
constexpr int BM = 256, BK = 64, HALF = 128, HTB = HALF * BK * 2  , STAGE_BYTES = 8 * HTB, NXCD = 8, WGM = 8;

__host__ __device__ __forceinline__ int lds_byte(int r, int c) { const int st = (r >> 4) * 2 + (c >> 5), rr = r & 15, cc = c & 31, ob = rr * 64 + cc * 2; return st * 1024 + (ob ^ (((ob >> 9) & 1) << 5)); }
__host__ __device__ __forceinline__ void stage_rc(int b, int& R, int& C) { const int st = b / 1024, sb = b % 1024, swz = sb ^ (((sb >> 9) & 1) << 5); R = (st >> 1) * 16 + swz / 64; C = (st & 1) * 32 + (swz % 64) / 2; }
__host__ __device__ __forceinline__ int perm32(int rho) { const int n = rho >> 4, i = rho & 15; return 8 * (i >> 2) + 4 * n + (i & 3); }

struct Unit { int pm, pn; };
struct Gemm { const bf16_t* A; const bf16_t* Bt; int M, N, K; };

struct StaticOrder {
    int nM, nN, nwg, G, c;
    __host__ __device__ void init(int M, int N, int G_, int c_) { nM = M / BM; nN = N / BM; nwg = nM * nN; G = G_; c = c_; }
    __host__ __device__ bool next(int i, Unit& u) const {
        const long L = (long)i * G + c; if (L >= nwg) return false;
        int wgid = (int)L; { const int q = nwg / NXCD, r = nwg % NXCD, xcd = wgid % NXCD, off = wgid / NXCD; wgid = (xcd < r ? xcd * (q + 1) : r * (q + 1) + (xcd - r) * q) + off; }
        const int nig = WGM * nN, gid = wgid / nig, fm = gid * WGM, gsz = (nM - fm) < WGM ? (nM - fm) : WGM;
        u.pm = fm + ((wgid % nig) % gsz); u.pn = (wgid % nig) / gsz; return true;
    }
    __device__ __forceinline__ void a_ready(const Unit&) const {}
    __device__ __forceinline__ void done(const Unit&) const {}
};

__device__ __forceinline__ unsigned cvt_pk_bf16(float lo, float hi) { unsigned r; asm volatile("v_cvt_pk_bf16_f32 %0, %1, %2" : "=v"(r) : "v"(lo), "v"(hi)); return r; }
typedef float f32x2 __attribute__((ext_vector_type(2)));
template <class Epi, class Sched, bool ALIGN_EPI = false, bool SP2 = false>
__device__ __forceinline__ void gemm_phase(PG8_LAS unsigned char* lds, const Gemm g, const Sched& S, const Epi& E) {
    const int tid = threadIdx.x, wid = __builtin_amdgcn_readfirstlane(tid >> 6), lane = tid & 63, wr = wid >> 2, wc = wid & 3, fr = lane & 15, fq = lane >> 4;
    const int K = g.K, nt = K / BK;
    unsigned voffA[2], voffB[2];
#pragma unroll
    for (int i = 0; i < 2; ++i) { int R, C; stage_rc(tid * 16 + i * 8192, R, C); const int Rb = Epi::PERM ? ((R & ~31) + perm32(R & 31)) : R;
        voffA[i] = (unsigned)(R * K + C) * 2u; voffB[i] = (unsigned)(Rb * K + C) * 2u; }
    const size_t kstep = (size_t)(BK * 2);
    const size_t hstep = (size_t)HALF * K * 2;
    const size_t tstep = 2 * hstep;
    const unsigned ldsw = (unsigned)wid * 1024u;
    const int aoff = lds_byte(wr * 64 + fr, fq * 8), boff = lds_byte(wc * 32 + fr, fq * 8);
#define PG8_SA(b, h) (((b) * 2 + (h)) * HTB)
#define PG8_SB(b, h) ((4 + (b) * 2 + (h)) * HTB)
#define PG8_STAGE(bufoff, gbase, voff) do { _Pragma("unroll") for (int _i = 0; _i < 2; ++_i) \
        __builtin_amdgcn_global_load_lds((const unsigned*)((const char*)(gbase) + (voff)[_i]), (PG8_LAS unsigned*)(lds + (bufoff) + ldsw + _i * 8192), 16, 0, 0); } while (0)
#define PG8_LDA(dst, b, h) do { _Pragma("unroll") for (int m = 0; m < 4; ++m) _Pragma("unroll") for (int k = 0; k < 2; ++k) dst[m][k] = *(const PG8_LAS bf16x8*)(lds + PG8_SA(b, h) + aoff + m * 2048 + k * 1024); } while (0)
#define PG8_LDB(dst, b, h) do { _Pragma("unroll") for (int n = 0; n < 2; ++n) _Pragma("unroll") for (int k = 0; k < 2; ++k) dst[n][k] = *(const PG8_LAS bf16x8*)(lds + PG8_SB(b, h) + boff + n * 2048 + k * 1024); } while (0)
#define PG8_MMA(ai, bj, At, Bt) do { __builtin_amdgcn_s_setprio(1); _Pragma("unroll") for (int m = 0; m < 4; ++m) _Pragma("unroll") for (int n = 0; n < 2; ++n) _Pragma("unroll") for (int k = 0; k < 2; ++k) \
        acc[ai][bj][m][n] = __builtin_amdgcn_mfma_f32_16x16x32_bf16(Bt[n][k], At[m][k], acc[ai][bj][m][n], 0, 0, 0); __builtin_amdgcn_s_setprio(0); } while (0)
#define PG8_WAIT_V(n) asm volatile("s_waitcnt vmcnt(" #n ")" ::: "memory")
#define PG8_WAIT_L(n) asm volatile("s_waitcnt lgkmcnt(" #n ")" ::: "memory")
#define PG8_BAR __builtin_amdgcn_s_barrier()
#define PG8_SCHED __builtin_amdgcn_sched_barrier(0)
    Unit cur, nxt; int ui = 0;
    if (!S.next(0, cur)) return;
    f32x4 acc[2][2][4][2];
#pragma unroll
    for (int a = 0; a < 2; ++a)
#pragma unroll
        for (int b = 0; b < 2; ++b)
#pragma unroll
            for (int m = 0; m < 4; ++m)
#pragma unroll
                for (int n = 0; n < 2; ++n) acc[a][b][m][n] = (f32x4){0.f, 0.f, 0.f, 0.f};
    bf16x8 At[4][2], B0[2][2], B1[2][2];
    const char* cA = (const char*)g.A + (size_t)cur.pm * tstep; const char* cB = (const char*)g.Bt + (size_t)cur.pn * tstep;
    S.a_ready(cur);
    if constexpr (SP2) {
        PG8_STAGE(PG8_SB(0, 0), cB, voffB); PG8_STAGE(PG8_SB(0, 1), cB + hstep, voffB); PG8_STAGE(PG8_SA(0, 0), cA, voffA); PG8_STAGE(PG8_SA(0, 1), cA + hstep, voffA);
        if (wr == 1) PG8_BAR;
        PG8_WAIT_V(2); PG8_BAR;
        PG8_STAGE(PG8_SB(1, 0), cB + kstep, voffB); PG8_STAGE(PG8_SA(1, 0), cA + kstep, voffA); PG8_STAGE(PG8_SB(1, 1), cB + hstep + kstep, voffB);
        PG8_WAIT_V(6); PG8_BAR;
    } else {
        PG8_STAGE(PG8_SB(0, 0), cB, voffB); PG8_STAGE(PG8_SA(0, 0), cA, voffA); PG8_STAGE(PG8_SB(0, 1), cB + hstep, voffB); PG8_STAGE(PG8_SA(0, 1), cA + hstep, voffA);
        if (wr == 1) PG8_BAR;
        PG8_WAIT_V(4); PG8_BAR;
        PG8_STAGE(PG8_SB(1, 0), cB + kstep, voffB); PG8_STAGE(PG8_SA(1, 0), cA + kstep, voffA); PG8_STAGE(PG8_SB(1, 1), cB + hstep + kstep, voffB);
        PG8_WAIT_V(6); PG8_BAR;
    }
    for (;;) {
        const bool has_next = S.next(ui + 1, nxt);
        const char* nA = has_next ? (const char*)g.A + (size_t)nxt.pm * tstep : cA; const char* nB = has_next ? (const char*)g.Bt + (size_t)nxt.pn * tstep : cB;
        for (int t = 0; t < nt; t += 2) {
            const bool last = (t == nt - 2);
            const char* a1 = cA + (size_t)(t + 1) * kstep;
            const char* a2 = last ? nA : cA + (size_t)(t + 2) * kstep; const char* b2 = last ? nB : cB + (size_t)(t + 2) * kstep;
            const char* a3 = a2 + kstep; const char* b3 = b2 + kstep;
            if (last && has_next) S.a_ready(nxt);
            if constexpr (SP2) {
            PG8_LDB(B0, 0, 0); PG8_LDB(B1, 0, 1); PG8_SCHED; PG8_LDA(At, 0, 0); PG8_STAGE(PG8_SA(1, 1), a1 + hstep, voffA);
            PG8_WAIT_V(8); PG8_WAIT_L(0); PG8_BAR; PG8_MMA(0, 0, At, B0); PG8_MMA(0, 1, At, B1); PG8_BAR; PG8_SCHED;
            PG8_LDA(At, 0, 1); PG8_STAGE(PG8_SB(0, 0), b2, voffB); PG8_STAGE(PG8_SB(0, 1), b2 + hstep, voffB); PG8_STAGE(PG8_SA(0, 0), a2, voffA);
            PG8_WAIT_V(8); PG8_WAIT_L(0); PG8_BAR; PG8_MMA(1, 0, At, B0); PG8_MMA(1, 1, At, B1); PG8_BAR; PG8_SCHED;
            PG8_LDB(B0, 1, 0); PG8_LDB(B1, 1, 1); PG8_SCHED; PG8_LDA(At, 1, 0); PG8_STAGE(PG8_SA(0, 1), a2 + hstep, voffA);
            PG8_WAIT_V(8); PG8_WAIT_L(0); PG8_BAR; PG8_MMA(0, 0, At, B0); PG8_MMA(0, 1, At, B1); PG8_BAR; PG8_SCHED;
            PG8_LDA(At, 1, 1); PG8_STAGE(PG8_SB(1, 0), b3, voffB); PG8_STAGE(PG8_SB(1, 1), b3 + hstep, voffB); PG8_STAGE(PG8_SA(1, 0), a3, voffA);
            PG8_WAIT_V(8); PG8_WAIT_L(0); PG8_BAR; PG8_MMA(1, 0, At, B0); PG8_MMA(1, 1, At, B1); PG8_BAR; PG8_SCHED;
            } else {
            PG8_LDB(B0, 0, 0); PG8_SCHED; PG8_LDA(At, 0, 0); PG8_STAGE(PG8_SA(1, 1), a1 + hstep, voffA);
            PG8_WAIT_L(8); PG8_BAR; PG8_WAIT_L(0); PG8_MMA(0, 0, At, B0); PG8_BAR; PG8_SCHED;
            PG8_LDB(B1, 0, 1); PG8_STAGE(PG8_SB(0, 0), b2, voffB);
            PG8_BAR; PG8_WAIT_L(0); PG8_MMA(0, 1, At, B1); PG8_BAR;
            PG8_LDA(At, 0, 1); PG8_STAGE(PG8_SA(0, 0), a2, voffA);
            PG8_BAR; PG8_WAIT_L(0); PG8_MMA(1, 0, At, B0); PG8_BAR; PG8_SCHED;
            PG8_STAGE(PG8_SB(0, 1), b2 + hstep, voffB);
            PG8_WAIT_V(6); PG8_BAR; PG8_MMA(1, 1, At, B1); PG8_BAR;
            PG8_LDB(B0, 1, 0); PG8_SCHED; PG8_LDA(At, 1, 0); PG8_STAGE(PG8_SA(0, 1), a2 + hstep, voffA);
            PG8_WAIT_L(8); PG8_BAR; PG8_WAIT_L(0); PG8_MMA(0, 0, At, B0); PG8_BAR; PG8_SCHED;
            PG8_LDB(B1, 1, 1); PG8_STAGE(PG8_SB(1, 0), b3, voffB);
            PG8_BAR; PG8_WAIT_L(0); PG8_MMA(0, 1, At, B1); PG8_BAR;
            PG8_LDA(At, 1, 1); PG8_STAGE(PG8_SA(1, 0), a3, voffA);
            PG8_BAR; PG8_WAIT_L(0); PG8_MMA(1, 0, At, B0); PG8_BAR; PG8_SCHED;
            PG8_STAGE(PG8_SB(1, 1), b3 + hstep, voffB);
            PG8_WAIT_V(6); PG8_BAR; PG8_MMA(1, 1, At, B1); PG8_BAR;
            }
        }
        if constexpr (ALIGN_EPI) { if (wr == 0) PG8_BAR; }
        if constexpr (!Epi::AFTER_DRAIN) { E(acc, cur, wr, wc, fr, fq); S.done(cur); }
        if (!has_next) break;
#pragma unroll
        for (int a = 0; a < 2; ++a)
#pragma unroll
            for (int b = 0; b < 2; ++b)
#pragma unroll
                for (int m = 0; m < 4; ++m)
#pragma unroll
                    for (int n = 0; n < 2; ++n) acc[a][b][m][n] = (f32x4){0.f, 0.f, 0.f, 0.f};
        cur = nxt; cA = nA; cB = nB; ++ui;
        if constexpr (ALIGN_EPI) { if (wr == 1) PG8_BAR; }
    }
    PG8_WAIT_V(0);
    if constexpr (!ALIGN_EPI) { if (wr == 0) PG8_BAR; }
    PG8_BAR;
    if constexpr (Epi::AFTER_DRAIN) { E.fused(acc, cur, wr, wc, fr, fq, lds, wid, lane); S.done(cur); }
#undef PG8_SA
#undef PG8_SB
#undef PG8_STAGE
#undef PG8_LDA
#undef PG8_LDB
#undef PG8_MMA
#undef PG8_WAIT_V
#undef PG8_WAIT_L
#undef PG8_BAR
#undef PG8_SCHED
}
}

#define LAS __attribute__((address_space(3)))
typedef unsigned short bf16_t;
typedef short bf16x8 __attribute__((ext_vector_type(8)));
typedef short bf16x4 __attribute__((ext_vector_type(4)));
typedef float f32x4 __attribute__((ext_vector_type(4)));
typedef float f32x16 __attribute__((ext_vector_type(16)));
typedef unsigned u32x4 __attribute__((ext_vector_type(4)));
typedef unsigned u32x2 __attribute__((ext_vector_type(2)));
typedef __bf16 bf16x2_t __attribute__((ext_vector_type(2)));

constexpr int NB = 16, SEQ = 2048, T = NB * SEQ, D = 1024;
constexpr int PP = 4608;
constexpr int C_Q = 0, C_KF = 512, C_LFF = 1024, C_KB = 1536, C_LFB = 2048, C_V = 2560, C_G = 3072, C_DQ = 3584, C_DK = 4096;
constexpr float EPS = 1e-6f;
constexpr float LOG2E = 1.4426950408889634f;
constexpr int NWAVES = 8, NTHREADS = 512;
constexpr int NGRP = 4, GRP_SHIFT = 12, GRP_SIZE = 4096, VSL = 128, NVS = 4;
constexpr int LDS_BYTES = 147456;

constexpr size_t MiB = (size_t)1 << 20;
constexpr size_t WS_SM = 64 * 1024;
constexpr size_t WS_WINT = 2 * MiB, WS_WOT = 10 * MiB, WS_WQT = 12 * MiB, WS_KEYS = 16 * MiB;
constexpr size_t WS_UT = 32 * MiB, WS_USC = 48 * MiB, WS_VSC = 49 * MiB, WS_VE = 64 * MiB, WS_XN = 96 * MiB, WS_PROJ = 160 * MiB, WS_VT = 448 * MiB, WS_END = 480 * MiB;
constexpr size_t WS_H1B = 160 * MiB, WS_QP = 224 * MiB, WS_IDX = 360 * MiB, WS_GATE = 376 * MiB, WS_SS = 392 * MiB, WS_C = 394 * MiB;
constexpr int QPS = 2048 + 64;
constexpr size_t WS_US8 = 48 * MiB + 131072;
constexpr size_t WS_H1Q = 96 * MiB, WS_HSC = 128 * MiB;
constexpr int SM_LBF = 0, SM_LBB = 512, SM_LAM = 1024, SM_BT = 2048, BT_STRIDE = 260;

struct Params { const float* in[19]; float* out; unsigned char* ws; int ph_lo, ph_hi; };
enum { I_X = 0, I_G1, I_WIN, I_LBF, I_LBB, I_HOG, I_LQ1, I_LK1, I_LQ2, I_LK2, I_DOG, I_RB, I_WOUT, I_G2, I_WQ, I_KEYS, I_U, I_V, I_FG };

#define LDS_WAIT() asm volatile("s_waitcnt lgkmcnt(0)" ::: "memory")
__device__ __forceinline__ unsigned f2bf(float f) { unsigned u = __builtin_bit_cast(unsigned, f); return (u + 0x7fffu + ((u >> 16) & 1u)) >> 16; }
typedef float f32x2v_ __attribute__((ext_vector_type(2)));
__device__ __forceinline__ unsigned pk2(float lo, float hi) { const f32x2v_ v = {lo, hi}; return __builtin_bit_cast(unsigned, __builtin_convertvector(v, bf16x2_t)); }
__device__ __forceinline__ float bflo(unsigned w) { return __uint_as_float(w << 16); }
__device__ __forceinline__ float bfhi(unsigned w) { return __uint_as_float(w & 0xffff0000u); }
template <int CTRL> __device__ __forceinline__ float dpp_mov(float v) { return __builtin_bit_cast(float, __builtin_amdgcn_update_dpp(0, __builtin_bit_cast(int, v), CTRL, 0xF, 0xF, false)); }
__device__ __forceinline__ void swap16_(float& a, float& b) { asm volatile("s_nop 1\n\tv_permlane16_swap_b32 %0, %1\n\ts_nop 1" : "+v"(a), "+v"(b)); }
__device__ __forceinline__ void swap32_(float& a, float& b) { asm volatile("s_nop 1\n\tv_permlane32_swap_b32 %0, %1\n\ts_nop 1" : "+v"(a), "+v"(b)); }
__device__ __forceinline__ void swap16i_(int& a, int& b) { asm volatile("s_nop 1\n\tv_permlane16_swap_b32 %0, %1\n\ts_nop 1" : "+v"(a), "+v"(b)); }
__device__ __forceinline__ void swap32i_(int& a, int& b) { asm volatile("s_nop 1\n\tv_permlane32_swap_b32 %0, %1\n\ts_nop 1" : "+v"(a), "+v"(b)); }
__device__ __forceinline__ float swap16_sum(float v) { float a = v, b = v; swap16_(a, b); return a + b; }
__device__ __forceinline__ float swap32_sum(float v) { float a = v, b = v; swap32_(a, b); return a + b; }
__device__ __forceinline__ float swap16_max(float v) { float a = v, b = v; swap16_(a, b); return fmaxf(a, b); }
__device__ __forceinline__ float swap32_max(float v) { float a = v, b = v; swap32_(a, b); return fmaxf(a, b); }
__device__ __forceinline__ float xchg16(float v, int lane) { float a = v, b = v; swap16_(a, b); return (lane & 16) ? a : b; }
__device__ __forceinline__ float xchg32(float v, int lane) { float a = v, b = v; swap32_(a, b); return (lane & 32) ? a : b; }
__device__ __forceinline__ float wave_sum(float v) {
    v += dpp_mov<0xB1>(v); v += dpp_mov<0x4E>(v); v += dpp_mov<0x141>(v); v += dpp_mov<0x140>(v);
    return swap32_sum(swap16_sum(v));
}
__device__ __forceinline__ float wave_max(float v) {
    v = fmaxf(v, dpp_mov<0xB1>(v)); v = fmaxf(v, dpp_mov<0x4E>(v)); v = fmaxf(v, dpp_mov<0x141>(v)); v = fmaxf(v, dpp_mov<0x140>(v));
    return swap32_max(swap16_max(v));
}
__device__ __forceinline__ float sigmoidf_(float z) { return __builtin_amdgcn_rcpf(1.0f + __expf(-z)); }

__device__ __forceinline__ void p0_transpose_item(const float* W, int K, int N, bf16_t* WT, const float* kscale, LAS float* scr, int item, int lane) {
    const int nblk = N / 32, kb = item / nblk, nb = item % nblk, k0 = 64 * kb, n0 = 32 * nb;
#pragma unroll 8
    for (int i = 0; i < 32; ++i) { const int kk = 2 * i + (lane >> 5); float w = W[(size_t)(k0 + kk) * N + n0 + (lane & 31)]; if (kscale) w *= kscale[k0 + kk]; scr[kk * 33 + (lane & 31)] = w; }
    LDS_WAIT(); asm volatile("" ::: "memory");
    const int c = lane & 7;
#pragma unroll
    for (int j = 0; j < 4; ++j) { const int n = (lane >> 3) + 8 * j; const LAS float* s = scr + (8 * c) * 33 + n;
        u32x4 o; o.x = pk2(s[0 * 33], s[1 * 33]); o.y = pk2(s[2 * 33], s[3 * 33]); o.z = pk2(s[4 * 33], s[5 * 33]); o.w = pk2(s[6 * 33], s[7 * 33]);
        *(u32x4*)(WT + (size_t)(n0 + n) * K + k0 + 8 * c) = o; }
    LDS_WAIT(); asm volatile("" ::: "memory");
}
__device__ __forceinline__ int t5_bucket(int rel) {
    const int n = rel < 0 ? -rel : rel;
    const int v = n < 8 ? n : n < 12 ? 8 : n < 16 ? 9 : n < 23 ? 10 : n < 32 ? 11 : n < 46 ? 12 : n < 64 ? 13 : n < 91 ? 14 : 15;
    return (rel > 0 ? 16 : 0) + v;
}
__device__ __forceinline__ void phase_prep(const Params& p, LAS unsigned char* lds, int vcu, int G) {
    const int tid = threadIdx.x, lane = tid & 63, wave = __builtin_amdgcn_readfirstlane(tid >> 6);
    unsigned char* ws = p.ws;
    LAS float* scr = (LAS float*)(lds + wave * 16384);
    const int gw = vcu * NWAVES + wave, NGW = G * NWAVES;
    constexpr int I_IN = (D / 64) * (4096 / 32), I_OUT = (D / 64) * (D / 32), I_QW = (D / 64) * (2048 / 32);
    for (int it = gw; it < I_IN + I_OUT + I_QW; it += NGW) {
        int r = it;
        if (r < I_IN) { p0_transpose_item(p.in[I_WIN], D, 4096, (bf16_t*)(ws + WS_WINT), nullptr, scr, r, lane); continue; } r -= I_IN;
        if (r < I_OUT) { p0_transpose_item(p.in[I_WOUT], D, D, (bf16_t*)(ws + WS_WOT), nullptr, scr, r, lane); continue; } r -= I_OUT;
        p0_transpose_item(p.in[I_WQ], D, 2048, (bf16_t*)(ws + WS_WQT), p.in[I_G2], scr, r, lane);
    }
    for (int i = blockIdx.x * NTHREADS + tid; i < 8 * 2 * 128 * 128 / 4; i += G * NTHREADS) {
        const f32x4 v = ((const f32x4*)p.in[I_KEYS])[i];
        ((u32x2*)(ws + WS_KEYS))[i] = (u32x2){pk2(v.x, v.y), pk2(v.z, v.w)};
    }
#define PX_LOAD(dst, m0_) { _Pragma("unroll") for (int u = 0; u < 4; ++u) { const int m = ((m0_) + u * NGW) < T ? ((m0_) + u * NGW) : gw; const f32x4* xr = (const f32x4*)(p.in[I_X] + (size_t)m * D) + lane; \
            _Pragma("unroll") for (int j = 0; j < 4; ++j) dst[u][j] = xr[64 * j]; } }
#define PX_PROC(src, m0_) { _Pragma("unroll") for (int u = 0; u < 4; ++u) { const int m = (m0_) + u * NGW; if (m < T) { float ssq = 0.f; \
            _Pragma("unroll") for (int j = 0; j < 4; ++j) ssq += (src[u][j].x * src[u][j].x + src[u][j].y * src[u][j].y) + (src[u][j].z * src[u][j].z + src[u][j].w * src[u][j].w); \
            const float rs = rsqrtf(wave_sum(ssq) * (1.f / D) + EPS); unsigned long long* o8 = (unsigned long long*)((bf16_t*)(ws + WS_XN) + (size_t)m * D) + lane; \
            _Pragma("unroll") for (int j = 0; j < 4; ++j) { const f32x4 y = src[u][j] * rs * ((const f32x4*)p.in[I_G1])[64 * j + lane]; o8[64 * j] = (unsigned long long)pk2(y.x, y.y) | ((unsigned long long)pk2(y.z, y.w) << 32); } } } }
    {
        f32x4 va[4][4], vb[4][4];
        PX_LOAD(va, gw)
        for (int m0 = gw; m0 < T; m0 += 8 * NGW) {
            if (m0 + 4 * NGW < T) PX_LOAD(vb, m0 + 4 * NGW)
            PX_PROC(va, m0)
            if (m0 + 8 * NGW < T) PX_LOAD(va, m0 + 8 * NGW)
            PX_PROC(vb, m0 + 4 * NGW)
        }
    }
    if (blockIdx.x == 0) {
        float* sm = (float*)(ws + WS_SM);
        { const float* a = p.in[I_LBF]; sm[SM_LBF + tid] = 1.f / (1.f + __expf(a[512 + tid] - a[tid])); }
        { const float* a = p.in[I_LBB]; sm[SM_LBB + tid] = 1.f / (1.f + __expf(a[512 + tid] - a[tid])); }
        if (tid < 64) {
            float a = p.in[I_LQ1][tid] * p.in[I_LK1][tid], b = p.in[I_LQ2][tid] * p.in[I_LK2][tid];
            a = wave_sum(a); b = wave_sum(b);
            if (tid == 0) sm[SM_LAM] = __expf(a) - __expf(b) + 0.2f;
        }
        for (int i = tid; i < 4 * 257; i += NTHREADS) { const int h = i / 257, r = i % 257; sm[SM_BT + h * BT_STRIDE + r] = p.in[I_RB][t5_bucket(r - 128) * 4 + h] * LOG2E; }
    }
}

__device__ __forceinline__ float silu_(float x) { return x * __builtin_amdgcn_rcpf(1.0f + __expf(-x)); }
struct EpiInProj {
    static constexpr bool PERM = true, AFTER_DRAIN = false;
    bf16_t* P; const float* sm;
    __device__ __forceinline__ void st8(bf16_t* dst, const float (&y)[8]) const { u32x4 w; w.x = pk2(y[0], y[1]); w.y = pk2(y[2], y[3]); w.z = pk2(y[4], y[5]); w.w = pk2(y[6], y[7]); *(u32x4*)dst = w; }
    __device__ __forceinline__ void operator()(const f32x4 (&acc)[2][2][4][2], const pg8::Unit& u, int wr, int wc, int fr, int fq) const {
        const int seg = u.pn >> 1;
        const int row0 = u.pm * 256 + wr * 64 + fr;
        const int cs0 = (u.pn & 1) * 256 + wc * 32 + 8 * fq;
#pragma unroll
        for (int bj = 0; bj < 2; ++bj) {
            const int cs = cs0 + bj * 128;
            float lb[8] = {0.f, 0.f, 0.f, 0.f, 0.f, 0.f, 0.f, 0.f};
            if (seg == 1 || seg == 2) {
#pragma unroll
                for (int i = 0; i < 8; ++i) lb[i] = sm[(seg == 1 ? SM_LBF : SM_LBB) + cs + i];
            }
#pragma unroll
            for (int ai = 0; ai < 2; ++ai)
#pragma unroll
                for (int m = 0; m < 4; ++m) {
                    const size_t row = (size_t)(row0 + ai * 128 + m * 16);
                    bf16_t* rp = P + row * PP + cs;
                    float x[8];
#pragma unroll
                    for (int i = 0; i < 4; ++i) { x[i] = acc[ai][bj][m][0][i]; x[4 + i] = acc[ai][bj][m][1][i]; }
                    float y[8];
                    if (seg == 0 || seg == 4) {
#pragma unroll
                        for (int i = 0; i < 8; ++i) y[i] = silu_(x[i]);
                        st8(rp + (seg == 0 ? C_Q : C_G), y);
                    } else if (seg == 1 || seg == 2) {
                        float lf[8];
#pragma unroll
                        for (int i = 0; i < 8; ++i) { const float s = sigmoidf_(x[i]); const float k = (1.f - lb[i]) * (1.f - s); y[i] = k; lf[i] = __logf(1.f - k); }
                        st8(rp + (seg == 1 ? C_KF : C_KB), y);
                        st8(rp + (seg == 1 ? C_LFF : C_LFB), lf);
                    } else if (seg == 3) {
                        st8(rp + C_V, x);
                    } else if (seg == 5) {
#pragma unroll
                        for (int i = 0; i < 8; ++i) y[i] = x[i] * (0.125f * LOG2E);
                        st8(rp + C_DQ, y);
                    } else {
                        st8(rp + C_DK, x);
                    }
                }
        }
    }
};
struct EpiStore {
    static constexpr bool PERM = true, AFTER_DRAIN = false;
    bf16_t* O; int ldc;
    __device__ __forceinline__ void operator()(const f32x4 (&acc)[2][2][4][2], const pg8::Unit& u, int wr, int wc, int fr, int fq) const {
        const int row0 = u.pm * 256 + wr * 64 + fr, col0 = u.pn * 256 + wc * 32 + 8 * fq;
#pragma unroll
        for (int ai = 0; ai < 2; ++ai)
#pragma unroll
            for (int m = 0; m < 4; ++m)
#pragma unroll
                for (int bj = 0; bj < 2; ++bj) {
                    const f32x4 a = acc[ai][bj][m][0], b = acc[ai][bj][m][1];
                    u32x4 w; w.x = pk2(a[0], a[1]); w.y = pk2(a[2], a[3]); w.z = pk2(b[0], b[1]); w.w = pk2(b[2], b[3]);
                    *(u32x4*)(O + (size_t)(row0 + ai * 128 + m * 16) * ldc + col0 + bj * 128) = w;
                }
    }
};
struct EpiOutProj {
    static constexpr bool PERM = true, AFTER_DRAIN = false;
    const float* x; float* H1; bf16_t* H1B; float* SS;
    __device__ __forceinline__ void operator()(const f32x4 (&acc)[2][2][4][2], const pg8::Unit& u, int wr, int wc, int fr, int fq) const {
        const int row0 = u.pm * 256 + wr * 64 + fr, col0 = u.pn * 256 + wc * 32 + 8 * fq;
#pragma unroll
        for (int ai = 0; ai < 2; ++ai)
#pragma unroll
            for (int m = 0; m < 4; ++m) {
                const size_t row = (size_t)(row0 + ai * 128 + m * 16);
                float ss = 0.f;
#pragma unroll
                for (int bj = 0; bj < 2; ++bj) {
                    const size_t off = row * D + col0 + bj * 128;
                    const f32x4 a = *(const f32x4*)(x + off) + acc[ai][bj][m][0], b = *(const f32x4*)(x + off + 4) + acc[ai][bj][m][1];
                    u32x4 w; w.x = pk2(a[0], a[1]); w.y = pk2(a[2], a[3]); w.z = pk2(b[0], b[1]); w.w = pk2(b[2], b[3]);
                    *(u32x4*)(H1B + off) = w;
                    ss += (a[0] * a[0] + a[1] * a[1]) + (a[2] * a[2] + a[3] * a[3]) + (b[0] * b[0] + b[1] * b[1]) + (b[2] * b[2] + b[3] * b[3]);
                }
                ss += __shfl_xor(ss, 16); ss += __shfl_xor(ss, 32);
                if (fq == 0) SS[row * 16 + u.pn * 4 + wc] = ss;
            }
    }
};
__device__ __forceinline__ float row_rstd(const float* SS, size_t row) {
    const f32x4* s = (const f32x4*)(SS + row * 16);
    const f32x4 a = s[0], b = s[1], c = s[2], d = s[3];
    const float t = ((a[0] + a[1]) + (a[2] + a[3])) + ((b[0] + b[1]) + (b[2] + b[3])) + ((c[0] + c[1]) + (c[2] + c[3])) + ((d[0] + d[1]) + (d[2] + d[3]));
    return rsqrtf(t * (1.f / D) + EPS);
}
struct EpiQ {
    static constexpr bool PERM = true, AFTER_DRAIN = false;
    bf16_t* O; const float* SS; float* RSTD;
    __device__ __forceinline__ void operator()(const f32x4 (&acc)[2][2][4][2], const pg8::Unit& u, int wr, int wc, int fr, int fq) const {
        const int row0 = u.pm * 256 + wr * 64 + fr, col0 = u.pn * 256 + wc * 32 + 8 * fq;
#pragma unroll
        for (int ai = 0; ai < 2; ++ai)
#pragma unroll
            for (int m = 0; m < 4; ++m) {
                const size_t row = (size_t)(row0 + ai * 128 + m * 16);
                const float rs = row_rstd(SS, row);
                if (u.pn == 0 && wc == 0 && fq == 0) RSTD[row] = rs;
#pragma unroll
                for (int bj = 0; bj < 2; ++bj) {
                    const f32x4 a = acc[ai][bj][m][0] * rs, b = acc[ai][bj][m][1] * rs;
                    u32x4 w; w.x = pk2(a[0], a[1]); w.y = pk2(a[2], a[3]); w.z = pk2(b[0], b[1]); w.w = pk2(b[2], b[3]);
                    *(u32x4*)(O + row * QPS + col0 + bj * 128) = w;
                }
            }
    }
};

constexpr int HQ_STRIDE = 272, HT_STRIDE = 48;
constexpr int H_QA = 0, H_KD = 4352, H_KH = 8704, H_VT = 14848, H_DEC = 20992, H_OPER = 21504, H_RAW = 2 * H_OPER, H_RAWB = 16384;
constexpr size_t HG_DONE_OFF = 32768 + 256;
__device__ __forceinline__ void phase_hgrn(const Params& p, LAS unsigned char* lds, int G) {
    const int tid = threadIdx.x, lane = tid & 63, wave = __builtin_amdgcn_readfirstlane(tid >> 6), fr = lane & 15, g = lane >> 4;
    const bf16_t* PROJ = (const bf16_t*)(p.ws + WS_PROJ);
    const int NCH = SEQ / 16;
    for (int item = blockIdx.x; item < 128; item += G) {
        const int dir = item & 1, h = (item >> 1) & 3, b = item >> 3;
        bf16_t* O = (bf16_t*)p.out + (size_t)dir * T * 512;
        const int ck = dir ? C_KB : C_KF, cl = dir ? C_LFB : C_LFF;
        const bool isv = tid >= 256; const int arow = (tid & 255) >> 4, ac8 = (tid & 15) * 8;
        u32x4 rq = (u32x4){0u, 0u, 0u, 0u}, rk = rq, rl = rq;
#define HG_GLOAD(ch) do { const int pos_ = (ch) * 16 + arow, tr_ = dir ? SEQ - 1 - pos_ : pos_; \
            const bf16_t* rp_ = PROJ + (size_t)(b * SEQ + tr_) * PP + h * 128 + ac8; \
            if (isv) { rq = *(const u32x4*)(rp_ + C_V); } else { rq = *(const u32x4*)(rp_ + C_Q); rk = *(const u32x4*)(rp_ + ck); rl = *(const u32x4*)(rp_ + cl); } } while (0)
#define HG_RAWSTORE(par) do { LAS unsigned char* R_ = lds + H_RAW + (par) * H_RAWB + arow * 256 + ac8 * 2; \
            if (isv) { *(LAS u32x4*)(R_ + 12288) = rq; } else { *(LAS u32x4*)R_ = rq; *(LAS u32x4*)(R_ + 4096) = rk; *(LAS u32x4*)(R_ + 8192) = rl; } } while (0)
        const int pc = tid & 127, part = tid >> 7;
        auto phaseB = [&](int par) {
            const LAS unsigned char* R = lds + H_RAW + par * H_RAWB; LAS unsigned char* OP = lds + par * H_OPER;
            float pre = 0.f, total = 0.f;
#pragma unroll
            for (int t = 0; t < 16; ++t) { const float v = __uint_as_float((unsigned)(*(const LAS unsigned short*)(R + 8192 + t * 256 + pc * 2)) << 16); total += v; pre += (t < 4 * part) ? v : 0.f; }
            float bb = pre; float kh[4], vv[4];
#pragma unroll
            for (int j = 0; j < 4; ++j) {
                const int t = 4 * part + j;
                const float lfv = __uint_as_float((unsigned)(*(const LAS unsigned short*)(R + 8192 + t * 256 + pc * 2)) << 16);
                const float qv = __uint_as_float((unsigned)(*(const LAS unsigned short*)(R + t * 256 + pc * 2)) << 16);
                const float kv = __uint_as_float((unsigned)(*(const LAS unsigned short*)(R + 4096 + t * 256 + pc * 2)) << 16);
                vv[j] = __uint_as_float((unsigned)(*(const LAS unsigned short*)(R + 12288 + t * 256 + pc * 2)) << 16);
                bb += lfv;
                *(LAS unsigned short*)(OP + H_QA + t * HQ_STRIDE + pc * 2) = (unsigned short)f2bf(qv * __expf(bb));
                *(LAS unsigned short*)(OP + H_KD + t * HQ_STRIDE + pc * 2) = (unsigned short)f2bf(kv * __expf(-bb));
                kh[j] = kv * __expf(total - bb);
            }
            *(LAS u32x2*)(OP + H_KH + pc * HT_STRIDE + part * 8) = (u32x2){pk2(kh[0], kh[1]), pk2(kh[2], kh[3])};
            *(LAS u32x2*)(OP + H_VT + pc * HT_STRIDE + part * 8) = (u32x2){pk2(vv[0], vv[1]), pk2(vv[2], vv[3])};
            if (part == 0) *(LAS float*)(OP + H_DEC + pc * 4) = __expf(total);
        };
        f32x4 S[8];
#pragma unroll
        for (int kt = 0; kt < 8; ++kt) S[kt] = (f32x4){0.f, 0.f, 0.f, 0.f};
        __syncthreads();
        HG_GLOAD(0); HG_RAWSTORE(0); HG_GLOAD(1);
        __syncthreads();
        phaseB(0); HG_RAWSTORE(1);
        __syncthreads();
        for (int i = 0; i < NCH; ++i) {
            if (i + 2 < NCH) HG_GLOAD(i + 2);
            if (i + 1 < NCH) phaseB((i + 1) & 1);
            {
                const LAS unsigned char* OP = lds + (i & 1) * H_OPER;
                f32x4 o = (f32x4){0.f, 0.f, 0.f, 0.f};
#pragma unroll
                for (int j = 0; j < 4; ++j) {
                    u32x4 w; w.x = pk2(S[2 * j][0], S[2 * j][1]); w.y = pk2(S[2 * j][2], S[2 * j][3]); w.z = pk2(S[2 * j + 1][0], S[2 * j + 1][1]); w.w = pk2(S[2 * j + 1][2], S[2 * j + 1][3]);
                    const u32x2 a0 = *(const LAS u32x2*)(OP + H_QA + fr * HQ_STRIDE + (32 * j + 4 * g) * 2), a1 = *(const LAS u32x2*)(OP + H_QA + fr * HQ_STRIDE + (32 * j + 16 + 4 * g) * 2);
                    o = __builtin_amdgcn_mfma_f32_16x16x32_bf16(__builtin_bit_cast(bf16x8, (u32x4){a0.x, a0.y, a1.x, a1.y}), __builtin_bit_cast(bf16x8, w), o, 0, 0, 0);
                }
                f32x4 X = (f32x4){0.f, 0.f, 0.f, 0.f};
#pragma unroll
                for (int j = 0; j < 4; ++j) {
                    const bf16x8 ak = *(const LAS bf16x8*)(OP + H_KD + fr * HQ_STRIDE + (32 * j + 8 * g) * 2), bq = *(const LAS bf16x8*)(OP + H_QA + fr * HQ_STRIDE + (32 * j + 8 * g) * 2);
                    X = __builtin_amdgcn_mfma_f32_16x16x32_bf16(ak, bq, X, 0, 0, 0);
                }
#pragma unroll
                for (int r = 0; r < 4; ++r) X[r] = (4 * g + r > fr) ? 0.f : X[r];
                const u32x2 vlo = *(const LAS u32x2*)(OP + H_VT + (16 * wave + fr) * HT_STRIDE + g * 8);
                const bf16x8 vb = __builtin_bit_cast(bf16x8, (u32x4){vlo.x, vlo.y, 0u, 0u});
                const bf16x8 pa = __builtin_bit_cast(bf16x8, (u32x4){pk2(X[0], X[1]), pk2(X[2], X[3]), 0u, 0u});
                o = __builtin_amdgcn_mfma_f32_16x16x32_bf16(pa, vb, o, 0, 0, 0);
#pragma unroll
                for (int r = 0; r < 4; ++r) { const int pos = i * 16 + 4 * g + r, tr = dir ? SEQ - 1 - pos : pos; O[(size_t)(b * SEQ + tr) * 512 + h * 128 + 16 * wave + fr] = (bf16_t)f2bf(o[r]); }
#pragma unroll
                for (int kt = 0; kt < 8; ++kt) {
                    const f32x4 dc = *(const LAS f32x4*)(OP + H_DEC + (16 * kt + 4 * g) * 4);
                    const u32x2 klo = *(const LAS u32x2*)(OP + H_KH + (16 * kt + fr) * HT_STRIDE + g * 8);
                    S[kt] = __builtin_amdgcn_mfma_f32_16x16x32_bf16(__builtin_bit_cast(bf16x8, (u32x4){klo.x, klo.y, 0u, 0u}), vb, S[kt] * dc, 0, 0, 0);
                }
            }
            if (i + 2 < NCH) HG_RAWSTORE(i & 1);
            __syncthreads();
        }
        asm volatile("s_waitcnt vmcnt(0)" ::: "memory");
        __syncthreads();
        if (tid == 0) { __builtin_amdgcn_fence(__ATOMIC_RELEASE, "agent"); asm volatile("s_waitcnt vmcnt(0)" ::: "memory");
            (void)__hip_atomic_fetch_add((unsigned*)(p.ws + HG_DONE_OFF), 1u, __ATOMIC_RELAXED, __HIP_MEMORY_SCOPE_AGENT); }
    }
}

constexpr int KT_STRIDE = 272, VT_STRIDE = 144;
constexpr int ATT_BUF = 64 * KT_STRIDE + 128 * VT_STRIDE;
constexpr int QUANT_ITEMS = 256;
__device__ __forceinline__ void quant_tables(const Params& p, int gw, int NGW, int lane) {
    unsigned char* ws = p.ws;
#define PQ_LOAD(dst, r0_) { _Pragma("unroll") for (int u = 0; u < 4; ++u) { const int r = ((r0_) + u * NGW) < 2 * 16384 ? ((r0_) + u * NGW) : gw; const bool isv = r >= 16384; const int e = isv ? r - 16384 : r; \
            const f32x4* xr = (const f32x4*)((isv ? p.in[I_V] : p.in[I_U]) + (size_t)e * D) + lane; _Pragma("unroll") for (int j = 0; j < 4; ++j) dst[u][j] = xr[64 * j]; } }
#define PQ_PROC(src, r0_) { _Pragma("unroll") for (int u = 0; u < 4; ++u) { const int r = (r0_) + u * NGW; if (r < 2 * 16384) { \
            const bool isv = r >= 16384; const int e = isv ? r - 16384 : r; f32x4 v[4]; float am = 0.f; \
            _Pragma("unroll") for (int j = 0; j < 4; ++j) { v[j] = src[u][j]; if (!isv) v[j] = v[j] * ((const f32x4*)p.in[I_G2])[64 * j + lane]; \
                am = fmaxf(am, fmaxf(fmaxf(fabsf(v[j].x), fabsf(v[j].y)), fmaxf(fabsf(v[j].z), fabsf(v[j].w)))); } \
            am = wave_max(am); const float sc = am > 0.f ? am * (1.f / 7.f) : 1.f, inv = 1.f / sc; unsigned pk[4]; int qs = 0; \
            _Pragma("unroll") for (int j = 0; j < 4; ++j) { \
                const int q0 = (int)rintf(v[j].x * inv), q1 = (int)rintf(v[j].y * inv), q2 = (int)rintf(v[j].z * inv), q3 = (int)rintf(v[j].w * inv); qs += (q0 + q1) + (q2 + q3); \
                pk[j] = (unsigned)((q0 & 0xFF) | ((q1 & 0xFF) << 8) | ((q2 & 0xFF) << 16) | ((q3 & 0xFF) << 24)); } \
            if (isv) {   \
                _Pragma("unroll") for (int j = 0; j < 4; ++j) { const unsigned k_ = pk[j]; \
                    *(unsigned short*)(ws + WS_VE + ((size_t)j * 16384 + e) * VSL + 2 * lane) = (unsigned short)(((k_ & 0xFu) ^ 8u) | ((k_ >> 4) & 0xF0u) | ((((k_ >> 16) & 0xFu) ^ 8u) << 8) | ((k_ >> 12) & 0xF000u)); } \
                if (lane == 0) ((float*)(ws + WS_VSC))[e] = sc; } \
            else {   \
                _Pragma("unroll") for (int j = 0; j < 2; ++j) *(unsigned*)(ws + WS_UT + (size_t)e * 512 + 256 * j + 4 * lane) = (pk[j] & 0x0F0F0F0Fu) | ((pk[j + 2] << 4) & 0xF0F0F0F0u); \
                const float qt = wave_sum((float)qs); if (lane == 0) { ((float*)(ws + WS_USC))[e] = sc; ((float*)(ws + WS_US8))[e] = 8.f * qt; } } } } }
    for (int r0 = gw; r0 < 2 * 16384; r0 += 4 * NGW) { f32x4 va[4][4]; PQ_LOAD(va, r0) PQ_PROC(va, r0) }
}
constexpr int MIX_ITEMS = 256;
__device__ __forceinline__ void mix_rows(const Params& p, int gw, int NGW, int lane) {
    const bf16_t* PROJ = (const bf16_t*)(p.ws + WS_PROJ);
    const bf16_t* OF = (const bf16_t*)p.out; const bf16_t* OB = OF + (size_t)T * 512;
    bf16_t* MIXED = (bf16_t*)(p.ws + WS_XN);
    const float* hog = p.in[I_HOG];
    const f32x4 g0 = *(const f32x4*)(hog + (lane & 15) * 8), g1 = *(const f32x4*)(hog + (lane & 15) * 8 + 4);
    for (int m0 = gw; m0 < T; m0 += 4 * NGW) {
        u32x4 av[4], bv[4], gv[4];
#pragma unroll
        for (int u = 0; u < 4; ++u) { const int m = (m0 + u * NGW) < T ? (m0 + u * NGW) : m0;
            av[u] = *(const u32x4*)(OF + (size_t)m * 512 + 8 * lane); bv[u] = *(const u32x4*)(OB + (size_t)m * 512 + 8 * lane); gv[u] = *(const u32x4*)(PROJ + (size_t)m * PP + C_G + 8 * lane); }
#pragma unroll
        for (int u = 0; u < 4; ++u) {
            const int m = m0 + u * NGW; if (m >= T) break;
            const u32x4 a = av[u], bb = bv[u], gg = gv[u];
            float o[8]; float ss = 0.f;
#pragma unroll
            for (int i = 0; i < 4; ++i) { o[2 * i] = bflo(a[i]) + bflo(bb[i]); o[2 * i + 1] = bfhi(a[i]) + bfhi(bb[i]); ss += o[2 * i] * o[2 * i] + o[2 * i + 1] * o[2 * i + 1]; }
            ss += dpp_mov<0xB1>(ss); ss += dpp_mov<0x4E>(ss); ss += dpp_mov<0x141>(ss); ss += dpp_mov<0x140>(ss);
            const float rs = rsqrtf(ss * (1.f / 128.f) + EPS);
            float y[8];
#pragma unroll
            for (int i = 0; i < 4; ++i) { y[2 * i] = o[2 * i] * rs * (i < 2 ? g0[2 * i] : g1[2 * i - 4]) * bflo(gg[i]); y[2 * i + 1] = o[2 * i + 1] * rs * (i < 2 ? g0[2 * i + 1] : g1[2 * i - 3]) * bfhi(gg[i]); }
            *(u32x4*)(MIXED + (size_t)m * D + 8 * lane) = (u32x4){pk2(y[0], y[1]), pk2(y[2], y[3]), pk2(y[4], y[5]), pk2(y[6], y[7])};
        }
    }
}

__device__ __forceinline__ float MAX3_(float a, float b, float c) { float r; asm("v_max3_f32 %0, %1, %2, %3" : "=v"(r) : "v"(a), "v"(b), "v"(c)); return r; }
__device__ __forceinline__ void phase_attn(const Params& p, LAS unsigned char* lds, int G) {
    const int tid = threadIdx.x, lane = tid & 63, wave = __builtin_amdgcn_readfirstlane(tid >> 6), fr = lane & 15, fq = lane >> 4;
    const bf16_t* PROJ = (const bf16_t*)(p.ws + WS_PROJ);
    const bf16_t* VT = (const bf16_t*)(p.ws + WS_VT);
    bf16_t* MIXED = (bf16_t*)(p.ws + WS_XN);
    const float* sm = (const float*)(p.ws + WS_SM);
    LAS unsigned char* LK = lds; LAS unsigned char* LV = lds + 64 * KT_STRIDE; LAS float* LB = (LAS float*)(lds + 2 * ATT_BUF);
    const float lam = sm[SM_LAM];
    float vinf = __builtin_inff(); asm volatile("" : "+v"(vinf));
    unsigned* qctr = (unsigned*)(p.ws + 32768);
    volatile LAS unsigned* qslot = (volatile LAS unsigned*)(lds + 131072 + 320 + 64);
    for (;;) {
        __syncthreads();
        if (tid == 0) qslot[0] = __hip_atomic_fetch_add(qctr, 1u, __ATOMIC_RELAXED, __HIP_MEMORY_SCOPE_AGENT);
        __syncthreads();
        const int item = (int)qslot[0];
        if (item >= 1024 + QUANT_ITEMS + MIX_ITEMS) break;
        if (item >= 1024 + QUANT_ITEMS) {
            if (tid == 0) { unsigned sp_ = 0; while (__hip_atomic_load((unsigned*)(p.ws + HG_DONE_OFF), __ATOMIC_RELAXED, __HIP_MEMORY_SCOPE_AGENT) < 128u && ++sp_ < (1u << 24)) __builtin_amdgcn_s_sleep(2);
                __builtin_amdgcn_fence(__ATOMIC_ACQUIRE, "agent"); asm volatile("s_waitcnt vmcnt(0)" ::: "memory"); }
            __syncthreads();
            mix_rows(p, (item - 1024 - QUANT_ITEMS) * NWAVES + wave, MIX_ITEMS * NWAVES, lane); continue;
        }
        if (item >= 1024) { quant_tables(p, (item - 1024) * NWAVES + wave, QUANT_ITEMS * NWAVES, lane); continue; }
        const int bh = item >> 4, qb = item & 15, b = bh >> 2, h = bh & 3;
        const int qabs = qb * 128 + wave * 16 + fr;
        const size_t qrow = (size_t)b * SEQ + qabs;
        __syncthreads();
        for (int i = tid; i < 257; i += NTHREADS) LB[i] = sm[SM_BT + h * BT_STRIDE + i];
        bf16x8 qf[2][2];
#pragma unroll
        for (int m = 0; m < 2; ++m)
#pragma unroll
            for (int kk = 0; kk < 2; ++kk) qf[m][kk] = *(const bf16x8*)(PROJ + qrow * PP + C_DQ + h * 128 + m * 64 + kk * 32 + fq * 8);
        float mrun[2] = {0.f, 0.f};
        f32x4 lacc[2] = {(f32x4){0.f, 0.f, 0.f, 0.f}, (f32x4){0.f, 0.f, 0.f, 0.f}};
        f32x4 o[2][8];
#pragma unroll
        for (int m = 0; m < 2; ++m)
#pragma unroll
            for (int dt = 0; dt < 8; ++dt) o[m][dt] = (f32x4){0.f, 0.f, 0.f, 0.f};
        u32x4 kreg[2], vreg[2];
        const bf16_t* kg[2]; const bf16_t* vg[2]; int koff[2], voff[2];
#pragma unroll
        for (int i = 0; i < 2; ++i) { const int c = tid + i * 512;
            const int kr = c >> 4, kc = (c & 15) * 8; kg[i] = PROJ + ((size_t)b * SEQ + kr) * PP + C_DK + h * 128 + kc; koff[i] = kr * KT_STRIDE + kc * 2;
            const int vr = c >> 3, vc = (c & 7) * 8; vg[i] = VT + (size_t)(h * 128 + vr) * T + (size_t)b * SEQ + vc; voff[i] = vr * VT_STRIDE + vc * 2; }
#pragma unroll
        for (int i = 0; i < 2; ++i) { kreg[i] = *(const u32x4*)kg[i]; vreg[i] = *(const u32x4*)vg[i]; }
#pragma unroll
        for (int i = 0; i < 2; ++i) { *(LAS u32x4*)(LK + koff[i]) = kreg[i]; *(LAS u32x4*)(LV + voff[i]) = vreg[i]; }
        __syncthreads();
        const int Qw = qb * 128 + wave * 16;
        for (int kt = 0; kt < SEQ / 64; ++kt) {
            const int pbuf = (kt & 1) * ATT_BUF;
            if (kt + 1 < SEQ / 64) {
#pragma unroll
                for (int i = 0; i < 2; ++i) { kreg[i] = *(const u32x4*)(kg[i] + (size_t)(kt + 1) * 64 * PP); vreg[i] = *(const u32x4*)(vg[i] + (kt + 1) * 64); }
            }
            const int k0 = kt * 64;
            const bool farl = (k0 + 63 - Qw) <= -91, farr = (k0 - (Qw + 15)) >= 91;
            const float binit = farl ? LB[0] : (farr ? LB[256] : 0.f);
            f32x4 s[2][4];
#pragma unroll
            for (int m = 0; m < 2; ++m) {
                const float ci = binit - mrun[m];
#pragma unroll
                for (int ks = 0; ks < 4; ++ks) {
                    f32x4 a = (f32x4){ci, ci, ci, ci};
#pragma unroll
                    for (int kk = 0; kk < 2; ++kk) {
                        const bf16x8 kf = *(const LAS bf16x8*)(LK + pbuf + (16 * ks + fr) * KT_STRIDE + (m * 64 + kk * 32 + fq * 8) * 2);
                        a = __builtin_amdgcn_mfma_f32_16x16x32_bf16(kf, qf[m][kk], a, 0, 0, 0);
                    }
                    s[m][ks] = a;
                }
            }
            if (!(farl || farr)) {
#pragma unroll
                for (int ks = 0; ks < 4; ++ks)
#pragma unroll
                    for (int r = 0; r < 4; ++r) {
                        int rel = k0 + 16 * ks + 4 * fq + r - qabs; rel = rel < -128 ? -128 : (rel > 128 ? 128 : rel);
                        const float bv = LB[rel + 128];
                        s[0][ks][r] += bv; s[1][ks][r] += bv;
                    }
            }
            bf16x8 pb[2][2];
#pragma unroll
            for (int m = 0; m < 2; ++m) {
                float mx = MAX3_(__builtin_amdgcn_fmed3f(s[m][0][0], s[m][1][0], vinf), __builtin_amdgcn_fmed3f(s[m][2][0], s[m][3][0], vinf), s[m][0][1]);
                mx = MAX3_(mx, s[m][0][2], s[m][0][3]); mx = MAX3_(mx, s[m][1][1], s[m][1][2]); mx = MAX3_(mx, s[m][1][3], s[m][2][1]);
                mx = MAX3_(mx, s[m][2][2], s[m][2][3]); mx = MAX3_(mx, s[m][3][1], s[m][3][2]); mx = MAX3_(mx, mx, s[m][3][3]);
                { float a_ = mx, b_ = mx; swap16_(a_, b_); mx = MAX3_(a_, b_, b_); }
                { float a_ = mx, b_ = mx; swap32_(a_, b_); mx = MAX3_(a_, b_, b_); }
                if (__any(fabsf(mx) > 8.0f)) {
                    const float dl = fabsf(mx) > 8.0f ? mx : 0.f, alpha = __builtin_amdgcn_exp2f(-dl);
                    mrun[m] += dl; lacc[m] *= alpha;
#pragma unroll
                    for (int ks = 0; ks < 4; ++ks) s[m][ks] = s[m][ks] - dl;
#pragma unroll
                    for (int dt = 0; dt < 8; ++dt) o[m][dt] *= alpha;
                }
#pragma unroll
                for (int ks = 0; ks < 4; ++ks)
#pragma unroll
                    for (int r = 0; r < 4; ++r) s[m][ks][r] = __builtin_amdgcn_exp2f(s[m][ks][r]);
#pragma unroll
                for (int k2 = 0; k2 < 2; ++k2) {
                    u32x4 w; w.x = pk2(s[m][2 * k2][0], s[m][2 * k2][1]); w.y = pk2(s[m][2 * k2][2], s[m][2 * k2][3]);
                    w.z = pk2(s[m][2 * k2 + 1][0], s[m][2 * k2 + 1][1]); w.w = pk2(s[m][2 * k2 + 1][2], s[m][2 * k2 + 1][3]);
                    pb[m][k2] = __builtin_bit_cast(bf16x8, w);
                }
            }
            const bf16x8 ones = __builtin_bit_cast(bf16x8, (u32x4){0x3F803F80u, 0x3F803F80u, 0x3F803F80u, 0x3F803F80u});
#pragma unroll
            for (int k2 = 0; k2 < 2; ++k2) {
                lacc[0] = __builtin_amdgcn_mfma_f32_16x16x32_bf16(ones, pb[0][k2], lacc[0], 0, 0, 0);
                lacc[1] = __builtin_amdgcn_mfma_f32_16x16x32_bf16(ones, pb[1][k2], lacc[1], 0, 0, 0);
#pragma unroll
                for (int dt = 0; dt < 8; ++dt) {
                    const u32x2 lo = *(const LAS u32x2*)(LV + pbuf + (16 * dt + fr) * VT_STRIDE + (32 * k2 + 4 * fq) * 2);
                    const u32x2 hi = *(const LAS u32x2*)(LV + pbuf + (16 * dt + fr) * VT_STRIDE + (32 * k2 + 16 + 4 * fq) * 2);
                    const bf16x8 vf = __builtin_bit_cast(bf16x8, (u32x4){lo.x, lo.y, hi.x, hi.y});
                    o[0][dt] = __builtin_amdgcn_mfma_f32_16x16x32_bf16(vf, pb[0][k2], o[0][dt], 0, 0, 0);
                    o[1][dt] = __builtin_amdgcn_mfma_f32_16x16x32_bf16(vf, pb[1][k2], o[1][dt], 0, 0, 0);
                }
            }
            if (kt + 1 < SEQ / 64) {
                const int nbuf = ((kt + 1) & 1) * ATT_BUF;
#pragma unroll
                for (int i = 0; i < 2; ++i) { *(LAS u32x4*)(LK + nbuf + koff[i]) = kreg[i]; *(LAS u32x4*)(LV + nbuf + voff[i]) = vreg[i]; }
            }
            __syncthreads();
        }
        float inv[2];
#pragma unroll
        for (int m = 0; m < 2; ++m) inv[m] = __builtin_amdgcn_rcpf(lacc[m][0]);
        float ssq = 0.f;
#pragma unroll
        for (int dt = 0; dt < 8; ++dt)
#pragma unroll
            for (int r = 0; r < 4; ++r) { const float ov = o[0][dt][r] * inv[0] - lam * (o[1][dt][r] * inv[1]); o[0][dt][r] = ov; ssq += ov * ov; }
        ssq += __shfl_xor(ssq, 16); ssq += __shfl_xor(ssq, 32);
        const float rs = rsqrtf(ssq * (1.f / 128.f) + EPS) * 0.8f;
        const float* og = p.in[I_DOG];
#pragma unroll
        for (int dt = 0; dt < 8; ++dt) {
            const f32x4 g = *(const f32x4*)(og + 16 * dt + 4 * fq);
            const f32x4 y = o[0][dt] * rs * g;
            *(u32x2*)(MIXED + qrow * D + 512 + h * 128 + 16 * dt + 4 * fq) = (u32x2){pk2(y[0], y[1]), pk2(y[2], y[3])};
        }
    }
}

__device__ __forceinline__ void phase_hquant(const Params& p, int vcu, int G) {
    const int tid = threadIdx.x, lane = tid & 63, wave = __builtin_amdgcn_readfirstlane(tid >> 6);
    const bf16_t* H1B = (const bf16_t*)(p.ws + WS_H1B); const float* SS = (const float*)(p.ws + WS_SS);
    for (int t0 = vcu * NWAVES + wave; t0 < T; t0 += 4 * G * NWAVES) {
        u32x4 ha[4], hb[4];
#pragma unroll
        for (int u = 0; u < 4; ++u) { const int t = (t0 + u * G * NWAVES) < T ? (t0 + u * G * NWAVES) : t0; ha[u] = *(const u32x4*)(H1B + (size_t)t * D + 8 * lane); hb[u] = *(const u32x4*)(H1B + (size_t)t * D + 512 + 8 * lane); }
#pragma unroll
        for (int u = 0; u < 4; ++u) {
            const int t = t0 + u * G * NWAVES; if (t >= T) break;
            const u32x4 h0 = ha[u], h1 = hb[u];
            float hf[16]; float am = 0.f;
#pragma unroll
            for (int k = 0; k < 4; ++k) { hf[2 * k] = bflo(h0[k]); hf[2 * k + 1] = bfhi(h0[k]); hf[8 + 2 * k] = bflo(h1[k]); hf[8 + 2 * k + 1] = bfhi(h1[k]); }
#pragma unroll
            for (int k = 0; k < 16; ++k) am = fmaxf(am, fabsf(hf[k]));
            am = wave_max(am);
            const float iv = am > 0.f ? 127.f / am : 0.f;
            u32x4 q;
#pragma unroll
            for (int w = 0; w < 4; ++w) { const int q0 = (int)rintf(hf[4 * w] * iv), q1 = (int)rintf(hf[4 * w + 1] * iv), q2 = (int)rintf(hf[4 * w + 2] * iv), q3 = (int)rintf(hf[4 * w + 3] * iv);
                q[w] = (unsigned)((q0 & 0xFF) | ((q1 & 0xFF) << 8) | ((q2 & 0xFF) << 16) | ((q3 & 0xFF) << 24)); }
            u32x2 ph, pl;
#pragma unroll
            for (int w = 0; w < 2; ++w) { ph[w] = ((q[w] >> 4) & 0x0F0F0F0Fu) | (q[2 + w] & 0xF0F0F0F0u); pl[w] = ((q[w] & 0x0F0F0F0Fu) | ((q[2 + w] << 4) & 0xF0F0F0F0u)) ^ 0x88888888u; }
            *(u32x2*)(p.ws + WS_H1Q + (size_t)t * D + 8 * lane) = ph; *(u32x2*)(p.ws + WS_H1Q + (size_t)t * D + 512 + 8 * lane) = pl;
            if (lane == 0) ((float*)(p.ws + WS_HSC))[t] = am * (1.f / 127.f) * row_rstd(SS, (size_t)t);
        }
    }
}
__device__ __forceinline__ unsigned ford(float f) { const unsigned u = __float_as_uint(f); return (u & 0x80000000u) ? ~u : (u | 0x80000000u); }
__device__ __forceinline__ float funord(unsigned u) { u = (u & 0x80000000u) ? (u & 0x7fffffffu) : ~u; return __uint_as_float(u); }
template <int N> __device__ __forceinline__ void bitonic_sort_desc(unsigned (&v)[N]) {
#pragma unroll
    for (int k = 2; k <= N; k <<= 1)
#pragma unroll
        for (int j = k >> 1; j > 0; j >>= 1)
#pragma unroll
            for (int i = 0; i < N; ++i) { const int l = i ^ j;
                if (l > i) { const unsigned a = v[i], b = v[l]; const unsigned mx = a > b ? a : b, mn = a > b ? b : a; if ((i & k) == 0) { v[i] = mx; v[l] = mn; } else { v[i] = mn; v[l] = mx; } } }
}
__device__ __forceinline__ void merge_top16(unsigned (&a)[16], const unsigned (&b)[16]) {
#pragma unroll
    for (int i = 0; i < 16; ++i) a[i] = a[i] > b[15 - i] ? a[i] : b[15 - i];
#pragma unroll
    for (int j = 8; j > 0; j >>= 1)
#pragma unroll
        for (int i = 0; i < 16; ++i) { const int l = i ^ j; if (l > i) { const unsigned x = a[i], y = a[l]; a[i] = x > y ? x : y; a[l] = x > y ? y : x; } }
}
__device__ __forceinline__ void top16_of64(const unsigned (&v)[64], unsigned (&out)[16]) {
    unsigned g1[16], g2[16], g3[16];
#pragma unroll
    for (int i = 0; i < 16; ++i) { out[i] = v[i]; g1[i] = v[16 + i]; g2[i] = v[32 + i]; g3[i] = v[48 + i]; }
    bitonic_sort_desc<16>(out); bitonic_sort_desc<16>(g1); bitonic_sort_desc<16>(g2); bitonic_sort_desc<16>(g3);
    merge_top16(out, g1); merge_top16(g2, g3); merge_top16(out, g2);
}
__device__ __forceinline__ unsigned xchg32u(unsigned v, int lane) { return __builtin_bit_cast(unsigned, xchg32(__builtin_bit_cast(float, v), lane)); }
constexpr int TK_KROW = 272, TK_TAB = 256 * TK_KROW;
__device__ __forceinline__ void phase_topk(const Params& p, LAS unsigned char* lds, int vcu, int G) {
    const int tid = threadIdx.x, lane = tid & 63, wave = __builtin_amdgcn_readfirstlane(tid >> 6), r32 = lane & 31, hi = lane >> 5;
    const bf16_t* QP = (const bf16_t*)(p.ws + WS_QP);
    const bf16_t* KEYS = (const bf16_t*)(p.ws + WS_KEYS);
    int* IDX = (int*)(p.ws + WS_IDX);
    LAS unsigned* tab = (LAS unsigned*)(lds + TK_TAB) + wave * 8 * 64 + lane;
    for (int item = blockIdx.x; item < (T / 256) * 2; item += G) {
        const int tg = item % (T / 256), hg = item / (T / 256);
        const size_t tok = (size_t)(tg * 8 + wave) * 32 + r32;
        for (int hh = 0; hh < 4; ++hh) {
            const int h = hg * 4 + hh;
            __syncthreads();
#pragma unroll
            for (int c8 = 0; c8 < 8; ++c8) { const int c = tid + c8 * NTHREADS, row = c >> 4, ch = c & 15;
                *(LAS u32x4*)(lds + row * TK_KROW + ch * 16) = *(const u32x4*)(KEYS + (size_t)(h * 256 + row) * 128 + ch * 8); }
            __syncthreads();
            unsigned lst[2][16];
#pragma unroll
            for (int pp = 0; pp < 2; ++pp) {
                f32x16 acc[4];
#pragma unroll
                for (int kt = 0; kt < 4; ++kt)
#pragma unroll
                    for (int r = 0; r < 16; ++r) acc[kt][r] = 0.f;
                const bf16_t* qrow = QP + tok * QPS + h * 256 + pp * 128 + 8 * hi;
                const LAS unsigned char* kb = lds + (pp * 128 + r32) * TK_KROW + 16 * hi;
#pragma unroll
                for (int s2 = 0; s2 < 8; ++s2) {
                    const bf16x8 bq = *(const bf16x8*)(qrow + 16 * s2);
#pragma unroll
                    for (int kt = 0; kt < 4; ++kt) {
                        const bf16x8 ak = *(const LAS bf16x8*)(kb + kt * 32 * TK_KROW + 32 * s2);
                        acc[kt] = __builtin_amdgcn_mfma_f32_32x32x16_bf16(ak, bq, acc[kt], 0, 0, 0);
                    }
                }
                unsigned v[64];
#pragma unroll
                for (int kt = 0; kt < 4; ++kt)
#pragma unroll
                    for (int r = 0; r < 16; ++r) { const int n = 32 * kt + (r & 3) + 8 * (r >> 2) + 4 * hi; v[kt * 16 + r] = (ford(acc[kt][r]) & ~0x7Fu) | (unsigned)(127 - n); }
                unsigned own[16], oth[16];
                top16_of64(v, own);
#pragma unroll
                for (int j = 0; j < 16; ++j) oth[j] = xchg32u(own[j], lane);
                merge_top16(own, oth);
#pragma unroll
                for (int j = 0; j < 16; ++j) lst[pp][j] = own[j];
            }
            float a[16], bs[16];
#pragma unroll
            for (int j = 0; j < 16; ++j) { a[j] = funord(lst[0][j] & ~0x7Fu); bs[j] = funord(lst[1][j] & ~0x7Fu); }
#pragma unroll
            for (int m = 0; m < 4; ++m) {
                tab[m * 64] = (127u - (lst[0][4 * m] & 0x7Fu)) | ((127u - (lst[0][4 * m + 1] & 0x7Fu)) << 8) | ((127u - (lst[0][4 * m + 2] & 0x7Fu)) << 16) | ((127u - (lst[0][4 * m + 3] & 0x7Fu)) << 24);
                tab[(4 + m) * 64] = (127u - (lst[1][4 * m] & 0x7Fu)) | ((127u - (lst[1][4 * m + 1] & 0x7Fu)) << 8) | ((127u - (lst[1][4 * m + 2] & 0x7Fu)) << 16) | ((127u - (lst[1][4 * m + 3] & 0x7Fu)) << 24);
            }
            unsigned cand[64];
            {
                int c = 0;
#pragma unroll
                for (int i = 0; i < 16; ++i)
#pragma unroll
                    for (int j = 0; j < 16; ++j)
                        if ((i + 1) * (j + 1) <= 16) { cand[c] = (ford(a[i] + bs[j]) & ~0xFFu) | (unsigned)(255 - (i * 16 + j)); ++c; }
#pragma unroll
                for (int q = 50; q < 64; ++q) cand[q] = 0u;
            }
            unsigned best[16], eidx[16];
            top16_of64(cand, best);
            LDS_WAIT();
#pragma unroll
            for (int r = 0; r < 16; ++r) { const unsigned code = 255u - (best[r] & 0xFFu), ci = code >> 4, cj = code & 15u;
                const unsigned wi = tab[(ci >> 2) * 64], wj = tab[(4 + (cj >> 2)) * 64];
                eidx[r] = ((wi >> (8 * (ci & 3u))) & 0x7Fu) * 128u + ((wj >> (8 * (cj & 3u))) & 0x7Fu); }
            LDS_WAIT();
            if (hi == 0) {
                float g[16]; const float mx = funord(best[0] & ~0xFFu); float tot = 0.f;
#pragma unroll
                for (int r = 0; r < 16; ++r) { g[r] = __expf(funord(best[r] & ~0xFFu) - mx); tot += g[r]; }
                const float it_ = 1.f / tot;
                unsigned* rp = (unsigned*)IDX + (tok * 8 + h) * 16;
#pragma unroll
                for (int q4 = 0; q4 < 4; ++q4)
                    *(u32x4*)(rp + 4 * q4) = (u32x4){eidx[4 * q4] | (f2bf(g[4 * q4] * it_) << 16), eidx[4 * q4 + 1] | (f2bf(g[4 * q4 + 1] * it_) << 16), eidx[4 * q4 + 2] | (f2bf(g[4 * q4 + 2] * it_) << 16), eidx[4 * q4 + 3] | (f2bf(g[4 * q4 + 3] * it_) << 16)};
            }
        }
    }
}

typedef float f32x2_ __attribute__((ext_vector_type(2)));
__device__ __forceinline__ float gelu_exact(float v) {
    const float av = fabsf(v), t = __builtin_amdgcn_rcpf(av * 0.2316418882f + 1.0f);
    float q = t * 0.5307027145f + (-0.7265760135f); q = q * t + 0.7107068705f; q = q * t + (-0.142248368f); q = q * t + 0.127414796f; q = q * t;
    const float e = __builtin_amdgcn_exp2f((v * v) * (-0.72134752044f));
    const float m = v * (q * e);
    return v < 0.f ? m : v - m;
}
typedef float f32x2_ __attribute__((ext_vector_type(2)));
__device__ __forceinline__ void phase_peer_u(const Params& p, LAS unsigned char* lds, int G, int mx, int mj) {
    const int tid = threadIdx.x, lane = tid & 63, wave = __builtin_amdgcn_readfirstlane(tid >> 6), bx = blockIdx.x;
    const bool xl = (G % 8 == 0);
    const int x = xl ? (mx & 3) : 0, nx = xl ? 4 : 1, jb = xl ? (mx >> 2) * (G / 8) + mj : bx, nw = (xl ? G / 4 : G) * NWAVES, widx = jb * NWAVES + wave;
    const unsigned char* H1Q = (const unsigned char*)(p.ws + WS_H1Q); const unsigned char* UQ = (const unsigned char*)(p.ws + WS_UT);
    const unsigned* REC = (const unsigned*)(p.ws + WS_IDX); const float* HSC = (const float*)(p.ws + WS_HSC);
    const float* USC = (const float*)(p.ws + WS_USC); const float* VSC = (const float*)(p.ws + WS_VSC);
    unsigned* CI = (unsigned*)(p.ws + WS_C);
    LAS float* SU = (LAS float*)lds; LAS float* SV = SU + GRP_SIZE; LAS float* U8 = SV + GRP_SIZE;
    LAS u32x2* slots = (LAS u32x2*)(lds + 49152 + wave * 2048);
    LAS u32x4* hbuf = (LAS u32x4*)(lds + 65536 + wave * 2048);
    const int K = (T - widx + nw - 1) / nw;
    const int lrow = lane >> 4, lcol = lane & 15, lc16 = 16 * lcol;
    for (int g = x; g < NGRP; g += nx) {
        __syncthreads();
        for (int i = tid; i < GRP_SIZE; i += NTHREADS) { SU[i] = USC[g * GRP_SIZE + i]; SV[i] = VSC[g * GRP_SIZE + i]; U8[i] = ((const float*)(p.ws + WS_US8))[g * GRP_SIZE + i]; }
        __syncthreads();
#define PU_R(S, k_) { const int kk_ = (k_) < K ? (k_) : K - 1; const size_t tt_ = (size_t)(widx + nw * kk_); \
            rq##S = *(const u32x2*)(REC + tt_ * 128 + 2 * lane); rr##S = HSC[tt_]; hr##S = *(const u32x4*)(H1Q + tt_ * D + 16 * lane); }
#define PU_C(S, k_) { LAS u32x2* sl_ = slots + S * 128; const bool ok_ = (k_) < K; tk##S = widx + nw * ((k_) < K ? (k_) : K - 1); rs##S = rr##S; \
            hbuf[S * 64 + lane] = hr##S; const unsigned rl##S = rq##S.x, rh##S = rq##S.y; \
            { const bool f0 = ((rl##S & 0x3FFFu) >> GRP_SHIFT) == (unsigned)g, f1 = ((rh##S & 0x3FFFu) >> GRP_SHIFT) == (unsigned)g; const unsigned long long m0 = __ballot(f0), m1 = __ballot(f1); const int n0 = __popcll(m0); \
              if (f0) sl_[(int)__builtin_amdgcn_mbcnt_hi((unsigned)(m0 >> 32), __builtin_amdgcn_mbcnt_lo((unsigned)m0, 0u))] = (u32x2){((rl##S & 0x3FFFu) << 9) | ((unsigned)(2 * lane) << 24), rl##S & 0xffff0000u}; \
              if (f1) sl_[n0 + (int)__builtin_amdgcn_mbcnt_hi((unsigned)(m1 >> 32), __builtin_amdgcn_mbcnt_lo((unsigned)m1, 0u))] = (u32x2){((rh##S & 0x3FFFu) << 9) | ((unsigned)(2 * lane + 1) << 24), rh##S & 0xffff0000u}; \
              nn##S = ok_ ? n0 + __popcll(m1) : 0; } \
            LDS_WAIT(); \
            _Pragma("unroll") for (int q = 0; q < 6; ++q) { sr##S[q] = sl_[4 * q + lrow]; sb##S[q] = sl_[24 + 4 * q + lrow]; } \
            _Pragma("unroll") for (int i = 0; i < 4; ++i) hq##S[i] = hbuf[S * 64 + 16 * i + lcol]; }
#define PU_ISSUE(R, SR, n_, QM) { \
            _Pragma("unroll") for (int q = 0; q < 6; ++q) if (q < (QM) || (n_) > 4 * q) { const bool v_ = (4 * q + lrow) < (n_); const unsigned char* a_ = UQ + (v_ ? (size_t)((SR[q].x & 0x7FFFFFu) + lc16) : (size_t)0); \
                row##R[2 * q] = *(const u32x4*)a_; row##R[2 * q + 1] = *(const u32x4*)(a_ + 256); } }
#define PU_DOT(R, HQ, ACC, n_, QM) { _Pragma("unroll") for (int q = 0; q < 6; ++q) if (q < (QM) || (n_) > 4 * q) { int a1_ = 0, a2_ = 0; \
                _Pragma("unroll") for (int i = 0; i < 2; ++i) _Pragma("unroll") for (int w = 0; w < 4; ++w) { a1_ = __builtin_amdgcn_sdot8((int)row##R[2 * q + i][w], (int)HQ[i][w], a1_, false); a2_ = __builtin_amdgcn_sdot8((int)row##R[2 * q + i][w], (int)HQ[2 + i][w], a2_, false); } \
                ACC[q] = (a1_ << 4) + a2_; } }
#define PU_EPI(S, SR, ACC, n_, QM) { float rt_[6]; \
            _Pragma("unroll") for (int q = 0; q < 6; ++q) { rt_[q] = 0.f; if (q < (QM) || (n_) > 4 * q) { float f_ = (float)ACC[q]; f_ += dpp_mov<0xB1>(f_); f_ += dpp_mov<0x4E>(f_); f_ += dpp_mov<0x141>(f_); f_ += dpp_mov<0x140>(f_); rt_[q] = f_; } } \
            float tot_ = rt_[0]; unsigned rx_ = SR[0].x, ry_ = SR[0].y; \
            _Pragma("unroll") for (int q = 1; q < 6; ++q) { const bool e_ = lcol == q; tot_ = e_ ? rt_[q] : tot_; rx_ = e_ ? SR[q].x : rx_; ry_ = e_ ? SR[q].y : ry_; } \
            if (lcol < 6 && (4 * lcol + lrow) < (n_)) { const unsigned idx_ = (rx_ >> 9) & 0x3FFFu; const int li_ = (int)(idx_ & (GRP_SIZE - 1)); \
                const float c_ = __uint_as_float(ry_) * gelu_exact((tot_ + U8[li_]) * SU[li_] * rs##S) * SV[li_]; CI[(size_t)tk##S * 128 + (rx_ >> 24)] = (f2bf(c_) << 16) | idx_; } }
#define PU_OVF(S) if (nn##S > 48) { for (int b1_ = 48; b1_ < nn##S; b1_ += 24) { u32x2 so2_[6]; _Pragma("unroll") for (int q = 0; q < 6; ++q) so2_[q] = slots[S * 128 + ((b1_ + 4 * q + lrow) & 127)]; \
            const int n2_ = nn##S - b1_; int ac2_[6]; PU_ISSUE(B, so2_, n2_, 0) PU_DOT(B, hq##S, ac2_, n2_, 0) PU_EPI(S, so2_, ac2_, n2_, 0) } }
        u32x2 rq0, rq1; u32x4 hr0, hr1, hq0[4], hq1[4]; float rr0, rr1, rs0 = 0.f, rs1 = 0.f; int tk0 = 0, tk1 = 0, nn0 = 0, nn1 = 0;
        u32x4 rowA[12], rowB[12]; u32x2 sr0[6], sr1[6], sb0[6], sb1[6]; int acc0[6], acc1[6];
#pragma unroll
        for (int q = 0; q < 4; ++q) { hq0[q] = (u32x4){0u, 0u, 0u, 0u}; hq1[q] = hq0[q]; }
#pragma unroll
        for (int q = 0; q < 6; ++q) { sr0[q] = (u32x2){0u, 0u}; sr1[q] = sr0[q]; sb0[q] = sr0[q]; sb1[q] = sr0[q]; acc0[q] = 0; acc1[q] = 0; }
#pragma unroll
        for (int q = 0; q < 12; ++q) { rowA[q] = (u32x4){0u, 0u, 0u, 0u}; rowB[q] = rowA[q]; }
        PU_R(0, 0) PU_R(1, 1)
        PU_C(0, 0)
        PU_ISSUE(A, sr0, nn0, 4)
        for (int k = 0; k < K; k += 2) {
            PU_ISSUE(B, sb0, nn0 - 24, 0)
            PU_R(0, k + 2)
            PU_DOT(A, hq0, acc0, nn0, 4) PU_EPI(0, sr0, acc0, nn0, 4)
            PU_C(1, k + 1)
            PU_ISSUE(A, sr1, nn1, 4)
            PU_DOT(B, hq0, acc0, nn0 - 24, 0) PU_EPI(0, sb0, acc0, nn0 - 24, 0) PU_OVF(0)
            PU_ISSUE(B, sb1, nn1 - 24, 0)
            PU_R(1, k + 3)
            PU_DOT(A, hq1, acc1, nn1, 4) PU_EPI(1, sr1, acc1, nn1, 4)
            PU_C(0, k + 2)
            PU_ISSUE(A, sr0, nn0, 4)
            PU_DOT(B, hq1, acc1, nn1 - 24, 0) PU_EPI(1, sb1, acc1, nn1 - 24, 0) PU_OVF(1)
        }
    }
    __syncthreads();
}
__device__ __forceinline__ void phase_peer_v(const Params& p, LAS unsigned char* lds, int G, int mx, int mj) {
    const int tid = threadIdx.x, lane = tid & 63, wave = __builtin_amdgcn_readfirstlane(tid >> 6), bx = blockIdx.x;
    const bool xl = (G % 8 == 0);
    const int x = xl ? (mx & 3) : 0, nx = xl ? 4 : 1, jb = xl ? (mx >> 2) * (G / 8) + mj : bx, nw = (xl ? G / 4 : G) * NWAVES, widx = jb * NWAVES + wave;
    const unsigned char* VQ = (const unsigned char*)(p.ws + WS_VE);
    const unsigned* CI = (const unsigned*)(p.ws + WS_C);
    bf16_t* H1B = (bf16_t*)(p.ws + WS_H1B);
    const int sub = lane & 7, es = lane >> 3;
    const int K = (T - widx + nw - 1) / nw, NB4 = (K + 3) / 4;
    LAS unsigned* RL = (LAS unsigned*)(lds + wave * 4096);
    for (int s = x; s < NVS; s += nx) {
        const unsigned char* VQs = VQ + (size_t)s * 16384 * VSL + 16 * sub;
#define PV_TOK(k_) ((size_t)(widx + nw * ((k_) < K ? (k_) : K - 1)))
#define PV_RQLOAD(blk_) { _Pragma("unroll") for (int j = 0; j < 4; ++j) rq[j] = *(const u32x2*)(CI + PV_TOK(4 * (blk_) + j) * 128 + 2 * lane); }
#define PV_RQSTORE(blk_) { _Pragma("unroll") for (int j = 0; j < 4; ++j) *(LAS u32x2*)(RL + (((blk_) & 1) * 4 + j) * 128 + 2 * lane) = rq[j]; }
#define PV_REC(blkpar_, j_, hf_, i_) RL[((blkpar_) * 4 + (j_)) * 128 + 64 * (hf_) + 8 * (i_) + es]
#define PV_GATHER8(vb, rg_, hf_) { _Pragma("unroll") for (int i = 0; i < 8; ++i) vb[i] = *(const u32x4*)(VQs + (size_t)(rg_[8 * (hf_) + i] & 0x3FFFu) * VSL); }
#define PV_PREP(blkpar_, j_, sl_, k_) { float cf_[16]; float am_ = 0.f; hvs[sl_] = *(const u32x2*)(H1B + PV_TOK(k_) * D + hoff); \
            _Pragma("unroll") for (int i = 0; i < 16; ++i) rg[i] = PV_REC(blkpar_, j_, (i >> 3), (i & 7)); \
            _Pragma("unroll") for (int i = 0; i < 16; ++i) { cf_[i] = __uint_as_float(rg[i] & 0xffff0000u); am_ = fmaxf(am_, fabsf(cf_[i])); } \
            am_ = fmaxf(am_, dpp_mov<0x128>(am_)); am_ = swap16_max(am_); am_ = swap32_max(am_); \
            const float iv_ = am_ > 0.f ? 127.f / am_ : 0.f; csc[sl_] = am_ * (1.f / 127.f); int cs_ = 0; \
            _Pragma("unroll") for (int m = 0; m < 4; ++m) { const int q0 = (int)rintf(cf_[4 * m] * iv_), q1 = (int)rintf(cf_[4 * m + 1] * iv_), q2 = (int)rintf(cf_[4 * m + 2] * iv_), q3 = (int)rintf(cf_[4 * m + 3] * iv_); \
                cqs[sl_][m] = (q0 & 0xFF) | ((q1 & 0xFF) << 8) | ((q2 & 0xFF) << 16) | ((q3 & 0xFF) << 24); cs_ = __builtin_amdgcn_sdot4(cqs[sl_][m], 0x01010101, cs_, false); } \
            float ct_ = (float)cs_; ct_ += dpp_mov<0x128>(ct_); ct_ = swap16_sum(ct_); ct_ = swap32_sum(ct_); cto[sl_] = -8.f * ct_; }
#define PV_T4(r0, r1, r2, r3, w, cqw) { const unsigned x0_ = __builtin_amdgcn_perm(r1[w], r0[w], 0x05010400u), x1_ = __builtin_amdgcn_perm(r1[w], r0[w], 0x07030602u), \
                y0_ = __builtin_amdgcn_perm(r3[w], r2[w], 0x05010400u), y1_ = __builtin_amdgcn_perm(r3[w], r2[w], 0x07030602u); \
            const unsigned t0_ = __builtin_amdgcn_perm(y0_, x0_, 0x05040100u), t1_ = __builtin_amdgcn_perm(y0_, x0_, 0x07060302u), t2_ = __builtin_amdgcn_perm(y1_, x1_, 0x05040100u), t3_ = __builtin_amdgcn_perm(y1_, x1_, 0x07060302u); \
            acci[8 * (w)] = __builtin_amdgcn_sdot4((int)(t0_ & 0x0F0F0F0Fu), cqw, acci[8 * (w)], false); acci[8 * (w) + 1] = __builtin_amdgcn_sdot4((int)(t0_ & 0xF0F0F0F0u), cqw, acci[8 * (w) + 1], false); \
            acci[8 * (w) + 2] = __builtin_amdgcn_sdot4((int)(t1_ & 0x0F0F0F0Fu), cqw, acci[8 * (w) + 2], false); acci[8 * (w) + 3] = __builtin_amdgcn_sdot4((int)(t1_ & 0xF0F0F0F0u), cqw, acci[8 * (w) + 3], false); \
            acci[8 * (w) + 4] = __builtin_amdgcn_sdot4((int)(t2_ & 0x0F0F0F0Fu), cqw, acci[8 * (w) + 4], false); acci[8 * (w) + 5] = __builtin_amdgcn_sdot4((int)(t2_ & 0xF0F0F0F0u), cqw, acci[8 * (w) + 5], false); \
            acci[8 * (w) + 6] = __builtin_amdgcn_sdot4((int)(t3_ & 0x0F0F0F0Fu), cqw, acci[8 * (w) + 6], false); acci[8 * (w) + 7] = __builtin_amdgcn_sdot4((int)(t3_ & 0xF0F0F0F0u), cqw, acci[8 * (w) + 7], false); }
#define PV_ACC8(vb, sl_, hf_) { _Pragma("unroll") for (int w = 0; w < 4; ++w) { PV_T4(vb[0], vb[1], vb[2], vb[3], w, cqs[sl_][2 * (hf_)]) PV_T4(vb[4], vb[5], vb[6], vb[7], w, cqs[sl_][2 * (hf_) + 1]) } }
#define PV_FIN(k_, sl_) { int r16[16], r8[8], r4[4]; \
            { const bool bt = lane & 8; _Pragma("unroll") for (int q = 0; q < 16; ++q) { const int keep = bt ? acci[q + 16] : acci[q], send = bt ? acci[q] : acci[q + 16]; r16[q] = keep + __builtin_amdgcn_update_dpp(0, send, 0x128, 0xF, 0xF, false); } } \
            _Pragma("unroll") for (int q = 0; q < 8; ++q) { int a_ = r16[q], b_ = r16[q + 8]; swap16i_(a_, b_); r8[q] = a_ + b_; } \
            _Pragma("unroll") for (int q = 0; q < 4; ++q) { int a_ = r8[q], b_ = r8[q + 4]; swap32i_(a_, b_); r4[q] = a_ + b_; } \
            _Pragma("unroll") for (int q = 0; q < 32; ++q) acci[q] = 0; \
            if ((k_) < K) { const u32x2 hw = hvs[sl_]; const float sc_ = csc[sl_], sh_ = sc_ * (1.f / 16.f), co_ = cto[sl_]; \
                *(u32x2*)(H1B + (size_t)(widx + nw * (k_)) * D + hoff) = (u32x2){pk2(bflo(hw.x) + ((float)r4[0] + co_) * sc_, bfhi(hw.x) + (float)r4[1] * sh_), pk2(bflo(hw.y) + ((float)r4[2] + co_) * sc_, bfhi(hw.y) + (float)r4[3] * sh_)}; } }
#define PV_STEP(vb, B_, j_, hf_) { PV_ACC8(vb, ((j_) & 3), hf_) if ((hf_) == 1) PV_FIN(4 * (B_) + (j_), ((j_) & 3)) \
            if ((hf_) == 0) PV_PREP((((j_) + 2) < 4) ? ((B_) & 1) : (((B_) + 1) & 1), (((j_) + 2) & 3), (((j_) + 2) & 3), 4 * (B_) + (j_) + 2) \
            PV_GATHER8(vb, rg, hf_) }
        u32x2 rq[4]; u32x4 v0[8], v1[8], v2[8], v3[8]; int acci[32]; int cqs[4][4]; float csc[4], cto[4]; unsigned rg[16]; u32x2 hvs[4];
        const int hoff = s * 256 + 32 * sub + 16 * (es & 1) + 8 * ((es >> 1) & 1) + 4 * (es >> 2);
#pragma unroll
        for (int q = 0; q < 32; ++q) acci[q] = 0;
        PV_RQLOAD(0) PV_RQSTORE(0) PV_RQLOAD(1) PV_RQSTORE(1)
        LDS_WAIT();
        PV_PREP(0, 0, 0, 0) PV_GATHER8(v0, rg, 0) PV_GATHER8(v1, rg, 1)
        PV_PREP(0, 1, 1, 1) PV_GATHER8(v2, rg, 0) PV_GATHER8(v3, rg, 1)
        for (int B = 0; B < NB4; ++B) {
            if (B > 0) { PV_RQSTORE(B + 1) LDS_WAIT(); }
            PV_STEP(v0, B, 0, 0) PV_STEP(v1, B, 0, 1)
            PV_STEP(v2, B, 1, 0) PV_STEP(v3, B, 1, 1)
            PV_RQLOAD(B + 2)
            PV_STEP(v0, B, 2, 0) PV_STEP(v1, B, 2, 1)
            PV_STEP(v2, B, 3, 0) PV_STEP(v3, B, 3, 1)
        }
    }
}
__device__ __forceinline__ void phase_final(const Params& p, int vcu, int G) {
    const int tid = threadIdx.x, lane = tid & 63, wave = __builtin_amdgcn_readfirstlane(tid >> 6);
    const bf16_t* H2B = (const bf16_t*)(p.ws + WS_H1B); float* Y = p.out; const float* fg = p.in[I_FG];
    const int w0 = vcu * NWAVES + wave, WS_ = G * NWAVES;
    const f32x4 g0 = ((const f32x4*)fg)[2 * lane], g1 = ((const f32x4*)fg)[2 * lane + 1], g2 = ((const f32x4*)fg)[128 + 2 * lane], g3 = ((const f32x4*)fg)[128 + 2 * lane + 1];
#define PF_LOAD(dst, t0_) { _Pragma("unroll") for (int u = 0; u < 4; ++u) { const int tok = ((t0_) + u * WS_) < T ? ((t0_) + u * WS_) : w0; \
            dst[u][0] = *(const u32x4*)(H2B + (size_t)tok * D + 8 * lane); dst[u][1] = *(const u32x4*)(H2B + (size_t)tok * D + 512 + 8 * lane); } }
#define PF_PROC(src, t0_) { _Pragma("unroll") for (int u = 0; u < 4; ++u) { const int tok = (t0_) + u * WS_; if (tok < T) { float f[16]; float ss = 0.f; \
            _Pragma("unroll") for (int k = 0; k < 4; ++k) { f[2 * k] = bflo(src[u][0][k]); f[2 * k + 1] = bfhi(src[u][0][k]); f[8 + 2 * k] = bflo(src[u][1][k]); f[8 + 2 * k + 1] = bfhi(src[u][1][k]); } \
            _Pragma("unroll") for (int k = 0; k < 16; ++k) ss += f[k] * f[k]; \
            const float rs = rsqrtf(wave_sum(ss) * (1.f / D) + EPS); f32x4* yr = (f32x4*)(Y + (size_t)tok * D); \
            yr[2 * lane] = (f32x4){f[0], f[1], f[2], f[3]} * rs * g0; yr[2 * lane + 1] = (f32x4){f[4], f[5], f[6], f[7]} * rs * g1; \
            yr[128 + 2 * lane] = (f32x4){f[8], f[9], f[10], f[11]} * rs * g2; yr[128 + 2 * lane + 1] = (f32x4){f[12], f[13], f[14], f[15]} * rs * g3; } } }
    u32x4 va[4][2], vb[4][2];
    PF_LOAD(va, w0)
    for (int t0 = w0; t0 < T; t0 += 8 * WS_) {
        if (t0 + 4 * WS_ < T) PF_LOAD(vb, t0 + 4 * WS_)
        PF_PROC(va, t0)
        if (t0 + 8 * WS_ < T) PF_LOAD(va, t0 + 8 * WS_)
        PF_PROC(vb, t0 + 4 * WS_)
    }
}
#define XB_TMO      128
#define XB_XCNT(j)  (256  + 64 * (j))
#define XB_XSUB(j)  (1280 + 64 * (j))
#define XB_XGEN(j)  (2304 + 64 * (j))
#define XB_TOP      3328
#define XB_TOPGEN   3392
#define XCD_BAR_WORDS 3456
#define XB_SPIN_CAP (1u << 18)

__device__ __forceinline__ unsigned xb_ld(unsigned* p)              { return __hip_atomic_load(p, __ATOMIC_RELAXED, __HIP_MEMORY_SCOPE_AGENT); }
__device__ __forceinline__ unsigned xb_add(unsigned* p, unsigned v) { return __hip_atomic_fetch_add(p, v, __ATOMIC_RELAXED, __HIP_MEMORY_SCOPE_AGENT); }
__device__ __forceinline__ unsigned xb_xcc_id() { return (unsigned)__builtin_amdgcn_s_getreg((3 << 11) | 20) & 0xFu; }
#define XB_SPIN(cond, bar) do { unsigned _sp = 0; while (cond) { __builtin_amdgcn_s_sleep(1); \
    if ((++_sp & 255u) == 0u) { if (xb_ld(&(bar)[XB_TMO])) break; if (_sp > XB_SPIN_CAP) { atomicAdd(&(bar)[XB_TMO], 1u); break; } } } } while (0)

struct XcdBarrier {
    unsigned* bar; unsigned x;
    volatile LAS unsigned* st;
};

__device__ __forceinline__ XcdBarrier xcd_barrier_post(unsigned* bar, volatile LAS unsigned* st) {
    XcdBarrier b; b.bar = bar; b.x = xb_xcc_id(); b.st = st;
    if (threadIdx.x == 0) (void)xb_add(&bar[XB_XCNT(b.x)], 1u);
    return b;
}
__device__ __forceinline__ void xcd_barrier_complete(unsigned* bar, unsigned x, unsigned& nloc, unsigned& nx) {
    const unsigned G = gridDim.x * gridDim.y * gridDim.z;
    unsigned sum, cnt, mine, sp = 0u;
    for (;;) {
        sum = 0u; cnt = 0u; mine = 0u;
#pragma unroll
        for (unsigned j = 0; j < 16; ++j) { const unsigned c = xb_ld(&bar[XB_XCNT(j)]); sum += c; cnt += (c > 0u) ? 1u : 0u; mine = (j == x) ? c : mine; }
        if (sum == G) break;
        __builtin_amdgcn_s_sleep(1);
        if ((++sp & 255u) == 0u) { if (xb_ld(&bar[XB_TMO])) break; if (sp > XB_SPIN_CAP) { atomicAdd(&bar[XB_TMO], 1u); break; } }
    }
    nloc = mine > 0u ? mine : 1u; nx = cnt > 0u ? cnt : 1u;
}

__device__ __forceinline__ void xcd_barrier(const XcdBarrier& b) {
    asm volatile("s_waitcnt vmcnt(0)" ::: "memory");
    __syncthreads();
    if (threadIdx.x == 0) {
        unsigned* bar = b.bar;
        __builtin_amdgcn_s_waitcnt(0);
        unsigned nloc = b.st[0], nx = b.st[1];
        if (nloc == 0u) { xcd_barrier_complete(bar, b.x, nloc, nx); b.st[0] = nloc; b.st[1] = nx; }
        const unsigned old = xb_add(&bar[XB_XSUB(b.x)], 1u);
        const unsigned gen = old / nloc;
        if (old + 1u == (gen + 1u) * nloc) {
            __builtin_amdgcn_fence(__ATOMIC_RELEASE, "agent");
            asm volatile("s_waitcnt vmcnt(0)" ::: "memory");
            const unsigned og = xb_add(&bar[XB_TOP], 1u);
            const unsigned tg = og / nx;
            if (og + 1u == (tg + 1u) * nx) xb_add(&bar[XB_TOPGEN], 1u);
            else XB_SPIN(xb_ld(&bar[XB_TOPGEN]) == tg, bar);
            __builtin_amdgcn_fence(__ATOMIC_ACQUIRE, "agent");
            xb_add(&bar[XB_XGEN(b.x)], 1u);
            asm volatile("s_waitcnt vmcnt(0)" ::: "memory");
        } else {
            XB_SPIN(xb_ld(&bar[XB_XGEN(b.x)]) == gen, bar);
            __builtin_amdgcn_fence(__ATOMIC_ACQUIRE, "agent");
            asm volatile("s_waitcnt vmcnt(0)" ::: "memory");
        }
    }
    __syncthreads();
}

constexpr int N_PHASES = 11;
__global__ void __launch_bounds__(NTHREADS, 2) hymba_fwd(Params p) {
    extern __shared__ __attribute__((aligned(16))) unsigned char lds_raw[];
    LAS unsigned char* lds = (LAS unsigned char*)lds_raw;
    cg::grid_group grid = cg::this_grid();
    const int G = gridDim.x; const int bx = blockIdx.x;
    const int vcu = (G % 8 == 0) ? (bx % 8) * (G / 8) + bx / 8 : bx;
    unsigned char* ws = p.ws;
    const int lo = p.ph_lo, hi = p.ph_hi;
    volatile LAS unsigned* MISC = (volatile LAS unsigned*)(lds + 131072 + 320);
    if (threadIdx.x < 32) MISC[threadIdx.x] = 0u;
    __syncthreads();
    XcdBarrier bar; bar.bar = (unsigned*)ws; bar.x = xb_xcc_id(); bar.st = MISC + 8;
    if (threadIdx.x == 0) { MISC[20] = xb_add(&bar.bar[XB_XCNT(bar.x)], 1u); MISC[21] = bar.x; MISC[22] = 0u; }
#define IN(k) (lo <= (k) && (k) < hi)
#define SEAM(k) do { if ((k) + 1 < hi) { if ((k) == 0) grid.sync(); else xcd_barrier(bar); } } while (0)
    if (IN(0)) { phase_prep(p, lds, vcu, G); SEAM(0); }
    {
        if (threadIdx.x == 0 && lo == 0 && hi > 1 && (G % 8) == 0) { bool ok = true; for (unsigned j = 0; j < 8; ++j) ok = ok && (xb_ld(&bar.bar[XB_XCNT(j)]) == (unsigned)(G / 8)); MISC[22] = ok ? 1u : 0u; }
        __syncthreads();
    }
    const bool xcc_ok = MISC[22] != 0u; const int xcc_x = xcc_ok ? (int)MISC[21] : (bx & 7), xcc_j = xcc_ok ? (int)MISC[20] : (bx >> 3);
    if (IN(1)) {
        { pg8::Gemm g{(const bf16_t*)(ws + WS_XN), (const bf16_t*)(ws + WS_WINT), T, 3584, D}; pg8::StaticOrder S; S.init(T, 3584, G, bx);
          EpiInProj E{(bf16_t*)(ws + WS_PROJ), (const float*)(ws + WS_SM)};
          pg8::gemm_phase<EpiInProj, pg8::StaticOrder, true, true>(lds, g, S, E); }
        { pg8::Gemm g{(const bf16_t*)(ws + WS_WINT) + (size_t)3584 * D, (const bf16_t*)(ws + WS_XN), 512, T, D}; pg8::StaticOrder S; S.init(512, T, G, bx);
          EpiStore E{(bf16_t*)(ws + WS_VT), T};
          pg8::gemm_phase<EpiStore, pg8::StaticOrder, true, true>(lds, g, S, E); }
        SEAM(1);
    }
    if (IN(2)) { phase_hgrn(p, lds, G); }
    if (IN(3)) { phase_attn(p, lds, G); SEAM(3); }
    if (IN(5)) {
        pg8::Gemm g{(const bf16_t*)(ws + WS_XN), (const bf16_t*)(ws + WS_WOT), T, D, D}; pg8::StaticOrder S; S.init(T, D, G, bx);
        EpiOutProj E{p.in[I_X], p.out, (bf16_t*)(ws + WS_H1B), (float*)(ws + WS_SS)};
        pg8::gemm_phase<EpiOutProj, pg8::StaticOrder, true, true>(lds, g, S, E);
        SEAM(5);
    }
    if (IN(6)) {
        phase_hquant(p, vcu, G);
        pg8::Gemm g{(const bf16_t*)(ws + WS_H1B), (const bf16_t*)(ws + WS_WQT), T, 2048, D}; pg8::StaticOrder S; S.init(T, 2048, G, bx);
        EpiQ E{(bf16_t*)(ws + WS_QP), (const float*)(ws + WS_SS), (float*)(ws + WS_GATE)};
        pg8::gemm_phase<EpiQ, pg8::StaticOrder, true, true>(lds, g, S, E);
        SEAM(6);
    }
    if (IN(7)) { phase_topk(p, lds, vcu, G); SEAM(7); }
    if (IN(8)) { phase_peer_u(p, lds, G, xcc_x, xcc_j); SEAM(8); }
    if (IN(9)) { phase_peer_v(p, lds, G, xcc_x, xcc_j); SEAM(9); }
    if (IN(10)) { phase_final(p, vcu, G); }
#undef IN
#undef SEAM
}

extern "C" void kernel_launch(void* const* d_in, const int* in_sizes, int n_in, void* d_out, int out_size, void* d_ws, size_t ws_size, hipStream_t stream) {
    static int grid = 0;
    if (grid == 0) {
        if (n_in != 19 || out_size != T * D || ws_size < WS_END) { fprintf(stderr, "kernel_launch: unexpected sizes (n_in %d out %d ws %zu)\n", n_in, out_size, ws_size); grid = -1; return; }
        int dev = 0, cus = 0, per_cu = 0;
        hipGetDevice(&dev); hipDeviceGetAttribute(&cus, hipDeviceAttributeMultiprocessorCount, dev);
        hipFuncSetAttribute((const void*)hymba_fwd, hipFuncAttributeMaxDynamicSharedMemorySize, LDS_BYTES);
        hipOccupancyMaxActiveBlocksPerMultiprocessor(&per_cu, (const void*)hymba_fwd, NTHREADS, LDS_BYTES);
        (void)hipGetLastError();
        if (per_cu < 1) { fprintf(stderr, "kernel_launch: occupancy query says %d blocks/CU\n", per_cu); per_cu = 1; }
        grid = cus;
    }
    if (grid < 0) return;
    if (hipMemsetAsync(d_ws, 0, 65536, stream) != hipSuccess) { fprintf(stderr, "kernel_launch: memset of the barrier words failed\n"); return; }
    Params p{};
    for (int i = 0; i < 19; ++i) p.in[i] = (const float*)d_in[i];
    p.out = (float*)d_out; p.ws = (unsigned char*)d_ws;
#if MK_ONE_LAUNCH
    p.ph_lo = 0; p.ph_hi = N_PHASES;
    void* args[] = {&p};
    hipError_t e = hipLaunchCooperativeKernel((const void*)hymba_fwd, dim3(grid), dim3(NTHREADS), args, LDS_BYTES, stream);
    if (e != hipSuccess) fprintf(stderr, "cooperative launch failed: %s (grid %d)\n", hipGetErrorString(e), grid);
#else
    for (int ph = 0; ph < N_PHASES; ++ph) { p.ph_lo = ph; p.ph_hi = ph + 1; hipLaunchKernelGGL(hymba_fwd, dim3(grid), dim3(NTHREADS), LDS_BYTES, stream, p); }
#endif
}
```

```cpp
#include <hip/hip_runtime.h>
#include <hip/hip_bf16.h>
#include <hip/hip_cooperative_groups.h>
#include <cstdio>
#include <cstdint>
#include <cmath>
namespace cg = cooperative_groups;
#ifndef MK_ONE_LAUNCH
#define MK_ONE_LAUNCH 1
#endif
namespace pg8 {
#define PG8_LAS __attribute__((address_space(3)))
typedef unsigned short bf16_t;
typedef short bf16x8 __attribute__((ext_vector_type(8)));
typedef float f32x4 __attribute__((ext_vector_type(4)));
typedef unsigned u32x4 __attribute__((ext_vector_type(4)));
constexpr int BM = 256, BK = 64, HALF = 128, HTB = HALF * BK * 2  , STAGE_BYTES = 8 * HTB, NXCD = 8, WGM = 8;

__host__ __device__ __forceinline__ int lds_byte(int r, int c) { const int st = (r >> 4) * 2 + (c >> 5), rr = r & 15, cc = c & 31, ob = rr * 64 + cc * 2; return st * 1024 + (ob ^ (((ob >> 9) & 1) << 5)); }
__host__ __device__ __forceinline__ void stage_rc(int b, int& R, int& C) { const int st = b / 1024, sb = b % 1024, swz = sb ^ (((sb >> 9) & 1) << 5); R = (st >> 1) * 16 + swz / 64; C = (st & 1) * 32 + (swz % 64) / 2; }
__host__ __device__ __forceinline__ int perm32(int rho) { const int n = rho >> 4, i = rho & 15; return 8 * (i >> 2) + 4 * n + (i & 3); }

struct Unit { int pm, pn; };
struct Gemm { const bf16_t* A; const bf16_t* Bt; int M, N, K; };

struct StaticOrder {
    int nM, nN, nwg, G, c;
    __host__ __device__ void init(int M, int N, int G_, int c_) { nM = M / BM; nN = N / BM; nwg = nM * nN; G = G_; c = c_; }
    __host__ __device__ bool next(int i, Unit& u) const {
        const long L = (long)i * G + c; if (L >= nwg) return false;
        int wgid = (int)L; { const int q = nwg / NXCD, r = nwg % NXCD, xcd = wgid % NXCD, off = wgid / NXCD; wgid = (xcd < r ? xcd * (q + 1) : r * (q + 1) + (xcd - r) * q) + off; }
        const int nig = WGM * nN, gid = wgid / nig, fm = gid * WGM, gsz = (nM - fm) < WGM ? (nM - fm) : WGM;
        u.pm = fm + ((wgid % nig) % gsz); u.pn = (wgid % nig) / gsz; return true;
    }
    __device__ __forceinline__ void a_ready(const Unit&) const {}
    __device__ __forceinline__ void done(const Unit&) const {}
};

__device__ __forceinline__ unsigned cvt_pk_bf16(float lo, float hi) { unsigned r; asm volatile("v_cvt_pk_bf16_f32 %0, %1, %2" : "=v"(r) : "v"(lo), "v"(hi)); return r; }
typedef float f32x2 __attribute__((ext_vector_type(2)));
template <class Epi, class Sched, bool ALIGN_EPI = false, bool SP2 = false>
__device__ __forceinline__ void gemm_phase(PG8_LAS unsigned char* lds, const Gemm g, const Sched& S, const Epi& E) {
    const int tid = threadIdx.x, wid = __builtin_amdgcn_readfirstlane(tid >> 6), lane = tid & 63, wr = wid >> 2, wc = wid & 3, fr = lane & 15, fq = lane >> 4;
    const int K = g.K, nt = K / BK;
    unsigned voffA[2], voffB[2];
#pragma unroll
    for (int i = 0; i < 2; ++i) { int R, C; stage_rc(tid * 16 + i * 8192, R, C); const int Rb = Epi::PERM ? ((R & ~31) + perm32(R & 31)) : R;
        voffA[i] = (unsigned)(R * K + C) * 2u; voffB[i] = (unsigned)(Rb * K + C) * 2u; }
    const size_t kstep = (size_t)(BK * 2);
    const size_t hstep = (size_t)HALF * K * 2;
    const size_t tstep = 2 * hstep;
    const unsigned ldsw = (unsigned)wid * 1024u;
    const int aoff = lds_byte(wr * 64 + fr, fq * 8), boff = lds_byte(wc * 32 + fr, fq * 8);
#define PG8_SA(b, h) (((b) * 2 + (h)) * HTB)
#define PG8_SB(b, h) ((4 + (b) * 2 + (h)) * HTB)
#define PG8_STAGE(bufoff, gbase, voff) do { _Pragma("unroll") for (int _i = 0; _i < 2; ++_i) \
        __builtin_amdgcn_global_load_lds((const unsigned*)((const char*)(gbase) + (voff)[_i]), (PG8_LAS unsigned*)(lds + (bufoff) + ldsw + _i * 8192), 16, 0, 0); } while (0)
#define PG8_LDA(dst, b, h) do { _Pragma("unroll") for (int m = 0; m < 4; ++m) _Pragma("unroll") for (int k = 0; k < 2; ++k) dst[m][k] = *(const PG8_LAS bf16x8*)(lds + PG8_SA(b, h) + aoff + m * 2048 + k * 1024); } while (0)
#define PG8_LDB(dst, b, h) do { _Pragma("unroll") for (int n = 0; n < 2; ++n) _Pragma("unroll") for (int k = 0; k < 2; ++k) dst[n][k] = *(const PG8_LAS bf16x8*)(lds + PG8_SB(b, h) + boff + n * 2048 + k * 1024); } while (0)
#define PG8_MMA(ai, bj, At, Bt) do { __builtin_amdgcn_s_setprio(1); _Pragma("unroll") for (int m = 0; m < 4; ++m) _Pragma("unroll") for (int n = 0; n < 2; ++n) _Pragma("unroll") for (int k = 0; k < 2; ++k) \
        acc[ai][bj][m][n] = __builtin_amdgcn_mfma_f32_16x16x32_bf16(Bt[n][k], At[m][k], acc[ai][bj][m][n], 0, 0, 0); __builtin_amdgcn_s_setprio(0); } while (0)
#define PG8_WAIT_V(n) asm volatile("s_waitcnt vmcnt(" #n ")" ::: "memory")
#define PG8_WAIT_L(n) asm volatile("s_waitcnt lgkmcnt(" #n ")" ::: "memory")
#define PG8_BAR __builtin_amdgcn_s_barrier()
#define PG8_SCHED __builtin_amdgcn_sched_barrier(0)
    Unit cur, nxt; int ui = 0;
    if (!S.next(0, cur)) return;
    f32x4 acc[2][2][4][2];
#pragma unroll
    for (int a = 0; a < 2; ++a)
#pragma unroll
        for (int b = 0; b < 2; ++b)
#pragma unroll
            for (int m = 0; m < 4; ++m)
#pragma unroll
                for (int n = 0; n < 2; ++n) acc[a][b][m][n] = (f32x4){0.f, 0.f, 0.f, 0.f};
    bf16x8 At[4][2], B0[2][2], B1[2][2];
    const char* cA = (const char*)g.A + (size_t)cur.pm * tstep; const char* cB = (const char*)g.Bt + (size_t)cur.pn * tstep;
    S.a_ready(cur);
    if constexpr (SP2) {
        PG8_STAGE(PG8_SB(0, 0), cB, voffB); PG8_STAGE(PG8_SB(0, 1), cB + hstep, voffB); PG8_STAGE(PG8_SA(0, 0), cA, voffA); PG8_STAGE(PG8_SA(0, 1), cA + hstep, voffA);
        if (wr == 1) PG8_BAR;
        PG8_WAIT_V(2); PG8_BAR;
        PG8_STAGE(PG8_SB(1, 0), cB + kstep, voffB); PG8_STAGE(PG8_SA(1, 0), cA + kstep, voffA); PG8_STAGE(PG8_SB(1, 1), cB + hstep + kstep, voffB);
        PG8_WAIT_V(6); PG8_BAR;
    } else {
        PG8_STAGE(PG8_SB(0, 0), cB, voffB); PG8_STAGE(PG8_SA(0, 0), cA, voffA); PG8_STAGE(PG8_SB(0, 1), cB + hstep, voffB); PG8_STAGE(PG8_SA(0, 1), cA + hstep, voffA);
        if (wr == 1) PG8_BAR;
        PG8_WAIT_V(4); PG8_BAR;
        PG8_STAGE(PG8_SB(1, 0), cB + kstep, voffB); PG8_STAGE(PG8_SA(1, 0), cA + kstep, voffA); PG8_STAGE(PG8_SB(1, 1), cB + hstep + kstep, voffB);
        PG8_WAIT_V(6); PG8_BAR;
    }
    for (;;) {
        const bool has_next = S.next(ui + 1, nxt);
        const char* nA = has_next ? (const char*)g.A + (size_t)nxt.pm * tstep : cA; const char* nB = has_next ? (const char*)g.Bt + (size_t)nxt.pn * tstep : cB;
        for (int t = 0; t < nt; t += 2) {
            const bool last = (t == nt - 2);
            const char* a1 = cA + (size_t)(t + 1) * kstep;
            const char* a2 = last ? nA : cA + (size_t)(t + 2) * kstep; const char* b2 = last ? nB : cB + (size_t)(t + 2) * kstep;
            const char* a3 = a2 + kstep; const char* b3 = b2 + kstep;
            if (last && has_next) S.a_ready(nxt);
            if constexpr (SP2) {
            PG8_LDB(B0, 0, 0); PG8_LDB(B1, 0, 1); PG8_SCHED; PG8_LDA(At, 0, 0); PG8_STAGE(PG8_SA(1, 1), a1 + hstep, voffA);
            PG8_WAIT_V(8); PG8_WAIT_L(0); PG8_BAR; PG8_MMA(0, 0, At, B0); PG8_MMA(0, 1, At, B1); PG8_BAR; PG8_SCHED;
            PG8_LDA(At, 0, 1); PG8_STAGE(PG8_SB(0, 0), b2, voffB); PG8_STAGE(PG8_SB(0, 1), b2 + hstep, voffB); PG8_STAGE(PG8_SA(0, 0), a2, voffA);
            PG8_WAIT_V(8); PG8_WAIT_L(0); PG8_BAR; PG8_MMA(1, 0, At, B0); PG8_MMA(1, 1, At, B1); PG8_BAR; PG8_SCHED;
            PG8_LDB(B0, 1, 0); PG8_LDB(B1, 1, 1); PG8_SCHED; PG8_LDA(At, 1, 0); PG8_STAGE(PG8_SA(0, 1), a2 + hstep, voffA);
            PG8_WAIT_V(8); PG8_WAIT_L(0); PG8_BAR; PG8_MMA(0, 0, At, B0); PG8_MMA(0, 1, At, B1); PG8_BAR; PG8_SCHED;
            PG8_LDA(At, 1, 1); PG8_STAGE(PG8_SB(1, 0), b3, voffB); PG8_STAGE(PG8_SB(1, 1), b3 + hstep, voffB); PG8_STAGE(PG8_SA(1, 0), a3, voffA);
            PG8_WAIT_V(8); PG8_WAIT_L(0); PG8_BAR; PG8_MMA(1, 0, At, B0); PG8_MMA(1, 1, At, B1); PG8_BAR; PG8_SCHED;
            } else {
            PG8_LDB(B0, 0, 0); PG8_SCHED; PG8_LDA(At, 0, 0); PG8_STAGE(PG8_SA(1, 1), a1 + hstep, voffA);
            PG8_WAIT_L(8); PG8_BAR; PG8_WAIT_L(0); PG8_MMA(0, 0, At, B0); PG8_BAR; PG8_SCHED;
            PG8_LDB(B1, 0, 1); PG8_STAGE(PG8_SB(0, 0), b2, voffB);
            PG8_BAR; PG8_WAIT_L(0); PG8_MMA(0, 1, At, B1); PG8_BAR;
            PG8_LDA(At, 0, 1); PG8_STAGE(PG8_SA(0, 0), a2, voffA);
            PG8_BAR; PG8_WAIT_L(0); PG8_MMA(1, 0, At, B0); PG8_BAR; PG8_SCHED;
            PG8_STAGE(PG8_SB(0, 1), b2 + hstep, voffB);
            PG8_WAIT_V(6); PG8_BAR; PG8_MMA(1, 1, At, B1); PG8_BAR;
            PG8_LDB(B0, 1, 0); PG8_SCHED; PG8_LDA(At, 1, 0); PG8_STAGE(PG8_SA(0, 1), a2 + hstep, voffA);
            PG8_WAIT_L(8); PG8_BAR; PG8_WAIT_L(0); PG8_MMA(0, 0, At, B0); PG8_BAR; PG8_SCHED;
            PG8_LDB(B1, 1, 1); PG8_STAGE(PG8_SB(1, 0), b3, voffB);
            PG8_BAR; PG8_WAIT_L(0); PG8_MMA(0, 1, At, B1); PG8_BAR;
            PG8_LDA(At, 1, 1); PG8_STAGE(PG8_SA(1, 0), a3, voffA);
            PG8_BAR; PG8_WAIT_L(0); PG8_MMA(1, 0, At, B0); PG8_BAR; PG8_SCHED;
            PG8_STAGE(PG8_SB(1, 1), b3 + hstep, voffB);
            PG8_WAIT_V(6); PG8_BAR; PG8_MMA(1, 1, At, B1); PG8_BAR;
            }
        }
        if constexpr (ALIGN_EPI) { if (wr == 0) PG8_BAR; }
        if constexpr (!Epi::AFTER_DRAIN) { E(acc, cur, wr, wc, fr, fq); S.done(cur); }
        if (!has_next) break;
#pragma unroll
        for (int a = 0; a < 2; ++a)
#pragma unroll
            for (int b = 0; b < 2; ++b)
#pragma unroll
                for (int m = 0; m < 4; ++m)
#pragma unroll
                    for (int n = 0; n < 2; ++n) acc[a][b][m][n] = (f32x4){0.f, 0.f, 0.f, 0.f};
        cur = nxt; cA = nA; cB = nB; ++ui;
        if constexpr (ALIGN_EPI) { if (wr == 1) PG8_BAR; }
    }
    PG8_WAIT_V(0);
    if constexpr (!ALIGN_EPI) { if (wr == 0) PG8_BAR; }
    PG8_BAR;
    if constexpr (Epi::AFTER_DRAIN) { E.fused(acc, cur, wr, wc, fr, fq, lds, wid, lane); S.done(cur); }
#undef PG8_SA
#undef PG8_SB
#undef PG8_STAGE
#undef PG8_LDA
#undef PG8_LDB
#undef PG8_MMA
#undef PG8_WAIT_V
#undef PG8_WAIT_L
#undef PG8_BAR
#undef PG8_SCHED
}
}

#define LAS __attribute__((address_space(3)))
typedef unsigned short bf16_t;
typedef short bf16x8 __attribute__((ext_vector_type(8)));
typedef short bf16x4 __attribute__((ext_vector_type(4)));
typedef float f32x4 __attribute__((ext_vector_type(4)));
typedef float f32x16 __attribute__((ext_vector_type(16)));
typedef unsigned u32x4 __attribute__((ext_vector_type(4)));
typedef unsigned u32x2 __attribute__((ext_vector_type(2)));
typedef __bf16 bf16x2_t __attribute__((ext_vector_type(2)));

constexpr int NB = 16, SEQ = 2048, T = NB * SEQ, D = 1024;
constexpr int PP = 4608;
constexpr int C_Q = 0, C_KF = 512, C_LFF = 1024, C_KB = 1536, C_LFB = 2048, C_V = 2560, C_G = 3072, C_DQ = 3584, C_DK = 4096;
constexpr float EPS = 1e-6f;
constexpr float LOG2E = 1.4426950408889634f;
constexpr int NWAVES = 8, NTHREADS = 512;
constexpr int NGRP = 4, GRP_SHIFT = 12, GRP_SIZE = 4096, VSL = 128, NVS = 4;
constexpr int LDS_BYTES = 147456;

constexpr size_t MiB = (size_t)1 << 20;
constexpr size_t WS_SM = 64 * 1024;
constexpr size_t WS_WINT = 2 * MiB, WS_WOT = 10 * MiB, WS_WQT = 12 * MiB, WS_KEYS = 16 * MiB;
constexpr size_t WS_UT = 32 * MiB, WS_USC = 48 * MiB, WS_VSC = 49 * MiB, WS_VE = 64 * MiB, WS_XN = 96 * MiB, WS_PROJ = 160 * MiB, WS_VT = 448 * MiB, WS_END = 480 * MiB;
constexpr size_t WS_H1B = 160 * MiB, WS_QP = 224 * MiB, WS_IDX = 360 * MiB, WS_GATE = 376 * MiB, WS_SS = 392 * MiB, WS_C = 394 * MiB;
constexpr int QPS = 2048 + 64;
constexpr size_t WS_US8 = 48 * MiB + 131072;
constexpr size_t WS_H1Q = 96 * MiB, WS_HSC = 128 * MiB;
constexpr int SM_LBF = 0, SM_LBB = 512, SM_LAM = 1024, SM_BT = 2048, BT_STRIDE = 260;

struct Params { const float* in[19]; float* out; unsigned char* ws; int ph_lo, ph_hi; };
enum { I_X = 0, I_G1, I_WIN, I_LBF, I_LBB, I_HOG, I_LQ1, I_LK1, I_LQ2, I_LK2, I_DOG, I_RB, I_WOUT, I_G2, I_WQ, I_KEYS, I_U, I_V, I_FG };

#define LDS_WAIT() asm volatile("s_waitcnt lgkmcnt(0)" ::: "memory")
__device__ __forceinline__ unsigned f2bf(float f) { unsigned u = __builtin_bit_cast(unsigned, f); return (u + 0x7fffu + ((u >> 16) & 1u)) >> 16; }
typedef float f32x2v_ __attribute__((ext_vector_type(2)));
__device__ __forceinline__ unsigned pk2(float lo, float hi) { const f32x2v_ v = {lo, hi}; return __builtin_bit_cast(unsigned, __builtin_convertvector(v, bf16x2_t)); }
__device__ __forceinline__ float bflo(unsigned w) { return __uint_as_float(w << 16); }
__device__ __forceinline__ float bfhi(unsigned w) { return __uint_as_float(w & 0xffff0000u); }
template <int CTRL> __device__ __forceinline__ float dpp_mov(float v) { return __builtin_bit_cast(float, __builtin_amdgcn_update_dpp(0, __builtin_bit_cast(int, v), CTRL, 0xF, 0xF, false)); }
__device__ __forceinline__ void swap16_(float& a, float& b) { asm volatile("s_nop 1\n\tv_permlane16_swap_b32 %0, %1\n\ts_nop 1" : "+v"(a), "+v"(b)); }
__device__ __forceinline__ void swap32_(float& a, float& b) { asm volatile("s_nop 1\n\tv_permlane32_swap_b32 %0, %1\n\ts_nop 1" : "+v"(a), "+v"(b)); }
__device__ __forceinline__ void swap16i_(int& a, int& b) { asm volatile("s_nop 1\n\tv_permlane16_swap_b32 %0, %1\n\ts_nop 1" : "+v"(a), "+v"(b)); }
__device__ __forceinline__ void swap32i_(int& a, int& b) { asm volatile("s_nop 1\n\tv_permlane32_swap_b32 %0, %1\n\ts_nop 1" : "+v"(a), "+v"(b)); }
__device__ __forceinline__ float swap16_sum(float v) { float a = v, b = v; swap16_(a, b); return a + b; }
__device__ __forceinline__ float swap32_sum(float v) { float a = v, b = v; swap32_(a, b); return a + b; }
__device__ __forceinline__ float swap16_max(float v) { float a = v, b = v; swap16_(a, b); return fmaxf(a, b); }
__device__ __forceinline__ float swap32_max(float v) { float a = v, b = v; swap32_(a, b); return fmaxf(a, b); }
__device__ __forceinline__ float xchg16(float v, int lane) { float a = v, b = v; swap16_(a, b); return (lane & 16) ? a : b; }
__device__ __forceinline__ float xchg32(float v, int lane) { float a = v, b = v; swap32_(a, b); return (lane & 32) ? a : b; }
__device__ __forceinline__ float wave_sum(float v) {
    v += dpp_mov<0xB1>(v); v += dpp_mov<0x4E>(v); v += dpp_mov<0x141>(v); v += dpp_mov<0x140>(v);
    return swap32_sum(swap16_sum(v));
}
__device__ __forceinline__ float wave_max(float v) {
    v = fmaxf(v, dpp_mov<0xB1>(v)); v = fmaxf(v, dpp_mov<0x4E>(v)); v = fmaxf(v, dpp_mov<0x141>(v)); v = fmaxf(v, dpp_mov<0x140>(v));
    return swap32_max(swap16_max(v));
}
__device__ __forceinline__ float sigmoidf_(float z) { return __builtin_amdgcn_rcpf(1.0f + __expf(-z)); }

__device__ __forceinline__ void p0_transpose_item(const float* W, int K, int N, bf16_t* WT, const float* kscale, LAS float* scr, int item, int lane) {
    const int nblk = N / 32, kb = item / nblk, nb = item % nblk, k0 = 64 * kb, n0 = 32 * nb;
#pragma unroll 8
    for (int i = 0; i < 32; ++i) { const int kk = 2 * i + (lane >> 5); float w = W[(size_t)(k0 + kk) * N + n0 + (lane & 31)]; if (kscale) w *= kscale[k0 + kk]; scr[kk * 33 + (lane & 31)] = w; }
    LDS_WAIT(); asm volatile("" ::: "memory");
    const int c = lane & 7;
#pragma unroll
    for (int j = 0; j < 4; ++j) { const int n = (lane >> 3) + 8 * j; const LAS float* s = scr + (8 * c) * 33 + n;
        u32x4 o; o.x = pk2(s[0 * 33], s[1 * 33]); o.y = pk2(s[2 * 33], s[3 * 33]); o.z = pk2(s[4 * 33], s[5 * 33]); o.w = pk2(s[6 * 33], s[7 * 33]);
        *(u32x4*)(WT + (size_t)(n0 + n) * K + k0 + 8 * c) = o; }
    LDS_WAIT(); asm volatile("" ::: "memory");
}
__device__ __forceinline__ int t5_bucket(int rel) {
    const int n = rel < 0 ? -rel : rel;
    const int v = n < 8 ? n : n < 12 ? 8 : n < 16 ? 9 : n < 23 ? 10 : n < 32 ? 11 : n < 46 ? 12 : n < 64 ? 13 : n < 91 ? 14 : 15;
    return (rel > 0 ? 16 : 0) + v;
}
__device__ __forceinline__ void phase_prep(const Params& p, LAS unsigned char* lds, int vcu, int G) {
    const int tid = threadIdx.x, lane = tid & 63, wave = __builtin_amdgcn_readfirstlane(tid >> 6);
    unsigned char* ws = p.ws;
    LAS float* scr = (LAS float*)(lds + wave * 16384);
    const int gw = vcu * NWAVES + wave, NGW = G * NWAVES;
    constexpr int I_IN = (D / 64) * (4096 / 32), I_OUT = (D / 64) * (D / 32), I_QW = (D / 64) * (2048 / 32);
    for (int it = gw; it < I_IN + I_OUT + I_QW; it += NGW) {
        int r = it;
        if (r < I_IN) { p0_transpose_item(p.in[I_WIN], D, 4096, (bf16_t*)(ws + WS_WINT), nullptr, scr, r, lane); continue; } r -= I_IN;
        if (r < I_OUT) { p0_transpose_item(p.in[I_WOUT], D, D, (bf16_t*)(ws + WS_WOT), nullptr, scr, r, lane); continue; } r -= I_OUT;
        p0_transpose_item(p.in[I_WQ], D, 2048, (bf16_t*)(ws + WS_WQT), p.in[I_G2], scr, r, lane);
    }
    for (int i = blockIdx.x * NTHREADS + tid; i < 8 * 2 * 128 * 128 / 4; i += G * NTHREADS) {
        const f32x4 v = ((const f32x4*)p.in[I_KEYS])[i];
        ((u32x2*)(ws + WS_KEYS))[i] = (u32x2){pk2(v.x, v.y), pk2(v.z, v.w)};
    }
#define PX_LOAD(dst, m0_) { _Pragma("unroll") for (int u = 0; u < 4; ++u) { const int m = ((m0_) + u * NGW) < T ? ((m0_) + u * NGW) : gw; const f32x4* xr = (const f32x4*)(p.in[I_X] + (size_t)m * D) + lane; \
            _Pragma("unroll") for (int j = 0; j < 4; ++j) dst[u][j] = xr[64 * j]; } }
#define PX_PROC(src, m0_) { _Pragma("unroll") for (int u = 0; u < 4; ++u) { const int m = (m0_) + u * NGW; if (m < T) { float ssq = 0.f; \
            _Pragma("unroll") for (int j = 0; j < 4; ++j) ssq += (src[u][j].x * src[u][j].x + src[u][j].y * src[u][j].y) + (src[u][j].z * src[u][j].z + src[u][j].w * src[u][j].w); \
            const float rs = rsqrtf(wave_sum(ssq) * (1.f / D) + EPS); unsigned long long* o8 = (unsigned long long*)((bf16_t*)(ws + WS_XN) + (size_t)m * D) + lane; \
            _Pragma("unroll") for (int j = 0; j < 4; ++j) { const f32x4 y = src[u][j] * rs * ((const f32x4*)p.in[I_G1])[64 * j + lane]; o8[64 * j] = (unsigned long long)pk2(y.x, y.y) | ((unsigned long long)pk2(y.z, y.w) << 32); } } } }
    {
        f32x4 va[4][4], vb[4][4];
        PX_LOAD(va, gw)
        for (int m0 = gw; m0 < T; m0 += 8 * NGW) {
            if (m0 + 4 * NGW < T) PX_LOAD(vb, m0 + 4 * NGW)
            PX_PROC(va, m0)
            if (m0 + 8 * NGW < T) PX_LOAD(va, m0 + 8 * NGW)
            PX_PROC(vb, m0 + 4 * NGW)
        }
    }
    if (blockIdx.x == 0) {
        float* sm = (float*)(ws + WS_SM);
        { const float* a = p.in[I_LBF]; sm[SM_LBF + tid] = 1.f / (1.f + __expf(a[512 + tid] - a[tid])); }
        { const float* a = p.in[I_LBB]; sm[SM_LBB + tid] = 1.f / (1.f + __expf(a[512 + tid] - a[tid])); }
        if (tid < 64) {
            float a = p.in[I_LQ1][tid] * p.in[I_LK1][tid], b = p.in[I_LQ2][tid] * p.in[I_LK2][tid];
            a = wave_sum(a); b = wave_sum(b);
            if (tid == 0) sm[SM_LAM] = __expf(a) - __expf(b) + 0.2f;
        }
        for (int i = tid; i < 4 * 257; i += NTHREADS) { const int h = i / 257, r = i % 257; sm[SM_BT + h * BT_STRIDE + r] = p.in[I_RB][t5_bucket(r - 128) * 4 + h] * LOG2E; }
    }
}

__device__ __forceinline__ float silu_(float x) { return x * __builtin_amdgcn_rcpf(1.0f + __expf(-x)); }
struct EpiInProj {
    static constexpr bool PERM = true, AFTER_DRAIN = false;
    bf16_t* P; const float* sm;
    __device__ __forceinline__ void st8(bf16_t* dst, const float (&y)[8]) const { u32x4 w; w.x = pk2(y[0], y[1]); w.y = pk2(y[2], y[3]); w.z = pk2(y[4], y[5]); w.w = pk2(y[6], y[7]); *(u32x4*)dst = w; }
    __device__ __forceinline__ void operator()(const f32x4 (&acc)[2][2][4][2], const pg8::Unit& u, int wr, int wc, int fr, int fq) const {
        const int seg = u.pn >> 1;
        const int row0 = u.pm * 256 + wr * 64 + fr;
        const int cs0 = (u.pn & 1) * 256 + wc * 32 + 8 * fq;
#pragma unroll
        for (int bj = 0; bj < 2; ++bj) {
            const int cs = cs0 + bj * 128;
            float lb[8] = {0.f, 0.f, 0.f, 0.f, 0.f, 0.f, 0.f, 0.f};
            if (seg == 1 || seg == 2) {
#pragma unroll
                for (int i = 0; i < 8; ++i) lb[i] = sm[(seg == 1 ? SM_LBF : SM_LBB) + cs + i];
            }
#pragma unroll
            for (int ai = 0; ai < 2; ++ai)
#pragma unroll
                for (int m = 0; m < 4; ++m) {
                    const size_t row = (size_t)(row0 + ai * 128 + m * 16);
                    bf16_t* rp = P + row * PP + cs;
                    float x[8];
#pragma unroll
                    for (int i = 0; i < 4; ++i) { x[i] = acc[ai][bj][m][0][i]; x[4 + i] = acc[ai][bj][m][1][i]; }
                    float y[8];
                    if (seg == 0 || seg == 4) {
#pragma unroll
                        for (int i = 0; i < 8; ++i) y[i] = silu_(x[i]);
                        st8(rp + (seg == 0 ? C_Q : C_G), y);
                    } else if (seg == 1 || seg == 2) {
                        float lf[8];
#pragma unroll
                        for (int i = 0; i < 8; ++i) { const float s = sigmoidf_(x[i]); const float k = (1.f - lb[i]) * (1.f - s); y[i] = k; lf[i] = __logf(1.f - k); }
                        st8(rp + (seg == 1 ? C_KF : C_KB), y);
                        st8(rp + (seg == 1 ? C_LFF : C_LFB), lf);
                    } else if (seg == 3) {
                        st8(rp + C_V, x);
                    } else if (seg == 5) {
#pragma unroll
                        for (int i = 0; i < 8; ++i) y[i] = x[i] * (0.125f * LOG2E);
                        st8(rp + C_DQ, y);
                    } else {
                        st8(rp + C_DK, x);
                    }
                }
        }
    }
};
struct EpiStore {
    static constexpr bool PERM = true, AFTER_DRAIN = false;
    bf16_t* O; int ldc;
    __device__ __forceinline__ void operator()(const f32x4 (&acc)[2][2][4][2], const pg8::Unit& u, int wr, int wc, int fr, int fq) const {
        const int row0 = u.pm * 256 + wr * 64 + fr, col0 = u.pn * 256 + wc * 32 + 8 * fq;
#pragma unroll
        for (int ai = 0; ai < 2; ++ai)
#pragma unroll
            for (int m = 0; m < 4; ++m)
#pragma unroll
                for (int bj = 0; bj < 2; ++bj) {
                    const f32x4 a = acc[ai][bj][m][0], b = acc[ai][bj][m][1];
                    u32x4 w; w.x = pk2(a[0], a[1]); w.y = pk2(a[2], a[3]); w.z = pk2(b[0], b[1]); w.w = pk2(b[2], b[3]);
                    *(u32x4*)(O + (size_t)(row0 + ai * 128 + m * 16) * ldc + col0 + bj * 128) = w;
                }
    }
};
struct EpiOutProj {
    static constexpr bool PERM = true, AFTER_DRAIN = false;
    const float* x; float* H1; bf16_t* H1B; float* SS;
    __device__ __forceinline__ void operator()(const f32x4 (&acc)[2][2][4][2], const pg8::Unit& u, int wr, int wc, int fr, int fq) const {
        const int row0 = u.pm * 256 + wr * 64 + fr, col0 = u.pn * 256 + wc * 32 + 8 * fq;
#pragma unroll
        for (int ai = 0; ai < 2; ++ai)
#pragma unroll
            for (int m = 0; m < 4; ++m) {
                const size_t row = (size_t)(row0 + ai * 128 + m * 16);
                float ss = 0.f;
#pragma unroll
                for (int bj = 0; bj < 2; ++bj) {
                    const size_t off = row * D + col0 + bj * 128;
                    const f32x4 a = *(const f32x4*)(x + off) + acc[ai][bj][m][0], b = *(const f32x4*)(x + off + 4) + acc[ai][bj][m][1];
                    u32x4 w; w.x = pk2(a[0], a[1]); w.y = pk2(a[2], a[3]); w.z = pk2(b[0], b[1]); w.w = pk2(b[2], b[3]);
                    *(u32x4*)(H1B + off) = w;
                    ss += (a[0] * a[0] + a[1] * a[1]) + (a[2] * a[2] + a[3] * a[3]) + (b[0] * b[0] + b[1] * b[1]) + (b[2] * b[2] + b[3] * b[3]);
                }
                ss += __shfl_xor(ss, 16); ss += __shfl_xor(ss, 32);
                if (fq == 0) SS[row * 16 + u.pn * 4 + wc] = ss;
            }
    }
};
__device__ __forceinline__ float row_rstd(const float* SS, size_t row) {
    const f32x4* s = (const f32x4*)(SS + row * 16);
    const f32x4 a = s[0], b = s[1], c = s[2], d = s[3];
    const float t = ((a[0] + a[1]) + (a[2] + a[3])) + ((b[0] + b[1]) + (b[2] + b[3])) + ((c[0] + c[1]) + (c[2] + c[3])) + ((d[0] + d[1]) + (d[2] + d[3]));
    return rsqrtf(t * (1.f / D) + EPS);
}
struct EpiQ {
    static constexpr bool PERM = true, AFTER_DRAIN = false;
    bf16_t* O; const float* SS; float* RSTD;
    __device__ __forceinline__ void operator()(const f32x4 (&acc)[2][2][4][2], const pg8::Unit& u, int wr, int wc, int fr, int fq) const {
        const int row0 = u.pm * 256 + wr * 64 + fr, col0 = u.pn * 256 + wc * 32 + 8 * fq;
#pragma unroll
        for (int ai = 0; ai < 2; ++ai)
#pragma unroll
            for (int m = 0; m < 4; ++m) {
                const size_t row = (size_t)(row0 + ai * 128 + m * 16);
                const float rs = row_rstd(SS, row);
                if (u.pn == 0 && wc == 0 && fq == 0) RSTD[row] = rs;
#pragma unroll
                for (int bj = 0; bj < 2; ++bj) {
                    const f32x4 a = acc[ai][bj][m][0] * rs, b = acc[ai][bj][m][1] * rs;
                    u32x4 w; w.x = pk2(a[0], a[1]); w.y = pk2(a[2], a[3]); w.z = pk2(b[0], b[1]); w.w = pk2(b[2], b[3]);
                    *(u32x4*)(O + row * QPS + col0 + bj * 128) = w;
                }
            }
    }
};

constexpr int HQ_STRIDE = 272, HT_STRIDE = 48;
constexpr int H_QA = 0, H_KD = 4352, H_KH = 8704, H_VT = 14848, H_DEC = 20992, H_OPER = 21504, H_RAW = 2 * H_OPER, H_RAWB = 16384;
constexpr size_t HG_DONE_OFF = 32768 + 256;
__device__ __forceinline__ void phase_hgrn(const Params& p, LAS unsigned char* lds, int G) {
    const int tid = threadIdx.x, lane = tid & 63, wave = __builtin_amdgcn_readfirstlane(tid >> 6), fr = lane & 15, g = lane >> 4;
    const bf16_t* PROJ = (const bf16_t*)(p.ws + WS_PROJ);
    const int NCH = SEQ / 16;
    for (int item = blockIdx.x; item < 128; item += G) {
        const int dir = item & 1, h = (item >> 1) & 3, b = item >> 3;
        bf16_t* O = (bf16_t*)p.out + (size_t)dir * T * 512;
        const int ck = dir ? C_KB : C_KF, cl = dir ? C_LFB : C_LFF;
        const bool isv = tid >= 256; const int arow = (tid & 255) >> 4, ac8 = (tid & 15) * 8;
        u32x4 rq = (u32x4){0u, 0u, 0u, 0u}, rk = rq, rl = rq;
#define HG_GLOAD(ch) do { const int pos_ = (ch) * 16 + arow, tr_ = dir ? SEQ - 1 - pos_ : pos_; \
            const bf16_t* rp_ = PROJ + (size_t)(b * SEQ + tr_) * PP + h * 128 + ac8; \
            if (isv) { rq = *(const u32x4*)(rp_ + C_V); } else { rq = *(const u32x4*)(rp_ + C_Q); rk = *(const u32x4*)(rp_ + ck); rl = *(const u32x4*)(rp_ + cl); } } while (0)
#define HG_RAWSTORE(par) do { LAS unsigned char* R_ = lds + H_RAW + (par) * H_RAWB + arow * 256 + ac8 * 2; \
            if (isv) { *(LAS u32x4*)(R_ + 12288) = rq; } else { *(LAS u32x4*)R_ = rq; *(LAS u32x4*)(R_ + 4096) = rk; *(LAS u32x4*)(R_ + 8192) = rl; } } while (0)
        const int pc = tid & 127, part = tid >> 7;
        auto phaseB = [&](int par) {
            const LAS unsigned char* R = lds + H_RAW + par * H_RAWB; LAS unsigned char* OP = lds + par * H_OPER;
            float pre = 0.f, total = 0.f;
#pragma unroll
            for (int t = 0; t < 16; ++t) { const float v = __uint_as_float((unsigned)(*(const LAS unsigned short*)(R + 8192 + t * 256 + pc * 2)) << 16); total += v; pre += (t < 4 * part) ? v : 0.f; }
            float bb = pre; float kh[4], vv[4];
#pragma unroll
            for (int j = 0; j < 4; ++j) {
                const int t = 4 * part + j;
                const float lfv = __uint_as_float((unsigned)(*(const LAS unsigned short*)(R + 8192 + t * 256 + pc * 2)) << 16);
                const float qv = __uint_as_float((unsigned)(*(const LAS unsigned short*)(R + t * 256 + pc * 2)) << 16);
                const float kv = __uint_as_float((unsigned)(*(const LAS unsigned short*)(R + 4096 + t * 256 + pc * 2)) << 16);
                vv[j] = __uint_as_float((unsigned)(*(const LAS unsigned short*)(R + 12288 + t * 256 + pc * 2)) << 16);
                bb += lfv;
                *(LAS unsigned short*)(OP + H_QA + t * HQ_STRIDE + pc * 2) = (unsigned short)f2bf(qv * __expf(bb));
                *(LAS unsigned short*)(OP + H_KD + t * HQ_STRIDE + pc * 2) = (unsigned short)f2bf(kv * __expf(-bb));
                kh[j] = kv * __expf(total - bb);
            }
            *(LAS u32x2*)(OP + H_KH + pc * HT_STRIDE + part * 8) = (u32x2){pk2(kh[0], kh[1]), pk2(kh[2], kh[3])};
            *(LAS u32x2*)(OP + H_VT + pc * HT_STRIDE + part * 8) = (u32x2){pk2(vv[0], vv[1]), pk2(vv[2], vv[3])};
            if (part == 0) *(LAS float*)(OP + H_DEC + pc * 4) = __expf(total);
        };
        f32x4 S[8];
#pragma unroll
        for (int kt = 0; kt < 8; ++kt) S[kt] = (f32x4){0.f, 0.f, 0.f, 0.f};
        __syncthreads();
        HG_GLOAD(0); HG_RAWSTORE(0); HG_GLOAD(1);
        __syncthreads();
        phaseB(0); HG_RAWSTORE(1);
        __syncthreads();
        for (int i = 0; i < NCH; ++i) {
            if (i + 2 < NCH) HG_GLOAD(i + 2);
            if (i + 1 < NCH) phaseB((i + 1) & 1);
            {
                const LAS unsigned char* OP = lds + (i & 1) * H_OPER;
                f32x4 o = (f32x4){0.f, 0.f, 0.f, 0.f};
#pragma unroll
                for (int j = 0; j < 4; ++j) {
                    u32x4 w; w.x = pk2(S[2 * j][0], S[2 * j][1]); w.y = pk2(S[2 * j][2], S[2 * j][3]); w.z = pk2(S[2 * j + 1][0], S[2 * j + 1][1]); w.w = pk2(S[2 * j + 1][2], S[2 * j + 1][3]);
                    const u32x2 a0 = *(const LAS u32x2*)(OP + H_QA + fr * HQ_STRIDE + (32 * j + 4 * g) * 2), a1 = *(const LAS u32x2*)(OP + H_QA + fr * HQ_STRIDE + (32 * j + 16 + 4 * g) * 2);
                    o = __builtin_amdgcn_mfma_f32_16x16x32_bf16(__builtin_bit_cast(bf16x8, (u32x4){a0.x, a0.y, a1.x, a1.y}), __builtin_bit_cast(bf16x8, w), o, 0, 0, 0);
                }
                f32x4 X = (f32x4){0.f, 0.f, 0.f, 0.f};
#pragma unroll
                for (int j = 0; j < 4; ++j) {
                    const bf16x8 ak = *(const LAS bf16x8*)(OP + H_KD + fr * HQ_STRIDE + (32 * j + 8 * g) * 2), bq = *(const LAS bf16x8*)(OP + H_QA + fr * HQ_STRIDE + (32 * j + 8 * g) * 2);
                    X = __builtin_amdgcn_mfma_f32_16x16x32_bf16(ak, bq, X, 0, 0, 0);
                }
#pragma unroll
                for (int r = 0; r < 4; ++r) X[r] = (4 * g + r > fr) ? 0.f : X[r];
                const u32x2 vlo = *(const LAS u32x2*)(OP + H_VT + (16 * wave + fr) * HT_STRIDE + g * 8);
                const bf16x8 vb = __builtin_bit_cast(bf16x8, (u32x4){vlo.x, vlo.y, 0u, 0u});
                const bf16x8 pa = __builtin_bit_cast(bf16x8, (u32x4){pk2(X[0], X[1]), pk2(X[2], X[3]), 0u, 0u});
                o = __builtin_amdgcn_mfma_f32_16x16x32_bf16(pa, vb, o, 0, 0, 0);
#pragma unroll
                for (int r = 0; r < 4; ++r) { const int pos = i * 16 + 4 * g + r, tr = dir ? SEQ - 1 - pos : pos; O[(size_t)(b * SEQ + tr) * 512 + h * 128 + 16 * wave + fr] = (bf16_t)f2bf(o[r]); }
#pragma unroll
                for (int kt = 0; kt < 8; ++kt) {
                    const f32x4 dc = *(const LAS f32x4*)(OP + H_DEC + (16 * kt + 4 * g) * 4);
                    const u32x2 klo = *(const LAS u32x2*)(OP + H_KH + (16 * kt + fr) * HT_STRIDE + g * 8);
                    S[kt] = __builtin_amdgcn_mfma_f32_16x16x32_bf16(__builtin_bit_cast(bf16x8, (u32x4){klo.x, klo.y, 0u, 0u}), vb, S[kt] * dc, 0, 0, 0);
                }
            }
            if (i + 2 < NCH) HG_RAWSTORE(i & 1);
            __syncthreads();
        }
        asm volatile("s_waitcnt vmcnt(0)" ::: "memory");
        __syncthreads();
        if (tid == 0) { __builtin_amdgcn_fence(__ATOMIC_RELEASE, "agent"); asm volatile("s_waitcnt vmcnt(0)" ::: "memory");
            (void)__hip_atomic_fetch_add((unsigned*)(p.ws + HG_DONE_OFF), 1u, __ATOMIC_RELAXED, __HIP_MEMORY_SCOPE_AGENT); }
    }
}

constexpr int KT_STRIDE = 272, VT_STRIDE = 144;
constexpr int ATT_BUF = 64 * KT_STRIDE + 128 * VT_STRIDE;
constexpr int QUANT_ITEMS = 256;
__device__ __forceinline__ void quant_tables(const Params& p, int gw, int NGW, int lane) {
    unsigned char* ws = p.ws;
#define PQ_LOAD(dst, r0_) { _Pragma("unroll") for (int u = 0; u < 4; ++u) { const int r = ((r0_) + u * NGW) < 2 * 16384 ? ((r0_) + u * NGW) : gw; const bool isv = r >= 16384; const int e = isv ? r - 16384 : r; \
            const f32x4* xr = (const f32x4*)((isv ? p.in[I_V] : p.in[I_U]) + (size_t)e * D) + lane; _Pragma("unroll") for (int j = 0; j < 4; ++j) dst[u][j] = xr[64 * j]; } }
#define PQ_PROC(src, r0_) { _Pragma("unroll") for (int u = 0; u < 4; ++u) { const int r = (r0_) + u * NGW; if (r < 2 * 16384) { \
            const bool isv = r >= 16384; const int e = isv ? r - 16384 : r; f32x4 v[4]; float am = 0.f; \
            _Pragma("unroll") for (int j = 0; j < 4; ++j) { v[j] = src[u][j]; if (!isv) v[j] = v[j] * ((const f32x4*)p.in[I_G2])[64 * j + lane]; \
                am = fmaxf(am, fmaxf(fmaxf(fabsf(v[j].x), fabsf(v[j].y)), fmaxf(fabsf(v[j].z), fabsf(v[j].w)))); } \
            am = wave_max(am); const float sc = am > 0.f ? am * (1.f / 7.f) : 1.f, inv = 1.f / sc; unsigned pk[4]; int qs = 0; \
            _Pragma("unroll") for (int j = 0; j < 4; ++j) { \
                const int q0 = (int)rintf(v[j].x * inv), q1 = (int)rintf(v[j].y * inv), q2 = (int)rintf(v[j].z * inv), q3 = (int)rintf(v[j].w * inv); qs += (q0 + q1) + (q2 + q3); \
                pk[j] = (unsigned)((q0 & 0xFF) | ((q1 & 0xFF) << 8) | ((q2 & 0xFF) << 16) | ((q3 & 0xFF) << 24)); } \
            if (isv) {   \
                _Pragma("unroll") for (int j = 0; j < 4; ++j) { const unsigned k_ = pk[j]; \
                    *(unsigned short*)(ws + WS_VE + ((size_t)j * 16384 + e) * VSL + 2 * lane) = (unsigned short)(((k_ & 0xFu) ^ 8u) | ((k_ >> 4) & 0xF0u) | ((((k_ >> 16) & 0xFu) ^ 8u) << 8) | ((k_ >> 12) & 0xF000u)); } \
                if (lane == 0) ((float*)(ws + WS_VSC))[e] = sc; } \
            else {   \
                _Pragma("unroll") for (int j = 0; j < 2; ++j) *(unsigned*)(ws + WS_UT + (size_t)e * 512 + 256 * j + 4 * lane) = (pk[j] & 0x0F0F0F0Fu) | ((pk[j + 2] << 4) & 0xF0F0F0F0u); \
                const float qt = wave_sum((float)qs); if (lane == 0) { ((float*)(ws + WS_USC))[e] = sc; ((float*)(ws + WS_US8))[e] = 8.f * qt; } } } } }
    for (int r0 = gw; r0 < 2 * 16384; r0 += 4 * NGW) { f32x4 va[4][4]; PQ_LOAD(va, r0) PQ_PROC(va, r0) }
}
constexpr int MIX_ITEMS = 256;
__device__ __forceinline__ void mix_rows(const Params& p, int gw, int NGW, int lane) {
    const bf16_t* PROJ = (const bf16_t*)(p.ws + WS_PROJ);
    const bf16_t* OF = (const bf16_t*)p.out; const bf16_t* OB = OF + (size_t)T * 512;
    bf16_t* MIXED = (bf16_t*)(p.ws + WS_XN);
    const float* hog = p.in[I_HOG];
    const f32x4 g0 = *(const f32x4*)(hog + (lane & 15) * 8), g1 = *(const f32x4*)(hog + (lane & 15) * 8 + 4);
    for (int m0 = gw; m0 < T; m0 += 4 * NGW) {
        u32x4 av[4], bv[4], gv[4];
#pragma unroll
        for (int u = 0; u < 4; ++u) { const int m = (m0 + u * NGW) < T ? (m0 + u * NGW) : m0;
            av[u] = *(const u32x4*)(OF + (size_t)m * 512 + 8 * lane); bv[u] = *(const u32x4*)(OB + (size_t)m * 512 + 8 * lane); gv[u] = *(const u32x4*)(PROJ + (size_t)m * PP + C_G + 8 * lane); }
#pragma unroll
        for (int u = 0; u < 4; ++u) {
            const int m = m0 + u * NGW; if (m >= T) break;
            const u32x4 a = av[u], bb = bv[u], gg = gv[u];
            float o[8]; float ss = 0.f;
#pragma unroll
            for (int i = 0; i < 4; ++i) { o[2 * i] = bflo(a[i]) + bflo(bb[i]); o[2 * i + 1] = bfhi(a[i]) + bfhi(bb[i]); ss += o[2 * i] * o[2 * i] + o[2 * i + 1] * o[2 * i + 1]; }
            ss += dpp_mov<0xB1>(ss); ss += dpp_mov<0x4E>(ss); ss += dpp_mov<0x141>(ss); ss += dpp_mov<0x140>(ss);
            const float rs = rsqrtf(ss * (1.f / 128.f) + EPS);
            float y[8];
#pragma unroll
            for (int i = 0; i < 4; ++i) { y[2 * i] = o[2 * i] * rs * (i < 2 ? g0[2 * i] : g1[2 * i - 4]) * bflo(gg[i]); y[2 * i + 1] = o[2 * i + 1] * rs * (i < 2 ? g0[2 * i + 1] : g1[2 * i - 3]) * bfhi(gg[i]); }
            *(u32x4*)(MIXED + (size_t)m * D + 8 * lane) = (u32x4){pk2(y[0], y[1]), pk2(y[2], y[3]), pk2(y[4], y[5]), pk2(y[6], y[7])};
        }
    }
}

__device__ __forceinline__ float MAX3_(float a, float b, float c) { float r; asm("v_max3_f32 %0, %1, %2, %3" : "=v"(r) : "v"(a), "v"(b), "v"(c)); return r; }
__device__ __forceinline__ void phase_attn(const Params& p, LAS unsigned char* lds, int G) {
    const int tid = threadIdx.x, lane = tid & 63, wave = __builtin_amdgcn_readfirstlane(tid >> 6), fr = lane & 15, fq = lane >> 4;
    const bf16_t* PROJ = (const bf16_t*)(p.ws + WS_PROJ);
    const bf16_t* VT = (const bf16_t*)(p.ws + WS_VT);
    bf16_t* MIXED = (bf16_t*)(p.ws + WS_XN);
    const float* sm = (const float*)(p.ws + WS_SM);
    LAS unsigned char* LK = lds; LAS unsigned char* LV = lds + 64 * KT_STRIDE; LAS float* LB = (LAS float*)(lds + 2 * ATT_BUF);
    const float lam = sm[SM_LAM];
    float vinf = __builtin_inff(); asm volatile("" : "+v"(vinf));
    unsigned* qctr = (unsigned*)(p.ws + 32768);
    volatile LAS unsigned* qslot = (volatile LAS unsigned*)(lds + 131072 + 320 + 64);
    for (;;) {
        __syncthreads();
        if (tid == 0) qslot[0] = __hip_atomic_fetch_add(qctr, 1u, __ATOMIC_RELAXED, __HIP_MEMORY_SCOPE_AGENT);
        __syncthreads();
        const int item = (int)qslot[0];
        if (item >= 1024 + QUANT_ITEMS + MIX_ITEMS) break;
        if (item >= 1024 + QUANT_ITEMS) {
            if (tid == 0) { unsigned sp_ = 0; while (__hip_atomic_load((unsigned*)(p.ws + HG_DONE_OFF), __ATOMIC_RELAXED, __HIP_MEMORY_SCOPE_AGENT) < 128u && ++sp_ < (1u << 24)) __builtin_amdgcn_s_sleep(2);
                __builtin_amdgcn_fence(__ATOMIC_ACQUIRE, "agent"); asm volatile("s_waitcnt vmcnt(0)" ::: "memory"); }
            __syncthreads();
            mix_rows(p, (item - 1024 - QUANT_ITEMS) * NWAVES + wave, MIX_ITEMS * NWAVES, lane); continue;
        }
        if (item >= 1024) { quant_tables(p, (item - 1024) * NWAVES + wave, QUANT_ITEMS * NWAVES, lane); continue; }
        const int bh = item >> 4, qb = item & 15, b = bh >> 2, h = bh & 3;
        const int qabs = qb * 128 + wave * 16 + fr;
        const size_t qrow = (size_t)b * SEQ + qabs;
        __syncthreads();
        for (int i = tid; i < 257; i += NTHREADS) LB[i] = sm[SM_BT + h * BT_STRIDE + i];
        bf16x8 qf[2][2];
#pragma unroll
        for (int m = 0; m < 2; ++m)
#pragma unroll
            for (int kk = 0; kk < 2; ++kk) qf[m][kk] = *(const bf16x8*)(PROJ + qrow * PP + C_DQ + h * 128 + m * 64 + kk * 32 + fq * 8);
        float mrun[2] = {0.f, 0.f};
        f32x4 lacc[2] = {(f32x4){0.f, 0.f, 0.f, 0.f}, (f32x4){0.f, 0.f, 0.f, 0.f}};
        f32x4 o[2][8];
#pragma unroll
        for (int m = 0; m < 2; ++m)
#pragma unroll
            for (int dt = 0; dt < 8; ++dt) o[m][dt] = (f32x4){0.f, 0.f, 0.f, 0.f};
        u32x4 kreg[2], vreg[2];
        const bf16_t* kg[2]; const bf16_t* vg[2]; int koff[2], voff[2];
#pragma unroll
        for (int i = 0; i < 2; ++i) { const int c = tid + i * 512;
            const int kr = c >> 4, kc = (c & 15) * 8; kg[i] = PROJ + ((size_t)b * SEQ + kr) * PP + C_DK + h * 128 + kc; koff[i] = kr * KT_STRIDE + kc * 2;
            const int vr = c >> 3, vc = (c & 7) * 8; vg[i] = VT + (size_t)(h * 128 + vr) * T + (size_t)b * SEQ + vc; voff[i] = vr * VT_STRIDE + vc * 2; }
#pragma unroll
        for (int i = 0; i < 2; ++i) { kreg[i] = *(const u32x4*)kg[i]; vreg[i] = *(const u32x4*)vg[i]; }
#pragma unroll
        for (int i = 0; i < 2; ++i) { *(LAS u32x4*)(LK + koff[i]) = kreg[i]; *(LAS u32x4*)(LV + voff[i]) = vreg[i]; }
        __syncthreads();
        const int Qw = qb * 128 + wave * 16;
        for (int kt = 0; kt < SEQ / 64; ++kt) {
            const int pbuf = (kt & 1) * ATT_BUF;
            if (kt + 1 < SEQ / 64) {
#pragma unroll
                for (int i = 0; i < 2; ++i) { kreg[i] = *(const u32x4*)(kg[i] + (size_t)(kt + 1) * 64 * PP); vreg[i] = *(const u32x4*)(vg[i] + (kt + 1) * 64); }
            }
            const int k0 = kt * 64;
            const bool farl = (k0 + 63 - Qw) <= -91, farr = (k0 - (Qw + 15)) >= 91;
            const float binit = farl ? LB[0] : (farr ? LB[256] : 0.f);
            f32x4 s[2][4];
#pragma unroll
            for (int m = 0; m < 2; ++m) {
                const float ci = binit - mrun[m];
#pragma unroll
                for (int ks = 0; ks < 4; ++ks) {
                    f32x4 a = (f32x4){ci, ci, ci, ci};
#pragma unroll
                    for (int kk = 0; kk < 2; ++kk) {
                        const bf16x8 kf = *(const LAS bf16x8*)(LK + pbuf + (16 * ks + fr) * KT_STRIDE + (m * 64 + kk * 32 + fq * 8) * 2);
                        a = __builtin_amdgcn_mfma_f32_16x16x32_bf16(kf, qf[m][kk], a, 0, 0, 0);
                    }
                    s[m][ks] = a;
                }
            }
            if (!(farl || farr)) {
#pragma unroll
                for (int ks = 0; ks < 4; ++ks)
#pragma unroll
                    for (int r = 0; r < 4; ++r) {
                        int rel = k0 + 16 * ks + 4 * fq + r - qabs; rel = rel < -128 ? -128 : (rel > 128 ? 128 : rel);
                        const float bv = LB[rel + 128];
                        s[0][ks][r] += bv; s[1][ks][r] += bv;
                    }
            }
            bf16x8 pb[2][2];
#pragma unroll
            for (int m = 0; m < 2; ++m) {
                float mx = MAX3_(__builtin_amdgcn_fmed3f(s[m][0][0], s[m][1][0], vinf), __builtin_amdgcn_fmed3f(s[m][2][0], s[m][3][0], vinf), s[m][0][1]);
                mx = MAX3_(mx, s[m][0][2], s[m][0][3]); mx = MAX3_(mx, s[m][1][1], s[m][1][2]); mx = MAX3_(mx, s[m][1][3], s[m][2][1]);
                mx = MAX3_(mx, s[m][2][2], s[m][2][3]); mx = MAX3_(mx, s[m][3][1], s[m][3][2]); mx = MAX3_(mx, mx, s[m][3][3]);
                { float a_ = mx, b_ = mx; swap16_(a_, b_); mx = MAX3_(a_, b_, b_); }
                { float a_ = mx, b_ = mx; swap32_(a_, b_); mx = MAX3_(a_, b_, b_); }
                if (__any(fabsf(mx) > 8.0f)) {
                    const float dl = fabsf(mx) > 8.0f ? mx : 0.f, alpha = __builtin_amdgcn_exp2f(-dl);
                    mrun[m] += dl; lacc[m] *= alpha;
#pragma unroll
                    for (int ks = 0; ks < 4; ++ks) s[m][ks] = s[m][ks] - dl;
#pragma unroll
                    for (int dt = 0; dt < 8; ++dt) o[m][dt] *= alpha;
                }
#pragma unroll
                for (int ks = 0; ks < 4; ++ks)
#pragma unroll
                    for (int r = 0; r < 4; ++r) s[m][ks][r] = __builtin_amdgcn_exp2f(s[m][ks][r]);
#pragma unroll
                for (int k2 = 0; k2 < 2; ++k2) {
                    u32x4 w; w.x = pk2(s[m][2 * k2][0], s[m][2 * k2][1]); w.y = pk2(s[m][2 * k2][2], s[m][2 * k2][3]);
                    w.z = pk2(s[m][2 * k2 + 1][0], s[m][2 * k2 + 1][1]); w.w = pk2(s[m][2 * k2 + 1][2], s[m][2 * k2 + 1][3]);
                    pb[m][k2] = __builtin_bit_cast(bf16x8, w);
                }
            }
            const bf16x8 ones = __builtin_bit_cast(bf16x8, (u32x4){0x3F803F80u, 0x3F803F80u, 0x3F803F80u, 0x3F803F80u});
#pragma unroll
            for (int k2 = 0; k2 < 2; ++k2) {
                lacc[0] = __builtin_amdgcn_mfma_f32_16x16x32_bf16(ones, pb[0][k2], lacc[0], 0, 0, 0);
                lacc[1] = __builtin_amdgcn_mfma_f32_16x16x32_bf16(ones, pb[1][k2], lacc[1], 0, 0, 0);
#pragma unroll
                for (int dt = 0; dt < 8; ++dt) {
                    const u32x2 lo = *(const LAS u32x2*)(LV + pbuf + (16 * dt + fr) * VT_STRIDE + (32 * k2 + 4 * fq) * 2);
                    const u32x2 hi = *(const LAS u32x2*)(LV + pbuf + (16 * dt + fr) * VT_STRIDE + (32 * k2 + 16 + 4 * fq) * 2);
                    const bf16x8 vf = __builtin_bit_cast(bf16x8, (u32x4){lo.x, lo.y, hi.x, hi.y});
                    o[0][dt] = __builtin_amdgcn_mfma_f32_16x16x32_bf16(vf, pb[0][k2], o[0][dt], 0, 0, 0);
                    o[1][dt] = __builtin_amdgcn_mfma_f32_16x16x32_bf16(vf, pb[1][k2], o[1][dt], 0, 0, 0);
                }
            }
            if (kt + 1 < SEQ / 64) {
                const int nbuf = ((kt + 1) & 1) * ATT_BUF;
#pragma unroll
                for (int i = 0; i < 2; ++i) { *(LAS u32x4*)(LK + nbuf + koff[i]) = kreg[i]; *(LAS u32x4*)(LV + nbuf + voff[i]) = vreg[i]; }
            }
            __syncthreads();
        }
        float inv[2];
#pragma unroll
        for (int m = 0; m < 2; ++m) inv[m] = __builtin_amdgcn_rcpf(lacc[m][0]);
        float ssq = 0.f;
#pragma unroll
        for (int dt = 0; dt < 8; ++dt)
#pragma unroll
            for (int r = 0; r < 4; ++r) { const float ov = o[0][dt][r] * inv[0] - lam * (o[1][dt][r] * inv[1]); o[0][dt][r] = ov; ssq += ov * ov; }
        ssq += __shfl_xor(ssq, 16); ssq += __shfl_xor(ssq, 32);
        const float rs = rsqrtf(ssq * (1.f / 128.f) + EPS) * 0.8f;
        const float* og = p.in[I_DOG];
#pragma unroll
        for (int dt = 0; dt < 8; ++dt) {
            const f32x4 g = *(const f32x4*)(og + 16 * dt + 4 * fq);
            const f32x4 y = o[0][dt] * rs * g;
            *(u32x2*)(MIXED + qrow * D + 512 + h * 128 + 16 * dt + 4 * fq) = (u32x2){pk2(y[0], y[1]), pk2(y[2], y[3])};
        }
    }
}

__device__ __forceinline__ void phase_hquant(const Params& p, int vcu, int G) {
    const int tid = threadIdx.x, lane = tid & 63, wave = __builtin_amdgcn_readfirstlane(tid >> 6);
    const bf16_t* H1B = (const bf16_t*)(p.ws + WS_H1B); const float* SS = (const float*)(p.ws + WS_SS);
    for (int t0 = vcu * NWAVES + wave; t0 < T; t0 += 4 * G * NWAVES) {
        u32x4 ha[4], hb[4];
#pragma unroll
        for (int u = 0; u < 4; ++u) { const int t = (t0 + u * G * NWAVES) < T ? (t0 + u * G * NWAVES) : t0; ha[u] = *(const u32x4*)(H1B + (size_t)t * D + 8 * lane); hb[u] = *(const u32x4*)(H1B + (size_t)t * D + 512 + 8 * lane); }
#pragma unroll
        for (int u = 0; u < 4; ++u) {
            const int t = t0 + u * G * NWAVES; if (t >= T) break;
            const u32x4 h0 = ha[u], h1 = hb[u];
            float hf[16]; float am = 0.f;
#pragma unroll
            for (int k = 0; k < 4; ++k) { hf[2 * k] = bflo(h0[k]); hf[2 * k + 1] = bfhi(h0[k]); hf[8 + 2 * k] = bflo(h1[k]); hf[8 + 2 * k + 1] = bfhi(h1[k]); }
#pragma unroll
            for (int k = 0; k < 16; ++k) am = fmaxf(am, fabsf(hf[k]));
            am = wave_max(am);
            const float iv = am > 0.f ? 127.f / am : 0.f;
            u32x4 q;
#pragma unroll
            for (int w = 0; w < 4; ++w) { const int q0 = (int)rintf(hf[4 * w] * iv), q1 = (int)rintf(hf[4 * w + 1] * iv), q2 = (int)rintf(hf[4 * w + 2] * iv), q3 = (int)rintf(hf[4 * w + 3] * iv);
                q[w] = (unsigned)((q0 & 0xFF) | ((q1 & 0xFF) << 8) | ((q2 & 0xFF) << 16) | ((q3 & 0xFF) << 24)); }
            u32x2 ph, pl;
#pragma unroll
            for (int w = 0; w < 2; ++w) { ph[w] = ((q[w] >> 4) & 0x0F0F0F0Fu) | (q[2 + w] & 0xF0F0F0F0u); pl[w] = ((q[w] & 0x0F0F0F0Fu) | ((q[2 + w] << 4) & 0xF0F0F0F0u)) ^ 0x88888888u; }
            *(u32x2*)(p.ws + WS_H1Q + (size_t)t * D + 8 * lane) = ph; *(u32x2*)(p.ws + WS_H1Q + (size_t)t * D + 512 + 8 * lane) = pl;
            if (lane == 0) ((float*)(p.ws + WS_HSC))[t] = am * (1.f / 127.f) * row_rstd(SS, (size_t)t);
        }
    }
}
__device__ __forceinline__ unsigned ford(float f) { const unsigned u = __float_as_uint(f); return (u & 0x80000000u) ? ~u : (u | 0x80000000u); }
__device__ __forceinline__ float funord(unsigned u) { u = (u & 0x80000000u) ? (u & 0x7fffffffu) : ~u; return __uint_as_float(u); }
template <int N> __device__ __forceinline__ void bitonic_sort_desc(unsigned (&v)[N]) {
#pragma unroll
    for (int k = 2; k <= N; k <<= 1)
#pragma unroll
        for (int j = k >> 1; j > 0; j >>= 1)
#pragma unroll
            for (int i = 0; i < N; ++i) { const int l = i ^ j;
                if (l > i) { const unsigned a = v[i], b = v[l]; const unsigned mx = a > b ? a : b, mn = a > b ? b : a; if ((i & k) == 0) { v[i] = mx; v[l] = mn; } else { v[i] = mn; v[l] = mx; } } }
}
__device__ __forceinline__ void merge_top16(unsigned (&a)[16], const unsigned (&b)[16]) {
#pragma unroll
    for (int i = 0; i < 16; ++i) a[i] = a[i] > b[15 - i] ? a[i] : b[15 - i];
#pragma unroll
    for (int j = 8; j > 0; j >>= 1)
#pragma unroll
        for (int i = 0; i < 16; ++i) { const int l = i ^ j; if (l > i) { const unsigned x = a[i], y = a[l]; a[i] = x > y ? x : y; a[l] = x > y ? y : x; } }
}
__device__ __forceinline__ void top16_of64(const unsigned (&v)[64], unsigned (&out)[16]) {
    unsigned g1[16], g2[16], g3[16];
#pragma unroll
    for (int i = 0; i < 16; ++i) { out[i] = v[i]; g1[i] = v[16 + i]; g2[i] = v[32 + i]; g3[i] = v[48 + i]; }
    bitonic_sort_desc<16>(out); bitonic_sort_desc<16>(g1); bitonic_sort_desc<16>(g2); bitonic_sort_desc<16>(g3);
    merge_top16(out, g1); merge_top16(g2, g3); merge_top16(out, g2);
}
__device__ __forceinline__ unsigned xchg32u(unsigned v, int lane) { return __builtin_bit_cast(unsigned, xchg32(__builtin_bit_cast(float, v), lane)); }
constexpr int TK_KROW = 272, TK_TAB = 256 * TK_KROW;
__device__ __forceinline__ void phase_topk(const Params& p, LAS unsigned char* lds, int vcu, int G) {
    const int tid = threadIdx.x, lane = tid & 63, wave = __builtin_amdgcn_readfirstlane(tid >> 6), r32 = lane & 31, hi = lane >> 5;
    const bf16_t* QP = (const bf16_t*)(p.ws + WS_QP);
    const bf16_t* KEYS = (const bf16_t*)(p.ws + WS_KEYS);
    int* IDX = (int*)(p.ws + WS_IDX);
    LAS unsigned* tab = (LAS unsigned*)(lds + TK_TAB) + wave * 8 * 64 + lane;
    for (int item = blockIdx.x; item < (T / 256) * 2; item += G) {
        const int tg = item % (T / 256), hg = item / (T / 256);
        const size_t tok = (size_t)(tg * 8 + wave) * 32 + r32;
        for (int hh = 0; hh < 4; ++hh) {
            const int h = hg * 4 + hh;
            __syncthreads();
#pragma unroll
            for (int c8 = 0; c8 < 8; ++c8) { const int c = tid + c8 * NTHREADS, row = c >> 4, ch = c & 15;
                *(LAS u32x4*)(lds + row * TK_KROW + ch * 16) = *(const u32x4*)(KEYS + (size_t)(h * 256 + row) * 128 + ch * 8); }
            __syncthreads();
            unsigned lst[2][16];
#pragma unroll
            for (int pp = 0; pp < 2; ++pp) {
                f32x16 acc[4];
#pragma unroll
                for (int kt = 0; kt < 4; ++kt)
#pragma unroll
                    for (int r = 0; r < 16; ++r) acc[kt][r] = 0.f;
                const bf16_t* qrow = QP + tok * QPS + h * 256 + pp * 128 + 8 * hi;
                const LAS unsigned char* kb = lds + (pp * 128 + r32) * TK_KROW + 16 * hi;
#pragma unroll
                for (int s2 = 0; s2 < 8; ++s2) {
                    const bf16x8 bq = *(const bf16x8*)(qrow + 16 * s2);
#pragma unroll
                    for (int kt = 0; kt < 4; ++kt) {
                        const bf16x8 ak = *(const LAS bf16x8*)(kb + kt * 32 * TK_KROW + 32 * s2);
                        acc[kt] = __builtin_amdgcn_mfma_f32_32x32x16_bf16(ak, bq, acc[kt], 0, 0, 0);
                    }
                }
                unsigned v[64];
#pragma unroll
                for (int kt = 0; kt < 4; ++kt)
#pragma unroll
                    for (int r = 0; r < 16; ++r) { const int n = 32 * kt + (r & 3) + 8 * (r >> 2) + 4 * hi; v[kt * 16 + r] = (ford(acc[kt][r]) & ~0x7Fu) | (unsigned)(127 - n); }
                unsigned own[16], oth[16];
                top16_of64(v, own);
#pragma unroll
                for (int j = 0; j < 16; ++j) oth[j] = xchg32u(own[j], lane);
                merge_top16(own, oth);
#pragma unroll
                for (int j = 0; j < 16; ++j) lst[pp][j] = own[j];
            }
            float a[16], bs[16];
#pragma unroll
            for (int j = 0; j < 16; ++j) { a[j] = funord(lst[0][j] & ~0x7Fu); bs[j] = funord(lst[1][j] & ~0x7Fu); }
#pragma unroll
            for (int m = 0; m < 4; ++m) {
                tab[m * 64] = (127u - (lst[0][4 * m] & 0x7Fu)) | ((127u - (lst[0][4 * m + 1] & 0x7Fu)) << 8) | ((127u - (lst[0][4 * m + 2] & 0x7Fu)) << 16) | ((127u - (lst[0][4 * m + 3] & 0x7Fu)) << 24);
                tab[(4 + m) * 64] = (127u - (lst[1][4 * m] & 0x7Fu)) | ((127u - (lst[1][4 * m + 1] & 0x7Fu)) << 8) | ((127u - (lst[1][4 * m + 2] & 0x7Fu)) << 16) | ((127u - (lst[1][4 * m + 3] & 0x7Fu)) << 24);
            }
            unsigned cand[64];
            {
                int c = 0;
#pragma unroll
                for (int i = 0; i < 16; ++i)
#pragma unroll
                    for (int j = 0; j < 16; ++j)
                        if ((i + 1) * (j + 1) <= 16) { cand[c] = (ford(a[i] + bs[j]) & ~0xFFu) | (unsigned)(255 - (i * 16 + j)); ++c; }
#pragma unroll
                for (int q = 50; q < 64; ++q) cand[q] = 0u;
            }
            unsigned best[16], eidx[16];
            top16_of64(cand, best);
            LDS_WAIT();
#pragma unroll
            for (int r = 0; r < 16; ++r) { const unsigned code = 255u - (best[r] & 0xFFu), ci = code >> 4, cj = code & 15u;
                const unsigned wi = tab[(ci >> 2) * 64], wj = tab[(4 + (cj >> 2)) * 64];
                eidx[r] = ((wi >> (8 * (ci & 3u))) & 0x7Fu) * 128u + ((wj >> (8 * (cj & 3u))) & 0x7Fu); }
            LDS_WAIT();
            if (hi == 0) {
                float g[16]; const float mx = funord(best[0] & ~0xFFu); float tot = 0.f;
#pragma unroll
                for (int r = 0; r < 16; ++r) { g[r] = __expf(funord(best[r] & ~0xFFu) - mx); tot += g[r]; }
                const float it_ = 1.f / tot;
                unsigned* rp = (unsigned*)IDX + (tok * 8 + h) * 16;
#pragma unroll
                for (int q4 = 0; q4 < 4; ++q4)
                    *(u32x4*)(rp + 4 * q4) = (u32x4){eidx[4 * q4] | (f2bf(g[4 * q4] * it_) << 16), eidx[4 * q4 + 1] | (f2bf(g[4 * q4 + 1] * it_) << 16), eidx[4 * q4 + 2] | (f2bf(g[4 * q4 + 2] * it_) << 16), eidx[4 * q4 + 3] | (f2bf(g[4 * q4 + 3] * it_) << 16)};
            }
        }
    }
}

typedef float f32x2_ __attribute__((ext_vector_type(2)));
__device__ __forceinline__ float gelu_exact(float v) {
    const float av = fabsf(v), t = __builtin_amdgcn_rcpf(av * 0.2316418882f + 1.0f);
    float q = t * 0.5307027145f + (-0.7265760135f); q = q * t + 0.7107068705f; q = q * t + (-0.142248368f); q = q * t + 0.127414796f; q = q * t;
    const float e = __builtin_amdgcn_exp2f((v * v) * (-0.72134752044f));
    const float m = v * (q * e);
    return v < 0.f ? m : v - m;
}
typedef float f32x2_ __attribute__((ext_vector_type(2)));
__device__ __forceinline__ void phase_peer_u(const Params& p, LAS unsigned char* lds, int G, int mx, int mj) {
    const int tid = threadIdx.x, lane = tid & 63, wave = __builtin_amdgcn_readfirstlane(tid >> 6), bx = blockIdx.x;
    const bool xl = (G % 8 == 0);
    const int x = xl ? (mx & 3) : 0, nx = xl ? 4 : 1, jb = xl ? (mx >> 2) * (G / 8) + mj : bx, nw = (xl ? G / 4 : G) * NWAVES, widx = jb * NWAVES + wave;
    const unsigned char* H1Q = (const unsigned char*)(p.ws + WS_H1Q); const unsigned char* UQ = (const unsigned char*)(p.ws + WS_UT);
    const unsigned* REC = (const unsigned*)(p.ws + WS_IDX); const float* HSC = (const float*)(p.ws + WS_HSC);
    const float* USC = (const float*)(p.ws + WS_USC); const float* VSC = (const float*)(p.ws + WS_VSC);
    unsigned* CI = (unsigned*)(p.ws + WS_C);
    LAS float* SU = (LAS float*)lds; LAS float* SV = SU + GRP_SIZE; LAS float* U8 = SV + GRP_SIZE;
    LAS u32x2* slots = (LAS u32x2*)(lds + 49152 + wave * 2048);
    LAS u32x4* hbuf = (LAS u32x4*)(lds + 65536 + wave * 2048);
    const int K = (T - widx + nw - 1) / nw;
    const int lrow = lane >> 4, lcol = lane & 15, lc16 = 16 * lcol;
    for (int g = x; g < NGRP; g += nx) {
        __syncthreads();
        for (int i = tid; i < GRP_SIZE; i += NTHREADS) { SU[i] = USC[g * GRP_SIZE + i]; SV[i] = VSC[g * GRP_SIZE + i]; U8[i] = ((const float*)(p.ws + WS_US8))[g * GRP_SIZE + i]; }
        __syncthreads();
#define PU_R(S, k_) { const int kk_ = (k_) < K ? (k_) : K - 1; const size_t tt_ = (size_t)(widx + nw * kk_); \
            rq##S = *(const u32x2*)(REC + tt_ * 128 + 2 * lane); rr##S = HSC[tt_]; hr##S = *(const u32x4*)(H1Q + tt_ * D + 16 * lane); }
#define PU_C(S, k_) { LAS u32x2* sl_ = slots + S * 128; const bool ok_ = (k_) < K; tk##S = widx + nw * ((k_) < K ? (k_) : K - 1); rs##S = rr##S; \
            hbuf[S * 64 + lane] = hr##S; const unsigned rl##S = rq##S.x, rh##S = rq##S.y; \
            { const bool f0 = ((rl##S & 0x3FFFu) >> GRP_SHIFT) == (unsigned)g, f1 = ((rh##S & 0x3FFFu) >> GRP_SHIFT) == (unsigned)g; const unsigned long long m0 = __ballot(f0), m1 = __ballot(f1); const int n0 = __popcll(m0); \
              if (f0) sl_[(int)__builtin_amdgcn_mbcnt_hi((unsigned)(m0 >> 32), __builtin_amdgcn_mbcnt_lo((unsigned)m0, 0u))] = (u32x2){((rl##S & 0x3FFFu) << 9) | ((unsigned)(2 * lane) << 24), rl##S & 0xffff0000u}; \
              if (f1) sl_[n0 + (int)__builtin_amdgcn_mbcnt_hi((unsigned)(m1 >> 32), __builtin_amdgcn_mbcnt_lo((unsigned)m1, 0u))] = (u32x2){((rh##S & 0x3FFFu) << 9) | ((unsigned)(2 * lane + 1) << 24), rh##S & 0xffff0000u}; \
              nn##S = __builtin_amdgcn_readfirstlane(ok_ ? n0 + __popcll(m1) : 0); } \
            LDS_WAIT(); \
            _Pragma("unroll") for (int j = 0; j < 12; ++j) sl##S[j] = sl_[4 * j + lrow]; \
            _Pragma("unroll") for (int i = 0; i < 4; ++i) hq##S[i] = hbuf[S * 64 + 16 * i + lcol]; }
#define PU_ISSUE(R, SL, c_, n_, QM) { int ns_ = (n_) - 12 * (c_); asm volatile("" : "+s"(ns_)); \
            _Pragma("unroll") for (int q = 0; q < 3; ++q) if (q < (QM) || ns_ > 4 * q) { const bool v_ = (4 * q + lrow) < ns_; const unsigned char* a_ = UQ + (v_ ? (size_t)((SL[3 * (c_) + q].x & 0x7FFFFFu) + lc16) : (size_t)0); \
                row##R[2 * q] = *(const u32x4*)a_; row##R[2 * q + 1] = *(const u32x4*)(a_ + 256); } }
#define PU_DOT(R, HQ, ACC, c_, n_, QM) { int ns_ = (n_) - 12 * (c_); asm volatile("" : "+s"(ns_)); _Pragma("unroll") for (int q = 0; q < 3; ++q) if (q < (QM) || ns_ > 4 * q) { int a1_ = 0, a2_ = 0; \
                _Pragma("unroll") for (int i = 0; i < 2; ++i) _Pragma("unroll") for (int w = 0; w < 4; ++w) { a1_ = __builtin_amdgcn_sdot8((int)row##R[2 * q + i][w], (int)HQ[i][w], a1_, false); a2_ = __builtin_amdgcn_sdot8((int)row##R[2 * q + i][w], (int)HQ[2 + i][w], a2_, false); } \
                ACC[q] = (a1_ << 4) + a2_; } }
#define PU_EPI(S, SL, ACC, c_, n_, QM) { float rt_[3]; int ns_ = (n_) - 12 * (c_); asm volatile("" : "+s"(ns_)); \
            _Pragma("unroll") for (int q = 0; q < 3; ++q) { rt_[q] = 0.f; if (q < (QM) || ns_ > 4 * q) { float f_ = (float)ACC[q]; f_ += dpp_mov<0xB1>(f_); f_ += dpp_mov<0x4E>(f_); f_ += dpp_mov<0x141>(f_); f_ += dpp_mov<0x140>(f_); rt_[q] = f_; } } \
            float tot_ = rt_[0]; unsigned rx_ = SL[3 * (c_)].x, ry_ = SL[3 * (c_)].y; \
            _Pragma("unroll") for (int q = 1; q < 3; ++q) { const bool e_ = lcol == q; tot_ = e_ ? rt_[q] : tot_; rx_ = e_ ? SL[3 * (c_) + q].x : rx_; ry_ = e_ ? SL[3 * (c_) + q].y : ry_; } \
            if (lcol < 3 && (4 * lcol + lrow) < ns_) { const unsigned idx_ = (rx_ >> 9) & 0x3FFFu; const int li_ = (int)(idx_ & (GRP_SIZE - 1)); \
                const float c_v = __uint_as_float(ry_) * gelu_exact((tot_ + U8[li_]) * SU[li_] * rs##S) * SV[li_]; CI[(size_t)tk##S * 128 + (rx_ >> 24)] = (f2bf(c_v) << 16) | idx_; } }
#define PU_OVF(S) if (nn##S > 48) { for (int b1_ = 48; b1_ < nn##S; b1_ += 12) { u32x2 so2_[12]; _Pragma("unroll") for (int q = 0; q < 3; ++q) so2_[q] = slots[S * 128 + ((b1_ + 4 * q + lrow) & 127)]; \
            const int n2_ = nn##S - b1_; int ac2_[3]; PU_ISSUE(3, so2_, 0, n2_, 0) PU_DOT(3, hq##S, ac2_, 0, n2_, 0) PU_EPI(S, so2_, ac2_, 0, n2_, 0) } }
#define PU_TOKEN(S, Sn) { \
            PU_DOT(0, hq##S, acc##S, 0, nn##S, 3) PU_EPI(S, sl##S, acc##S, 0, nn##S, 3) PU_ISSUE(0, sl##Sn, 0, nn##Sn, 3) \
            PU_DOT(1, hq##S, acc##S, 1, nn##S, 3) PU_EPI(S, sl##S, acc##S, 1, nn##S, 3) PU_ISSUE(1, sl##Sn, 1, nn##Sn, 3) \
            PU_DOT(2, hq##S, acc##S, 2, nn##S, 0) PU_EPI(S, sl##S, acc##S, 2, nn##S, 0) PU_ISSUE(2, sl##Sn, 2, nn##Sn, 0) \
            PU_DOT(3, hq##S, acc##S, 3, nn##S, 0) PU_EPI(S, sl##S, acc##S, 3, nn##S, 0) PU_OVF(S) PU_ISSUE(3, sl##Sn, 3, nn##Sn, 0) }
        u32x2 rq0, rq1; u32x4 hr0, hr1, hq0[4], hq1[4]; float rr0, rr1, rs0 = 0.f, rs1 = 0.f; int tk0 = 0, tk1 = 0, nn0 = 0, nn1 = 0;
        u32x4 row0[6], row1[6], row2[6], row3[6]; u32x2 sl0[12], sl1[12]; int acc0[3], acc1[3];
#pragma unroll
        for (int q = 0; q < 4; ++q) { hq0[q] = (u32x4){0u, 0u, 0u, 0u}; hq1[q] = hq0[q]; }
#pragma unroll
        for (int q = 0; q < 12; ++q) { sl0[q] = (u32x2){0u, 0u}; sl1[q] = sl0[q]; }
#pragma unroll
        for (int q = 0; q < 6; ++q) { row0[q] = (u32x4){0u, 0u, 0u, 0u}; row1[q] = row0[q]; row2[q] = row0[q]; row3[q] = row0[q]; }
#pragma unroll
        for (int q = 0; q < 3; ++q) { acc0[q] = 0; acc1[q] = 0; }
        PU_R(0, 0) PU_R(1, 1)
        PU_C(0, 0)
        PU_ISSUE(0, sl0, 0, nn0, 3) PU_ISSUE(1, sl0, 1, nn0, 3) PU_ISSUE(2, sl0, 2, nn0, 0) PU_ISSUE(3, sl0, 3, nn0, 0)
        PU_R(0, 2)
        for (int k = 0; k < K; k += 2) {
            PU_C(1, k + 1)
            PU_R(1, k + 3)
            PU_TOKEN(0, 1)
            PU_C(0, k + 2)
            PU_R(0, k + 4)
            PU_TOKEN(1, 0)
        }
    }
    __syncthreads();
}
__device__ __forceinline__ void phase_peer_v(const Params& p, LAS unsigned char* lds, int G, int mx, int mj) {
    const int tid = threadIdx.x, lane = tid & 63, wave = __builtin_amdgcn_readfirstlane(tid >> 6), bx = blockIdx.x;
    const bool xl = (G % 8 == 0);
    const int x = xl ? (mx & 3) : 0, nx = xl ? 4 : 1, jb = xl ? (mx >> 2) * (G / 8) + mj : bx, nw = (xl ? G / 4 : G) * NWAVES, widx = jb * NWAVES + wave;
    const unsigned char* VQ = (const unsigned char*)(p.ws + WS_VE);
    const unsigned* CI = (const unsigned*)(p.ws + WS_C);
    bf16_t* H1B = (bf16_t*)(p.ws + WS_H1B);
    const int sub = lane & 7, es = lane >> 3;
    const int K = (T - widx + nw - 1) / nw, NB4 = (K + 3) / 4;
    LAS unsigned* RL = (LAS unsigned*)(lds + wave * 4096);
    for (int s = x; s < NVS; s += nx) {
        const unsigned char* VQs = VQ + (size_t)s * 16384 * VSL + 16 * sub;
#define PV_TOK(k_) ((size_t)(widx + nw * ((k_) < K ? (k_) : K - 1)))
#define PV_RQLOAD(blk_) { _Pragma("unroll") for (int j = 0; j < 4; ++j) rq[j] = *(const u32x2*)(CI + PV_TOK(4 * (blk_) + j) * 128 + 2 * lane); }
#define PV_RQSTORE(blk_) { _Pragma("unroll") for (int j = 0; j < 4; ++j) *(LAS u32x2*)(RL + (((blk_) & 1) * 4 + j) * 128 + 2 * lane) = rq[j]; }
#define PV_REC(blkpar_, j_, hf_, i_) RL[((blkpar_) * 4 + (j_)) * 128 + 64 * (hf_) + 8 * (i_) + es]
#define PV_GATHER8(vb, rg_, hf_) { _Pragma("unroll") for (int i = 0; i < 8; ++i) vb[i] = *(const u32x4*)(VQs + (size_t)(rg_[8 * (hf_) + i] & 0x3FFFu) * VSL); }
#define PV_PREP(blkpar_, j_, sl_, k_) { float cf_[16]; float am_ = 0.f; hvs[sl_] = *(const u32x2*)(H1B + PV_TOK(k_) * D + hoff); \
            _Pragma("unroll") for (int i = 0; i < 16; ++i) rg[i] = PV_REC(blkpar_, j_, (i >> 3), (i & 7)); \
            _Pragma("unroll") for (int i = 0; i < 16; ++i) { cf_[i] = __uint_as_float(rg[i] & 0xffff0000u); am_ = fmaxf(am_, fabsf(cf_[i])); } \
            am_ = fmaxf(am_, dpp_mov<0x128>(am_)); am_ = swap16_max(am_); am_ = swap32_max(am_); \
            const float iv_ = am_ > 0.f ? 127.f / am_ : 0.f; csc[sl_] = am_ * (1.f / 127.f); int cs_ = 0; \
            _Pragma("unroll") for (int m = 0; m < 4; ++m) { const int q0 = (int)rintf(cf_[4 * m] * iv_), q1 = (int)rintf(cf_[4 * m + 1] * iv_), q2 = (int)rintf(cf_[4 * m + 2] * iv_), q3 = (int)rintf(cf_[4 * m + 3] * iv_); \
                cqs[sl_][m] = (q0 & 0xFF) | ((q1 & 0xFF) << 8) | ((q2 & 0xFF) << 16) | ((q3 & 0xFF) << 24); cs_ = __builtin_amdgcn_sdot4(cqs[sl_][m], 0x01010101, cs_, false); } \
            float ct_ = (float)cs_; ct_ += dpp_mov<0x128>(ct_); ct_ = swap16_sum(ct_); ct_ = swap32_sum(ct_); cto[sl_] = -8.f * ct_; }
#define PV_T4(r0, r1, r2, r3, w, cqw) { const unsigned x0_ = __builtin_amdgcn_perm(r1[w], r0[w], 0x05010400u), x1_ = __builtin_amdgcn_perm(r1[w], r0[w], 0x07030602u), \
                y0_ = __builtin_amdgcn_perm(r3[w], r2[w], 0x05010400u), y1_ = __builtin_amdgcn_perm(r3[w], r2[w], 0x07030602u); \
            const unsigned t0_ = __builtin_amdgcn_perm(y0_, x0_, 0x05040100u), t1_ = __builtin_amdgcn_perm(y0_, x0_, 0x07060302u), t2_ = __builtin_amdgcn_perm(y1_, x1_, 0x05040100u), t3_ = __builtin_amdgcn_perm(y1_, x1_, 0x07060302u); \
            acci[8 * (w)] = __builtin_amdgcn_sdot4((int)(t0_ & 0x0F0F0F0Fu), cqw, acci[8 * (w)], false); acci[8 * (w) + 1] = __builtin_amdgcn_sdot4((int)(t0_ & 0xF0F0F0F0u), cqw, acci[8 * (w) + 1], false); \
            acci[8 * (w) + 2] = __builtin_amdgcn_sdot4((int)(t1_ & 0x0F0F0F0Fu), cqw, acci[8 * (w) + 2], false); acci[8 * (w) + 3] = __builtin_amdgcn_sdot4((int)(t1_ & 0xF0F0F0F0u), cqw, acci[8 * (w) + 3], false); \
            acci[8 * (w) + 4] = __builtin_amdgcn_sdot4((int)(t2_ & 0x0F0F0F0Fu), cqw, acci[8 * (w) + 4], false); acci[8 * (w) + 5] = __builtin_amdgcn_sdot4((int)(t2_ & 0xF0F0F0F0u), cqw, acci[8 * (w) + 5], false); \
            acci[8 * (w) + 6] = __builtin_amdgcn_sdot4((int)(t3_ & 0x0F0F0F0Fu), cqw, acci[8 * (w) + 6], false); acci[8 * (w) + 7] = __builtin_amdgcn_sdot4((int)(t3_ & 0xF0F0F0F0u), cqw, acci[8 * (w) + 7], false); }
#define PV_ACC8(vb, sl_, hf_) { _Pragma("unroll") for (int w = 0; w < 4; ++w) { PV_T4(vb[0], vb[1], vb[2], vb[3], w, cqs[sl_][2 * (hf_)]) PV_T4(vb[4], vb[5], vb[6], vb[7], w, cqs[sl_][2 * (hf_) + 1]) } }
#define PV_FIN(k_, sl_) { int r16[16], r8[8], r4[4]; \
            { const bool bt = lane & 8; _Pragma("unroll") for (int q = 0; q < 16; ++q) { const int keep = bt ? acci[q + 16] : acci[q], send = bt ? acci[q] : acci[q + 16]; r16[q] = keep + __builtin_amdgcn_update_dpp(0, send, 0x128, 0xF, 0xF, false); } } \
            _Pragma("unroll") for (int q = 0; q < 8; ++q) { int a_ = r16[q], b_ = r16[q + 8]; swap16i_(a_, b_); r8[q] = a_ + b_; } \
            _Pragma("unroll") for (int q = 0; q < 4; ++q) { int a_ = r8[q], b_ = r8[q + 4]; swap32i_(a_, b_); r4[q] = a_ + b_; } \
            _Pragma("unroll") for (int q = 0; q < 32; ++q) acci[q] = 0; \
            if ((k_) < K) { const u32x2 hw = hvs[sl_]; const float sc_ = csc[sl_], sh_ = sc_ * (1.f / 16.f), co_ = cto[sl_]; \
                *(u32x2*)(H1B + (size_t)(widx + nw * (k_)) * D + hoff) = (u32x2){pk2(bflo(hw.x) + ((float)r4[0] + co_) * sc_, bfhi(hw.x) + (float)r4[1] * sh_), pk2(bflo(hw.y) + ((float)r4[2] + co_) * sc_, bfhi(hw.y) + (float)r4[3] * sh_)}; } }
#define PV_STEP(vb, B_, j_, hf_) { PV_ACC8(vb, ((j_) & 3), hf_) if ((hf_) == 1) PV_FIN(4 * (B_) + (j_), ((j_) & 3)) \
            if ((hf_) == 0) PV_PREP((((j_) + 2) < 4) ? ((B_) & 1) : (((B_) + 1) & 1), (((j_) + 2) & 3), (((j_) + 2) & 3), 4 * (B_) + (j_) + 2) \
            PV_GATHER8(vb, rg, hf_) }
        u32x2 rq[4]; u32x4 v0[8], v1[8], v2[8], v3[8]; int acci[32]; int cqs[4][4]; float csc[4], cto[4]; unsigned rg[16]; u32x2 hvs[4];
        const int hoff = s * 256 + 32 * sub + 16 * (es & 1) + 8 * ((es >> 1) & 1) + 4 * (es >> 2);
#pragma unroll
        for (int q = 0; q < 32; ++q) acci[q] = 0;
        PV_RQLOAD(0) PV_RQSTORE(0) PV_RQLOAD(1) PV_RQSTORE(1)
        LDS_WAIT();
        PV_PREP(0, 0, 0, 0) PV_GATHER8(v0, rg, 0) PV_GATHER8(v1, rg, 1)
        PV_PREP(0, 1, 1, 1) PV_GATHER8(v2, rg, 0) PV_GATHER8(v3, rg, 1)
        for (int B = 0; B < NB4; ++B) {
            if (B > 0) { PV_RQSTORE(B + 1) LDS_WAIT(); }
            PV_STEP(v0, B, 0, 0) PV_STEP(v1, B, 0, 1)
            PV_STEP(v2, B, 1, 0) PV_STEP(v3, B, 1, 1)
            PV_RQLOAD(B + 2)
            PV_STEP(v0, B, 2, 0) PV_STEP(v1, B, 2, 1)
            PV_STEP(v2, B, 3, 0) PV_STEP(v3, B, 3, 1)
        }
    }
}
__device__ __forceinline__ void phase_final(const Params& p, int vcu, int G) {
    const int tid = threadIdx.x, lane = tid & 63, wave = __builtin_amdgcn_readfirstlane(tid >> 6);
    const bf16_t* H2B = (const bf16_t*)(p.ws + WS_H1B); float* Y = p.out; const float* fg = p.in[I_FG];
    const int w0 = vcu * NWAVES + wave, WS_ = G * NWAVES;
    const f32x4 g0 = ((const f32x4*)fg)[2 * lane], g1 = ((const f32x4*)fg)[2 * lane + 1], g2 = ((const f32x4*)fg)[128 + 2 * lane], g3 = ((const f32x4*)fg)[128 + 2 * lane + 1];
#define PF_LOAD(dst, t0_) { _Pragma("unroll") for (int u = 0; u < 4; ++u) { const int tok = ((t0_) + u * WS_) < T ? ((t0_) + u * WS_) : w0; \
            dst[u][0] = *(const u32x4*)(H2B + (size_t)tok * D + 8 * lane); dst[u][1] = *(const u32x4*)(H2B + (size_t)tok * D + 512 + 8 * lane); } }
#define PF_PROC(src, t0_) { _Pragma("unroll") for (int u = 0; u < 4; ++u) { const int tok = (t0_) + u * WS_; if (tok < T) { float f[16]; float ss = 0.f; \
            _Pragma("unroll") for (int k = 0; k < 4; ++k) { f[2 * k] = bflo(src[u][0][k]); f[2 * k + 1] = bfhi(src[u][0][k]); f[8 + 2 * k] = bflo(src[u][1][k]); f[8 + 2 * k + 1] = bfhi(src[u][1][k]); } \
            _Pragma("unroll") for (int k = 0; k < 16; ++k) ss += f[k] * f[k]; \
            const float rs = rsqrtf(wave_sum(ss) * (1.f / D) + EPS); f32x4* yr = (f32x4*)(Y + (size_t)tok * D); \
            yr[2 * lane] = (f32x4){f[0], f[1], f[2], f[3]} * rs * g0; yr[2 * lane + 1] = (f32x4){f[4], f[5], f[6], f[7]} * rs * g1; \
            yr[128 + 2 * lane] = (f32x4){f[8], f[9], f[10], f[11]} * rs * g2; yr[128 + 2 * lane + 1] = (f32x4){f[12], f[13], f[14], f[15]} * rs * g3; } } }
    u32x4 va[4][2], vb[4][2];
    PF_LOAD(va, w0)
    for (int t0 = w0; t0 < T; t0 += 8 * WS_) {
        if (t0 + 4 * WS_ < T) PF_LOAD(vb, t0 + 4 * WS_)
        PF_PROC(va, t0)
        if (t0 + 8 * WS_ < T) PF_LOAD(va, t0 + 8 * WS_)
        PF_PROC(vb, t0 + 4 * WS_)
    }
}
#define XB_TMO      128
#define XB_XCNT(j)  (256  + 64 * (j))
#define XB_XSUB(j)  (1280 + 64 * (j))
#define XB_XGEN(j)  (2304 + 64 * (j))
#define XB_TOP      3328
#define XB_TOPGEN   3392
#define XCD_BAR_WORDS 3456
#define XB_SPIN_CAP (1u << 18)

__device__ __forceinline__ unsigned xb_ld(unsigned* p)              { return __hip_atomic_load(p, __ATOMIC_RELAXED, __HIP_MEMORY_SCOPE_AGENT); }
__device__ __forceinline__ unsigned xb_add(unsigned* p, unsigned v) { return __hip_atomic_fetch_add(p, v, __ATOMIC_RELAXED, __HIP_MEMORY_SCOPE_AGENT); }
__device__ __forceinline__ unsigned xb_xcc_id() { return (unsigned)__builtin_amdgcn_s_getreg((3 << 11) | 20) & 0xFu; }
#define XB_SPIN(cond, bar) do { unsigned _sp = 0; while (cond) { __builtin_amdgcn_s_sleep(1); \
    if ((++_sp & 255u) == 0u) { if (xb_ld(&(bar)[XB_TMO])) break; if (_sp > XB_SPIN_CAP) { atomicAdd(&(bar)[XB_TMO], 1u); break; } } } } while (0)

struct XcdBarrier {
    unsigned* bar; unsigned x;
    volatile LAS unsigned* st;
};

__device__ __forceinline__ XcdBarrier xcd_barrier_post(unsigned* bar, volatile LAS unsigned* st) {
    XcdBarrier b; b.bar = bar; b.x = xb_xcc_id(); b.st = st;
    if (threadIdx.x == 0) (void)xb_add(&bar[XB_XCNT(b.x)], 1u);
    return b;
}
__device__ __forceinline__ void xcd_barrier_complete(unsigned* bar, unsigned x, unsigned& nloc, unsigned& nx) {
    const unsigned G = gridDim.x * gridDim.y * gridDim.z;
    unsigned sum, cnt, mine, sp = 0u;
    for (;;) {
        sum = 0u; cnt = 0u; mine = 0u;
#pragma unroll
        for (unsigned j = 0; j < 16; ++j) { const unsigned c = xb_ld(&bar[XB_XCNT(j)]); sum += c; cnt += (c > 0u) ? 1u : 0u; mine = (j == x) ? c : mine; }
        if (sum == G) break;
        __builtin_amdgcn_s_sleep(1);
        if ((++sp & 255u) == 0u) { if (xb_ld(&bar[XB_TMO])) break; if (sp > XB_SPIN_CAP) { atomicAdd(&bar[XB_TMO], 1u); break; } }
    }
    nloc = mine > 0u ? mine : 1u; nx = cnt > 0u ? cnt : 1u;
}

__device__ __forceinline__ void xcd_barrier(const XcdBarrier& b) {
    asm volatile("s_waitcnt vmcnt(0)" ::: "memory");
    __syncthreads();
    if (threadIdx.x == 0) {
        unsigned* bar = b.bar;
        __builtin_amdgcn_s_waitcnt(0);
        unsigned nloc = b.st[0], nx = b.st[1];
        if (nloc == 0u) { xcd_barrier_complete(bar, b.x, nloc, nx); b.st[0] = nloc; b.st[1] = nx; }
        const unsigned old = xb_add(&bar[XB_XSUB(b.x)], 1u);
        const unsigned gen = old / nloc;
        if (old + 1u == (gen + 1u) * nloc) {
            __builtin_amdgcn_fence(__ATOMIC_RELEASE, "agent");
            asm volatile("s_waitcnt vmcnt(0)" ::: "memory");
            const unsigned og = xb_add(&bar[XB_TOP], 1u);
            const unsigned tg = og / nx;
            if (og + 1u == (tg + 1u) * nx) xb_add(&bar[XB_TOPGEN], 1u);
            else XB_SPIN(xb_ld(&bar[XB_TOPGEN]) == tg, bar);
            __builtin_amdgcn_fence(__ATOMIC_ACQUIRE, "agent");
            xb_add(&bar[XB_XGEN(b.x)], 1u);
            asm volatile("s_waitcnt vmcnt(0)" ::: "memory");
        } else {
            XB_SPIN(xb_ld(&bar[XB_XGEN(b.x)]) == gen, bar);
            __builtin_amdgcn_fence(__ATOMIC_ACQUIRE, "agent");
            asm volatile("s_waitcnt vmcnt(0)" ::: "memory");
        }
    }
    __syncthreads();
}

constexpr int N_PHASES = 11;
__global__ void __launch_bounds__(NTHREADS, 2) hymba_fwd(Params p) {
    extern __shared__ __attribute__((aligned(16))) unsigned char lds_raw[];
    LAS unsigned char* lds = (LAS unsigned char*)lds_raw;
    cg::grid_group grid = cg::this_grid();
    const int G = gridDim.x; const int bx = blockIdx.x;
    const int vcu = (G % 8 == 0) ? (bx % 8) * (G / 8) + bx / 8 : bx;
    unsigned char* ws = p.ws;
    const int lo = p.ph_lo, hi = p.ph_hi;
    volatile LAS unsigned* MISC = (volatile LAS unsigned*)(lds + 131072 + 320);
    if (threadIdx.x < 32) MISC[threadIdx.x] = 0u;
    __syncthreads();
    XcdBarrier bar; bar.bar = (unsigned*)ws; bar.x = xb_xcc_id(); bar.st = MISC + 8;
    if (threadIdx.x == 0) { MISC[20] = xb_add(&bar.bar[XB_XCNT(bar.x)], 1u); MISC[21] = bar.x; MISC[22] = 0u; }
#define IN(k) (lo <= (k) && (k) < hi)
#define SEAM(k) do { if ((k) + 1 < hi) { if ((k) == 0) grid.sync(); else xcd_barrier(bar); } } while (0)
    if (IN(0)) { phase_prep(p, lds, vcu, G); SEAM(0); }
    {
        if (threadIdx.x == 0 && lo == 0 && hi > 1 && (G % 8) == 0) { bool ok = true; for (unsigned j = 0; j < 8; ++j) ok = ok && (xb_ld(&bar.bar[XB_XCNT(j)]) == (unsigned)(G / 8)); MISC[22] = ok ? 1u : 0u; }
        __syncthreads();
    }
    const bool xcc_ok = MISC[22] != 0u; const int xcc_x = xcc_ok ? (int)MISC[21] : (bx & 7), xcc_j = xcc_ok ? (int)MISC[20] : (bx >> 3);
    if (IN(1)) {
        { pg8::Gemm g{(const bf16_t*)(ws + WS_XN), (const bf16_t*)(ws + WS_WINT), T, 3584, D}; pg8::StaticOrder S; S.init(T, 3584, G, bx);
          EpiInProj E{(bf16_t*)(ws + WS_PROJ), (const float*)(ws + WS_SM)};
          pg8::gemm_phase<EpiInProj, pg8::StaticOrder, true, true>(lds, g, S, E); }
        { pg8::Gemm g{(const bf16_t*)(ws + WS_WINT) + (size_t)3584 * D, (const bf16_t*)(ws + WS_XN), 512, T, D}; pg8::StaticOrder S; S.init(512, T, G, bx);
          EpiStore E{(bf16_t*)(ws + WS_VT), T};
          pg8::gemm_phase<EpiStore, pg8::StaticOrder, true, true>(lds, g, S, E); }
        SEAM(1);
    }
    if (IN(2)) { phase_hgrn(p, lds, G); }
    if (IN(3)) { phase_attn(p, lds, G); SEAM(3); }
    if (IN(5)) {
        pg8::Gemm g{(const bf16_t*)(ws + WS_XN), (const bf16_t*)(ws + WS_WOT), T, D, D}; pg8::StaticOrder S; S.init(T, D, G, bx);
        EpiOutProj E{p.in[I_X], p.out, (bf16_t*)(ws + WS_H1B), (float*)(ws + WS_SS)};
        pg8::gemm_phase<EpiOutProj, pg8::StaticOrder, true, true>(lds, g, S, E);
        SEAM(5);
    }
    if (IN(6)) {
        phase_hquant(p, vcu, G);
        pg8::Gemm g{(const bf16_t*)(ws + WS_H1B), (const bf16_t*)(ws + WS_WQT), T, 2048, D}; pg8::StaticOrder S; S.init(T, 2048, G, bx);
        EpiQ E{(bf16_t*)(ws + WS_QP), (const float*)(ws + WS_SS), (float*)(ws + WS_GATE)};
        pg8::gemm_phase<EpiQ, pg8::StaticOrder, true, true>(lds, g, S, E);
        SEAM(6);
    }
    if (IN(7)) { phase_topk(p, lds, vcu, G); SEAM(7); }
    if (IN(8)) { phase_peer_u(p, lds, G, xcc_x, xcc_j); SEAM(8); }
    if (IN(9)) { phase_peer_v(p, lds, G, xcc_x, xcc_j); SEAM(9); }
    if (IN(10)) { phase_final(p, vcu, G); }
#undef IN
#undef SEAM
}

extern "C" void kernel_launch(void* const* d_in, const int* in_sizes, int n_in, void* d_out, int out_size, void* d_ws, size_t ws_size, hipStream_t stream) {
    static int grid = 0;
    if (grid == 0) {
        if (n_in != 19 || out_size != T * D || ws_size < WS_END) { fprintf(stderr, "kernel_launch: unexpected sizes (n_in %d out %d ws %zu)\n", n_in, out_size, ws_size); grid = -1; return; }
        int dev = 0, cus = 0, per_cu = 0;
        hipGetDevice(&dev); hipDeviceGetAttribute(&cus, hipDeviceAttributeMultiprocessorCount, dev);
        hipFuncSetAttribute((const void*)hymba_fwd, hipFuncAttributeMaxDynamicSharedMemorySize, LDS_BYTES);
        hipOccupancyMaxActiveBlocksPerMultiprocessor(&per_cu, (const void*)hymba_fwd, NTHREADS, LDS_BYTES);
        (void)hipGetLastError();
        if (per_cu < 1) { fprintf(stderr, "kernel_launch: occupancy query says %d blocks/CU\n", per_cu); per_cu = 1; }
        grid = cus;
    }
    if (grid < 0) return;
    if (hipMemsetAsync(d_ws, 0, 65536, stream) != hipSuccess) { fprintf(stderr, "kernel_launch: memset of the barrier words failed\n"); return; }
    Params p{};
    for (int i = 0; i < 19; ++i) p.in[i] = (const float*)d_in[i];
    p.out = (float*)d_out; p.ws = (unsigned char*)d_ws;
#if MK_ONE_LAUNCH
    p.ph_lo = 0; p.ph_hi = N_PHASES;
    void* args[] = {&p};
    hipError_t e = hipLaunchCooperativeKernel((const void*)hymba_fwd, dim3(grid), dim3(NTHREADS), args, LDS_BYTES, stream);
    if (e != hipSuccess) fprintf(stderr, "cooperative launch failed: %s (grid %d)\n", hipGetErrorString(e), grid);
#else
    for (int ph = 0; ph < N_PHASES; ++ph) { p.ph_lo = ph; p.ph_hi = ph + 1; hipLaunchKernelGGL(hymba_fwd, dim3(grid), dim3(NTHREADS), LDS_BYTES, stream, p); }
#endif
}
```

```cpp
#include <hip/hip_runtime.h>
#include <hip/hip_bf16.h>
#include <hip/hip_cooperative_groups.h>
#include <cstdio>
#include <cstdint>
#include <cmath>
namespace cg = cooperative_groups;
#ifndef MK_ONE_LAUNCH
#define MK_ONE_LAUNCH 1
#endif
namespace pg8 {
#define PG8_LAS __attribute__((address_space(3)))
typedef unsigned short bf16_t;
typedef short bf16x8 __attribute__((ext_vector_type(8)));
typedef float f32x4 __attribute__((ext_vector_type(4)));
typedef unsigned u32x4 __attribute__((ext_vector_type(4)));
constexpr int BM = 256, BK = 64, HALF = 128, HTB = HALF * BK * 2  , STAGE_BYTES = 8 * HTB, NXCD = 8, WGM = 8;

__host__ __device__ __forceinline__ int lds_byte(int r, int c) { const int st = (r >> 4) * 2 + (c >> 5), rr = r & 15, cc = c & 31, ob = rr * 64 + cc * 2; return st * 1024 + (ob ^ (((ob >> 9) & 1) << 5)); }
__host__ __device__ __forceinline__ void stage_rc(int b, int& R, int& C) { const int st = b / 1024, sb = b % 1024, swz = sb ^ (((sb >> 9) & 1) << 5); R = (st >> 1) * 16 + swz / 64; C = (st & 1) * 32 + (swz % 64) / 2; }
__host__ __device__ __forceinline__ int perm32(int rho) { const int n = rho >> 4, i = rho & 15; return 8 * (i >> 2) + 4 * n + (i & 3); }

struct Unit { int pm, pn; };
struct Gemm { const bf16_t* A; const bf16_t* Bt; int M, N, K; };

struct StaticOrder {
    int nM, nN, nwg, G, c;
    __host__ __device__ void init(int M, int N, int G_, int c_) { nM = M / BM; nN = N / BM; nwg = nM * nN; G = G_; c = c_; }
    __host__ __device__ bool next(int i, Unit& u) const {
        const long L = (long)i * G + c; if (L >= nwg) return false;
        int wgid = (int)L; { const int q = nwg / NXCD, r = nwg % NXCD, xcd = wgid % NXCD, off = wgid / NXCD; wgid = (xcd < r ? xcd * (q + 1) : r * (q + 1) + (xcd - r) * q) + off; }
        const int nig = WGM * nN, gid = wgid / nig, fm = gid * WGM, gsz = (nM - fm) < WGM ? (nM - fm) : WGM;
        u.pm = fm + ((wgid % nig) % gsz); u.pn = (wgid % nig) / gsz; return true;
    }
    __device__ __forceinline__ void a_ready(const Unit&) const {}
    __device__ __forceinline__ void done(const Unit&) const {}
};

__device__ __forceinline__ unsigned cvt_pk_bf16(float lo, float hi) { unsigned r; asm volatile("v_cvt_pk_bf16_f32 %0, %1, %2" : "=v"(r) : "v"(lo), "v"(hi)); return r; }
typedef float f32x2 __attribute__((ext_vector_type(2)));
template <class Epi, class Sched, bool ALIGN_EPI = false, bool SP2 = false>
__device__ __forceinline__ void gemm_phase(PG8_LAS unsigned char* lds, const Gemm g, const Sched& S, const Epi& E) {
    const int tid = threadIdx.x, wid = __builtin_amdgcn_readfirstlane(tid >> 6), lane = tid & 63, wr = wid >> 2, wc = wid & 3, fr = lane & 15, fq = lane >> 4;
    const int K = g.K, nt = K / BK;
    unsigned voffA[2], voffB[2];
#pragma unroll
    for (int i = 0; i < 2; ++i) { int R, C; stage_rc(tid * 16 + i * 8192, R, C); const int Rb = Epi::PERM ? ((R & ~31) + perm32(R & 31)) : R;
        voffA[i] = (unsigned)(R * K + C) * 2u; voffB[i] = (unsigned)(Rb * K + C) * 2u; }
    const size_t kstep = (size_t)(BK * 2);
    const size_t hstep = (size_t)HALF * K * 2;
    const size_t tstep = 2 * hstep;
    const unsigned ldsw = (unsigned)wid * 1024u;
    const int aoff = lds_byte(wr * 64 + fr, fq * 8), boff = lds_byte(wc * 32 + fr, fq * 8);
#define PG8_SA(b, h) (((b) * 2 + (h)) * HTB)
#define PG8_SB(b, h) ((4 + (b) * 2 + (h)) * HTB)
#define PG8_STAGE(bufoff, gbase, voff) do { _Pragma("unroll") for (int _i = 0; _i < 2; ++_i) \
        __builtin_amdgcn_global_load_lds((const unsigned*)((const char*)(gbase) + (voff)[_i]), (PG8_LAS unsigned*)(lds + (bufoff) + ldsw + _i * 8192), 16, 0, 0); } while (0)
#define PG8_LDA(dst, b, h) do { _Pragma("unroll") for (int m = 0; m < 4; ++m) _Pragma("unroll") for (int k = 0; k < 2; ++k) dst[m][k] = *(const PG8_LAS bf16x8*)(lds + PG8_SA(b, h) + aoff + m * 2048 + k * 1024); } while (0)
#define PG8_LDB(dst, b, h) do { _Pragma("unroll") for (int n = 0; n < 2; ++n) _Pragma("unroll") for (int k = 0; k < 2; ++k) dst[n][k] = *(const PG8_LAS bf16x8*)(lds + PG8_SB(b, h) + boff + n * 2048 + k * 1024); } while (0)
#define PG8_MMA(ai, bj, At, Bt) do { __builtin_amdgcn_s_setprio(1); _Pragma("unroll") for (int m = 0; m < 4; ++m) _Pragma("unroll") for (int n = 0; n < 2; ++n) _Pragma("unroll") for (int k = 0; k < 2; ++k) \
        acc[ai][bj][m][n] = __builtin_amdgcn_mfma_f32_16x16x32_bf16(Bt[n][k], At[m][k], acc[ai][bj][m][n], 0, 0, 0); __builtin_amdgcn_s_setprio(0); } while (0)
#define PG8_WAIT_V(n) asm volatile("s_waitcnt vmcnt(" #n ")" ::: "memory")
#define PG8_WAIT_L(n) asm volatile("s_waitcnt lgkmcnt(" #n ")" ::: "memory")
#define PG8_BAR __builtin_amdgcn_s_barrier()
#define PG8_SCHED __builtin_amdgcn_sched_barrier(0)
    Unit cur, nxt; int ui = 0;
    if (!S.next(0, cur)) return;
    f32x4 acc[2][2][4][2];
#pragma unroll
    for (int a = 0; a < 2; ++a)
#pragma unroll
        for (int b = 0; b < 2; ++b)
#pragma unroll
            for (int m = 0; m < 4; ++m)
#pragma unroll
                for (int n = 0; n < 2; ++n) acc[a][b][m][n] = (f32x4){0.f, 0.f, 0.f, 0.f};
    bf16x8 At[4][2], B0[2][2], B1[2][2];
    const char* cA = (const char*)g.A + (size_t)cur.pm * tstep; const char* cB = (const char*)g.Bt + (size_t)cur.pn * tstep;
    S.a_ready(cur);
    if constexpr (SP2) {
        PG8_STAGE(PG8_SB(0, 0), cB, voffB); PG8_STAGE(PG8_SB(0, 1), cB + hstep, voffB); PG8_STAGE(PG8_SA(0, 0), cA, voffA); PG8_STAGE(PG8_SA(0, 1), cA + hstep, voffA);
        if (wr == 1) PG8_BAR;
        PG8_WAIT_V(2); PG8_BAR;
        PG8_STAGE(PG8_SB(1, 0), cB + kstep, voffB); PG8_STAGE(PG8_SA(1, 0), cA + kstep, voffA); PG8_STAGE(PG8_SB(1, 1), cB + hstep + kstep, voffB);
        PG8_WAIT_V(6); PG8_BAR;
    } else {
        PG8_STAGE(PG8_SB(0, 0), cB, voffB); PG8_STAGE(PG8_SA(0, 0), cA, voffA); PG8_STAGE(PG8_SB(0, 1), cB + hstep, voffB); PG8_STAGE(PG8_SA(0, 1), cA + hstep, voffA);
        if (wr == 1) PG8_BAR;
        PG8_WAIT_V(4); PG8_BAR;
        PG8_STAGE(PG8_SB(1, 0), cB + kstep, voffB); PG8_STAGE(PG8_SA(1, 0), cA + kstep, voffA); PG8_STAGE(PG8_SB(1, 1), cB + hstep + kstep, voffB);
        PG8_WAIT_V(6); PG8_BAR;
    }
    for (;;) {
        const bool has_next = S.next(ui + 1, nxt);
        const char* nA = has_next ? (const char*)g.A + (size_t)nxt.pm * tstep : cA; const char* nB = has_next ? (const char*)g.Bt + (size_t)nxt.pn * tstep : cB;
        for (int t = 0; t < nt; t += 2) {
            const bool last = (t == nt - 2);
            const char* a1 = cA + (size_t)(t + 1) * kstep;
            const char* a2 = last ? nA : cA + (size_t)(t + 2) * kstep; const char* b2 = last ? nB : cB + (size_t)(t + 2) * kstep;
            const char* a3 = a2 + kstep; const char* b3 = b2 + kstep;
            if (last && has_next) S.a_ready(nxt);
            if constexpr (SP2) {
            PG8_LDB(B0, 0, 0); PG8_LDB(B1, 0, 1); PG8_SCHED; PG8_LDA(At, 0, 0); PG8_STAGE(PG8_SA(1, 1), a1 + hstep, voffA);
            PG8_WAIT_V(8); PG8_WAIT_L(0); PG8_BAR; PG8_MMA(0, 0, At, B0); PG8_MMA(0, 1, At, B1); PG8_BAR; PG8_SCHED;
            PG8_LDA(At, 0, 1); PG8_STAGE(PG8_SB(0, 0), b2, voffB); PG8_STAGE(PG8_SB(0, 1), b2 + hstep, voffB); PG8_STAGE(PG8_SA(0, 0), a2, voffA);
            PG8_WAIT_V(8); PG8_WAIT_L(0); PG8_BAR; PG8_MMA(1, 0, At, B0); PG8_MMA(1, 1, At, B1); PG8_BAR; PG8_SCHED;
            PG8_LDB(B0, 1, 0); PG8_LDB(B1, 1, 1); PG8_SCHED; PG8_LDA(At, 1, 0); PG8_STAGE(PG8_SA(0, 1), a2 + hstep, voffA);
            PG8_WAIT_V(8); PG8_WAIT_L(0); PG8_BAR; PG8_MMA(0, 0, At, B0); PG8_MMA(0, 1, At, B1); PG8_BAR; PG8_SCHED;
            PG8_LDA(At, 1, 1); PG8_STAGE(PG8_SB(1, 0), b3, voffB); PG8_STAGE(PG8_SB(1, 1), b3 + hstep, voffB); PG8_STAGE(PG8_SA(1, 0), a3, voffA);
            PG8_WAIT_V(8); PG8_WAIT_L(0); PG8_BAR; PG8_MMA(1, 0, At, B0); PG8_MMA(1, 1, At, B1); PG8_BAR; PG8_SCHED;
            } else {
            PG8_LDB(B0, 0, 0); PG8_SCHED; PG8_LDA(At, 0, 0); PG8_STAGE(PG8_SA(1, 1), a1 + hstep, voffA);
            PG8_WAIT_L(8); PG8_BAR; PG8_WAIT_L(0); PG8_MMA(0, 0, At, B0); PG8_BAR; PG8_SCHED;
            PG8_LDB(B1, 0, 1); PG8_STAGE(PG8_SB(0, 0), b2, voffB);
            PG8_BAR; PG8_WAIT_L(0); PG8_MMA(0, 1, At, B1); PG8_BAR;
            PG8_LDA(At, 0, 1); PG8_STAGE(PG8_SA(0, 0), a2, voffA);
            PG8_BAR; PG8_WAIT_L(0); PG8_MMA(1, 0, At, B0); PG8_BAR; PG8_SCHED;
            PG8_STAGE(PG8_SB(0, 1), b2 + hstep, voffB);
            PG8_WAIT_V(6); PG8_BAR; PG8_MMA(1, 1, At, B1); PG8_BAR;
            PG8_LDB(B0, 1, 0); PG8_SCHED; PG8_LDA(At, 1, 0); PG8_STAGE(PG8_SA(0, 1), a2 + hstep, voffA);
            PG8_WAIT_L(8); PG8_BAR; PG8_WAIT_L(0); PG8_MMA(0, 0, At, B0); PG8_BAR; PG8_SCHED;
            PG8_LDB(B1, 1, 1); PG8_STAGE(PG8_SB(1, 0), b3, voffB);
            PG8_BAR; PG8_WAIT_L(0); PG8_MMA(0, 1, At, B1); PG8_BAR;
            PG8_LDA(At, 1, 1); PG8_STAGE(PG8_SA(1, 0), a3, voffA);
            PG8_BAR; PG8_WAIT_L(0); PG8_MMA(1, 0, At, B0); PG8_BAR; PG8_SCHED;
            PG8_STAGE(PG8_SB(1, 1), b3 + hstep, voffB);
            PG8_WAIT_V(6); PG8_BAR; PG8_MMA(1, 1, At, B1); PG8_BAR;
            }
        }
        if constexpr (ALIGN_EPI) { if (wr == 0) PG8_BAR; }
        if constexpr (!Epi::AFTER_DRAIN) { E(acc, cur, wr, wc, fr, fq); S.done(cur); }
        if (!has_next) break;
#pragma unroll
        for (int a = 0; a < 2; ++a)
#pragma unroll
            for (int b = 0; b < 2; ++b)
#pragma unroll
                for (int m = 0; m < 4; ++m)
#pragma unroll
                    for (int n = 0; n < 2; ++n) acc[a][b][m][n] = (f32x4){0.f, 0.f, 0.f, 0.f};
        cur = nxt; cA = nA; cB = nB; ++ui;
        if constexpr (ALIGN_EPI) { if (wr == 1) PG8_BAR; }
    }
    PG8_WAIT_V(0);
    if constexpr (!ALIGN_EPI) { if (wr == 0) PG8_BAR; }
    PG8_BAR;
    if constexpr (Epi::AFTER_DRAIN) { E.fused(acc, cur, wr, wc, fr, fq, lds, wid, lane); S.done(cur); }
#undef PG8_SA
#undef PG8_SB
#undef PG8_STAGE
#undef PG8_LDA
#undef PG8_LDB
#undef PG8_MMA
#undef PG8_WAIT_V
#undef PG8_WAIT_L
#undef PG8_BAR
#undef PG8_SCHED
}
}

#define LAS __attribute__((address_space(3)))
typedef unsigned short bf16_t;
typedef short bf16x8 __attribute__((ext_vector_type(8)));
typedef short bf16x4 __attribute__((ext_vector_type(4)));
typedef float f32x4 __attribute__((ext_vector_type(4)));
typedef float f32x16 __attribute__((ext_vector_type(16)));
typedef unsigned u32x4 __attribute__((ext_vector_type(4)));
typedef unsigned u32x2 __attribute__((ext_vector_type(2)));
typedef __bf16 bf16x2_t __attribute__((ext_vector_type(2)));

constexpr int NB = 16, SEQ = 2048, T = NB * SEQ, D = 1024;
constexpr int PP = 4608;
constexpr int C_Q = 0, C_KF = 512, C_LFF = 1024, C_KB = 1536, C_LFB = 2048, C_V = 2560, C_G = 3072, C_DQ = 3584, C_DK = 4096;
constexpr float EPS = 1e-6f;
constexpr float LOG2E = 1.4426950408889634f;
constexpr int NWAVES = 8, NTHREADS = 512;
constexpr int NGRP = 4, GRP_SHIFT = 12, GRP_SIZE = 4096, VSL = 128, NVS = 4;
constexpr int LDS_BYTES = 147456;

constexpr size_t MiB = (size_t)1 << 20;
constexpr size_t WS_SM = 64 * 1024;
constexpr size_t WS_WINT = 2 * MiB, WS_WOT = 10 * MiB, WS_WQT = 12 * MiB, WS_KEYS = 16 * MiB;
constexpr size_t WS_UT = 32 * MiB, WS_USC = 48 * MiB, WS_VSC = 49 * MiB, WS_VE = 64 * MiB, WS_XN = 96 * MiB, WS_PROJ = 160 * MiB, WS_VT = 448 * MiB, WS_END = 480 * MiB;
constexpr size_t WS_H1B = 160 * MiB, WS_QP = 224 * MiB, WS_IDX = 360 * MiB, WS_GATE = 376 * MiB, WS_SS = 392 * MiB, WS_C = 394 * MiB;
constexpr int QPS = 2048 + 64;
constexpr size_t WS_US8 = 48 * MiB + 131072;
constexpr size_t WS_H1Q = 96 * MiB, WS_HSC = 128 * MiB;
constexpr int SM_LBF = 0, SM_LBB = 512, SM_LAM = 1024, SM_BT = 2048, BT_STRIDE = 260;

struct Params { const float* in[19]; float* out; unsigned char* ws; int ph_lo, ph_hi; };
enum { I_X = 0, I_G1, I_WIN, I_LBF, I_LBB, I_HOG, I_LQ1, I_LK1, I_LQ2, I_LK2, I_DOG, I_RB, I_WOUT, I_G2, I_WQ, I_KEYS, I_U, I_V, I_FG };

#define LDS_WAIT() asm volatile("s_waitcnt lgkmcnt(0)" ::: "memory")
__device__ __forceinline__ unsigned f2bf(float f) { unsigned u = __builtin_bit_cast(unsigned, f); return (u + 0x7fffu + ((u >> 16) & 1u)) >> 16; }
typedef float f32x2v_ __attribute__((ext_vector_type(2)));
__device__ __forceinline__ unsigned pk2(float lo, float hi) { const f32x2v_ v = {lo, hi}; return __builtin_bit_cast(unsigned, __builtin_convertvector(v, bf16x2_t)); }
__device__ __forceinline__ float bflo(unsigned w) { return __uint_as_float(w << 16); }
__device__ __forceinline__ float bfhi(unsigned w) { return __uint_as_float(w & 0xffff0000u); }
template <int CTRL> __device__ __forceinline__ float dpp_mov(float v) { return __builtin_bit_cast(float, __builtin_amdgcn_update_dpp(0, __builtin_bit_cast(int, v), CTRL, 0xF, 0xF, false)); }
__device__ __forceinline__ void swap16_(float& a, float& b) { asm volatile("s_nop 1\n\tv_permlane16_swap_b32 %0, %1\n\ts_nop 1" : "+v"(a), "+v"(b)); }
__device__ __forceinline__ void swap32_(float& a, float& b) { asm volatile("s_nop 1\n\tv_permlane32_swap_b32 %0, %1\n\ts_nop 1" : "+v"(a), "+v"(b)); }
__device__ __forceinline__ void swap16i_(int& a, int& b) { asm volatile("s_nop 1\n\tv_permlane16_swap_b32 %0, %1\n\ts_nop 1" : "+v"(a), "+v"(b)); }
__device__ __forceinline__ void swap32i_(int& a, int& b) { asm volatile("s_nop 1\n\tv_permlane32_swap_b32 %0, %1\n\ts_nop 1" : "+v"(a), "+v"(b)); }
__device__ __forceinline__ float swap16_sum(float v) { float a = v, b = v; swap16_(a, b); return a + b; }
__device__ __forceinline__ float swap32_sum(float v) { float a = v, b = v; swap32_(a, b); return a + b; }
__device__ __forceinline__ float swap16_max(float v) { float a = v, b = v; swap16_(a, b); return fmaxf(a, b); }
__device__ __forceinline__ float swap32_max(float v) { float a = v, b = v; swap32_(a, b); return fmaxf(a, b); }
__device__ __forceinline__ float xchg16(float v, int lane) { float a = v, b = v; swap16_(a, b); return (lane & 16) ? a : b; }
__device__ __forceinline__ float xchg32(float v, int lane) { float a = v, b = v; swap32_(a, b); return (lane & 32) ? a : b; }
__device__ __forceinline__ float wave_sum(float v) {
    v += dpp_mov<0xB1>(v); v += dpp_mov<0x4E>(v); v += dpp_mov<0x141>(v); v += dpp_mov<0x140>(v);
    return swap32_sum(swap16_sum(v));
}
__device__ __forceinline__ float wave_max(float v) {
    v = fmaxf(v, dpp_mov<0xB1>(v)); v = fmaxf(v, dpp_mov<0x4E>(v)); v = fmaxf(v, dpp_mov<0x141>(v)); v = fmaxf(v, dpp_mov<0x140>(v));
    return swap32_max(swap16_max(v));
}
__device__ __forceinline__ float sigmoidf_(float z) { return __builtin_amdgcn_rcpf(1.0f + __expf(-z)); }

__device__ __forceinline__ void p0_transpose_item(const float* W, int K, int N, bf16_t* WT, const float* kscale, LAS float* scr, int item, int lane) {
    const int nblk = N / 32, kb = item / nblk, nb = item % nblk, k0 = 64 * kb, n0 = 32 * nb;
#pragma unroll 8
    for (int i = 0; i < 32; ++i) { const int kk = 2 * i + (lane >> 5); float w = W[(size_t)(k0 + kk) * N + n0 + (lane & 31)]; if (kscale) w *= kscale[k0 + kk]; scr[kk * 33 + (lane & 31)] = w; }
    LDS_WAIT(); asm volatile("" ::: "memory");
    const int c = lane & 7;
#pragma unroll
    for (int j = 0; j < 4; ++j) { const int n = (lane >> 3) + 8 * j; const LAS float* s = scr + (8 * c) * 33 + n;
        u32x4 o; o.x = pk2(s[0 * 33], s[1 * 33]); o.y = pk2(s[2 * 33], s[3 * 33]); o.z = pk2(s[4 * 33], s[5 * 33]); o.w = pk2(s[6 * 33], s[7 * 33]);
        *(u32x4*)(WT + (size_t)(n0 + n) * K + k0 + 8 * c) = o; }
    LDS_WAIT(); asm volatile("" ::: "memory");
}
__device__ __forceinline__ int t5_bucket(int rel) {
    const int n = rel < 0 ? -rel : rel;
    const int v = n < 8 ? n : n < 12 ? 8 : n < 16 ? 9 : n < 23 ? 10 : n < 32 ? 11 : n < 46 ? 12 : n < 64 ? 13 : n < 91 ? 14 : 15;
    return (rel > 0 ? 16 : 0) + v;
}
__device__ __forceinline__ void phase_prep(const Params& p, LAS unsigned char* lds, int vcu, int G) {
    const int tid = threadIdx.x, lane = tid & 63, wave = __builtin_amdgcn_readfirstlane(tid >> 6);
    unsigned char* ws = p.ws;
    LAS float* scr = (LAS float*)(lds + wave * 16384);
    const int gw = vcu * NWAVES + wave, NGW = G * NWAVES;
    constexpr int I_IN = (D / 64) * (4096 / 32), I_OUT = (D / 64) * (D / 32), I_QW = (D / 64) * (2048 / 32);
    for (int it = gw; it < I_IN + I_OUT + I_QW; it += NGW) {
        int r = it;
        if (r < I_IN) { p0_transpose_item(p.in[I_WIN], D, 4096, (bf16_t*)(ws + WS_WINT), nullptr, scr, r, lane); continue; } r -= I_IN;
        if (r < I_OUT) { p0_transpose_item(p.in[I_WOUT], D, D, (bf16_t*)(ws + WS_WOT), nullptr, scr, r, lane); continue; } r -= I_OUT;
        p0_transpose_item(p.in[I_WQ], D, 2048, (bf16_t*)(ws + WS_WQT), p.in[I_G2], scr, r, lane);
    }
    for (int i = blockIdx.x * NTHREADS + tid; i < 8 * 2 * 128 * 128 / 4; i += G * NTHREADS) {
        const f32x4 v = ((const f32x4*)p.in[I_KEYS])[i];
        ((u32x2*)(ws + WS_KEYS))[i] = (u32x2){pk2(v.x, v.y), pk2(v.z, v.w)};
    }
#define PX_LOAD(dst, m0_) { _Pragma("unroll") for (int u = 0; u < 4; ++u) { const int m = ((m0_) + u * NGW) < T ? ((m0_) + u * NGW) : gw; const f32x4* xr = (const f32x4*)(p.in[I_X] + (size_t)m * D) + lane; \
            _Pragma("unroll") for (int j = 0; j < 4; ++j) dst[u][j] = xr[64 * j]; } }
#define PX_PROC(src, m0_) { _Pragma("unroll") for (int u = 0; u < 4; ++u) { const int m = (m0_) + u * NGW; if (m < T) { float ssq = 0.f; \
            _Pragma("unroll") for (int j = 0; j < 4; ++j) ssq += (src[u][j].x * src[u][j].x + src[u][j].y * src[u][j].y) + (src[u][j].z * src[u][j].z + src[u][j].w * src[u][j].w); \
            const float rs = rsqrtf(wave_sum(ssq) * (1.f / D) + EPS); unsigned long long* o8 = (unsigned long long*)((bf16_t*)(ws + WS_XN) + (size_t)m * D) + lane; \
            _Pragma("unroll") for (int j = 0; j < 4; ++j) { const f32x4 y = src[u][j] * rs * ((const f32x4*)p.in[I_G1])[64 * j + lane]; o8[64 * j] = (unsigned long long)pk2(y.x, y.y) | ((unsigned long long)pk2(y.z, y.w) << 32); } } } }
    {
        f32x4 va[4][4], vb[4][4];
        PX_LOAD(va, gw)
        for (int m0 = gw; m0 < T; m0 += 8 * NGW) {
            if (m0 + 4 * NGW < T) PX_LOAD(vb, m0 + 4 * NGW)
            PX_PROC(va, m0)
            if (m0 + 8 * NGW < T) PX_LOAD(va, m0 + 8 * NGW)
            PX_PROC(vb, m0 + 4 * NGW)
        }
    }
    if (blockIdx.x == 0) {
        float* sm = (float*)(ws + WS_SM);
        { const float* a = p.in[I_LBF]; sm[SM_LBF + tid] = 1.f / (1.f + __expf(a[512 + tid] - a[tid])); }
        { const float* a = p.in[I_LBB]; sm[SM_LBB + tid] = 1.f / (1.f + __expf(a[512 + tid] - a[tid])); }
        if (tid < 64) {
            float a = p.in[I_LQ1][tid] * p.in[I_LK1][tid], b = p.in[I_LQ2][tid] * p.in[I_LK2][tid];
            a = wave_sum(a); b = wave_sum(b);
            if (tid == 0) sm[SM_LAM] = __expf(a) - __expf(b) + 0.2f;
        }
        for (int i = tid; i < 4 * 257; i += NTHREADS) { const int h = i / 257, r = i % 257; sm[SM_BT + h * BT_STRIDE + r] = p.in[I_RB][t5_bucket(r - 128) * 4 + h] * LOG2E; }
    }
}

__device__ __forceinline__ float silu_(float x) { return x * __builtin_amdgcn_rcpf(1.0f + __expf(-x)); }
struct EpiInProj {
    static constexpr bool PERM = true, AFTER_DRAIN = false;
    bf16_t* P; const float* sm;
    __device__ __forceinline__ void st8(bf16_t* dst, const float (&y)[8]) const { u32x4 w; w.x = pk2(y[0], y[1]); w.y = pk2(y[2], y[3]); w.z = pk2(y[4], y[5]); w.w = pk2(y[6], y[7]); *(u32x4*)dst = w; }
    __device__ __forceinline__ void operator()(const f32x4 (&acc)[2][2][4][2], const pg8::Unit& u, int wr, int wc, int fr, int fq) const {
        const int seg = u.pn >> 1;
        const int row0 = u.pm * 256 + wr * 64 + fr;
        const int cs0 = (u.pn & 1) * 256 + wc * 32 + 8 * fq;
#pragma unroll
        for (int bj = 0; bj < 2; ++bj) {
            const int cs = cs0 + bj * 128;
            float lb[8] = {0.f, 0.f, 0.f, 0.f, 0.f, 0.f, 0.f, 0.f};
            if (seg == 1 || seg == 2) {
#pragma unroll
                for (int i = 0; i < 8; ++i) lb[i] = sm[(seg == 1 ? SM_LBF : SM_LBB) + cs + i];
            }
#pragma unroll
            for (int ai = 0; ai < 2; ++ai)
#pragma unroll
                for (int m = 0; m < 4; ++m) {
                    const size_t row = (size_t)(row0 + ai * 128 + m * 16);
                    bf16_t* rp = P + row * PP + cs;
                    float x[8];
#pragma unroll
                    for (int i = 0; i < 4; ++i) { x[i] = acc[ai][bj][m][0][i]; x[4 + i] = acc[ai][bj][m][1][i]; }
                    float y[8];
                    if (seg == 0 || seg == 4) {
#pragma unroll
                        for (int i = 0; i < 8; ++i) y[i] = silu_(x[i]);
                        st8(rp + (seg == 0 ? C_Q : C_G), y);
                    } else if (seg == 1 || seg == 2) {
                        float lf[8];
#pragma unroll
                        for (int i = 0; i < 8; ++i) { const float s = sigmoidf_(x[i]); const float k = (1.f - lb[i]) * (1.f - s); y[i] = k; lf[i] = __logf(1.f - k); }
                        st8(rp + (seg == 1 ? C_KF : C_KB), y);
                        st8(rp + (seg == 1 ? C_LFF : C_LFB), lf);
                    } else if (seg == 3) {
                        st8(rp + C_V, x);
                    } else if (seg == 5) {
#pragma unroll
                        for (int i = 0; i < 8; ++i) y[i] = x[i] * (0.125f * LOG2E);
                        st8(rp + C_DQ, y);
                    } else {
                        st8(rp + C_DK, x);
                    }
                }
        }
    }
};
struct EpiStore {
    static constexpr bool PERM = true, AFTER_DRAIN = false;
    bf16_t* O; int ldc;
    __device__ __forceinline__ void operator()(const f32x4 (&acc)[2][2][4][2], const pg8::Unit& u, int wr, int wc, int fr, int fq) const {
        const int row0 = u.pm * 256 + wr * 64 + fr, col0 = u.pn * 256 + wc * 32 + 8 * fq;
#pragma unroll
        for (int ai = 0; ai < 2; ++ai)
#pragma unroll
            for (int m = 0; m < 4; ++m)
#pragma unroll
                for (int bj = 0; bj < 2; ++bj) {
                    const f32x4 a = acc[ai][bj][m][0], b = acc[ai][bj][m][1];
                    u32x4 w; w.x = pk2(a[0], a[1]); w.y = pk2(a[2], a[3]); w.z = pk2(b[0], b[1]); w.w = pk2(b[2], b[3]);
                    *(u32x4*)(O + (size_t)(row0 + ai * 128 + m * 16) * ldc + col0 + bj * 128) = w;
                }
    }
};
struct EpiOutProj {
    static constexpr bool PERM = true, AFTER_DRAIN = false;
    const float* x; float* H1; bf16_t* H1B; float* SS;
    __device__ __forceinline__ void operator()(const f32x4 (&acc)[2][2][4][2], const pg8::Unit& u, int wr, int wc, int fr, int fq) const {
        const int row0 = u.pm * 256 + wr * 64 + fr, col0 = u.pn * 256 + wc * 32 + 8 * fq;
#pragma unroll
        for (int ai = 0; ai < 2; ++ai)
#pragma unroll
            for (int m = 0; m < 4; ++m) {
                const size_t row = (size_t)(row0 + ai * 128 + m * 16);
                float ss = 0.f;
#pragma unroll
                for (int bj = 0; bj < 2; ++bj) {
                    const size_t off = row * D + col0 + bj * 128;
                    const f32x4 a = *(const f32x4*)(x + off) + acc[ai][bj][m][0], b = *(const f32x4*)(x + off + 4) + acc[ai][bj][m][1];
                    u32x4 w; w.x = pk2(a[0], a[1]); w.y = pk2(a[2], a[3]); w.z = pk2(b[0], b[1]); w.w = pk2(b[2], b[3]);
                    *(u32x4*)(H1B + off) = w;
                    ss += (a[0] * a[0] + a[1] * a[1]) + (a[2] * a[2] + a[3] * a[3]) + (b[0] * b[0] + b[1] * b[1]) + (b[2] * b[2] + b[3] * b[3]);
                }
                ss += __shfl_xor(ss, 16); ss += __shfl_xor(ss, 32);
                if (fq == 0) SS[row * 16 + u.pn * 4 + wc] = ss;
            }
    }
};
__device__ __forceinline__ float row_rstd(const float* SS, size_t row) {
    const f32x4* s = (const f32x4*)(SS + row * 16);
    const f32x4 a = s[0], b = s[1], c = s[2], d = s[3];
    const float t = ((a[0] + a[1]) + (a[2] + a[3])) + ((b[0] + b[1]) + (b[2] + b[3])) + ((c[0] + c[1]) + (c[2] + c[3])) + ((d[0] + d[1]) + (d[2] + d[3]));
    return rsqrtf(t * (1.f / D) + EPS);
}
struct EpiQ {
    static constexpr bool PERM = true, AFTER_DRAIN = false;
    bf16_t* O; const float* SS; float* RSTD;
    __device__ __forceinline__ void operator()(const f32x4 (&acc)[2][2][4][2], const pg8::Unit& u, int wr, int wc, int fr, int fq) const {
        const int row0 = u.pm * 256 + wr * 64 + fr, col0 = u.pn * 256 + wc * 32 + 8 * fq;
#pragma unroll
        for (int ai = 0; ai < 2; ++ai)
#pragma unroll
            for (int m = 0; m < 4; ++m) {
                const size_t row = (size_t)(row0 + ai * 128 + m * 16);
                const float rs = row_rstd(SS, row);
                if (u.pn == 0 && wc == 0 && fq == 0) RSTD[row] = rs;
#pragma unroll
                for (int bj = 0; bj < 2; ++bj) {
                    const f32x4 a = acc[ai][bj][m][0] * rs, b = acc[ai][bj][m][1] * rs;
                    u32x4 w; w.x = pk2(a[0], a[1]); w.y = pk2(a[2], a[3]); w.z = pk2(b[0], b[1]); w.w = pk2(b[2], b[3]);
                    *(u32x4*)(O + row * QPS + col0 + bj * 128) = w;
                }
            }
    }
};

constexpr int HQ_STRIDE = 272, HT_STRIDE = 48;
constexpr int H_QA = 0, H_KD = 4352, H_KH = 8704, H_VT = 14848, H_DEC = 20992, H_OPER = 21504, H_RAW = 2 * H_OPER, H_RAWB = 16384;
constexpr size_t HG_DONE_OFF = 32768 + 256;
__device__ __forceinline__ void phase_hgrn(const Params& p, LAS unsigned char* lds, int G) {
    const int tid = threadIdx.x, lane = tid & 63, wave = __builtin_amdgcn_readfirstlane(tid >> 6), fr = lane & 15, g = lane >> 4;
    const bf16_t* PROJ = (const bf16_t*)(p.ws + WS_PROJ);
    const int NCH = SEQ / 16;
    for (int item = blockIdx.x; item < 128; item += G) {
        const int dir = item & 1, h = (item >> 1) & 3, b = item >> 3;
        bf16_t* O = (bf16_t*)p.out + (size_t)dir * T * 512;
        const int ck = dir ? C_KB : C_KF, cl = dir ? C_LFB : C_LFF;
        const bool isv = tid >= 256; const int arow = (tid & 255) >> 4, ac8 = (tid & 15) * 8;
        u32x4 rq = (u32x4){0u, 0u, 0u, 0u}, rk = rq, rl = rq;
#define HG_GLOAD(ch) do { const int pos_ = (ch) * 16 + arow, tr_ = dir ? SEQ - 1 - pos_ : pos_; \
            const bf16_t* rp_ = PROJ + (size_t)(b * SEQ + tr_) * PP + h * 128 + ac8; \
            if (isv) { rq = *(const u32x4*)(rp_ + C_V); } else { rq = *(const u32x4*)(rp_ + C_Q); rk = *(const u32x4*)(rp_ + ck); rl = *(const u32x4*)(rp_ + cl); } } while (0)
#define HG_RAWSTORE(par) do { LAS unsigned char* R_ = lds + H_RAW + (par) * H_RAWB + arow * 256 + ac8 * 2; \
            if (isv) { *(LAS u32x4*)(R_ + 12288) = rq; } else { *(LAS u32x4*)R_ = rq; *(LAS u32x4*)(R_ + 4096) = rk; *(LAS u32x4*)(R_ + 8192) = rl; } } while (0)
        const int pc = tid & 127, part = tid >> 7;
        auto phaseB = [&](int par) {
            const LAS unsigned char* R = lds + H_RAW + par * H_RAWB; LAS unsigned char* OP = lds + par * H_OPER;
            float pre = 0.f, total = 0.f;
#pragma unroll
            for (int t = 0; t < 16; ++t) { const float v = __uint_as_float((unsigned)(*(const LAS unsigned short*)(R + 8192 + t * 256 + pc * 2)) << 16); total += v; pre += (t < 4 * part) ? v : 0.f; }
            float bb = pre; float kh[4], vv[4];
#pragma unroll
            for (int j = 0; j < 4; ++j) {
                const int t = 4 * part + j;
                const float lfv = __uint_as_float((unsigned)(*(const LAS unsigned short*)(R + 8192 + t * 256 + pc * 2)) << 16);
                const float qv = __uint_as_float((unsigned)(*(const LAS unsigned short*)(R + t * 256 + pc * 2)) << 16);
                const float kv = __uint_as_float((unsigned)(*(const LAS unsigned short*)(R + 4096 + t * 256 + pc * 2)) << 16);
                vv[j] = __uint_as_float((unsigned)(*(const LAS unsigned short*)(R + 12288 + t * 256 + pc * 2)) << 16);
                bb += lfv;
                *(LAS unsigned short*)(OP + H_QA + t * HQ_STRIDE + pc * 2) = (unsigned short)f2bf(qv * __expf(bb));
                *(LAS unsigned short*)(OP + H_KD + t * HQ_STRIDE + pc * 2) = (unsigned short)f2bf(kv * __expf(-bb));
                kh[j] = kv * __expf(total - bb);
            }
            *(LAS u32x2*)(OP + H_KH + pc * HT_STRIDE + part * 8) = (u32x2){pk2(kh[0], kh[1]), pk2(kh[2], kh[3])};
            *(LAS u32x2*)(OP + H_VT + pc * HT_STRIDE + part * 8) = (u32x2){pk2(vv[0], vv[1]), pk2(vv[2], vv[3])};
            if (part == 0) *(LAS float*)(OP + H_DEC + pc * 4) = __expf(total);
        };
        f32x4 S[8];
#pragma unroll
        for (int kt = 0; kt < 8; ++kt) S[kt] = (f32x4){0.f, 0.f, 0.f, 0.f};
        __syncthreads();
        HG_GLOAD(0); HG_RAWSTORE(0); HG_GLOAD(1);
        __syncthreads();
        phaseB(0); HG_RAWSTORE(1);
        __syncthreads();
        for (int i = 0; i < NCH; ++i) {
            if (i + 2 < NCH) HG_GLOAD(i + 2);
            if (i + 1 < NCH) phaseB((i + 1) & 1);
            {
                const LAS unsigned char* OP = lds + (i & 1) * H_OPER;
                f32x4 o = (f32x4){0.f, 0.f, 0.f, 0.f};
#pragma unroll
                for (int j = 0; j < 4; ++j) {
                    u32x4 w; w.x = pk2(S[2 * j][0], S[2 * j][1]); w.y = pk2(S[2 * j][2], S[2 * j][3]); w.z = pk2(S[2 * j + 1][0], S[2 * j + 1][1]); w.w = pk2(S[2 * j + 1][2], S[2 * j + 1][3]);
                    const u32x2 a0 = *(const LAS u32x2*)(OP + H_QA + fr * HQ_STRIDE + (32 * j + 4 * g) * 2), a1 = *(const LAS u32x2*)(OP + H_QA + fr * HQ_STRIDE + (32 * j + 16 + 4 * g) * 2);
                    o = __builtin_amdgcn_mfma_f32_16x16x32_bf16(__builtin_bit_cast(bf16x8, (u32x4){a0.x, a0.y, a1.x, a1.y}), __builtin_bit_cast(bf16x8, w), o, 0, 0, 0);
                }
                f32x4 X = (f32x4){0.f, 0.f, 0.f, 0.f};
#pragma unroll
                for (int j = 0; j < 4; ++j) {
                    const bf16x8 ak = *(const LAS bf16x8*)(OP + H_KD + fr * HQ_STRIDE + (32 * j + 8 * g) * 2), bq = *(const LAS bf16x8*)(OP + H_QA + fr * HQ_STRIDE + (32 * j + 8 * g) * 2);
                    X = __builtin_amdgcn_mfma_f32_16x16x32_bf16(ak, bq, X, 0, 0, 0);
                }
#pragma unroll
                for (int r = 0; r < 4; ++r) X[r] = (4 * g + r > fr) ? 0.f : X[r];
                const u32x2 vlo = *(const LAS u32x2*)(OP + H_VT + (16 * wave + fr) * HT_STRIDE + g * 8);
                const bf16x8 vb = __builtin_bit_cast(bf16x8, (u32x4){vlo.x, vlo.y, 0u, 0u});
                const bf16x8 pa = __builtin_bit_cast(bf16x8, (u32x4){pk2(X[0], X[1]), pk2(X[2], X[3]), 0u, 0u});
                o = __builtin_amdgcn_mfma_f32_16x16x32_bf16(pa, vb, o, 0, 0, 0);
#pragma unroll
                for (int r = 0; r < 4; ++r) { const int pos = i * 16 + 4 * g + r, tr = dir ? SEQ - 1 - pos : pos; O[(size_t)(b * SEQ + tr) * 512 + h * 128 + 16 * wave + fr] = (bf16_t)f2bf(o[r]); }
#pragma unroll
                for (int kt = 0; kt < 8; ++kt) {
                    const f32x4 dc = *(const LAS f32x4*)(OP + H_DEC + (16 * kt + 4 * g) * 4);
                    const u32x2 klo = *(const LAS u32x2*)(OP + H_KH + (16 * kt + fr) * HT_STRIDE + g * 8);
                    S[kt] = __builtin_amdgcn_mfma_f32_16x16x32_bf16(__builtin_bit_cast(bf16x8, (u32x4){klo.x, klo.y, 0u, 0u}), vb, S[kt] * dc, 0, 0, 0);
                }
            }
            if (i + 2 < NCH) HG_RAWSTORE(i & 1);
            __syncthreads();
        }
        asm volatile("s_waitcnt vmcnt(0)" ::: "memory");
        __syncthreads();
        if (tid == 0) { __builtin_amdgcn_fence(__ATOMIC_RELEASE, "agent"); asm volatile("s_waitcnt vmcnt(0)" ::: "memory");
            (void)__hip_atomic_fetch_add((unsigned*)(p.ws + HG_DONE_OFF), 1u, __ATOMIC_RELAXED, __HIP_MEMORY_SCOPE_AGENT); }
    }
}

constexpr int KT_STRIDE = 272, VT_STRIDE = 144;
constexpr int ATT_BUF = 64 * KT_STRIDE + 128 * VT_STRIDE;
constexpr int QUANT_ITEMS = 256;
__device__ __forceinline__ void quant_tables(const Params& p, int gw, int NGW, int lane) {
    unsigned char* ws = p.ws;
#define PQ_LOAD(dst, r0_) { _Pragma("unroll") for (int u = 0; u < 4; ++u) { const int r = ((r0_) + u * NGW) < 2 * 16384 ? ((r0_) + u * NGW) : gw; const bool isv = r >= 16384; const int e = isv ? r - 16384 : r; \
            const f32x4* xr = (const f32x4*)((isv ? p.in[I_V] : p.in[I_U]) + (size_t)e * D) + lane; _Pragma("unroll") for (int j = 0; j < 4; ++j) dst[u][j] = xr[64 * j]; } }
#define PQ_PROC(src, r0_) { _Pragma("unroll") for (int u = 0; u < 4; ++u) { const int r = (r0_) + u * NGW; if (r < 2 * 16384) { \
            const bool isv = r >= 16384; const int e = isv ? r - 16384 : r; f32x4 v[4]; float am = 0.f; \
            _Pragma("unroll") for (int j = 0; j < 4; ++j) { v[j] = src[u][j]; if (!isv) v[j] = v[j] * ((const f32x4*)p.in[I_G2])[64 * j + lane]; \
                am = fmaxf(am, fmaxf(fmaxf(fabsf(v[j].x), fabsf(v[j].y)), fmaxf(fabsf(v[j].z), fabsf(v[j].w)))); } \
            am = wave_max(am); const float sc = am > 0.f ? am * (1.f / 7.f) : 1.f, inv = 1.f / sc; unsigned pk[4]; int qs = 0; \
            _Pragma("unroll") for (int j = 0; j < 4; ++j) { \
                const int q0 = (int)rintf(v[j].x * inv), q1 = (int)rintf(v[j].y * inv), q2 = (int)rintf(v[j].z * inv), q3 = (int)rintf(v[j].w * inv); qs += (q0 + q1) + (q2 + q3); \
                pk[j] = (unsigned)((q0 & 0xFF) | ((q1 & 0xFF) << 8) | ((q2 & 0xFF) << 16) | ((q3 & 0xFF) << 24)); } \
            if (isv) {   \
                _Pragma("unroll") for (int j = 0; j < 4; ++j) { const unsigned k_ = pk[j]; \
                    *(unsigned short*)(ws + WS_VE + ((size_t)j * 16384 + e) * VSL + 2 * lane) = (unsigned short)(((k_ & 0xFu) ^ 8u) | ((k_ >> 4) & 0xF0u) | ((((k_ >> 16) & 0xFu) ^ 8u) << 8) | ((k_ >> 12) & 0xF000u)); } \
                if (lane == 0) ((float*)(ws + WS_VSC))[e] = sc; } \
            else {   \
                _Pragma("unroll") for (int j = 0; j < 2; ++j) *(unsigned*)(ws + WS_UT + (size_t)e * 512 + 256 * j + 4 * lane) = (pk[j] & 0x0F0F0F0Fu) | ((pk[j + 2] << 4) & 0xF0F0F0F0u); \
                const float qt = wave_sum((float)qs); if (lane == 0) { ((float*)(ws + WS_USC))[e] = sc; ((float*)(ws + WS_US8))[e] = 8.f * qt; } } } } }
    for (int r0 = gw; r0 < 2 * 16384; r0 += 4 * NGW) { f32x4 va[4][4]; PQ_LOAD(va, r0) PQ_PROC(va, r0) }
}
constexpr int MIX_ITEMS = 256;
__device__ __forceinline__ void mix_rows(const Params& p, int gw, int NGW, int lane) {
    const bf16_t* PROJ = (const bf16_t*)(p.ws + WS_PROJ);
    const bf16_t* OF = (const bf16_t*)p.out; const bf16_t* OB = OF + (size_t)T * 512;
    bf16_t* MIXED = (bf16_t*)(p.ws + WS_XN);
    const float* hog = p.in[I_HOG];
    const f32x4 g0 = *(const f32x4*)(hog + (lane & 15) * 8), g1 = *(const f32x4*)(hog + (lane & 15) * 8 + 4);
    for (int m0 = gw; m0 < T; m0 += 4 * NGW) {
        u32x4 av[4], bv[4], gv[4];
#pragma unroll
        for (int u = 0; u < 4; ++u) { const int m = (m0 + u * NGW) < T ? (m0 + u * NGW) : m0;
            av[u] = *(const u32x4*)(OF + (size_t)m * 512 + 8 * lane); bv[u] = *(const u32x4*)(OB + (size_t)m * 512 + 8 * lane); gv[u] = *(const u32x4*)(PROJ + (size_t)m * PP + C_G + 8 * lane); }
#pragma unroll
        for (int u = 0; u < 4; ++u) {
            const int m = m0 + u * NGW; if (m >= T) break;
            const u32x4 a = av[u], bb = bv[u], gg = gv[u];
            float o[8]; float ss = 0.f;
#pragma unroll
            for (int i = 0; i < 4; ++i) { o[2 * i] = bflo(a[i]) + bflo(bb[i]); o[2 * i + 1] = bfhi(a[i]) + bfhi(bb[i]); ss += o[2 * i] * o[2 * i] + o[2 * i + 1] * o[2 * i + 1]; }
            ss += dpp_mov<0xB1>(ss); ss += dpp_mov<0x4E>(ss); ss += dpp_mov<0x141>(ss); ss += dpp_mov<0x140>(ss);
            const float rs = rsqrtf(ss * (1.f / 128.f) + EPS);
            float y[8];
#pragma unroll
            for (int i = 0; i < 4; ++i) { y[2 * i] = o[2 * i] * rs * (i < 2 ? g0[2 * i] : g1[2 * i - 4]) * bflo(gg[i]); y[2 * i + 1] = o[2 * i + 1] * rs * (i < 2 ? g0[2 * i + 1] : g1[2 * i - 3]) * bfhi(gg[i]); }
            *(u32x4*)(MIXED + (size_t)m * D + 8 * lane) = (u32x4){pk2(y[0], y[1]), pk2(y[2], y[3]), pk2(y[4], y[5]), pk2(y[6], y[7])};
        }
    }
}

__device__ __forceinline__ float MAX3_(float a, float b, float c) { float r; asm("v_max3_f32 %0, %1, %2, %3" : "=v"(r) : "v"(a), "v"(b), "v"(c)); return r; }
__device__ __forceinline__ void phase_attn(const Params& p, LAS unsigned char* lds, int G) {
    const int tid = threadIdx.x, lane = tid & 63, wave = __builtin_amdgcn_readfirstlane(tid >> 6), fr = lane & 15, fq = lane >> 4;
    const bf16_t* PROJ = (const bf16_t*)(p.ws + WS_PROJ);
    const bf16_t* VT = (const bf16_t*)(p.ws + WS_VT);
    bf16_t* MIXED = (bf16_t*)(p.ws + WS_XN);
    const float* sm = (const float*)(p.ws + WS_SM);
    LAS unsigned char* LK = lds; LAS unsigned char* LV = lds + 64 * KT_STRIDE; LAS float* LB = (LAS float*)(lds + 2 * ATT_BUF);
    const float lam = sm[SM_LAM];
    float vinf = __builtin_inff(); asm volatile("" : "+v"(vinf));
    unsigned* qctr = (unsigned*)(p.ws + 32768);
    volatile LAS unsigned* qslot = (volatile LAS unsigned*)(lds + 131072 + 320 + 64);
    for (;;) {
        __syncthreads();
        if (tid == 0) qslot[0] = __hip_atomic_fetch_add(qctr, 1u, __ATOMIC_RELAXED, __HIP_MEMORY_SCOPE_AGENT);
        __syncthreads();
        const int item = (int)qslot[0];
        if (item >= 1024 + QUANT_ITEMS + MIX_ITEMS) break;
        if (item >= 1024 + QUANT_ITEMS) {
            if (tid == 0) { unsigned sp_ = 0; while (__hip_atomic_load((unsigned*)(p.ws + HG_DONE_OFF), __ATOMIC_RELAXED, __HIP_MEMORY_SCOPE_AGENT) < 128u && ++sp_ < (1u << 24)) __builtin_amdgcn_s_sleep(2);
                __builtin_amdgcn_fence(__ATOMIC_ACQUIRE, "agent"); asm volatile("s_waitcnt vmcnt(0)" ::: "memory"); }
            __syncthreads();
            mix_rows(p, (item - 1024 - QUANT_ITEMS) * NWAVES + wave, MIX_ITEMS * NWAVES, lane); continue;
        }
        if (item >= 1024) { quant_tables(p, (item - 1024) * NWAVES + wave, QUANT_ITEMS * NWAVES, lane); continue; }
        const int bh = item >> 4, qb = item & 15, b = bh >> 2, h = bh & 3;
        const int qabs = qb * 128 + wave * 16 + fr;
        const size_t qrow = (size_t)b * SEQ + qabs;
        __syncthreads();
        for (int i = tid; i < 257; i += NTHREADS) LB[i] = sm[SM_BT + h * BT_STRIDE + i];
        bf16x8 qf[2][2];
#pragma unroll
        for (int m = 0; m < 2; ++m)
#pragma unroll
            for (int kk = 0; kk < 2; ++kk) qf[m][kk] = *(const bf16x8*)(PROJ + qrow * PP + C_DQ + h * 128 + m * 64 + kk * 32 + fq * 8);
        float mrun[2] = {0.f, 0.f};
        f32x4 lacc[2] = {(f32x4){0.f, 0.f, 0.f, 0.f}, (f32x4){0.f, 0.f, 0.f, 0.f}};
        f32x4 o[2][8];
#pragma unroll
        for (int m = 0; m < 2; ++m)
#pragma unroll
            for (int dt = 0; dt < 8; ++dt) o[m][dt] = (f32x4){0.f, 0.f, 0.f, 0.f};
        u32x4 kreg[2], vreg[2];
        const bf16_t* kg[2]; const bf16_t* vg[2]; int koff[2], voff[2];
#pragma unroll
        for (int i = 0; i < 2; ++i) { const int c = tid + i * 512;
            const int kr = c >> 4, kc = (c & 15) * 8; kg[i] = PROJ + ((size_t)b * SEQ + kr) * PP + C_DK + h * 128 + kc; koff[i] = kr * KT_STRIDE + kc * 2;
            const int vr = c >> 3, vc = (c & 7) * 8; vg[i] = VT + (size_t)(h * 128 + vr) * T + (size_t)b * SEQ + vc; voff[i] = vr * VT_STRIDE + vc * 2; }
#pragma unroll
        for (int i = 0; i < 2; ++i) { kreg[i] = *(const u32x4*)kg[i]; vreg[i] = *(const u32x4*)vg[i]; }
#pragma unroll
        for (int i = 0; i < 2; ++i) { *(LAS u32x4*)(LK + koff[i]) = kreg[i]; *(LAS u32x4*)(LV + voff[i]) = vreg[i]; }
        __syncthreads();
        const int Qw = qb * 128 + wave * 16;
        for (int kt = 0; kt < SEQ / 64; ++kt) {
            const int pbuf = (kt & 1) * ATT_BUF;
            if (kt + 1 < SEQ / 64) {
#pragma unroll
                for (int i = 0; i < 2; ++i) { kreg[i] = *(const u32x4*)(kg[i] + (size_t)(kt + 1) * 64 * PP); vreg[i] = *(const u32x4*)(vg[i] + (kt + 1) * 64); }
            }
            const int k0 = kt * 64;
            const bool farl = (k0 + 63 - Qw) <= -91, farr = (k0 - (Qw + 15)) >= 91;
            const float binit = farl ? LB[0] : (farr ? LB[256] : 0.f);
            f32x4 s[2][4];
#pragma unroll
            for (int m = 0; m < 2; ++m) {
                const float ci = binit - mrun[m];
#pragma unroll
                for (int ks = 0; ks < 4; ++ks) {
                    f32x4 a = (f32x4){ci, ci, ci, ci};
#pragma unroll
                    for (int kk = 0; kk < 2; ++kk) {
                        const bf16x8 kf = *(const LAS bf16x8*)(LK + pbuf + (16 * ks + fr) * KT_STRIDE + (m * 64 + kk * 32 + fq * 8) * 2);
                        a = __builtin_amdgcn_mfma_f32_16x16x32_bf16(kf, qf[m][kk], a, 0, 0, 0);
                    }
                    s[m][ks] = a;
                }
            }
            if (!(farl || farr)) {
#pragma unroll
                for (int ks = 0; ks < 4; ++ks)
#pragma unroll
                    for (int r = 0; r < 4; ++r) {
                        int rel = k0 + 16 * ks + 4 * fq + r - qabs; rel = rel < -128 ? -128 : (rel > 128 ? 128 : rel);
                        const float bv = LB[rel + 128];
                        s[0][ks][r] += bv; s[1][ks][r] += bv;
                    }
            }
            bf16x8 pb[2][2];
#pragma unroll
            for (int m = 0; m < 2; ++m) {
                float mx = MAX3_(__builtin_amdgcn_fmed3f(s[m][0][0], s[m][1][0], vinf), __builtin_amdgcn_fmed3f(s[m][2][0], s[m][3][0], vinf), s[m][0][1]);
                mx = MAX3_(mx, s[m][0][2], s[m][0][3]); mx = MAX3_(mx, s[m][1][1], s[m][1][2]); mx = MAX3_(mx, s[m][1][3], s[m][2][1]);
                mx = MAX3_(mx, s[m][2][2], s[m][2][3]); mx = MAX3_(mx, s[m][3][1], s[m][3][2]); mx = MAX3_(mx, mx, s[m][3][3]);
                { float a_ = mx, b_ = mx; swap16_(a_, b_); mx = MAX3_(a_, b_, b_); }
                { float a_ = mx, b_ = mx; swap32_(a_, b_); mx = MAX3_(a_, b_, b_); }
                if (__any(fabsf(mx) > 8.0f)) {
                    const float dl = fabsf(mx) > 8.0f ? mx : 0.f, alpha = __builtin_amdgcn_exp2f(-dl);
                    mrun[m] += dl; lacc[m] *= alpha;
#pragma unroll
                    for (int ks = 0; ks < 4; ++ks) s[m][ks] = s[m][ks] - dl;
#pragma unroll
                    for (int dt = 0; dt < 8; ++dt) o[m][dt] *= alpha;
                }
#pragma unroll
                for (int ks = 0; ks < 4; ++ks)
#pragma unroll
                    for (int r = 0; r < 4; ++r) s[m][ks][r] = __builtin_amdgcn_exp2f(s[m][ks][r]);
#pragma unroll
                for (int k2 = 0; k2 < 2; ++k2) {
                    u32x4 w; w.x = pk2(s[m][2 * k2][0], s[m][2 * k2][1]); w.y = pk2(s[m][2 * k2][2], s[m][2 * k2][3]);
                    w.z = pk2(s[m][2 * k2 + 1][0], s[m][2 * k2 + 1][1]); w.w = pk2(s[m][2 * k2 + 1][2], s[m][2 * k2 + 1][3]);
                    pb[m][k2] = __builtin_bit_cast(bf16x8, w);
                }
            }
            const bf16x8 ones = __builtin_bit_cast(bf16x8, (u32x4){0x3F803F80u, 0x3F803F80u, 0x3F803F80u, 0x3F803F80u});
#pragma unroll
            for (int k2 = 0; k2 < 2; ++k2) {
                lacc[0] = __builtin_amdgcn_mfma_f32_16x16x32_bf16(ones, pb[0][k2], lacc[0], 0, 0, 0);
                lacc[1] = __builtin_amdgcn_mfma_f32_16x16x32_bf16(ones, pb[1][k2], lacc[1], 0, 0, 0);
#pragma unroll
                for (int dt = 0; dt < 8; ++dt) {
                    const u32x2 lo = *(const LAS u32x2*)(LV + pbuf + (16 * dt + fr) * VT_STRIDE + (32 * k2 + 4 * fq) * 2);
                    const u32x2 hi = *(const LAS u32x2*)(LV + pbuf + (16 * dt + fr) * VT_STRIDE + (32 * k2 + 16 + 4 * fq) * 2);
                    const bf16x8 vf = __builtin_bit_cast(bf16x8, (u32x4){lo.x, lo.y, hi.x, hi.y});
                    o[0][dt] = __builtin_amdgcn_mfma_f32_16x16x32_bf16(vf, pb[0][k2], o[0][dt], 0, 0, 0);
                    o[1][dt] = __builtin_amdgcn_mfma_f32_16x16x32_bf16(vf, pb[1][k2], o[1][dt], 0, 0, 0);
                }
            }
            if (kt + 1 < SEQ / 64) {
                const int nbuf = ((kt + 1) & 1) * ATT_BUF;
#pragma unroll
                for (int i = 0; i < 2; ++i) { *(LAS u32x4*)(LK + nbuf + koff[i]) = kreg[i]; *(LAS u32x4*)(LV + nbuf + voff[i]) = vreg[i]; }
            }
            __syncthreads();
        }
        float inv[2];
#pragma unroll
        for (int m = 0; m < 2; ++m) inv[m] = __builtin_amdgcn_rcpf(lacc[m][0]);
        float ssq = 0.f;
#pragma unroll
        for (int dt = 0; dt < 8; ++dt)
#pragma unroll
            for (int r = 0; r < 4; ++r) { const float ov = o[0][dt][r] * inv[0] - lam * (o[1][dt][r] * inv[1]); o[0][dt][r] = ov; ssq += ov * ov; }
        ssq += __shfl_xor(ssq, 16); ssq += __shfl_xor(ssq, 32);
        const float rs = rsqrtf(ssq * (1.f / 128.f) + EPS) * 0.8f;
        const float* og = p.in[I_DOG];
#pragma unroll
        for (int dt = 0; dt < 8; ++dt) {
            const f32x4 g = *(const f32x4*)(og + 16 * dt + 4 * fq);
            const f32x4 y = o[0][dt] * rs * g;
            *(u32x2*)(MIXED + qrow * D + 512 + h * 128 + 16 * dt + 4 * fq) = (u32x2){pk2(y[0], y[1]), pk2(y[2], y[3])};
        }
    }
}

__device__ __forceinline__ void phase_hquant(const Params& p, int vcu, int G) {
    const int tid = threadIdx.x, lane = tid & 63, wave = __builtin_amdgcn_readfirstlane(tid >> 6);
    const bf16_t* H1B = (const bf16_t*)(p.ws + WS_H1B); const float* SS = (const float*)(p.ws + WS_SS);
    for (int t0 = vcu * NWAVES + wave; t0 < T; t0 += 4 * G * NWAVES) {
        u32x4 ha[4], hb[4];
#pragma unroll
        for (int u = 0; u < 4; ++u) { const int t = (t0 + u * G * NWAVES) < T ? (t0 + u * G * NWAVES) : t0; ha[u] = *(const u32x4*)(H1B + (size_t)t * D + 8 * lane); hb[u] = *(const u32x4*)(H1B + (size_t)t * D + 512 + 8 * lane); }
#pragma unroll
        for (int u = 0; u < 4; ++u) {
            const int t = t0 + u * G * NWAVES; if (t >= T) break;
            const u32x4 h0 = ha[u], h1 = hb[u];
            float hf[16]; float am = 0.f;
#pragma unroll
            for (int k = 0; k < 4; ++k) { hf[2 * k] = bflo(h0[k]); hf[2 * k + 1] = bfhi(h0[k]); hf[8 + 2 * k] = bflo(h1[k]); hf[8 + 2 * k + 1] = bfhi(h1[k]); }
#pragma unroll
            for (int k = 0; k < 16; ++k) am = fmaxf(am, fabsf(hf[k]));
            am = wave_max(am);
            const float iv = am > 0.f ? 127.f / am : 0.f;
            u32x4 q;
#pragma unroll
            for (int w = 0; w < 4; ++w) { const int q0 = (int)rintf(hf[4 * w] * iv), q1 = (int)rintf(hf[4 * w + 1] * iv), q2 = (int)rintf(hf[4 * w + 2] * iv), q3 = (int)rintf(hf[4 * w + 3] * iv);
                q[w] = (unsigned)((q0 & 0xFF) | ((q1 & 0xFF) << 8) | ((q2 & 0xFF) << 16) | ((q3 & 0xFF) << 24)); }
            u32x2 ph, pl;
#pragma unroll
            for (int w = 0; w < 2; ++w) { ph[w] = ((q[w] >> 4) & 0x0F0F0F0Fu) | (q[2 + w] & 0xF0F0F0F0u); pl[w] = ((q[w] & 0x0F0F0F0Fu) | ((q[2 + w] << 4) & 0xF0F0F0F0u)) ^ 0x88888888u; }
            *(u32x2*)(p.ws + WS_H1Q + (size_t)t * D + 8 * lane) = ph; *(u32x2*)(p.ws + WS_H1Q + (size_t)t * D + 512 + 8 * lane) = pl;
            if (lane == 0) ((float*)(p.ws + WS_HSC))[t] = am * (1.f / 127.f) * row_rstd(SS, (size_t)t);
        }
    }
}
__device__ __forceinline__ unsigned ford(float f) { const unsigned u = __float_as_uint(f); return (u & 0x80000000u) ? ~u : (u | 0x80000000u); }
__device__ __forceinline__ float funord(unsigned u) { u = (u & 0x80000000u) ? (u & 0x7fffffffu) : ~u; return __uint_as_float(u); }
template <int N> __device__ __forceinline__ void bitonic_sort_desc(unsigned (&v)[N]) {
#pragma unroll
    for (int k = 2; k <= N; k <<= 1)
#pragma unroll
        for (int j = k >> 1; j > 0; j >>= 1)
#pragma unroll
            for (int i = 0; i < N; ++i) { const int l = i ^ j;
                if (l > i) { const unsigned a = v[i], b = v[l]; const unsigned mx = a > b ? a : b, mn = a > b ? b : a; if ((i & k) == 0) { v[i] = mx; v[l] = mn; } else { v[i] = mn; v[l] = mx; } } }
}
__device__ __forceinline__ void merge_top16(unsigned (&a)[16], const unsigned (&b)[16]) {
#pragma unroll
    for (int i = 0; i < 16; ++i) a[i] = a[i] > b[15 - i] ? a[i] : b[15 - i];
#pragma unroll
    for (int j = 8; j > 0; j >>= 1)
#pragma unroll
        for (int i = 0; i < 16; ++i) { const int l = i ^ j; if (l > i) { const unsigned x = a[i], y = a[l]; a[i] = x > y ? x : y; a[l] = x > y ? y : x; } }
}
__device__ __forceinline__ void sort16_desc(unsigned (&v)[16]) {
#define CE_(a_, b_) { const unsigned x_ = v[a_], y_ = v[b_]; v[a_] = x_ > y_ ? x_ : y_; v[b_] = x_ > y_ ? y_ : x_; }
    CE_(0, 1) CE_(2, 3) CE_(0, 2) CE_(1, 3) CE_(1, 2) CE_(4, 5) CE_(6, 7) CE_(4, 6) CE_(5, 7) CE_(5, 6) CE_(0, 4) CE_(2, 6) CE_(2, 4) CE_(1, 5) CE_(3, 7) CE_(3, 5) CE_(1, 2) CE_(3, 4) CE_(5, 6) CE_(8, 9) CE_(10, 11) CE_(8, 10) CE_(9, 11) CE_(9, 10) CE_(12, 13) CE_(14, 15) CE_(12, 14) CE_(13, 15) CE_(13, 14) CE_(8, 12) CE_(10, 14) CE_(10, 12) CE_(9, 13) CE_(11, 15) CE_(11, 13) CE_(9, 10) CE_(11, 12) CE_(13, 14) CE_(0, 8) CE_(4, 12) CE_(4, 8) CE_(2, 10) CE_(6, 14) CE_(6, 10) CE_(2, 4) CE_(6, 8) CE_(10, 12) CE_(1, 9) CE_(5, 13) CE_(5, 9) CE_(3, 11) CE_(7, 15) CE_(7, 11) CE_(3, 5) CE_(7, 9) CE_(11, 13) CE_(1, 2) CE_(3, 4) CE_(5, 6) CE_(7, 8) CE_(9, 10) CE_(11, 12) CE_(13, 14)
#undef CE_
}
__device__ __forceinline__ void top16_of64(const unsigned (&v)[64], unsigned (&out)[16]) {
    unsigned g1[16], g2[16], g3[16];
#pragma unroll
    for (int i = 0; i < 16; ++i) { out[i] = v[i]; g1[i] = v[16 + i]; g2[i] = v[32 + i]; g3[i] = v[48 + i]; }
    sort16_desc(out); sort16_desc(g1); sort16_desc(g2); sort16_desc(g3);
    merge_top16(out, g1); merge_top16(g2, g3); merge_top16(out, g2);
}
__device__ __forceinline__ unsigned xchg32u(unsigned v, int lane) { return __builtin_bit_cast(unsigned, xchg32(__builtin_bit_cast(float, v), lane)); }
constexpr int TK_KROW = 272, TK_TAB = 256 * TK_KROW;
__device__ __forceinline__ void phase_topk(const Params& p, LAS unsigned char* lds, int vcu, int G) {
    const int tid = threadIdx.x, lane = tid & 63, wave = __builtin_amdgcn_readfirstlane(tid >> 6), r32 = lane & 31, hi = lane >> 5;
    const bf16_t* QP = (const bf16_t*)(p.ws + WS_QP);
    const bf16_t* KEYS = (const bf16_t*)(p.ws + WS_KEYS);
    int* IDX = (int*)(p.ws + WS_IDX);
    LAS unsigned* tab = (LAS unsigned*)(lds + TK_TAB) + wave * 8 * 64 + lane;
    for (int item = blockIdx.x; item < (T / 256) * 2; item += G) {
        const int tg = item % (T / 256), hg = item / (T / 256);
        const size_t tok = (size_t)(tg * 8 + wave) * 32 + r32;
        for (int hh = 0; hh < 4; ++hh) {
            const int h = hg * 4 + hh;
            __syncthreads();
#pragma unroll
            for (int c8 = 0; c8 < 8; ++c8) { const int c = tid + c8 * NTHREADS, row = c >> 4, ch = c & 15;
                *(LAS u32x4*)(lds + row * TK_KROW + ch * 16) = *(const u32x4*)(KEYS + (size_t)(h * 256 + row) * 128 + ch * 8); }
            __syncthreads();
            unsigned lst[2][16];
#pragma unroll
            for (int pp = 0; pp < 2; ++pp) {
                f32x16 acc[4];
#pragma unroll
                for (int kt = 0; kt < 4; ++kt)
#pragma unroll
                    for (int r = 0; r < 16; ++r) acc[kt][r] = 0.f;
                const bf16_t* qrow = QP + tok * QPS + h * 256 + pp * 128 + 8 * hi;
                const LAS unsigned char* kb = lds + (pp * 128 + r32) * TK_KROW + 16 * hi;
#pragma unroll
                for (int s2 = 0; s2 < 8; ++s2) {
                    const bf16x8 bq = *(const bf16x8*)(qrow + 16 * s2);
#pragma unroll
                    for (int kt = 0; kt < 4; ++kt) {
                        const bf16x8 ak = *(const LAS bf16x8*)(kb + kt * 32 * TK_KROW + 32 * s2);
                        acc[kt] = __builtin_amdgcn_mfma_f32_32x32x16_bf16(ak, bq, acc[kt], 0, 0, 0);
                    }
                }
                unsigned v[64];
#pragma unroll
                for (int kt = 0; kt < 4; ++kt)
#pragma unroll
                    for (int r = 0; r < 16; ++r) { const int n = 32 * kt + (r & 3) + 8 * (r >> 2) + 4 * hi; v[kt * 16 + r] = (ford(acc[kt][r]) & ~0x7Fu) | (unsigned)(127 - n); }
                unsigned own[16], oth[16];
                top16_of64(v, own);
#pragma unroll
                for (int j = 0; j < 16; ++j) oth[j] = xchg32u(own[j], lane);
                merge_top16(own, oth);
#pragma unroll
                for (int j = 0; j < 16; ++j) lst[pp][j] = own[j];
            }
            float a[16], bs[16];
#pragma unroll
            for (int j = 0; j < 16; ++j) { a[j] = funord(lst[0][j] & ~0x7Fu); bs[j] = funord(lst[1][j] & ~0x7Fu); }
#pragma unroll
            for (int m = 0; m < 4; ++m) {
                tab[m * 64] = (127u - (lst[0][4 * m] & 0x7Fu)) | ((127u - (lst[0][4 * m + 1] & 0x7Fu)) << 8) | ((127u - (lst[0][4 * m + 2] & 0x7Fu)) << 16) | ((127u - (lst[0][4 * m + 3] & 0x7Fu)) << 24);
                tab[(4 + m) * 64] = (127u - (lst[1][4 * m] & 0x7Fu)) | ((127u - (lst[1][4 * m + 1] & 0x7Fu)) << 8) | ((127u - (lst[1][4 * m + 2] & 0x7Fu)) << 16) | ((127u - (lst[1][4 * m + 3] & 0x7Fu)) << 24);
            }
            unsigned cand[64];
            {
                int c = 0;
#pragma unroll
                for (int i = 0; i < 16; ++i)
#pragma unroll
                    for (int j = 0; j < 16; ++j)
                        if ((i + 1) * (j + 1) <= 16) { cand[c] = (ford(a[i] + bs[j]) & ~0xFFu) | (unsigned)(255 - (i * 16 + j)); ++c; }
#pragma unroll
                for (int q = 50; q < 64; ++q) cand[q] = 0u;
            }
            unsigned best[16], eidx[16];
            top16_of64(cand, best);
            LDS_WAIT();
#pragma unroll
            for (int r = 0; r < 16; ++r) { const unsigned code = 255u - (best[r] & 0xFFu), ci = code >> 4, cj = code & 15u;
                const unsigned wi = tab[(ci >> 2) * 64], wj = tab[(4 + (cj >> 2)) * 64];
                eidx[r] = ((wi >> (8 * (ci & 3u))) & 0x7Fu) * 128u + ((wj >> (8 * (cj & 3u))) & 0x7Fu); }
            LDS_WAIT();
            if (hi == 0) {
                float g[16]; const float mx = funord(best[0] & ~0xFFu); float tot = 0.f;
#pragma unroll
                for (int r = 0; r < 16; ++r) { g[r] = __expf(funord(best[r] & ~0xFFu) - mx); tot += g[r]; }
                const float it_ = 1.f / tot;
                unsigned* rp = (unsigned*)IDX + (tok * 8 + h) * 16;
#pragma unroll
                for (int q4 = 0; q4 < 4; ++q4)
                    *(u32x4*)(rp + 4 * q4) = (u32x4){eidx[4 * q4] | (f2bf(g[4 * q4] * it_) << 16), eidx[4 * q4 + 1] | (f2bf(g[4 * q4 + 1] * it_) << 16), eidx[4 * q4 + 2] | (f2bf(g[4 * q4 + 2] * it_) << 16), eidx[4 * q4 + 3] | (f2bf(g[4 * q4 + 3] * it_) << 16)};
            }
        }
    }
}

typedef float f32x2_ __attribute__((ext_vector_type(2)));
__device__ __forceinline__ float gelu_exact(float v) {
    const float av = fabsf(v), t = __builtin_amdgcn_rcpf(av * 0.2316418882f + 1.0f);
    float q = t * 0.5307027145f + (-0.7265760135f); q = q * t + 0.7107068705f; q = q * t + (-0.142248368f); q = q * t + 0.127414796f; q = q * t;
    const float e = __builtin_amdgcn_exp2f((v * v) * (-0.72134752044f));
    const float m = v * (q * e);
    return v < 0.f ? m : v - m;
}
typedef float f32x2_ __attribute__((ext_vector_type(2)));
__device__ __forceinline__ void phase_peer_u(const Params& p, LAS unsigned char* lds, int G, int mx, int mj) {
    const int tid = threadIdx.x, lane = tid & 63, wave = __builtin_amdgcn_readfirstlane(tid >> 6), bx = blockIdx.x;
    const bool xl = (G % 8 == 0);
    const int x = xl ? (mx & 3) : 0, nx = xl ? 4 : 1, jb = xl ? (mx >> 2) * (G / 8) + mj : bx, nw = (xl ? G / 4 : G) * NWAVES, widx = jb * NWAVES + wave;
    const unsigned char* H1Q = (const unsigned char*)(p.ws + WS_H1Q); const unsigned char* UQ = (const unsigned char*)(p.ws + WS_UT);
    const unsigned* REC = (const unsigned*)(p.ws + WS_IDX); const float* HSC = (const float*)(p.ws + WS_HSC);
    const float* USC = (const float*)(p.ws + WS_USC); const float* VSC = (const float*)(p.ws + WS_VSC);
    unsigned* CI = (unsigned*)(p.ws + WS_C);
    LAS float* SU = (LAS float*)lds; LAS float* SV = SU + GRP_SIZE; LAS float* U8 = SV + GRP_SIZE;
    LAS u32x2* slots = (LAS u32x2*)(lds + 49152 + wave * 2048);
    LAS u32x4* hbuf = (LAS u32x4*)(lds + 65536 + wave * 2048);
    const int K = (T - widx + nw - 1) / nw;
    const int lrow = lane >> 4, lcol = lane & 15, lc16 = 16 * lcol;
    for (int g = x; g < NGRP; g += nx) {
        __syncthreads();
        for (int i = tid; i < GRP_SIZE; i += NTHREADS) { SU[i] = USC[g * GRP_SIZE + i]; SV[i] = VSC[g * GRP_SIZE + i]; U8[i] = ((const float*)(p.ws + WS_US8))[g * GRP_SIZE + i]; }
        __syncthreads();
#define PU_R(S, k_) { const int kk_ = (k_) < K ? (k_) : K - 1; const size_t tt_ = (size_t)(widx + nw * kk_); \
            rq##S = *(const u32x2*)(REC + tt_ * 128 + 2 * lane); rr##S = HSC[tt_]; hr##S = *(const u32x4*)(H1Q + tt_ * D + 16 * lane); }
#define PU_C(S, k_) { LAS u32x2* sl_ = slots + S * 128; const bool ok_ = (k_) < K; tk##S = widx + nw * ((k_) < K ? (k_) : K - 1); rs##S = rr##S; \
            hbuf[S * 64 + lane] = hr##S; const unsigned rl##S = rq##S.x, rh##S = rq##S.y; \
            { const bool f0 = ((rl##S & 0x3FFFu) >> GRP_SHIFT) == (unsigned)g, f1 = ((rh##S & 0x3FFFu) >> GRP_SHIFT) == (unsigned)g; const unsigned long long m0 = __ballot(f0), m1 = __ballot(f1); const int n0 = __popcll(m0); \
              if (f0) sl_[(int)__builtin_amdgcn_mbcnt_hi((unsigned)(m0 >> 32), __builtin_amdgcn_mbcnt_lo((unsigned)m0, 0u))] = (u32x2){((rl##S & 0x3FFFu) << 9) | ((unsigned)(2 * lane) << 24), rl##S & 0xffff0000u}; \
              if (f1) sl_[n0 + (int)__builtin_amdgcn_mbcnt_hi((unsigned)(m1 >> 32), __builtin_amdgcn_mbcnt_lo((unsigned)m1, 0u))] = (u32x2){((rh##S & 0x3FFFu) << 9) | ((unsigned)(2 * lane + 1) << 24), rh##S & 0xffff0000u}; \
              nn##S = __builtin_amdgcn_readfirstlane(ok_ ? n0 + __popcll(m1) : 0); } \
            LDS_WAIT(); \
            _Pragma("unroll") for (int j = 0; j < 12; ++j) sl##S[j] = sl_[4 * j + lrow]; \
            _Pragma("unroll") for (int i = 0; i < 4; ++i) hq##S[i] = hbuf[S * 64 + 16 * i + lcol]; }
#define PU_ISSUE(R, SL, c_, n_, QM) { int ns_ = (n_) - 12 * (c_); asm volatile("" : "+s"(ns_)); \
            _Pragma("unroll") for (int q = 0; q < 3; ++q) if (q < (QM) || ns_ > 4 * q) { const bool v_ = (4 * q + lrow) < ns_; const unsigned char* a_ = UQ + (v_ ? (size_t)((SL[3 * (c_) + q].x & 0x7FFFFFu) + lc16) : (size_t)0); \
                row##R[2 * q] = *(const u32x4*)a_; row##R[2 * q + 1] = *(const u32x4*)(a_ + 256); } }
#define PU_DOT(R, HQ, ACC, c_, n_, QM) { int ns_ = (n_) - 12 * (c_); asm volatile("" : "+s"(ns_)); _Pragma("unroll") for (int q = 0; q < 3; ++q) if (q < (QM) || ns_ > 4 * q) { int a1_ = 0, a2_ = 0; \
                _Pragma("unroll") for (int i = 0; i < 2; ++i) _Pragma("unroll") for (int w = 0; w < 4; ++w) { a1_ = __builtin_amdgcn_sdot8((int)row##R[2 * q + i][w], (int)HQ[i][w], a1_, false); a2_ = __builtin_amdgcn_sdot8((int)row##R[2 * q + i][w], (int)HQ[2 + i][w], a2_, false); } \
                ACC[q] = (a1_ << 4) + a2_; } }
#define PU_EPI(S, SL, ACC, c_, n_, QM) { float rt_[3]; int ns_ = (n_) - 12 * (c_); asm volatile("" : "+s"(ns_)); \
            _Pragma("unroll") for (int q = 0; q < 3; ++q) { rt_[q] = 0.f; if (q < (QM) || ns_ > 4 * q) { float f_ = (float)ACC[q]; f_ += dpp_mov<0xB1>(f_); f_ += dpp_mov<0x4E>(f_); f_ += dpp_mov<0x141>(f_); f_ += dpp_mov<0x140>(f_); rt_[q] = f_; } } \
            float tot_ = rt_[0]; unsigned rx_ = SL[3 * (c_)].x, ry_ = SL[3 * (c_)].y; \
            _Pragma("unroll") for (int q = 1; q < 3; ++q) { const bool e_ = lcol == q; tot_ = e_ ? rt_[q] : tot_; rx_ = e_ ? SL[3 * (c_) + q].x : rx_; ry_ = e_ ? SL[3 * (c_) + q].y : ry_; } \
            if (lcol < 3 && (4 * lcol + lrow) < ns_) { const unsigned idx_ = (rx_ >> 9) & 0x3FFFu; const int li_ = (int)(idx_ & (GRP_SIZE - 1)); \
                const float c_v = __uint_as_float(ry_) * gelu_exact((tot_ + U8[li_]) * SU[li_] * rs##S) * SV[li_]; CI[(size_t)tk##S * 128 + (rx_ >> 24)] = (f2bf(c_v) << 16) | idx_; } }
#define PU_OVF(S) if (nn##S > 48) { for (int b1_ = 48; b1_ < nn##S; b1_ += 12) { u32x2 so2_[12]; _Pragma("unroll") for (int q = 0; q < 3; ++q) so2_[q] = slots[S * 128 + ((b1_ + 4 * q + lrow) & 127)]; \
            const int n2_ = nn##S - b1_; int ac2_[3]; PU_ISSUE(3, so2_, 0, n2_, 0) PU_DOT(3, hq##S, ac2_, 0, n2_, 0) PU_EPI(S, so2_, ac2_, 0, n2_, 0) } }
#define PU_TOKEN(S, Sn) { \
            PU_DOT(0, hq##S, acc##S, 0, nn##S, 3) PU_EPI(S, sl##S, acc##S, 0, nn##S, 3) PU_ISSUE(0, sl##Sn, 0, nn##Sn, 3) \
            PU_DOT(1, hq##S, acc##S, 1, nn##S, 3) PU_EPI(S, sl##S, acc##S, 1, nn##S, 3) PU_ISSUE(1, sl##Sn, 1, nn##Sn, 3) \
            PU_DOT(2, hq##S, acc##S, 2, nn##S, 0) PU_EPI(S, sl##S, acc##S, 2, nn##S, 0) PU_ISSUE(2, sl##Sn, 2, nn##Sn, 0) \
            PU_DOT(3, hq##S, acc##S, 3, nn##S, 0) PU_EPI(S, sl##S, acc##S, 3, nn##S, 0) PU_OVF(S) PU_ISSUE(3, sl##Sn, 3, nn##Sn, 0) }
        u32x2 rq0, rq1; u32x4 hr0, hr1, hq0[4], hq1[4]; float rr0, rr1, rs0 = 0.f, rs1 = 0.f; int tk0 = 0, tk1 = 0, nn0 = 0, nn1 = 0;
        u32x4 row0[6], row1[6], row2[6], row3[6]; u32x2 sl0[12], sl1[12]; int acc0[3], acc1[3];
#pragma unroll
        for (int q = 0; q < 4; ++q) { hq0[q] = (u32x4){0u, 0u, 0u, 0u}; hq1[q] = hq0[q]; }
#pragma unroll
        for (int q = 0; q < 12; ++q) { sl0[q] = (u32x2){0u, 0u}; sl1[q] = sl0[q]; }
#pragma unroll
        for (int q = 0; q < 6; ++q) { row0[q] = (u32x4){0u, 0u, 0u, 0u}; row1[q] = row0[q]; row2[q] = row0[q]; row3[q] = row0[q]; }
#pragma unroll
        for (int q = 0; q < 3; ++q) { acc0[q] = 0; acc1[q] = 0; }
        PU_R(0, 0) PU_R(1, 1)
        PU_C(0, 0)
        PU_ISSUE(0, sl0, 0, nn0, 3) PU_ISSUE(1, sl0, 1, nn0, 3) PU_ISSUE(2, sl0, 2, nn0, 0) PU_ISSUE(3, sl0, 3, nn0, 0)
        PU_R(0, 2)
        for (int k = 0; k < K; k += 2) {
            PU_C(1, k + 1)
            PU_R(1, k + 3)
            PU_TOKEN(0, 1)
            PU_C(0, k + 2)
            PU_R(0, k + 4)
            PU_TOKEN(1, 0)
        }
    }
    __syncthreads();
}
__device__ __forceinline__ void phase_peer_v(const Params& p, LAS unsigned char* lds, int G, int mx, int mj) {
    const int tid = threadIdx.x, lane = tid & 63, wave = __builtin_amdgcn_readfirstlane(tid >> 6), bx = blockIdx.x;
    const bool xl = (G % 8 == 0);
    const int x = xl ? (mx & 3) : 0, nx = xl ? 4 : 1, jb = xl ? (mx >> 2) * (G / 8) + mj : bx, nw = (xl ? G / 4 : G) * NWAVES, widx = jb * NWAVES + wave;
    const unsigned char* VQ = (const unsigned char*)(p.ws + WS_VE);
    const unsigned* CI = (const unsigned*)(p.ws + WS_C);
    bf16_t* H1B = (bf16_t*)(p.ws + WS_H1B);
    const int sub = lane & 7, es = lane >> 3;
    const int K = (T - widx + nw - 1) / nw, NB4 = (K + 3) / 4;
    LAS unsigned* RL = (LAS unsigned*)(lds + wave * 4096);
    for (int s = x; s < NVS; s += nx) {
        const unsigned char* VQs = VQ + (size_t)s * 16384 * VSL + 16 * sub;
#define PV_TOK(k_) ((size_t)(widx + nw * ((k_) < K ? (k_) : K - 1)))
#define PV_RQLOAD(blk_) { _Pragma("unroll") for (int j = 0; j < 4; ++j) rq[j] = *(const u32x2*)(CI + PV_TOK(4 * (blk_) + j) * 128 + 2 * lane); }
#define PV_RQSTORE(blk_) { _Pragma("unroll") for (int j = 0; j < 4; ++j) *(LAS u32x2*)(RL + (((blk_) & 1) * 4 + j) * 128 + 2 * lane) = rq[j]; }
#define PV_REC(blkpar_, j_, hf_, i_) RL[((blkpar_) * 4 + (j_)) * 128 + 64 * (hf_) + 8 * (i_) + es]
#define PV_GATHER8(vb, rg_, hf_) { _Pragma("unroll") for (int i = 0; i < 8; ++i) vb[i] = *(const u32x4*)(VQs + (size_t)(rg_[8 * (hf_) + i] & 0x3FFFu) * VSL); }
#define PV_PREP(blkpar_, j_, sl_, k_) { float cf_[16]; float am_ = 0.f; hvs[sl_] = *(const u32x2*)(H1B + PV_TOK(k_) * D + hoff); \
            _Pragma("unroll") for (int i = 0; i < 16; ++i) rg[i] = PV_REC(blkpar_, j_, (i >> 3), (i & 7)); \
            _Pragma("unroll") for (int i = 0; i < 16; ++i) { cf_[i] = __uint_as_float(rg[i] & 0xffff0000u); am_ = fmaxf(am_, fabsf(cf_[i])); } \
            am_ = fmaxf(am_, dpp_mov<0x128>(am_)); am_ = swap16_max(am_); am_ = swap32_max(am_); \
            const float iv_ = am_ > 0.f ? 127.f / am_ : 0.f; csc[sl_] = am_ * (1.f / 127.f); int cs_ = 0; \
            _Pragma("unroll") for (int m = 0; m < 4; ++m) { const int q0 = (int)rintf(cf_[4 * m] * iv_), q1 = (int)rintf(cf_[4 * m + 1] * iv_), q2 = (int)rintf(cf_[4 * m + 2] * iv_), q3 = (int)rintf(cf_[4 * m + 3] * iv_); \
                cqs[sl_][m] = (q0 & 0xFF) | ((q1 & 0xFF) << 8) | ((q2 & 0xFF) << 16) | ((q3 & 0xFF) << 24); cs_ = __builtin_amdgcn_sdot4(cqs[sl_][m], 0x01010101, cs_, false); } \
            float ct_ = (float)cs_; ct_ += dpp_mov<0x128>(ct_); ct_ = swap16_sum(ct_); ct_ = swap32_sum(ct_); cto[sl_] = -8.f * ct_; }
#define PV_T4(r0, r1, r2, r3, w, cqw) { const unsigned x0_ = __builtin_amdgcn_perm(r1[w], r0[w], 0x05010400u), x1_ = __builtin_amdgcn_perm(r1[w], r0[w], 0x07030602u), \
                y0_ = __builtin_amdgcn_perm(r3[w], r2[w], 0x05010400u), y1_ = __builtin_amdgcn_perm(r3[w], r2[w], 0x07030602u); \
            const unsigned t0_ = __builtin_amdgcn_perm(y0_, x0_, 0x05040100u), t1_ = __builtin_amdgcn_perm(y0_, x0_, 0x07060302u), t2_ = __builtin_amdgcn_perm(y1_, x1_, 0x05040100u), t3_ = __builtin_amdgcn_perm(y1_, x1_, 0x07060302u); \
            acci[8 * (w)] = __builtin_amdgcn_sdot4((int)(t0_ & 0x0F0F0F0Fu), cqw, acci[8 * (w)], false); acci[8 * (w) + 1] = __builtin_amdgcn_sdot4((int)(t0_ & 0xF0F0F0F0u), cqw, acci[8 * (w) + 1], false); \
            acci[8 * (w) + 2] = __builtin_amdgcn_sdot4((int)(t1_ & 0x0F0F0F0Fu), cqw, acci[8 * (w) + 2], false); acci[8 * (w) + 3] = __builtin_amdgcn_sdot4((int)(t1_ & 0xF0F0F0F0u), cqw, acci[8 * (w) + 3], false); \
            acci[8 * (w) + 4] = __builtin_amdgcn_sdot4((int)(t2_ & 0x0F0F0F0Fu), cqw, acci[8 * (w) + 4], false); acci[8 * (w) + 5] = __builtin_amdgcn_sdot4((int)(t2_ & 0xF0F0F0F0u), cqw, acci[8 * (w) + 5], false); \
            acci[8 * (w) + 6] = __builtin_amdgcn_sdot4((int)(t3_ & 0x0F0F0F0Fu), cqw, acci[8 * (w) + 6], false); acci[8 * (w) + 7] = __builtin_amdgcn_sdot4((int)(t3_ & 0xF0F0F0F0u), cqw, acci[8 * (w) + 7], false); }
#define PV_ACC8(vb, sl_, hf_) { _Pragma("unroll") for (int w = 0; w < 4; ++w) { PV_T4(vb[0], vb[1], vb[2], vb[3], w, cqs[sl_][2 * (hf_)]) PV_T4(vb[4], vb[5], vb[6], vb[7], w, cqs[sl_][2 * (hf_) + 1]) } }
#define PV_FIN(k_, sl_) { int r16[16], r8[8], r4[4]; \
            { const bool bt = lane & 8; _Pragma("unroll") for (int q = 0; q < 16; ++q) { const int keep = bt ? acci[q + 16] : acci[q], send = bt ? acci[q] : acci[q + 16]; r16[q] = keep + __builtin_amdgcn_update_dpp(0, send, 0x128, 0xF, 0xF, false); } } \
            _Pragma("unroll") for (int q = 0; q < 8; ++q) { int a_ = r16[q], b_ = r16[q + 8]; swap16i_(a_, b_); r8[q] = a_ + b_; } \
            _Pragma("unroll") for (int q = 0; q < 4; ++q) { int a_ = r8[q], b_ = r8[q + 4]; swap32i_(a_, b_); r4[q] = a_ + b_; } \
            _Pragma("unroll") for (int q = 0; q < 32; ++q) acci[q] = 0; \
            if ((k_) < K) { const u32x2 hw = hvs[sl_]; const float sc_ = csc[sl_], sh_ = sc_ * (1.f / 16.f), co_ = cto[sl_]; \
                *(u32x2*)(H1B + (size_t)(widx + nw * (k_)) * D + hoff) = (u32x2){pk2(bflo(hw.x) + ((float)r4[0] + co_) * sc_, bfhi(hw.x) + (float)r4[1] * sh_), pk2(bflo(hw.y) + ((float)r4[2] + co_) * sc_, bfhi(hw.y) + (float)r4[3] * sh_)}; } }
#define PV_STEP(vb, B_, j_, hf_) { PV_ACC8(vb, ((j_) & 3), hf_) if ((hf_) == 1) PV_FIN(4 * (B_) + (j_), ((j_) & 3)) \
            if ((hf_) == 0) PV_PREP((((j_) + 2) < 4) ? ((B_) & 1) : (((B_) + 1) & 1), (((j_) + 2) & 3), (((j_) + 2) & 3), 4 * (B_) + (j_) + 2) \
            PV_GATHER8(vb, rg, hf_) }
        u32x2 rq[4]; u32x4 v0[8], v1[8], v2[8], v3[8]; int acci[32]; int cqs[4][4]; float csc[4], cto[4]; unsigned rg[16]; u32x2 hvs[4];
        const int hoff = s * 256 + 32 * sub + 16 * (es & 1) + 8 * ((es >> 1) & 1) + 4 * (es >> 2);
#pragma unroll
        for (int q = 0; q < 32; ++q) acci[q] = 0;
        PV_RQLOAD(0) PV_RQSTORE(0) PV_RQLOAD(1) PV_RQSTORE(1)
        LDS_WAIT();
        PV_PREP(0, 0, 0, 0) PV_GATHER8(v0, rg, 0) PV_GATHER8(v1, rg, 1)
        PV_PREP(0, 1, 1, 1) PV_GATHER8(v2, rg, 0) PV_GATHER8(v3, rg, 1)
        for (int B = 0; B < NB4; ++B) {
            if (B > 0) { PV_RQSTORE(B + 1) LDS_WAIT(); }
            PV_STEP(v0, B, 0, 0) PV_STEP(v1, B, 0, 1)
            PV_STEP(v2, B, 1, 0) PV_STEP(v3, B, 1, 1)
            PV_RQLOAD(B + 2)
            PV_STEP(v0, B, 2, 0) PV_STEP(v1, B, 2, 1)
            PV_STEP(v2, B, 3, 0) PV_STEP(v3, B, 3, 1)
        }
    }
}
__device__ __forceinline__ void phase_final(const Params& p, int vcu, int G) {
    const int tid = threadIdx.x, lane = tid & 63, wave = __builtin_amdgcn_readfirstlane(tid >> 6);
    const bf16_t* H2B = (const bf16_t*)(p.ws + WS_H1B); float* Y = p.out; const float* fg = p.in[I_FG];
    const int w0 = vcu * NWAVES + wave, WS_ = G * NWAVES;
    const f32x4 g0 = ((const f32x4*)fg)[2 * lane], g1 = ((const f32x4*)fg)[2 * lane + 1], g2 = ((const f32x4*)fg)[128 + 2 * lane], g3 = ((const f32x4*)fg)[128 + 2 * lane + 1];
#define PF_LOAD(dst, t0_) { _Pragma("unroll") for (int u = 0; u < 4; ++u) { const int tok = ((t0_) + u * WS_) < T ? ((t0_) + u * WS_) : w0; \
            dst[u][0] = *(const u32x4*)(H2B + (size_t)tok * D + 8 * lane); dst[u][1] = *(const u32x4*)(H2B + (size_t)tok * D + 512 + 8 * lane); } }
#define PF_PROC(src, t0_) { _Pragma("unroll") for (int u = 0; u < 4; ++u) { const int tok = (t0_) + u * WS_; if (tok < T) { float f[16]; float ss = 0.f; \
            _Pragma("unroll") for (int k = 0; k < 4; ++k) { f[2 * k] = bflo(src[u][0][k]); f[2 * k + 1] = bfhi(src[u][0][k]); f[8 + 2 * k] = bflo(src[u][1][k]); f[8 + 2 * k + 1] = bfhi(src[u][1][k]); } \
            _Pragma("unroll") for (int k = 0; k < 16; ++k) ss += f[k] * f[k]; \
            const float rs = rsqrtf(wave_sum(ss) * (1.f / D) + EPS); f32x4* yr = (f32x4*)(Y + (size_t)tok * D); \
            yr[2 * lane] = (f32x4){f[0], f[1], f[2], f[3]} * rs * g0; yr[2 * lane + 1] = (f32x4){f[4], f[5], f[6], f[7]} * rs * g1; \
            yr[128 + 2 * lane] = (f32x4){f[8], f[9], f[10], f[11]} * rs * g2; yr[128 + 2 * lane + 1] = (f32x4){f[12], f[13], f[14], f[15]} * rs * g3; } } }
    u32x4 va[4][2], vb[4][2];
    PF_LOAD(va, w0)
    for (int t0 = w0; t0 < T; t0 += 8 * WS_) {
        if (t0 + 4 * WS_ < T) PF_LOAD(vb, t0 + 4 * WS_)
        PF_PROC(va, t0)
        if (t0 + 8 * WS_ < T) PF_LOAD(va, t0 + 8 * WS_)
        PF_PROC(vb, t0 + 4 * WS_)
    }
}
#define XB_TMO      128
#define XB_XCNT(j)  (256  + 64 * (j))
#define XB_XSUB(j)  (1280 + 64 * (j))
#define XB_XGEN(j)  (2304 + 64 * (j))
#define XB_TOP      3328
#define XB_TOPGEN   3392
#define XCD_BAR_WORDS 3456
#define XB_SPIN_CAP (1u << 18)

__device__ __forceinline__ unsigned xb_ld(unsigned* p)              { return __hip_atomic_load(p, __ATOMIC_RELAXED, __HIP_MEMORY_SCOPE_AGENT); }
__device__ __forceinline__ unsigned xb_add(unsigned* p, unsigned v) { return __hip_atomic_fetch_add(p, v, __ATOMIC_RELAXED, __HIP_MEMORY_SCOPE_AGENT); }
__device__ __forceinline__ unsigned xb_xcc_id() { return (unsigned)__builtin_amdgcn_s_getreg((3 << 11) | 20) & 0xFu; }
#define XB_SPIN(cond, bar) do { unsigned _sp = 0; while (cond) { __builtin_amdgcn_s_sleep(1); \
    if ((++_sp & 255u) == 0u) { if (xb_ld(&(bar)[XB_TMO])) break; if (_sp > XB_SPIN_CAP) { atomicAdd(&(bar)[XB_TMO], 1u); break; } } } } while (0)

struct XcdBarrier {
    unsigned* bar; unsigned x;
    volatile LAS unsigned* st;
};

__device__ __forceinline__ XcdBarrier xcd_barrier_post(unsigned* bar, volatile LAS unsigned* st) {
    XcdBarrier b; b.bar = bar; b.x = xb_xcc_id(); b.st = st;
    if (threadIdx.x == 0) (void)xb_add(&bar[XB_XCNT(b.x)], 1u);
    return b;
}
__device__ __forceinline__ void xcd_barrier_complete(unsigned* bar, unsigned x, unsigned& nloc, unsigned& nx) {
    const unsigned G = gridDim.x * gridDim.y * gridDim.z;
    unsigned sum, cnt, mine, sp = 0u;
    for (;;) {
        sum = 0u; cnt = 0u; mine = 0u;
#pragma unroll
        for (unsigned j = 0; j < 16; ++j) { const unsigned c = xb_ld(&bar[XB_XCNT(j)]); sum += c; cnt += (c > 0u) ? 1u : 0u; mine = (j == x) ? c : mine; }
        if (sum == G) break;
        __builtin_amdgcn_s_sleep(1);
        if ((++sp & 255u) == 0u) { if (xb_ld(&bar[XB_TMO])) break; if (sp > XB_SPIN_CAP) { atomicAdd(&bar[XB_TMO], 1u); break; } }
    }
    nloc = mine > 0u ? mine : 1u; nx = cnt > 0u ? cnt : 1u;
}

__device__ __forceinline__ void xcd_barrier(const XcdBarrier& b) {
    asm volatile("s_waitcnt vmcnt(0)" ::: "memory");
    __syncthreads();
    if (threadIdx.x == 0) {
        unsigned* bar = b.bar;
        __builtin_amdgcn_s_waitcnt(0);
        unsigned nloc = b.st[0], nx = b.st[1];
        if (nloc == 0u) { xcd_barrier_complete(bar, b.x, nloc, nx); b.st[0] = nloc; b.st[1] = nx; }
        const unsigned old = xb_add(&bar[XB_XSUB(b.x)], 1u);
        const unsigned gen = old / nloc;
        if (old + 1u == (gen + 1u) * nloc) {
            __builtin_amdgcn_fence(__ATOMIC_RELEASE, "agent");
            asm volatile("s_waitcnt vmcnt(0)" ::: "memory");
            const unsigned og = xb_add(&bar[XB_TOP], 1u);
            const unsigned tg = og / nx;
            if (og + 1u == (tg + 1u) * nx) xb_add(&bar[XB_TOPGEN], 1u);
            else XB_SPIN(xb_ld(&bar[XB_TOPGEN]) == tg, bar);
            __builtin_amdgcn_fence(__ATOMIC_ACQUIRE, "agent");
            xb_add(&bar[XB_XGEN(b.x)], 1u);
            asm volatile("s_waitcnt vmcnt(0)" ::: "memory");
        } else {
            XB_SPIN(xb_ld(&bar[XB_XGEN(b.x)]) == gen, bar);
            __builtin_amdgcn_fence(__ATOMIC_ACQUIRE, "agent");
            asm volatile("s_waitcnt vmcnt(0)" ::: "memory");
        }
    }
    __syncthreads();
}

constexpr int N_PHASES = 11;
__global__ void __launch_bounds__(NTHREADS, 2) hymba_fwd(Params p) {
    extern __shared__ __attribute__((aligned(16))) unsigned char lds_raw[];
    LAS unsigned char* lds = (LAS unsigned char*)lds_raw;
    cg::grid_group grid = cg::this_grid();
    const int G = gridDim.x; const int bx = blockIdx.x;
    const int vcu = (G % 8 == 0) ? (bx % 8) * (G / 8) + bx / 8 : bx;
    unsigned char* ws = p.ws;
    const int lo = p.ph_lo, hi = p.ph_hi;
    volatile LAS unsigned* MISC = (volatile LAS unsigned*)(lds + 131072 + 320);
    if (threadIdx.x < 32) MISC[threadIdx.x] = 0u;
    __syncthreads();
    XcdBarrier bar; bar.bar = (unsigned*)ws; bar.x = xb_xcc_id(); bar.st = MISC + 8;
    if (threadIdx.x == 0) { MISC[20] = xb_add(&bar.bar[XB_XCNT(bar.x)], 1u); MISC[21] = bar.x; MISC[22] = 0u; }
#define IN(k) (lo <= (k) && (k) < hi)
#define SEAM(k) do { if ((k) + 1 < hi) { if ((k) == 0) grid.sync(); else xcd_barrier(bar); } } while (0)
    if (IN(0)) { phase_prep(p, lds, vcu, G); SEAM(0); }
    {
        if (threadIdx.x == 0 && lo == 0 && hi > 1 && (G % 8) == 0) { bool ok = true; for (unsigned j = 0; j < 8; ++j) ok = ok && (xb_ld(&bar.bar[XB_XCNT(j)]) == (unsigned)(G / 8)); MISC[22] = ok ? 1u : 0u; }
        __syncthreads();
    }
    const bool xcc_ok = MISC[22] != 0u; const int xcc_x = xcc_ok ? (int)MISC[21] : (bx & 7), xcc_j = xcc_ok ? (int)MISC[20] : (bx >> 3);
    if (IN(1)) {
        { pg8::Gemm g{(const bf16_t*)(ws + WS_XN), (const bf16_t*)(ws + WS_WINT), T, 3584, D}; pg8::StaticOrder S; S.init(T, 3584, G, bx);
          EpiInProj E{(bf16_t*)(ws + WS_PROJ), (const float*)(ws + WS_SM)};
          pg8::gemm_phase<EpiInProj, pg8::StaticOrder, true, true>(lds, g, S, E); }
        { pg8::Gemm g{(const bf16_t*)(ws + WS_WINT) + (size_t)3584 * D, (const bf16_t*)(ws + WS_XN), 512, T, D}; pg8::StaticOrder S; S.init(512, T, G, bx);
          EpiStore E{(bf16_t*)(ws + WS_VT), T};
          pg8::gemm_phase<EpiStore, pg8::StaticOrder, true, true>(lds, g, S, E); }
        SEAM(1);
    }
    if (IN(2)) { phase_hgrn(p, lds, G); }
    if (IN(3)) { phase_attn(p, lds, G); SEAM(3); }
    if (IN(5)) {
        pg8::Gemm g{(const bf16_t*)(ws + WS_XN), (const bf16_t*)(ws + WS_WOT), T, D, D}; pg8::StaticOrder S; S.init(T, D, G, bx);
        EpiOutProj E{p.in[I_X], p.out, (bf16_t*)(ws + WS_H1B), (float*)(ws + WS_SS)};
        pg8::gemm_phase<EpiOutProj, pg8::StaticOrder, true, true>(lds, g, S, E);
        SEAM(5);
    }
    if (IN(6)) {
        phase_hquant(p, vcu, G);
        pg8::Gemm g{(const bf16_t*)(ws + WS_H1B), (const bf16_t*)(ws + WS_WQT), T, 2048, D}; pg8::StaticOrder S; S.init(T, 2048, G, bx);
        EpiQ E{(bf16_t*)(ws + WS_QP), (const float*)(ws + WS_SS), (float*)(ws + WS_GATE)};
        pg8::gemm_phase<EpiQ, pg8::StaticOrder, true, true>(lds, g, S, E);
        SEAM(6);
    }
    if (IN(7)) { phase_topk(p, lds, vcu, G); SEAM(7); }
    if (IN(8)) { phase_peer_u(p, lds, G, xcc_x, xcc_j); SEAM(8); }
    if (IN(9)) { phase_peer_v(p, lds, G, xcc_x, xcc_j); SEAM(9); }
    if (IN(10)) { phase_final(p, vcu, G); }
#undef IN
#undef SEAM
}

extern "C" void kernel_launch(void* const* d_in, const int* in_sizes, int n_in, void* d_out, int out_size, void* d_ws, size_t ws_size, hipStream_t stream) {
    static int grid = 0;
    if (grid == 0) {
        if (n_in != 19 || out_size != T * D || ws_size < WS_END) { fprintf(stderr, "kernel_launch: unexpected sizes (n_in %d out %d ws %zu)\n", n_in, out_size, ws_size); grid = -1; return; }
        int dev = 0, cus = 0, per_cu = 0;
        hipGetDevice(&dev); hipDeviceGetAttribute(&cus, hipDeviceAttributeMultiprocessorCount, dev);
        hipFuncSetAttribute((const void*)hymba_fwd, hipFuncAttributeMaxDynamicSharedMemorySize, LDS_BYTES);
        hipOccupancyMaxActiveBlocksPerMultiprocessor(&per_cu, (const void*)hymba_fwd, NTHREADS, LDS_BYTES);
        (void)hipGetLastError();
        if (per_cu < 1) { fprintf(stderr, "kernel_launch: occupancy query says %d blocks/CU\n", per_cu); per_cu = 1; }
        grid = cus;
    }
    if (grid < 0) return;
    if (hipMemsetAsync(d_ws, 0, 65536, stream) != hipSuccess) { fprintf(stderr, "kernel_launch: memset of the barrier words failed\n"); return; }
    Params p{};
    for (int i = 0; i < 19; ++i) p.in[i] = (const float*)d_in[i];
    p.out = (float*)d_out; p.ws = (unsigned char*)d_ws;
#if MK_ONE_LAUNCH
    p.ph_lo = 0; p.ph_hi = N_PHASES;
    void* args[] = {&p};
    hipError_t e = hipLaunchCooperativeKernel((const void*)hymba_fwd, dim3(grid), dim3(NTHREADS), args, LDS_BYTES, stream);
    if (e != hipSuccess) fprintf(stderr, "cooperative launch failed: %s (grid %d)\n", hipGetErrorString(e), grid);
#else
    for (int ph = 0; ph < N_PHASES; ++ph) { p.ph_lo = ph; p.ph_hi = ph + 1; hipLaunchKernelGGL(hymba_fwd, dim3(grid), dim3(NTHREADS), LDS_BYTES, stream, p); }
#endif
}
```

```cpp
#include <hip/hip_runtime.h>
#include <hip/hip_bf16.h>
#include <hip/hip_cooperative_groups.h>
#include <cstdio>
#include <cstdint>
#include <cmath>
namespace cg = cooperative_groups;
#ifndef MK_ONE_LAUNCH
#define MK_ONE_LAUNCH 1
#endif
namespace pg8 {
#define PG8_LAS __attribute__((address_space(3)))
typedef unsigned short bf16_t;
typedef short bf16x8 __attribute__((ext_vector_type(8)));
typedef float f32x4 __attribute__((ext_vector_type(4)));
typedef unsigned u32x4 __attribute__((ext_vector_type(4)));
constexpr int BM = 256, BK = 64, HALF = 128, HTB = HALF * BK * 2  , STAGE_BYTES = 8 * HTB, NXCD = 8, WGM = 8;

__host__ __device__ __forceinline__ int lds_byte(int r, int c) { const int st = (r >> 4) * 2 + (c >> 5), rr = r & 15, cc = c & 31, ob = rr * 64 + cc * 2; return st * 1024 + (ob ^ (((ob >> 9) & 1) << 5)); }
__host__ __device__ __forceinline__ void stage_rc(int b, int& R, int& C) { const int st = b / 1024, sb = b % 1024, swz = sb ^ (((sb >> 9) & 1) << 5); R = (st >> 1) * 16 + swz / 64; C = (st & 1) * 32 + (swz % 64) / 2; }
__host__ __device__ __forceinline__ int perm32(int rho) { const int n = rho >> 4, i = rho & 15; return 8 * (i >> 2) + 4 * n + (i & 3); }

struct Unit { int pm, pn; };
struct Gemm { const bf16_t* A; const bf16_t* Bt; int M, N, K; };

struct StaticOrder {
    int nM, nN, nwg, G, c;
    __host__ __device__ void init(int M, int N, int G_, int c_) { nM = M / BM; nN = N / BM; nwg = nM * nN; G = G_; c = c_; }
    __host__ __device__ bool next(int i, Unit& u) const {
        const long L = (long)i * G + c; if (L >= nwg) return false;
        int wgid = (int)L; { const int q = nwg / NXCD, r = nwg % NXCD, xcd = wgid % NXCD, off = wgid / NXCD; wgid = (xcd < r ? xcd * (q + 1) : r * (q + 1) + (xcd - r) * q) + off; }
        const int nig = WGM * nN, gid = wgid / nig, fm = gid * WGM, gsz = (nM - fm) < WGM ? (nM - fm) : WGM;
        u.pm = fm + ((wgid % nig) % gsz); u.pn = (wgid % nig) / gsz; return true;
    }
    __device__ __forceinline__ void a_ready(const Unit&) const {}
    __device__ __forceinline__ void done(const Unit&) const {}
};

__device__ __forceinline__ unsigned cvt_pk_bf16(float lo, float hi) { unsigned r; asm volatile("v_cvt_pk_bf16_f32 %0, %1, %2" : "=v"(r) : "v"(lo), "v"(hi)); return r; }
typedef float f32x2 __attribute__((ext_vector_type(2)));
template <class Epi, class Sched, bool ALIGN_EPI = false, bool SP2 = false>
__device__ __forceinline__ void gemm_phase(PG8_LAS unsigned char* lds, const Gemm g, const Sched& S, const Epi& E) {
    const int tid = threadIdx.x, wid = __builtin_amdgcn_readfirstlane(tid >> 6), lane = tid & 63, wr = wid >> 2, wc = wid & 3, fr = lane & 15, fq = lane >> 4;
    const int K = g.K, nt = K / BK;
    unsigned voffA[2], voffB[2];
#pragma unroll
    for (int i = 0; i < 2; ++i) { int R, C; stage_rc(tid * 16 + i * 8192, R, C); const int Rb = Epi::PERM ? ((R & ~31) + perm32(R & 31)) : R;
        voffA[i] = (unsigned)(R * K + C) * 2u; voffB[i] = (unsigned)(Rb * K + C) * 2u; }
    const size_t kstep = (size_t)(BK * 2);
    const size_t hstep = (size_t)HALF * K * 2;
    const size_t tstep = 2 * hstep;
    const unsigned ldsw = (unsigned)wid * 1024u;
    const int aoff = lds_byte(wr * 64 + fr, fq * 8), boff = lds_byte(wc * 32 + fr, fq * 8);
#define PG8_SA(b, h) (((b) * 2 + (h)) * HTB)
#define PG8_SB(b, h) ((4 + (b) * 2 + (h)) * HTB)
#define PG8_STAGE(bufoff, gbase, voff) do { _Pragma("unroll") for (int _i = 0; _i < 2; ++_i) \
        __builtin_amdgcn_global_load_lds((const unsigned*)((const char*)(gbase) + (voff)[_i]), (PG8_LAS unsigned*)(lds + (bufoff) + ldsw + _i * 8192), 16, 0, 0); } while (0)
#define PG8_LDA(dst, b, h) do { _Pragma("unroll") for (int m = 0; m < 4; ++m) _Pragma("unroll") for (int k = 0; k < 2; ++k) dst[m][k] = *(const PG8_LAS bf16x8*)(lds + PG8_SA(b, h) + aoff + m * 2048 + k * 1024); } while (0)
#define PG8_LDB(dst, b, h) do { _Pragma("unroll") for (int n = 0; n < 2; ++n) _Pragma("unroll") for (int k = 0; k < 2; ++k) dst[n][k] = *(const PG8_LAS bf16x8*)(lds + PG8_SB(b, h) + boff + n * 2048 + k * 1024); } while (0)
#define PG8_MMA(ai, bj, At, Bt) do { __builtin_amdgcn_s_setprio(1); _Pragma("unroll") for (int m = 0; m < 4; ++m) _Pragma("unroll") for (int n = 0; n < 2; ++n) _Pragma("unroll") for (int k = 0; k < 2; ++k) \
        acc[ai][bj][m][n] = __builtin_amdgcn_mfma_f32_16x16x32_bf16(Bt[n][k], At[m][k], acc[ai][bj][m][n], 0, 0, 0); __builtin_amdgcn_s_setprio(0); } while (0)
#define PG8_WAIT_V(n) asm volatile("s_waitcnt vmcnt(" #n ")" ::: "memory")
#define PG8_WAIT_L(n) asm volatile("s_waitcnt lgkmcnt(" #n ")" ::: "memory")
#define PG8_BAR __builtin_amdgcn_s_barrier()
#define PG8_SCHED __builtin_amdgcn_sched_barrier(0)
    Unit cur, nxt; int ui = 0;
    if (!S.next(0, cur)) return;
    f32x4 acc[2][2][4][2];
#pragma unroll
    for (int a = 0; a < 2; ++a)
#pragma unroll
        for (int b = 0; b < 2; ++b)
#pragma unroll
            for (int m = 0; m < 4; ++m)
#pragma unroll
                for (int n = 0; n < 2; ++n) acc[a][b][m][n] = (f32x4){0.f, 0.f, 0.f, 0.f};
    bf16x8 At[4][2], B0[2][2], B1[2][2];
    const char* cA = (const char*)g.A + (size_t)cur.pm * tstep; const char* cB = (const char*)g.Bt + (size_t)cur.pn * tstep;
    S.a_ready(cur);
    if constexpr (SP2) {
        PG8_STAGE(PG8_SB(0, 0), cB, voffB); PG8_STAGE(PG8_SB(0, 1), cB + hstep, voffB); PG8_STAGE(PG8_SA(0, 0), cA, voffA); PG8_STAGE(PG8_SA(0, 1), cA + hstep, voffA);
        if (wr == 1) PG8_BAR;
        PG8_WAIT_V(2); PG8_BAR;
        PG8_STAGE(PG8_SB(1, 0), cB + kstep, voffB); PG8_STAGE(PG8_SA(1, 0), cA + kstep, voffA); PG8_STAGE(PG8_SB(1, 1), cB + hstep + kstep, voffB);
        PG8_WAIT_V(6); PG8_BAR;
    } else {
        PG8_STAGE(PG8_SB(0, 0), cB, voffB); PG8_STAGE(PG8_SA(0, 0), cA, voffA); PG8_STAGE(PG8_SB(0, 1), cB + hstep, voffB); PG8_STAGE(PG8_SA(0, 1), cA + hstep, voffA);
        if (wr == 1) PG8_BAR;
        PG8_WAIT_V(4); PG8_BAR;
        PG8_STAGE(PG8_SB(1, 0), cB + kstep, voffB); PG8_STAGE(PG8_SA(1, 0), cA + kstep, voffA); PG8_STAGE(PG8_SB(1, 1), cB + hstep + kstep, voffB);
        PG8_WAIT_V(6); PG8_BAR;
    }
    for (;;) {
        const bool has_next = S.next(ui + 1, nxt);
        const char* nA = has_next ? (const char*)g.A + (size_t)nxt.pm * tstep : cA; const char* nB = has_next ? (const char*)g.Bt + (size_t)nxt.pn * tstep : cB;
        for (int t = 0; t < nt; t += 2) {
            const bool last = (t == nt - 2);
            const char* a1 = cA + (size_t)(t + 1) * kstep;
            const char* a2 = last ? nA : cA + (size_t)(t + 2) * kstep; const char* b2 = last ? nB : cB + (size_t)(t + 2) * kstep;
            const char* a3 = a2 + kstep; const char* b3 = b2 + kstep;
            if (last && has_next) S.a_ready(nxt);
            if constexpr (SP2) {
            PG8_LDB(B0, 0, 0); PG8_LDB(B1, 0, 1); PG8_SCHED; PG8_LDA(At, 0, 0); PG8_STAGE(PG8_SA(1, 1), a1 + hstep, voffA);
            PG8_WAIT_V(8); PG8_WAIT_L(0); PG8_BAR; PG8_MMA(0, 0, At, B0); PG8_MMA(0, 1, At, B1); PG8_BAR; PG8_SCHED;
            PG8_LDA(At, 0, 1); PG8_STAGE(PG8_SB(0, 0), b2, voffB); PG8_STAGE(PG8_SB(0, 1), b2 + hstep, voffB); PG8_STAGE(PG8_SA(0, 0), a2, voffA);
            PG8_WAIT_V(8); PG8_WAIT_L(0); PG8_BAR; PG8_MMA(1, 0, At, B0); PG8_MMA(1, 1, At, B1); PG8_BAR; PG8_SCHED;
            PG8_LDB(B0, 1, 0); PG8_LDB(B1, 1, 1); PG8_SCHED; PG8_LDA(At, 1, 0); PG8_STAGE(PG8_SA(0, 1), a2 + hstep, voffA);
            PG8_WAIT_V(8); PG8_WAIT_L(0); PG8_BAR; PG8_MMA(0, 0, At, B0); PG8_MMA(0, 1, At, B1); PG8_BAR; PG8_SCHED;
            PG8_LDA(At, 1, 1); PG8_STAGE(PG8_SB(1, 0), b3, voffB); PG8_STAGE(PG8_SB(1, 1), b3 + hstep, voffB); PG8_STAGE(PG8_SA(1, 0), a3, voffA);
            PG8_WAIT_V(8); PG8_WAIT_L(0); PG8_BAR; PG8_MMA(1, 0, At, B0); PG8_MMA(1, 1, At, B1); PG8_BAR; PG8_SCHED;
            } else {
            PG8_LDB(B0, 0, 0); PG8_SCHED; PG8_LDA(At, 0, 0); PG8_STAGE(PG8_SA(1, 1), a1 + hstep, voffA);
            PG8_WAIT_L(8); PG8_BAR; PG8_WAIT_L(0); PG8_MMA(0, 0, At, B0); PG8_BAR; PG8_SCHED;
            PG8_LDB(B1, 0, 1); PG8_STAGE(PG8_SB(0, 0), b2, voffB);
            PG8_BAR; PG8_WAIT_L(0); PG8_MMA(0, 1, At, B1); PG8_BAR;
            PG8_LDA(At, 0, 1); PG8_STAGE(PG8_SA(0, 0), a2, voffA);
            PG8_BAR; PG8_WAIT_L(0); PG8_MMA(1, 0, At, B0); PG8_BAR; PG8_SCHED;
            PG8_STAGE(PG8_SB(0, 1), b2 + hstep, voffB);
            PG8_WAIT_V(6); PG8_BAR; PG8_MMA(1, 1, At, B1); PG8_BAR;
            PG8_LDB(B0, 1, 0); PG8_SCHED; PG8_LDA(At, 1, 0); PG8_STAGE(PG8_SA(0, 1), a2 + hstep, voffA);
            PG8_WAIT_L(8); PG8_BAR; PG8_WAIT_L(0); PG8_MMA(0, 0, At, B0); PG8_BAR; PG8_SCHED;
            PG8_LDB(B1, 1, 1); PG8_STAGE(PG8_SB(1, 0), b3, voffB);
            PG8_BAR; PG8_WAIT_L(0); PG8_MMA(0, 1, At, B1); PG8_BAR;
            PG8_LDA(At, 1, 1); PG8_STAGE(PG8_SA(1, 0), a3, voffA);
            PG8_BAR; PG8_WAIT_L(0); PG8_MMA(1, 0, At, B0); PG8_BAR; PG8_SCHED;
            PG8_STAGE(PG8_SB(1, 1), b3 + hstep, voffB);
            PG8_WAIT_V(6); PG8_BAR; PG8_MMA(1, 1, At, B1); PG8_BAR;
            }
        }
        if constexpr (ALIGN_EPI) { if (wr == 0) PG8_BAR; }
        if constexpr (!Epi::AFTER_DRAIN) { E(acc, cur, wr, wc, fr, fq); S.done(cur); }
        if (!has_next) break;
#pragma unroll
        for (int a = 0; a < 2; ++a)
#pragma unroll
            for (int b = 0; b < 2; ++b)
#pragma unroll
                for (int m = 0; m < 4; ++m)
#pragma unroll
                    for (int n = 0; n < 2; ++n) acc[a][b][m][n] = (f32x4){0.f, 0.f, 0.f, 0.f};
        cur = nxt; cA = nA; cB = nB; ++ui;
        if constexpr (ALIGN_EPI) { if (wr == 1) PG8_BAR; }
    }
    PG8_WAIT_V(0);
    if constexpr (!ALIGN_EPI) { if (wr == 0) PG8_BAR; }
    PG8_BAR;
    if constexpr (Epi::AFTER_DRAIN) { E.fused(acc, cur, wr, wc, fr, fq, lds, wid, lane); S.done(cur); }
#undef PG8_SA
#undef PG8_SB
#undef PG8_STAGE
#undef PG8_LDA
#undef PG8_LDB
#undef PG8_MMA
#undef PG8_WAIT_V
#undef PG8_WAIT_L
#undef PG8_BAR
#undef PG8_SCHED
}
}

#define LAS __attribute__((address_space(3)))
typedef unsigned short bf16_t;
typedef short bf16x8 __attribute__((ext_vector_type(8)));
typedef short bf16x4 __attribute__((ext_vector_type(4)));
typedef float f32x4 __attribute__((ext_vector_type(4)));
typedef float f32x16 __attribute__((ext_vector_type(16)));
typedef unsigned u32x4 __attribute__((ext_vector_type(4)));
typedef unsigned u32x2 __attribute__((ext_vector_type(2)));
typedef __bf16 bf16x2_t __attribute__((ext_vector_type(2)));

constexpr int NB = 16, SEQ = 2048, T = NB * SEQ, D = 1024;
constexpr int PP = 4608;
constexpr int C_Q = 0, C_KF = 512, C_LFF = 1024, C_KB = 1536, C_LFB = 2048, C_V = 2560, C_G = 3072, C_DQ = 3584, C_DK = 4096;
constexpr float EPS = 1e-6f;
constexpr float LOG2E = 1.4426950408889634f;
constexpr int NWAVES = 8, NTHREADS = 512;
constexpr int NGRP = 4, GRP_SHIFT = 12, GRP_SIZE = 4096, VSL = 128, NVS = 4;
constexpr int LDS_BYTES = 147456;

constexpr size_t MiB = (size_t)1 << 20;
constexpr size_t WS_SM = 64 * 1024;
constexpr size_t WS_WINT = 2 * MiB, WS_WOT = 10 * MiB, WS_WQT = 12 * MiB, WS_KEYS = 16 * MiB;
constexpr size_t WS_UT = 32 * MiB, WS_USC = 48 * MiB, WS_VSC = 49 * MiB, WS_VE = 64 * MiB, WS_XN = 96 * MiB, WS_PROJ = 160 * MiB, WS_VT = 448 * MiB, WS_END = 480 * MiB;
constexpr size_t WS_H1B = 160 * MiB, WS_QP = 224 * MiB, WS_IDX = 360 * MiB, WS_GATE = 376 * MiB, WS_SS = 392 * MiB, WS_C = 394 * MiB;
constexpr int QPS = 2048 + 64;
constexpr size_t WS_US8 = 48 * MiB + 131072;
constexpr size_t WS_H1Q = 96 * MiB, WS_HSC = 128 * MiB;
constexpr int SM_LBF = 0, SM_LBB = 512, SM_LAM = 1024, SM_BT = 2048, BT_STRIDE = 260;

struct Params { const float* in[19]; float* out; unsigned char* ws; int ph_lo, ph_hi; };
enum { I_X = 0, I_G1, I_WIN, I_LBF, I_LBB, I_HOG, I_LQ1, I_LK1, I_LQ2, I_LK2, I_DOG, I_RB, I_WOUT, I_G2, I_WQ, I_KEYS, I_U, I_V, I_FG };

#define LDS_WAIT() asm volatile("s_waitcnt lgkmcnt(0)" ::: "memory")
__device__ __forceinline__ unsigned f2bf(float f) { unsigned u = __builtin_bit_cast(unsigned, f); return (u + 0x7fffu + ((u >> 16) & 1u)) >> 16; }
typedef float f32x2v_ __attribute__((ext_vector_type(2)));
__device__ __forceinline__ unsigned pk2(float lo, float hi) { const f32x2v_ v = {lo, hi}; return __builtin_bit_cast(unsigned, __builtin_convertvector(v, bf16x2_t)); }
__device__ __forceinline__ float bflo(unsigned w) { return __uint_as_float(w << 16); }
__device__ __forceinline__ float bfhi(unsigned w) { return __uint_as_float(w & 0xffff0000u); }
template <int CTRL> __device__ __forceinline__ float dpp_mov(float v) { return __builtin_bit_cast(float, __builtin_amdgcn_update_dpp(0, __builtin_bit_cast(int, v), CTRL, 0xF, 0xF, false)); }
__device__ __forceinline__ void swap16_(float& a, float& b) { asm volatile("s_nop 1\n\tv_permlane16_swap_b32 %0, %1\n\ts_nop 1" : "+v"(a), "+v"(b)); }
__device__ __forceinline__ void swap32_(float& a, float& b) { asm volatile("s_nop 1\n\tv_permlane32_swap_b32 %0, %1\n\ts_nop 1" : "+v"(a), "+v"(b)); }
__device__ __forceinline__ void swap16i_(int& a, int& b) { asm volatile("s_nop 1\n\tv_permlane16_swap_b32 %0, %1\n\ts_nop 1" : "+v"(a), "+v"(b)); }
__device__ __forceinline__ void swap32i_(int& a, int& b) { asm volatile("s_nop 1\n\tv_permlane32_swap_b32 %0, %1\n\ts_nop 1" : "+v"(a), "+v"(b)); }
__device__ __forceinline__ float swap16_sum(float v) { float a = v, b = v; swap16_(a, b); return a + b; }
__device__ __forceinline__ float swap32_sum(float v) { float a = v, b = v; swap32_(a, b); return a + b; }
__device__ __forceinline__ float swap16_max(float v) { float a = v, b = v; swap16_(a, b); return fmaxf(a, b); }
__device__ __forceinline__ float swap32_max(float v) { float a = v, b = v; swap32_(a, b); return fmaxf(a, b); }
__device__ __forceinline__ float xchg16(float v, int lane) { float a = v, b = v; swap16_(a, b); return (lane & 16) ? a : b; }
__device__ __forceinline__ float xchg32(float v, int lane) { float a = v, b = v; swap32_(a, b); return (lane & 32) ? a : b; }
__device__ __forceinline__ float wave_sum(float v) {
    v += dpp_mov<0xB1>(v); v += dpp_mov<0x4E>(v); v += dpp_mov<0x141>(v); v += dpp_mov<0x140>(v);
    return swap32_sum(swap16_sum(v));
}
__device__ __forceinline__ float wave_max(float v) {
    v = fmaxf(v, dpp_mov<0xB1>(v)); v = fmaxf(v, dpp_mov<0x4E>(v)); v = fmaxf(v, dpp_mov<0x141>(v)); v = fmaxf(v, dpp_mov<0x140>(v));
    return swap32_max(swap16_max(v));
}
__device__ __forceinline__ float sigmoidf_(float z) { return __builtin_amdgcn_rcpf(1.0f + __expf(-z)); }

__device__ __forceinline__ void p0_transpose_item(const float* W, int K, int N, bf16_t* WT, const float* kscale, LAS float* scr, int item, int lane) {
    const int nblk = N / 32, kb = item / nblk, nb = item % nblk, k0 = 64 * kb, n0 = 32 * nb;
#pragma unroll 8
    for (int i = 0; i < 32; ++i) { const int kk = 2 * i + (lane >> 5); float w = W[(size_t)(k0 + kk) * N + n0 + (lane & 31)]; if (kscale) w *= kscale[k0 + kk]; scr[kk * 33 + (lane & 31)] = w; }
    LDS_WAIT(); asm volatile("" ::: "memory");
    const int c = lane & 7;
#pragma unroll
    for (int j = 0; j < 4; ++j) { const int n = (lane >> 3) + 8 * j; const LAS float* s = scr + (8 * c) * 33 + n;
        u32x4 o; o.x = pk2(s[0 * 33], s[1 * 33]); o.y = pk2(s[2 * 33], s[3 * 33]); o.z = pk2(s[4 * 33], s[5 * 33]); o.w = pk2(s[6 * 33], s[7 * 33]);
        *(u32x4*)(WT + (size_t)(n0 + n) * K + k0 + 8 * c) = o; }
    LDS_WAIT(); asm volatile("" ::: "memory");
}
__device__ __forceinline__ int t5_bucket(int rel) {
    const int n = rel < 0 ? -rel : rel;
    const int v = n < 8 ? n : n < 12 ? 8 : n < 16 ? 9 : n < 23 ? 10 : n < 32 ? 11 : n < 46 ? 12 : n < 64 ? 13 : n < 91 ? 14 : 15;
    return (rel > 0 ? 16 : 0) + v;
}
__device__ __forceinline__ void phase_prep(const Params& p, LAS unsigned char* lds, int vcu, int G) {
    const int tid = threadIdx.x, lane = tid & 63, wave = __builtin_amdgcn_readfirstlane(tid >> 6);
    unsigned char* ws = p.ws;
    LAS float* scr = (LAS float*)(lds + wave * 16384);
    const int gw = vcu * NWAVES + wave, NGW = G * NWAVES;
    constexpr int I_IN = (D / 64) * (4096 / 32), I_OUT = (D / 64) * (D / 32), I_QW = (D / 64) * (2048 / 32);
    for (int it = gw; it < I_IN + I_OUT + I_QW; it += NGW) {
        int r = it;
        if (r < I_IN) { p0_transpose_item(p.in[I_WIN], D, 4096, (bf16_t*)(ws + WS_WINT), nullptr, scr, r, lane); continue; } r -= I_IN;
        if (r < I_OUT) { p0_transpose_item(p.in[I_WOUT], D, D, (bf16_t*)(ws + WS_WOT), nullptr, scr, r, lane); continue; } r -= I_OUT;
        p0_transpose_item(p.in[I_WQ], D, 2048, (bf16_t*)(ws + WS_WQT), p.in[I_G2], scr, r, lane);
    }
    for (int i = blockIdx.x * NTHREADS + tid; i < 8 * 2 * 128 * 128 / 4; i += G * NTHREADS) {
        const f32x4 v = ((const f32x4*)p.in[I_KEYS])[i];
        ((u32x2*)(ws + WS_KEYS))[i] = (u32x2){pk2(v.x, v.y), pk2(v.z, v.w)};
    }
#define PX_LOAD(dst, m0_) { _Pragma("unroll") for (int u = 0; u < 4; ++u) { const int m = ((m0_) + u * NGW) < T ? ((m0_) + u * NGW) : gw; const f32x4* xr = (const f32x4*)(p.in[I_X] + (size_t)m * D) + lane; \
            _Pragma("unroll") for (int j = 0; j < 4; ++j) dst[u][j] = xr[64 * j]; } }
#define PX_PROC(src, m0_) { _Pragma("unroll") for (int u = 0; u < 4; ++u) { const int m = (m0_) + u * NGW; if (m < T) { float ssq = 0.f; \
            _Pragma("unroll") for (int j = 0; j < 4; ++j) ssq += (src[u][j].x * src[u][j].x + src[u][j].y * src[u][j].y) + (src[u][j].z * src[u][j].z + src[u][j].w * src[u][j].w); \
            const float rs = rsqrtf(wave_sum(ssq) * (1.f / D) + EPS); unsigned long long* o8 = (unsigned long long*)((bf16_t*)(ws + WS_XN) + (size_t)m * D) + lane; \
            _Pragma("unroll") for (int j = 0; j < 4; ++j) { const f32x4 y = src[u][j] * rs * ((const f32x4*)p.in[I_G1])[64 * j + lane]; o8[64 * j] = (unsigned long long)pk2(y.x, y.y) | ((unsigned long long)pk2(y.z, y.w) << 32); } } } }
    {
        f32x4 va[4][4], vb[4][4];
        PX_LOAD(va, gw)
        for (int m0 = gw; m0 < T; m0 += 8 * NGW) {
            if (m0 + 4 * NGW < T) PX_LOAD(vb, m0 + 4 * NGW)
            PX_PROC(va, m0)
            if (m0 + 8 * NGW < T) PX_LOAD(va, m0 + 8 * NGW)
            PX_PROC(vb, m0 + 4 * NGW)
        }
    }
    if (blockIdx.x == 0) {
        float* sm = (float*)(ws + WS_SM);
        { const float* a = p.in[I_LBF]; sm[SM_LBF + tid] = 1.f / (1.f + __expf(a[512 + tid] - a[tid])); }
        { const float* a = p.in[I_LBB]; sm[SM_LBB + tid] = 1.f / (1.f + __expf(a[512 + tid] - a[tid])); }
        if (tid < 64) {
            float a = p.in[I_LQ1][tid] * p.in[I_LK1][tid], b = p.in[I_LQ2][tid] * p.in[I_LK2][tid];
            a = wave_sum(a); b = wave_sum(b);
            if (tid == 0) sm[SM_LAM] = __expf(a) - __expf(b) + 0.2f;
        }
        for (int i = tid; i < 4 * 257; i += NTHREADS) { const int h = i / 257, r = i % 257; sm[SM_BT + h * BT_STRIDE + r] = p.in[I_RB][t5_bucket(r - 128) * 4 + h] * LOG2E; }
    }
}

__device__ __forceinline__ float silu_(float x) { return x * __builtin_amdgcn_rcpf(1.0f + __expf(-x)); }
struct EpiInProj {
    static constexpr bool PERM = true, AFTER_DRAIN = false;
    bf16_t* P; const float* sm;
    __device__ __forceinline__ void st8(bf16_t* dst, const float (&y)[8]) const { u32x4 w; w.x = pk2(y[0], y[1]); w.y = pk2(y[2], y[3]); w.z = pk2(y[4], y[5]); w.w = pk2(y[6], y[7]); *(u32x4*)dst = w; }
    __device__ __forceinline__ void operator()(const f32x4 (&acc)[2][2][4][2], const pg8::Unit& u, int wr, int wc, int fr, int fq) const {
        const int seg = u.pn >> 1;
        const int row0 = u.pm * 256 + wr * 64 + fr;
        const int cs0 = (u.pn & 1) * 256 + wc * 32 + 8 * fq;
#pragma unroll
        for (int bj = 0; bj < 2; ++bj) {
            const int cs = cs0 + bj * 128;
            float lb[8] = {0.f, 0.f, 0.f, 0.f, 0.f, 0.f, 0.f, 0.f};
            if (seg == 1 || seg == 2) {
#pragma unroll
                for (int i = 0; i < 8; ++i) lb[i] = sm[(seg == 1 ? SM_LBF : SM_LBB) + cs + i];
            }
#pragma unroll
            for (int ai = 0; ai < 2; ++ai)
#pragma unroll
                for (int m = 0; m < 4; ++m) {
                    const size_t row = (size_t)(row0 + ai * 128 + m * 16);
                    bf16_t* rp = P + row * PP + cs;
                    float x[8];
#pragma unroll
                    for (int i = 0; i < 4; ++i) { x[i] = acc[ai][bj][m][0][i]; x[4 + i] = acc[ai][bj][m][1][i]; }
                    float y[8];
                    if (seg == 0 || seg == 4) {
#pragma unroll
                        for (int i = 0; i < 8; ++i) y[i] = silu_(x[i]);
                        st8(rp + (seg == 0 ? C_Q : C_G), y);
                    } else if (seg == 1 || seg == 2) {
                        float lf[8];
#pragma unroll
                        for (int i = 0; i < 8; ++i) { const float s = sigmoidf_(x[i]); const float k = (1.f - lb[i]) * (1.f - s); y[i] = k; lf[i] = __logf(1.f - k); }
                        st8(rp + (seg == 1 ? C_KF : C_KB), y);
                        st8(rp + (seg == 1 ? C_LFF : C_LFB), lf);
                    } else if (seg == 3) {
                        st8(rp + C_V, x);
                    } else if (seg == 5) {
#pragma unroll
                        for (int i = 0; i < 8; ++i) y[i] = x[i] * (0.125f * LOG2E);
                        st8(rp + C_DQ, y);
                    } else {
                        st8(rp + C_DK, x);
                    }
                }
        }
    }
};
struct EpiStore {
    static constexpr bool PERM = true, AFTER_DRAIN = false;
    bf16_t* O; int ldc;
    __device__ __forceinline__ void operator()(const f32x4 (&acc)[2][2][4][2], const pg8::Unit& u, int wr, int wc, int fr, int fq) const {
        const int row0 = u.pm * 256 + wr * 64 + fr, col0 = u.pn * 256 + wc * 32 + 8 * fq;
#pragma unroll
        for (int ai = 0; ai < 2; ++ai)
#pragma unroll
            for (int m = 0; m < 4; ++m)
#pragma unroll
                for (int bj = 0; bj < 2; ++bj) {
                    const f32x4 a = acc[ai][bj][m][0], b = acc[ai][bj][m][1];
                    u32x4 w; w.x = pk2(a[0], a[1]); w.y = pk2(a[2], a[3]); w.z = pk2(b[0], b[1]); w.w = pk2(b[2], b[3]);
                    *(u32x4*)(O + (size_t)(row0 + ai * 128 + m * 16) * ldc + col0 + bj * 128) = w;
                }
    }
};
struct EpiOutProj {
    static constexpr bool PERM = true, AFTER_DRAIN = false;
    const float* x; float* H1; bf16_t* H1B; float* SS;
    __device__ __forceinline__ void operator()(const f32x4 (&acc)[2][2][4][2], const pg8::Unit& u, int wr, int wc, int fr, int fq) const {
        const int row0 = u.pm * 256 + wr * 64 + fr, col0 = u.pn * 256 + wc * 32 + 8 * fq;
#pragma unroll
        for (int ai = 0; ai < 2; ++ai)
#pragma unroll
            for (int m = 0; m < 4; ++m) {
                const size_t row = (size_t)(row0 + ai * 128 + m * 16);
                float ss = 0.f;
#pragma unroll
                for (int bj = 0; bj < 2; ++bj) {
                    const size_t off = row * D + col0 + bj * 128;
                    const f32x4 a = *(const f32x4*)(x + off) + acc[ai][bj][m][0], b = *(const f32x4*)(x + off + 4) + acc[ai][bj][m][1];
                    u32x4 w; w.x = pk2(a[0], a[1]); w.y = pk2(a[2], a[3]); w.z = pk2(b[0], b[1]); w.w = pk2(b[2], b[3]);
                    *(u32x4*)(H1B + off) = w;
                    ss += (a[0] * a[0] + a[1] * a[1]) + (a[2] * a[2] + a[3] * a[3]) + (b[0] * b[0] + b[1] * b[1]) + (b[2] * b[2] + b[3] * b[3]);
                }
                ss += __shfl_xor(ss, 16); ss += __shfl_xor(ss, 32);
                if (fq == 0) SS[row * 16 + u.pn * 4 + wc] = ss;
            }
    }
};
__device__ __forceinline__ float row_rstd(const float* SS, size_t row) {
    const f32x4* s = (const f32x4*)(SS + row * 16);
    const f32x4 a = s[0], b = s[1], c = s[2], d = s[3];
    const float t = ((a[0] + a[1]) + (a[2] + a[3])) + ((b[0] + b[1]) + (b[2] + b[3])) + ((c[0] + c[1]) + (c[2] + c[3])) + ((d[0] + d[1]) + (d[2] + d[3]));
    return rsqrtf(t * (1.f / D) + EPS);
}
struct EpiQ {
    static constexpr bool PERM = true, AFTER_DRAIN = false;
    bf16_t* O; const float* SS; float* RSTD;
    __device__ __forceinline__ void operator()(const f32x4 (&acc)[2][2][4][2], const pg8::Unit& u, int wr, int wc, int fr, int fq) const {
        const int row0 = u.pm * 256 + wr * 64 + fr, col0 = u.pn * 256 + wc * 32 + 8 * fq;
#pragma unroll
        for (int ai = 0; ai < 2; ++ai)
#pragma unroll
            for (int m = 0; m < 4; ++m) {
                const size_t row = (size_t)(row0 + ai * 128 + m * 16);
                const float rs = row_rstd(SS, row);
                if (u.pn == 0 && wc == 0 && fq == 0) RSTD[row] = rs;
#pragma unroll
                for (int bj = 0; bj < 2; ++bj) {
                    const f32x4 a = acc[ai][bj][m][0] * rs, b = acc[ai][bj][m][1] * rs;
                    u32x4 w; w.x = pk2(a[0], a[1]); w.y = pk2(a[2], a[3]); w.z = pk2(b[0], b[1]); w.w = pk2(b[2], b[3]);
                    *(u32x4*)(O + row * QPS + col0 + bj * 128) = w;
                }
            }
    }
};

constexpr int HQ_STRIDE = 272, HT_STRIDE = 48;
constexpr int H_QA = 0, H_KD = 4352, H_KH = 8704, H_VT = 14848, H_DEC = 20992, H_OPER = 21504, H_RAW = 2 * H_OPER, H_RAWB = 16384;
constexpr size_t HG_DONE_OFF = 32768 + 256;
__device__ __forceinline__ void phase_hgrn(const Params& p, LAS unsigned char* lds, int G) {
    const int tid = threadIdx.x, lane = tid & 63, wave = __builtin_amdgcn_readfirstlane(tid >> 6), fr = lane & 15, g = lane >> 4;
    const bf16_t* PROJ = (const bf16_t*)(p.ws + WS_PROJ);
    const int NCH = SEQ / 16;
    for (int item = blockIdx.x; item < 128; item += G) {
        const int dir = item & 1, h = (item >> 1) & 3, b = item >> 3;
        bf16_t* O = (bf16_t*)p.out + (size_t)dir * T * 512;
        const int ck = dir ? C_KB : C_KF, cl = dir ? C_LFB : C_LFF;
        const bool isv = tid >= 256; const int arow = (tid & 255) >> 4, ac8 = (tid & 15) * 8;
        u32x4 rq = (u32x4){0u, 0u, 0u, 0u}, rk = rq, rl = rq;
#define HG_GLOAD(ch) do { const int pos_ = (ch) * 16 + arow, tr_ = dir ? SEQ - 1 - pos_ : pos_; \
            const bf16_t* rp_ = PROJ + (size_t)(b * SEQ + tr_) * PP + h * 128 + ac8; \
            if (isv) { rq = *(const u32x4*)(rp_ + C_V); } else { rq = *(const u32x4*)(rp_ + C_Q); rk = *(const u32x4*)(rp_ + ck); rl = *(const u32x4*)(rp_ + cl); } } while (0)
#define HG_RAWSTORE(par) do { LAS unsigned char* R_ = lds + H_RAW + (par) * H_RAWB + arow * 256 + ac8 * 2; \
            if (isv) { *(LAS u32x4*)(R_ + 12288) = rq; } else { *(LAS u32x4*)R_ = rq; *(LAS u32x4*)(R_ + 4096) = rk; *(LAS u32x4*)(R_ + 8192) = rl; } } while (0)
        const int pc = tid & 127, part = tid >> 7;
        auto phaseB = [&](int par) {
            const LAS unsigned char* R = lds + H_RAW + par * H_RAWB; LAS unsigned char* OP = lds + par * H_OPER;
            float pre = 0.f, total = 0.f;
#pragma unroll
            for (int t = 0; t < 16; ++t) { const float v = __uint_as_float((unsigned)(*(const LAS unsigned short*)(R + 8192 + t * 256 + pc * 2)) << 16); total += v; pre += (t < 4 * part) ? v : 0.f; }
            float bb = pre; float kh[4], vv[4];
#pragma unroll
            for (int j = 0; j < 4; ++j) {
                const int t = 4 * part + j;
                const float lfv = __uint_as_float((unsigned)(*(const LAS unsigned short*)(R + 8192 + t * 256 + pc * 2)) << 16);
                const float qv = __uint_as_float((unsigned)(*(const LAS unsigned short*)(R + t * 256 + pc * 2)) << 16);
                const float kv = __uint_as_float((unsigned)(*(const LAS unsigned short*)(R + 4096 + t * 256 + pc * 2)) << 16);
                vv[j] = __uint_as_float((unsigned)(*(const LAS unsigned short*)(R + 12288 + t * 256 + pc * 2)) << 16);
                bb += lfv;
                *(LAS unsigned short*)(OP + H_QA + t * HQ_STRIDE + pc * 2) = (unsigned short)f2bf(qv * __expf(bb));
                *(LAS unsigned short*)(OP + H_KD + t * HQ_STRIDE + pc * 2) = (unsigned short)f2bf(kv * __expf(-bb));
                kh[j] = kv * __expf(total - bb);
            }
            *(LAS u32x2*)(OP + H_KH + pc * HT_STRIDE + part * 8) = (u32x2){pk2(kh[0], kh[1]), pk2(kh[2], kh[3])};
            *(LAS u32x2*)(OP + H_VT + pc * HT_STRIDE + part * 8) = (u32x2){pk2(vv[0], vv[1]), pk2(vv[2], vv[3])};
            if (part == 0) *(LAS float*)(OP + H_DEC + pc * 4) = __expf(total);
        };
        f32x4 S[8];
#pragma unroll
        for (int kt = 0; kt < 8; ++kt) S[kt] = (f32x4){0.f, 0.f, 0.f, 0.f};
        __syncthreads();
        HG_GLOAD(0); HG_RAWSTORE(0); HG_GLOAD(1);
        __syncthreads();
        phaseB(0); HG_RAWSTORE(1);
        __syncthreads();
        for (int i = 0; i < NCH; ++i) {
            if (i + 2 < NCH) HG_GLOAD(i + 2);
            if (i + 1 < NCH) phaseB((i + 1) & 1);
            {
                const LAS unsigned char* OP = lds + (i & 1) * H_OPER;
                f32x4 o = (f32x4){0.f, 0.f, 0.f, 0.f};
#pragma unroll
                for (int j = 0; j < 4; ++j) {
                    u32x4 w; w.x = pk2(S[2 * j][0], S[2 * j][1]); w.y = pk2(S[2 * j][2], S[2 * j][3]); w.z = pk2(S[2 * j + 1][0], S[2 * j + 1][1]); w.w = pk2(S[2 * j + 1][2], S[2 * j + 1][3]);
                    const u32x2 a0 = *(const LAS u32x2*)(OP + H_QA + fr * HQ_STRIDE + (32 * j + 4 * g) * 2), a1 = *(const LAS u32x2*)(OP + H_QA + fr * HQ_STRIDE + (32 * j + 16 + 4 * g) * 2);
                    o = __builtin_amdgcn_mfma_f32_16x16x32_bf16(__builtin_bit_cast(bf16x8, (u32x4){a0.x, a0.y, a1.x, a1.y}), __builtin_bit_cast(bf16x8, w), o, 0, 0, 0);
                }
                f32x4 X = (f32x4){0.f, 0.f, 0.f, 0.f};
#pragma unroll
                for (int j = 0; j < 4; ++j) {
                    const bf16x8 ak = *(const LAS bf16x8*)(OP + H_KD + fr * HQ_STRIDE + (32 * j + 8 * g) * 2), bq = *(const LAS bf16x8*)(OP + H_QA + fr * HQ_STRIDE + (32 * j + 8 * g) * 2);
                    X = __builtin_amdgcn_mfma_f32_16x16x32_bf16(ak, bq, X, 0, 0, 0);
                }
#pragma unroll
                for (int r = 0; r < 4; ++r) X[r] = (4 * g + r > fr) ? 0.f : X[r];
                const u32x2 vlo = *(const LAS u32x2*)(OP + H_VT + (16 * wave + fr) * HT_STRIDE + g * 8);
                const bf16x8 vb = __builtin_bit_cast(bf16x8, (u32x4){vlo.x, vlo.y, 0u, 0u});
                const bf16x8 pa = __builtin_bit_cast(bf16x8, (u32x4){pk2(X[0], X[1]), pk2(X[2], X[3]), 0u, 0u});
                o = __builtin_amdgcn_mfma_f32_16x16x32_bf16(pa, vb, o, 0, 0, 0);
#pragma unroll
                for (int r = 0; r < 4; ++r) { const int pos = i * 16 + 4 * g + r, tr = dir ? SEQ - 1 - pos : pos; O[(size_t)(b * SEQ + tr) * 512 + h * 128 + 16 * wave + fr] = (bf16_t)f2bf(o[r]); }
#pragma unroll
                for (int kt = 0; kt < 8; ++kt) {
                    const f32x4 dc = *(const LAS f32x4*)(OP + H_DEC + (16 * kt + 4 * g) * 4);
                    const u32x2 klo = *(const LAS u32x2*)(OP + H_KH + (16 * kt + fr) * HT_STRIDE + g * 8);
                    S[kt] = __builtin_amdgcn_mfma_f32_16x16x32_bf16(__builtin_bit_cast(bf16x8, (u32x4){klo.x, klo.y, 0u, 0u}), vb, S[kt] * dc, 0, 0, 0);
                }
            }
            if (i + 2 < NCH) HG_RAWSTORE(i & 1);
            __syncthreads();
        }
        asm volatile("s_waitcnt vmcnt(0)" ::: "memory");
        __syncthreads();
        if (tid == 0) { __builtin_amdgcn_fence(__ATOMIC_RELEASE, "agent"); asm volatile("s_waitcnt vmcnt(0)" ::: "memory");
            (void)__hip_atomic_fetch_add((unsigned*)(p.ws + HG_DONE_OFF), 1u, __ATOMIC_RELAXED, __HIP_MEMORY_SCOPE_AGENT); }
    }
}

constexpr int KT_STRIDE = 272, VT_STRIDE = 144;
constexpr int ATT_BUF = 64 * KT_STRIDE + 128 * VT_STRIDE;
constexpr int QUANT_ITEMS = 256;
__device__ __forceinline__ void quant_tables(const Params& p, int gw, int NGW, int lane) {
    unsigned char* ws = p.ws;
#define PQ_LOAD(dst, r0_) { _Pragma("unroll") for (int u = 0; u < 4; ++u) { const int r = ((r0_) + u * NGW) < 2 * 16384 ? ((r0_) + u * NGW) : gw; const bool isv = r >= 16384; const int e = isv ? r - 16384 : r; \
            const f32x4* xr = (const f32x4*)((isv ? p.in[I_V] : p.in[I_U]) + (size_t)e * D) + lane; _Pragma("unroll") for (int j = 0; j < 4; ++j) dst[u][j] = xr[64 * j]; } }
#define PQ_PROC(src, r0_) { _Pragma("unroll") for (int u = 0; u < 4; ++u) { const int r = (r0_) + u * NGW; if (r < 2 * 16384) { \
            const bool isv = r >= 16384; const int e = isv ? r - 16384 : r; f32x4 v[4]; float am = 0.f; \
            _Pragma("unroll") for (int j = 0; j < 4; ++j) { v[j] = src[u][j]; if (!isv) v[j] = v[j] * ((const f32x4*)p.in[I_G2])[64 * j + lane]; \
                am = fmaxf(am, fmaxf(fmaxf(fabsf(v[j].x), fabsf(v[j].y)), fmaxf(fabsf(v[j].z), fabsf(v[j].w)))); } \
            am = wave_max(am); const float sc = am > 0.f ? am * (1.f / 7.f) : 1.f, inv = 1.f / sc; unsigned pk[4]; int qs = 0; \
            _Pragma("unroll") for (int j = 0; j < 4; ++j) { \
                const int q0 = (int)rintf(v[j].x * inv), q1 = (int)rintf(v[j].y * inv), q2 = (int)rintf(v[j].z * inv), q3 = (int)rintf(v[j].w * inv); qs += (q0 + q1) + (q2 + q3); \
                pk[j] = (unsigned)((q0 & 0xFF) | ((q1 & 0xFF) << 8) | ((q2 & 0xFF) << 16) | ((q3 & 0xFF) << 24)); } \
            if (isv) {   \
                _Pragma("unroll") for (int j = 0; j < 4; ++j) { const unsigned k_ = pk[j]; \
                    *(unsigned short*)(ws + WS_VE + ((size_t)j * 16384 + e) * VSL + 2 * lane) = (unsigned short)(((k_ & 0xFu) ^ 8u) | ((k_ >> 4) & 0xF0u) | ((((k_ >> 16) & 0xFu) ^ 8u) << 8) | ((k_ >> 12) & 0xF000u)); } \
                if (lane == 0) ((float*)(ws + WS_VSC))[e] = sc; } \
            else {   \
                _Pragma("unroll") for (int j = 0; j < 2; ++j) *(unsigned*)(ws + WS_UT + (size_t)e * 512 + 256 * j + 4 * lane) = (pk[j] & 0x0F0F0F0Fu) | ((pk[j + 2] << 4) & 0xF0F0F0F0u); \
                const float qt = wave_sum((float)qs); if (lane == 0) { ((float*)(ws + WS_USC))[e] = sc; ((float*)(ws + WS_US8))[e] = 8.f * qt; } } } } }
    for (int r0 = gw; r0 < 2 * 16384; r0 += 4 * NGW) { f32x4 va[4][4]; PQ_LOAD(va, r0) PQ_PROC(va, r0) }
}
constexpr int MIX_ITEMS = 256;
__device__ __forceinline__ void mix_rows(const Params& p, int gw, int NGW, int lane) {
    const bf16_t* PROJ = (const bf16_t*)(p.ws + WS_PROJ);
    const bf16_t* OF = (const bf16_t*)p.out; const bf16_t* OB = OF + (size_t)T * 512;
    bf16_t* MIXED = (bf16_t*)(p.ws + WS_XN);
    const float* hog = p.in[I_HOG];
    const f32x4 g0 = *(const f32x4*)(hog + (lane & 15) * 8), g1 = *(const f32x4*)(hog + (lane & 15) * 8 + 4);
    for (int m0 = gw; m0 < T; m0 += 4 * NGW) {
        u32x4 av[4], bv[4], gv[4];
#pragma unroll
        for (int u = 0; u < 4; ++u) { const int m = (m0 + u * NGW) < T ? (m0 + u * NGW) : m0;
            av[u] = *(const u32x4*)(OF + (size_t)m * 512 + 8 * lane); bv[u] = *(const u32x4*)(OB + (size_t)m * 512 + 8 * lane); gv[u] = *(const u32x4*)(PROJ + (size_t)m * PP + C_G + 8 * lane); }
#pragma unroll
        for (int u = 0; u < 4; ++u) {
            const int m = m0 + u * NGW; if (m >= T) break;
            const u32x4 a = av[u], bb = bv[u], gg = gv[u];
            float o[8]; float ss = 0.f;
#pragma unroll
            for (int i = 0; i < 4; ++i) { o[2 * i] = bflo(a[i]) + bflo(bb[i]); o[2 * i + 1] = bfhi(a[i]) + bfhi(bb[i]); ss += o[2 * i] * o[2 * i] + o[2 * i + 1] * o[2 * i + 1]; }
            ss += dpp_mov<0xB1>(ss); ss += dpp_mov<0x4E>(ss); ss += dpp_mov<0x141>(ss); ss += dpp_mov<0x140>(ss);
            const float rs = rsqrtf(ss * (1.f / 128.f) + EPS);
            float y[8];
#pragma unroll
            for (int i = 0; i < 4; ++i) { y[2 * i] = o[2 * i] * rs * (i < 2 ? g0[2 * i] : g1[2 * i - 4]) * bflo(gg[i]); y[2 * i + 1] = o[2 * i + 1] * rs * (i < 2 ? g0[2 * i + 1] : g1[2 * i - 3]) * bfhi(gg[i]); }
            *(u32x4*)(MIXED + (size_t)m * D + 8 * lane) = (u32x4){pk2(y[0], y[1]), pk2(y[2], y[3]), pk2(y[4], y[5]), pk2(y[6], y[7])};
        }
    }
}

__device__ __forceinline__ float MAX3_(float a, float b, float c) { float r; asm("v_max3_f32 %0, %1, %2, %3" : "=v"(r) : "v"(a), "v"(b), "v"(c)); return r; }
__device__ __forceinline__ void phase_attn(const Params& p, LAS unsigned char* lds, int G) {
    const int tid = threadIdx.x, lane = tid & 63, wave = __builtin_amdgcn_readfirstlane(tid >> 6), fr = lane & 15, fq = lane >> 4;
    const bf16_t* PROJ = (const bf16_t*)(p.ws + WS_PROJ);
    const bf16_t* VT = (const bf16_t*)(p.ws + WS_VT);
    bf16_t* MIXED = (bf16_t*)(p.ws + WS_XN);
    const float* sm = (const float*)(p.ws + WS_SM);
    LAS unsigned char* LK = lds; LAS unsigned char* LV = lds + 64 * KT_STRIDE; LAS float* LB = (LAS float*)(lds + 2 * ATT_BUF);
    const float lam = sm[SM_LAM];
    float vinf = __builtin_inff(); asm volatile("" : "+v"(vinf));
    unsigned* qctr = (unsigned*)(p.ws + 32768);
    volatile LAS unsigned* qslot = (volatile LAS unsigned*)(lds + 131072 + 320 + 64);
    for (;;) {
        __syncthreads();
        if (tid == 0) qslot[0] = __hip_atomic_fetch_add(qctr, 1u, __ATOMIC_RELAXED, __HIP_MEMORY_SCOPE_AGENT);
        __syncthreads();
        const int item = (int)qslot[0];
        if (item >= 1024 + QUANT_ITEMS + MIX_ITEMS) break;
        if (item >= 1024 + QUANT_ITEMS) {
            if (tid == 0) { unsigned sp_ = 0; while (__hip_atomic_load((unsigned*)(p.ws + HG_DONE_OFF), __ATOMIC_RELAXED, __HIP_MEMORY_SCOPE_AGENT) < 128u && ++sp_ < (1u << 24)) __builtin_amdgcn_s_sleep(2);
                __builtin_amdgcn_fence(__ATOMIC_ACQUIRE, "agent"); asm volatile("s_waitcnt vmcnt(0)" ::: "memory"); }
            __syncthreads();
            mix_rows(p, (item - 1024 - QUANT_ITEMS) * NWAVES + wave, MIX_ITEMS * NWAVES, lane); continue;
        }
        if (item >= 1024) { quant_tables(p, (item - 1024) * NWAVES + wave, QUANT_ITEMS * NWAVES, lane); continue; }
        const int bh = item >> 4, qb = item & 15, b = bh >> 2, h = bh & 3;
        const int qabs = qb * 128 + wave * 16 + fr;
        const size_t qrow = (size_t)b * SEQ + qabs;
        __syncthreads();
        for (int i = tid; i < 257; i += NTHREADS) LB[i] = sm[SM_BT + h * BT_STRIDE + i];
        bf16x8 qf[2][2];
#pragma unroll
        for (int m = 0; m < 2; ++m)
#pragma unroll
            for (int kk = 0; kk < 2; ++kk) qf[m][kk] = *(const bf16x8*)(PROJ + qrow * PP + C_DQ + h * 128 + m * 64 + kk * 32 + fq * 8);
        float mrun[2] = {0.f, 0.f};
        f32x4 lacc[2] = {(f32x4){0.f, 0.f, 0.f, 0.f}, (f32x4){0.f, 0.f, 0.f, 0.f}};
        f32x4 o[2][8];
#pragma unroll
        for (int m = 0; m < 2; ++m)
#pragma unroll
            for (int dt = 0; dt < 8; ++dt) o[m][dt] = (f32x4){0.f, 0.f, 0.f, 0.f};
        u32x4 kreg[2], vreg[2];
        const bf16_t* kg[2]; const bf16_t* vg[2]; int koff[2], voff[2];
#pragma unroll
        for (int i = 0; i < 2; ++i) { const int c = tid + i * 512;
            const int kr = c >> 4, kc = (c & 15) * 8; kg[i] = PROJ + ((size_t)b * SEQ + kr) * PP + C_DK + h * 128 + kc; koff[i] = kr * KT_STRIDE + kc * 2;
            const int vr = c >> 3, vc = (c & 7) * 8; vg[i] = VT + (size_t)(h * 128 + vr) * T + (size_t)b * SEQ + vc; voff[i] = vr * VT_STRIDE + vc * 2; }
#pragma unroll
        for (int i = 0; i < 2; ++i) { kreg[i] = *(const u32x4*)kg[i]; vreg[i] = *(const u32x4*)vg[i]; }
#pragma unroll
        for (int i = 0; i < 2; ++i) { *(LAS u32x4*)(LK + koff[i]) = kreg[i]; *(LAS u32x4*)(LV + voff[i]) = vreg[i]; }
        __syncthreads();
        const int Qw = qb * 128 + wave * 16;
        for (int kt = 0; kt < SEQ / 64; ++kt) {
            const int pbuf = (kt & 1) * ATT_BUF;
            if (kt + 1 < SEQ / 64) {
#pragma unroll
                for (int i = 0; i < 2; ++i) { kreg[i] = *(const u32x4*)(kg[i] + (size_t)(kt + 1) * 64 * PP); vreg[i] = *(const u32x4*)(vg[i] + (kt + 1) * 64); }
            }
            const int k0 = kt * 64;
            const bool farl = (k0 + 63 - Qw) <= -91, farr = (k0 - (Qw + 15)) >= 91;
            const float binit = farl ? LB[0] : (farr ? LB[256] : 0.f);
            f32x4 s[2][4];
#pragma unroll
            for (int m = 0; m < 2; ++m) {
                const float ci = binit - mrun[m];
#pragma unroll
                for (int ks = 0; ks < 4; ++ks) {
                    f32x4 a = (f32x4){ci, ci, ci, ci};
#pragma unroll
                    for (int kk = 0; kk < 2; ++kk) {
                        const bf16x8 kf = *(const LAS bf16x8*)(LK + pbuf + (16 * ks + fr) * KT_STRIDE + (m * 64 + kk * 32 + fq * 8) * 2);
                        a = __builtin_amdgcn_mfma_f32_16x16x32_bf16(kf, qf[m][kk], a, 0, 0, 0);
                    }
                    s[m][ks] = a;
                }
            }
            if (!(farl || farr)) {
#pragma unroll
                for (int ks = 0; ks < 4; ++ks)
#pragma unroll
                    for (int r = 0; r < 4; ++r) {
                        int rel = k0 + 16 * ks + 4 * fq + r - qabs; rel = rel < -128 ? -128 : (rel > 128 ? 128 : rel);
                        const float bv = LB[rel + 128];
                        s[0][ks][r] += bv; s[1][ks][r] += bv;
                    }
            }
            bf16x8 pb[2][2];
#pragma unroll
            for (int m = 0; m < 2; ++m) {
                float mx = MAX3_(__builtin_amdgcn_fmed3f(s[m][0][0], s[m][1][0], vinf), __builtin_amdgcn_fmed3f(s[m][2][0], s[m][3][0], vinf), s[m][0][1]);
                mx = MAX3_(mx, s[m][0][2], s[m][0][3]); mx = MAX3_(mx, s[m][1][1], s[m][1][2]); mx = MAX3_(mx, s[m][1][3], s[m][2][1]);
                mx = MAX3_(mx, s[m][2][2], s[m][2][3]); mx = MAX3_(mx, s[m][3][1], s[m][3][2]); mx = MAX3_(mx, mx, s[m][3][3]);
                { float a_ = mx, b_ = mx; swap16_(a_, b_); mx = MAX3_(a_, b_, b_); }
                { float a_ = mx, b_ = mx; swap32_(a_, b_); mx = MAX3_(a_, b_, b_); }
                if (__any(fabsf(mx) > 8.0f)) {
                    const float dl = fabsf(mx) > 8.0f ? mx : 0.f, alpha = __builtin_amdgcn_exp2f(-dl);
                    mrun[m] += dl; lacc[m] *= alpha;
#pragma unroll
                    for (int ks = 0; ks < 4; ++ks) s[m][ks] = s[m][ks] - dl;
#pragma unroll
                    for (int dt = 0; dt < 8; ++dt) o[m][dt] *= alpha;
                }
#pragma unroll
                for (int ks = 0; ks < 4; ++ks)
#pragma unroll
                    for (int r = 0; r < 4; ++r) s[m][ks][r] = __builtin_amdgcn_exp2f(s[m][ks][r]);
#pragma unroll
                for (int k2 = 0; k2 < 2; ++k2) {
                    u32x4 w; w.x = pk2(s[m][2 * k2][0], s[m][2 * k2][1]); w.y = pk2(s[m][2 * k2][2], s[m][2 * k2][3]);
                    w.z = pk2(s[m][2 * k2 + 1][0], s[m][2 * k2 + 1][1]); w.w = pk2(s[m][2 * k2 + 1][2], s[m][2 * k2 + 1][3]);
                    pb[m][k2] = __builtin_bit_cast(bf16x8, w);
                }
            }
            const bf16x8 ones = __builtin_bit_cast(bf16x8, (u32x4){0x3F803F80u, 0x3F803F80u, 0x3F803F80u, 0x3F803F80u});
#pragma unroll
            for (int k2 = 0; k2 < 2; ++k2) {
                lacc[0] = __builtin_amdgcn_mfma_f32_16x16x32_bf16(ones, pb[0][k2], lacc[0], 0, 0, 0);
                lacc[1] = __builtin_amdgcn_mfma_f32_16x16x32_bf16(ones, pb[1][k2], lacc[1], 0, 0, 0);
#pragma unroll
                for (int dt = 0; dt < 8; ++dt) {
                    const u32x2 lo = *(const LAS u32x2*)(LV + pbuf + (16 * dt + fr) * VT_STRIDE + (32 * k2 + 4 * fq) * 2);
                    const u32x2 hi = *(const LAS u32x2*)(LV + pbuf + (16 * dt + fr) * VT_STRIDE + (32 * k2 + 16 + 4 * fq) * 2);
                    const bf16x8 vf = __builtin_bit_cast(bf16x8, (u32x4){lo.x, lo.y, hi.x, hi.y});
                    o[0][dt] = __builtin_amdgcn_mfma_f32_16x16x32_bf16(vf, pb[0][k2], o[0][dt], 0, 0, 0);
                    o[1][dt] = __builtin_amdgcn_mfma_f32_16x16x32_bf16(vf, pb[1][k2], o[1][dt], 0, 0, 0);
                }
            }
            if (kt + 1 < SEQ / 64) {
                const int nbuf = ((kt + 1) & 1) * ATT_BUF;
#pragma unroll
                for (int i = 0; i < 2; ++i) { *(LAS u32x4*)(LK + nbuf + koff[i]) = kreg[i]; *(LAS u32x4*)(LV + nbuf + voff[i]) = vreg[i]; }
            }
            __syncthreads();
        }
        float inv[2];
#pragma unroll
        for (int m = 0; m < 2; ++m) inv[m] = __builtin_amdgcn_rcpf(lacc[m][0]);
        float ssq = 0.f;
#pragma unroll
        for (int dt = 0; dt < 8; ++dt)
#pragma unroll
            for (int r = 0; r < 4; ++r) { const float ov = o[0][dt][r] * inv[0] - lam * (o[1][dt][r] * inv[1]); o[0][dt][r] = ov; ssq += ov * ov; }
        ssq += __shfl_xor(ssq, 16); ssq += __shfl_xor(ssq, 32);
        const float rs = rsqrtf(ssq * (1.f / 128.f) + EPS) * 0.8f;
        const float* og = p.in[I_DOG];
#pragma unroll
        for (int dt = 0; dt < 8; ++dt) {
            const f32x4 g = *(const f32x4*)(og + 16 * dt + 4 * fq);
            const f32x4 y = o[0][dt] * rs * g;
            *(u32x2*)(MIXED + qrow * D + 512 + h * 128 + 16 * dt + 4 * fq) = (u32x2){pk2(y[0], y[1]), pk2(y[2], y[3])};
        }
    }
}

__device__ __forceinline__ void phase_hquant(const Params& p, int vcu, int G) {
    const int tid = threadIdx.x, lane = tid & 63, wave = __builtin_amdgcn_readfirstlane(tid >> 6);
    const bf16_t* H1B = (const bf16_t*)(p.ws + WS_H1B); const float* SS = (const float*)(p.ws + WS_SS);
    for (int t0 = vcu * NWAVES + wave; t0 < T; t0 += 4 * G * NWAVES) {
        u32x4 ha[4], hb[4];
#pragma unroll
        for (int u = 0; u < 4; ++u) { const int t = (t0 + u * G * NWAVES) < T ? (t0 + u * G * NWAVES) : t0; ha[u] = *(const u32x4*)(H1B + (size_t)t * D + 8 * lane); hb[u] = *(const u32x4*)(H1B + (size_t)t * D + 512 + 8 * lane); }
#pragma unroll
        for (int u = 0; u < 4; ++u) {
            const int t = t0 + u * G * NWAVES; if (t >= T) break;
            const u32x4 h0 = ha[u], h1 = hb[u];
            float hf[16]; float am = 0.f;
#pragma unroll
            for (int k = 0; k < 4; ++k) { hf[2 * k] = bflo(h0[k]); hf[2 * k + 1] = bfhi(h0[k]); hf[8 + 2 * k] = bflo(h1[k]); hf[8 + 2 * k + 1] = bfhi(h1[k]); }
#pragma unroll
            for (int k = 0; k < 16; ++k) am = fmaxf(am, fabsf(hf[k]));
            am = wave_max(am);
            const float iv = am > 0.f ? 127.f / am : 0.f;
            u32x4 q;
#pragma unroll
            for (int w = 0; w < 4; ++w) { const int q0 = (int)rintf(hf[4 * w] * iv), q1 = (int)rintf(hf[4 * w + 1] * iv), q2 = (int)rintf(hf[4 * w + 2] * iv), q3 = (int)rintf(hf[4 * w + 3] * iv);
                q[w] = (unsigned)((q0 & 0xFF) | ((q1 & 0xFF) << 8) | ((q2 & 0xFF) << 16) | ((q3 & 0xFF) << 24)); }
            u32x2 ph, pl;
#pragma unroll
            for (int w = 0; w < 2; ++w) { ph[w] = ((q[w] >> 4) & 0x0F0F0F0Fu) | (q[2 + w] & 0xF0F0F0F0u); pl[w] = ((q[w] & 0x0F0F0F0Fu) | ((q[2 + w] << 4) & 0xF0F0F0F0u)) ^ 0x88888888u; }
            *(u32x2*)(p.ws + WS_H1Q + (size_t)t * D + 8 * lane) = ph; *(u32x2*)(p.ws + WS_H1Q + (size_t)t * D + 512 + 8 * lane) = pl;
            if (lane == 0) ((float*)(p.ws + WS_HSC))[t] = am * (1.f / 127.f) * row_rstd(SS, (size_t)t);
        }
    }
}
__device__ __forceinline__ unsigned ford(float f) { const unsigned u = __float_as_uint(f); return (u & 0x80000000u) ? ~u : (u | 0x80000000u); }
__device__ __forceinline__ float funord(unsigned u) { u = (u & 0x80000000u) ? (u & 0x7fffffffu) : ~u; return __uint_as_float(u); }
template <int N> __device__ __forceinline__ void bitonic_sort_desc(unsigned (&v)[N]) {
#pragma unroll
    for (int k = 2; k <= N; k <<= 1)
#pragma unroll
        for (int j = k >> 1; j > 0; j >>= 1)
#pragma unroll
            for (int i = 0; i < N; ++i) { const int l = i ^ j;
                if (l > i) { const unsigned a = v[i], b = v[l]; const unsigned mx = a > b ? a : b, mn = a > b ? b : a; if ((i & k) == 0) { v[i] = mx; v[l] = mn; } else { v[i] = mn; v[l] = mx; } } }
}
__device__ __forceinline__ void merge_top16(unsigned (&a)[16], const unsigned (&b)[16]) {
#pragma unroll
    for (int i = 0; i < 16; ++i) a[i] = a[i] > b[15 - i] ? a[i] : b[15 - i];
#pragma unroll
    for (int j = 8; j > 0; j >>= 1)
#pragma unroll
        for (int i = 0; i < 16; ++i) { const int l = i ^ j; if (l > i) { const unsigned x = a[i], y = a[l]; a[i] = x > y ? x : y; a[l] = x > y ? y : x; } }
}
__device__ __forceinline__ void sort16_desc(unsigned (&v)[16]) {
#define CE_(a_, b_) { const unsigned x_ = v[a_], y_ = v[b_]; v[a_] = x_ > y_ ? x_ : y_; v[b_] = x_ > y_ ? y_ : x_; }
    CE_(0, 1) CE_(2, 3) CE_(0, 2) CE_(1, 3) CE_(1, 2) CE_(4, 5) CE_(6, 7) CE_(4, 6) CE_(5, 7) CE_(5, 6) CE_(0, 4) CE_(2, 6) CE_(2, 4) CE_(1, 5) CE_(3, 7) CE_(3, 5) CE_(1, 2) CE_(3, 4) CE_(5, 6) CE_(8, 9) CE_(10, 11) CE_(8, 10) CE_(9, 11) CE_(9, 10) CE_(12, 13) CE_(14, 15) CE_(12, 14) CE_(13, 15) CE_(13, 14) CE_(8, 12) CE_(10, 14) CE_(10, 12) CE_(9, 13) CE_(11, 15) CE_(11, 13) CE_(9, 10) CE_(11, 12) CE_(13, 14) CE_(0, 8) CE_(4, 12) CE_(4, 8) CE_(2, 10) CE_(6, 14) CE_(6, 10) CE_(2, 4) CE_(6, 8) CE_(10, 12) CE_(1, 9) CE_(5, 13) CE_(5, 9) CE_(3, 11) CE_(7, 15) CE_(7, 11) CE_(3, 5) CE_(7, 9) CE_(11, 13) CE_(1, 2) CE_(3, 4) CE_(5, 6) CE_(7, 8) CE_(9, 10) CE_(11, 12) CE_(13, 14)
#undef CE_
}
__device__ __forceinline__ void top16_of64(const unsigned (&v)[64], unsigned (&out)[16]) {
    unsigned g1[16], g2[16], g3[16];
#pragma unroll
    for (int i = 0; i < 16; ++i) { out[i] = v[i]; g1[i] = v[16 + i]; g2[i] = v[32 + i]; g3[i] = v[48 + i]; }
    sort16_desc(out); sort16_desc(g1); sort16_desc(g2); sort16_desc(g3);
    merge_top16(out, g1); merge_top16(g2, g3); merge_top16(out, g2);
}
__device__ __forceinline__ unsigned xchg32u(unsigned v, int lane) { return __builtin_bit_cast(unsigned, xchg32(__builtin_bit_cast(float, v), lane)); }
constexpr int TK_KROW = 272, TK_TAB = 256 * TK_KROW;
__device__ __forceinline__ void phase_topk(const Params& p, LAS unsigned char* lds, int vcu, int G) {
    const int tid = threadIdx.x, lane = tid & 63, wave = __builtin_amdgcn_readfirstlane(tid >> 6), r32 = lane & 31, hi = lane >> 5;
    const bf16_t* QP = (const bf16_t*)(p.ws + WS_QP);
    const bf16_t* KEYS = (const bf16_t*)(p.ws + WS_KEYS);
    int* IDX = (int*)(p.ws + WS_IDX);
    LAS unsigned* tab = (LAS unsigned*)(lds + TK_TAB) + wave * 8 * 64 + lane;
    for (int item = blockIdx.x; item < (T / 256) * 2; item += G) {
        const int tg = item % (T / 256), hg = item / (T / 256);
        const size_t tok = (size_t)(tg * 8 + wave) * 32 + r32;
        for (int hh = 0; hh < 4; ++hh) {
            const int h = hg * 4 + hh;
            __syncthreads();
#pragma unroll
            for (int c8 = 0; c8 < 8; ++c8) { const int c = tid + c8 * NTHREADS, row = c >> 4, ch = c & 15;
                *(LAS u32x4*)(lds + row * TK_KROW + ch * 16) = *(const u32x4*)(KEYS + (size_t)(h * 256 + row) * 128 + ch * 8); }
            __syncthreads();
            unsigned lst[2][16];
#pragma unroll
            for (int pp = 0; pp < 2; ++pp) {
                f32x16 acc[4];
#pragma unroll
                for (int kt = 0; kt < 4; ++kt)
#pragma unroll
                    for (int r = 0; r < 16; ++r) acc[kt][r] = 0.f;
                const bf16_t* qrow = QP + tok * QPS + h * 256 + pp * 128 + 8 * hi;
                const LAS unsigned char* kb = lds + (pp * 128 + r32) * TK_KROW + 16 * hi;
#pragma unroll
                for (int s2 = 0; s2 < 8; ++s2) {
                    const bf16x8 bq = *(const bf16x8*)(qrow + 16 * s2);
#pragma unroll
                    for (int kt = 0; kt < 4; ++kt) {
                        const bf16x8 ak = *(const LAS bf16x8*)(kb + kt * 32 * TK_KROW + 32 * s2);
                        acc[kt] = __builtin_amdgcn_mfma_f32_32x32x16_bf16(ak, bq, acc[kt], 0, 0, 0);
                    }
                }
                unsigned v[64];
#pragma unroll
                for (int kt = 0; kt < 4; ++kt)
#pragma unroll
                    for (int r = 0; r < 16; ++r) { const int n = 32 * kt + (r & 3) + 8 * (r >> 2) + 4 * hi; v[kt * 16 + r] = (ford(acc[kt][r]) & ~0x7Fu) | (unsigned)(127 - n); }
                unsigned own[16], oth[16];
                top16_of64(v, own);
#pragma unroll
                for (int j = 0; j < 16; ++j) oth[j] = xchg32u(own[j], lane);
                merge_top16(own, oth);
#pragma unroll
                for (int j = 0; j < 16; ++j) lst[pp][j] = own[j];
            }
            float a[16], bs[16];
#pragma unroll
            for (int j = 0; j < 16; ++j) { a[j] = funord(lst[0][j] & ~0x7Fu); bs[j] = funord(lst[1][j] & ~0x7Fu); }
#pragma unroll
            for (int m = 0; m < 4; ++m) {
                tab[m * 64] = (127u - (lst[0][4 * m] & 0x7Fu)) | ((127u - (lst[0][4 * m + 1] & 0x7Fu)) << 8) | ((127u - (lst[0][4 * m + 2] & 0x7Fu)) << 16) | ((127u - (lst[0][4 * m + 3] & 0x7Fu)) << 24);
                tab[(4 + m) * 64] = (127u - (lst[1][4 * m] & 0x7Fu)) | ((127u - (lst[1][4 * m + 1] & 0x7Fu)) << 8) | ((127u - (lst[1][4 * m + 2] & 0x7Fu)) << 16) | ((127u - (lst[1][4 * m + 3] & 0x7Fu)) << 24);
            }
            unsigned cand[50];
            {
                int c = 0;
#pragma unroll
                for (int i = 0; i < 16; ++i)
#pragma unroll
                    for (int j = 0; j < 16; ++j)
                        if ((i + 1) * (j + 1) <= 16) { cand[c] = (ford(a[i] + bs[j]) & ~0xFFu) | (unsigned)(255 - (i * 16 + j)); ++c; }
            }
            unsigned best[16], c1[16], c2[16], eidx[16];
#pragma unroll
            for (int i = 0; i < 16; ++i) { best[i] = cand[i]; c1[i] = cand[16 + i]; c2[i] = cand[32 + i]; }
            sort16_desc(best); sort16_desc(c1); sort16_desc(c2);
            merge_top16(best, c1); merge_top16(best, c2);
            const unsigned e_hi = cand[48] > cand[49] ? cand[48] : cand[49], e_lo = cand[48] > cand[49] ? cand[49] : cand[48];
            const unsigned top_ = best[0] > e_hi ? best[0] : e_hi;
            best[15] = best[15] > e_hi ? best[15] : e_hi; best[14] = best[14] > e_lo ? best[14] : e_lo;
            LDS_WAIT();
#pragma unroll
            for (int r = 0; r < 16; ++r) { const unsigned code = 255u - (best[r] & 0xFFu), ci = code >> 4, cj = code & 15u;
                const unsigned wi = tab[(ci >> 2) * 64], wj = tab[(4 + (cj >> 2)) * 64];
                eidx[r] = ((wi >> (8 * (ci & 3u))) & 0x7Fu) * 128u + ((wj >> (8 * (cj & 3u))) & 0x7Fu); }
            LDS_WAIT();
            if (hi == 0) {
                float g[16]; const float mx = funord(top_ & ~0xFFu); float tot = 0.f;
#pragma unroll
                for (int r = 0; r < 16; ++r) { g[r] = __expf(funord(best[r] & ~0xFFu) - mx); tot += g[r]; }
                const float it_ = 1.f / tot;
                unsigned* rp = (unsigned*)IDX + (tok * 8 + h) * 16;
#pragma unroll
                for (int q4 = 0; q4 < 4; ++q4)
                    *(u32x4*)(rp + 4 * q4) = (u32x4){eidx[4 * q4] | (f2bf(g[4 * q4] * it_) << 16), eidx[4 * q4 + 1] | (f2bf(g[4 * q4 + 1] * it_) << 16), eidx[4 * q4 + 2] | (f2bf(g[4 * q4 + 2] * it_) << 16), eidx[4 * q4 + 3] | (f2bf(g[4 * q4 + 3] * it_) << 16)};
            }
        }
    }
}

typedef float f32x2_ __attribute__((ext_vector_type(2)));
__device__ __forceinline__ float gelu_exact(float v) {
    const float av = fabsf(v), t = __builtin_amdgcn_rcpf(av * 0.2316418882f + 1.0f);
    float q = t * 0.5307027145f + (-0.7265760135f); q = q * t + 0.7107068705f; q = q * t + (-0.142248368f); q = q * t + 0.127414796f; q = q * t;
    const float e = __builtin_amdgcn_exp2f((v * v) * (-0.72134752044f));
    const float m = v * (q * e);
    return v < 0.f ? m : v - m;
}
typedef float f32x2_ __attribute__((ext_vector_type(2)));
__device__ __forceinline__ void phase_peer_u(const Params& p, LAS unsigned char* lds, int G, int mx, int mj) {
    const int tid = threadIdx.x, lane = tid & 63, wave = __builtin_amdgcn_readfirstlane(tid >> 6), bx = blockIdx.x;
    const bool xl = (G % 8 == 0);
    const int x = xl ? (mx & 3) : 0, nx = xl ? 4 : 1, jb = xl ? (mx >> 2) * (G / 8) + mj : bx, nw = (xl ? G / 4 : G) * NWAVES, widx = jb * NWAVES + wave;
    const unsigned char* H1Q = (const unsigned char*)(p.ws + WS_H1Q); const unsigned char* UQ = (const unsigned char*)(p.ws + WS_UT);
    const unsigned* REC = (const unsigned*)(p.ws + WS_IDX); const float* HSC = (const float*)(p.ws + WS_HSC);
    const float* USC = (const float*)(p.ws + WS_USC); const float* VSC = (const float*)(p.ws + WS_VSC);
    unsigned* CI = (unsigned*)(p.ws + WS_C);
    LAS float* SU = (LAS float*)lds; LAS float* SV = SU + GRP_SIZE; LAS float* U8 = SV + GRP_SIZE;
    LAS u32x2* slots = (LAS u32x2*)(lds + 49152 + wave * 2048);
    LAS u32x4* hbuf = (LAS u32x4*)(lds + 65536 + wave * 2048);
    const int K = (T - widx + nw - 1) / nw;
    const int lrow = lane >> 4, lcol = lane & 15, lc16 = 16 * lcol;
    for (int g = x; g < NGRP; g += nx) {
        __syncthreads();
        for (int i = tid; i < GRP_SIZE; i += NTHREADS) { SU[i] = USC[g * GRP_SIZE + i]; SV[i] = VSC[g * GRP_SIZE + i]; U8[i] = ((const float*)(p.ws + WS_US8))[g * GRP_SIZE + i]; }
        __syncthreads();
#define PU_R(S, k_) { const int kk_ = (k_) < K ? (k_) : K - 1; const size_t tt_ = (size_t)(widx + nw * kk_); \
            rq##S = *(const u32x2*)(REC + tt_ * 128 + 2 * lane); rr##S = HSC[tt_]; hr##S = *(const u32x4*)(H1Q + tt_ * D + 16 * lane); }
#define PU_C(S, k_) { LAS u32x2* sl_ = slots + S * 128; const bool ok_ = (k_) < K; tk##S = widx + nw * ((k_) < K ? (k_) : K - 1); rs##S = rr##S; \
            hbuf[S * 64 + lane] = hr##S; const unsigned rl##S = rq##S.x, rh##S = rq##S.y; \
            { const bool f0 = ((rl##S & 0x3FFFu) >> GRP_SHIFT) == (unsigned)g, f1 = ((rh##S & 0x3FFFu) >> GRP_SHIFT) == (unsigned)g; const unsigned long long m0 = __ballot(f0), m1 = __ballot(f1); const int n0 = __popcll(m0); \
              if (f0) sl_[(int)__builtin_amdgcn_mbcnt_hi((unsigned)(m0 >> 32), __builtin_amdgcn_mbcnt_lo((unsigned)m0, 0u))] = (u32x2){((rl##S & 0x3FFFu) << 9) | ((unsigned)(2 * lane) << 24), rl##S & 0xffff0000u}; \
              if (f1) sl_[n0 + (int)__builtin_amdgcn_mbcnt_hi((unsigned)(m1 >> 32), __builtin_amdgcn_mbcnt_lo((unsigned)m1, 0u))] = (u32x2){((rh##S & 0x3FFFu) << 9) | ((unsigned)(2 * lane + 1) << 24), rh##S & 0xffff0000u}; \
              nn##S = __builtin_amdgcn_readfirstlane(ok_ ? n0 + __popcll(m1) : 0); } \
            LDS_WAIT(); \
            _Pragma("unroll") for (int j = 0; j < 12; ++j) sl##S[j] = sl_[4 * j + lrow]; \
            _Pragma("unroll") for (int i = 0; i < 4; ++i) hq##S[i] = hbuf[S * 64 + 16 * i + lcol]; }
#define PU_ISSUE(R, SL, c_, n_, QM) { int ns_ = (n_) - 12 * (c_); asm volatile("" : "+s"(ns_)); \
            _Pragma("unroll") for (int q = 0; q < 3; ++q) if (q < (QM) || ns_ > 4 * q) { const bool v_ = (4 * q + lrow) < ns_; const unsigned char* a_ = UQ + (v_ ? (size_t)((SL[3 * (c_) + q].x & 0x7FFFFFu) + lc16) : (size_t)0); \
                row##R[2 * q] = *(const u32x4*)a_; row##R[2 * q + 1] = *(const u32x4*)(a_ + 256); } }
#define PU_DOT(R, HQ, ACC, c_, n_, QM) { int ns_ = (n_) - 12 * (c_); asm volatile("" : "+s"(ns_)); _Pragma("unroll") for (int q = 0; q < 3; ++q) if (q < (QM) || ns_ > 4 * q) { int a1_ = 0, a2_ = 0; \
                _Pragma("unroll") for (int i = 0; i < 2; ++i) _Pragma("unroll") for (int w = 0; w < 4; ++w) { a1_ = __builtin_amdgcn_sdot8((int)row##R[2 * q + i][w], (int)HQ[i][w], a1_, false); a2_ = __builtin_amdgcn_sdot8((int)row##R[2 * q + i][w], (int)HQ[2 + i][w], a2_, false); } \
                ACC[q] = (a1_ << 4) + a2_; } }
#define PU_EPI(S, SL, ACC, c_, n_, QM) { float rt_[3]; int ns_ = (n_) - 12 * (c_); asm volatile("" : "+s"(ns_)); \
            _Pragma("unroll") for (int q = 0; q < 3; ++q) { rt_[q] = 0.f; if (q < (QM) || ns_ > 4 * q) { float f_ = (float)ACC[q]; f_ += dpp_mov<0xB1>(f_); f_ += dpp_mov<0x4E>(f_); f_ += dpp_mov<0x141>(f_); f_ += dpp_mov<0x140>(f_); rt_[q] = f_; } } \
            float tot_ = rt_[0]; unsigned rx_ = SL[3 * (c_)].x, ry_ = SL[3 * (c_)].y; \
            _Pragma("unroll") for (int q = 1; q < 3; ++q) { const bool e_ = lcol == q; tot_ = e_ ? rt_[q] : tot_; rx_ = e_ ? SL[3 * (c_) + q].x : rx_; ry_ = e_ ? SL[3 * (c_) + q].y : ry_; } \
            if (lcol < 3 && (4 * lcol + lrow) < ns_) { const unsigned idx_ = (rx_ >> 9) & 0x3FFFu; const int li_ = (int)(idx_ & (GRP_SIZE - 1)); \
                const float c_v = __uint_as_float(ry_) * gelu_exact((tot_ + U8[li_]) * SU[li_] * rs##S) * SV[li_]; CI[(size_t)tk##S * 128 + (rx_ >> 24)] = (f2bf(c_v) << 16) | idx_; } }
#define PU_OVF(S) if (nn##S > 48) { for (int b1_ = 48; b1_ < nn##S; b1_ += 12) { u32x2 so2_[12]; _Pragma("unroll") for (int q = 0; q < 3; ++q) so2_[q] = slots[S * 128 + ((b1_ + 4 * q + lrow) & 127)]; \
            const int n2_ = nn##S - b1_; int ac2_[3]; PU_ISSUE(3, so2_, 0, n2_, 0) PU_DOT(3, hq##S, ac2_, 0, n2_, 0) PU_EPI(S, so2_, ac2_, 0, n2_, 0) } }
#define PU_TOKEN(S, Sn) { \
            PU_DOT(0, hq##S, acc##S, 0, nn##S, 3) PU_EPI(S, sl##S, acc##S, 0, nn##S, 3) PU_ISSUE(0, sl##Sn, 0, nn##Sn, 3) \
            PU_DOT(1, hq##S, acc##S, 1, nn##S, 3) PU_EPI(S, sl##S, acc##S, 1, nn##S, 3) PU_ISSUE(1, sl##Sn, 1, nn##Sn, 3) \
            PU_DOT(2, hq##S, acc##S, 2, nn##S, 0) PU_EPI(S, sl##S, acc##S, 2, nn##S, 0) PU_ISSUE(2, sl##Sn, 2, nn##Sn, 0) \
            PU_DOT(3, hq##S, acc##S, 3, nn##S, 0) PU_EPI(S, sl##S, acc##S, 3, nn##S, 0) PU_OVF(S) PU_ISSUE(3, sl##Sn, 3, nn##Sn, 0) }
        u32x2 rq0, rq1; u32x4 hr0, hr1, hq0[4], hq1[4]; float rr0, rr1, rs0 = 0.f, rs1 = 0.f; int tk0 = 0, tk1 = 0, nn0 = 0, nn1 = 0;
        u32x4 row0[6], row1[6], row2[6], row3[6]; u32x2 sl0[12], sl1[12]; int acc0[3], acc1[3];
#pragma unroll
        for (int q = 0; q < 4; ++q) { hq0[q] = (u32x4){0u, 0u, 0u, 0u}; hq1[q] = hq0[q]; }
#pragma unroll
        for (int q = 0; q < 12; ++q) { sl0[q] = (u32x2){0u, 0u}; sl1[q] = sl0[q]; }
#pragma unroll
        for (int q = 0; q < 6; ++q) { row0[q] = (u32x4){0u, 0u, 0u, 0u}; row1[q] = row0[q]; row2[q] = row0[q]; row3[q] = row0[q]; }
#pragma unroll
        for (int q = 0; q < 3; ++q) { acc0[q] = 0; acc1[q] = 0; }
        PU_R(0, 0) PU_R(1, 1)
        PU_C(0, 0)
        PU_ISSUE(0, sl0, 0, nn0, 3) PU_ISSUE(1, sl0, 1, nn0, 3) PU_ISSUE(2, sl0, 2, nn0, 0) PU_ISSUE(3, sl0, 3, nn0, 0)
        PU_R(0, 2)
        for (int k = 0; k < K; k += 2) {
            PU_C(1, k + 1)
            PU_R(1, k + 3)
            PU_TOKEN(0, 1)
            PU_C(0, k + 2)
            PU_R(0, k + 4)
            PU_TOKEN(1, 0)
        }
    }
    __syncthreads();
}
__device__ __forceinline__ void phase_peer_v(const Params& p, LAS unsigned char* lds, int G, int mx, int mj) {
    const int tid = threadIdx.x, lane = tid & 63, wave = __builtin_amdgcn_readfirstlane(tid >> 6), bx = blockIdx.x;
    const bool xl = (G % 8 == 0);
    const int x = xl ? (mx & 3) : 0, nx = xl ? 4 : 1, jb = xl ? (mx >> 2) * (G / 8) + mj : bx, nw = (xl ? G / 4 : G) * NWAVES, widx = jb * NWAVES + wave;
    const unsigned char* VQ = (const unsigned char*)(p.ws + WS_VE);
    const unsigned* CI = (const unsigned*)(p.ws + WS_C);
    bf16_t* H1B = (bf16_t*)(p.ws + WS_H1B);
    const int sub = lane & 7, es = lane >> 3;
    const int K = (T - widx + nw - 1) / nw, NB4 = (K + 3) / 4;
    LAS unsigned* RL = (LAS unsigned*)(lds + wave * 4096);
    for (int s = x; s < NVS; s += nx) {
        const unsigned char* VQs = VQ + (size_t)s * 16384 * VSL + 16 * sub;
#define PV_TOK(k_) ((size_t)(widx + nw * ((k_) < K ? (k_) : K - 1)))
#define PV_RQLOAD(blk_) { _Pragma("unroll") for (int j = 0; j < 4; ++j) rq[j] = *(const u32x2*)(CI + PV_TOK(4 * (blk_) + j) * 128 + 2 * lane); }
#define PV_RQSTORE(blk_) { _Pragma("unroll") for (int j = 0; j < 4; ++j) *(LAS u32x2*)(RL + (((blk_) & 1) * 4 + j) * 128 + 2 * lane) = rq[j]; }
#define PV_REC(blkpar_, j_, hf_, i_) RL[((blkpar_) * 4 + (j_)) * 128 + 64 * (hf_) + 8 * (i_) + es]
#define PV_GATHER8(vb, rg_, hf_) { _Pragma("unroll") for (int i = 0; i < 8; ++i) vb[i] = *(const u32x4*)(VQs + (size_t)(rg_[8 * (hf_) + i] & 0x3FFFu) * VSL); }
#define PV_PREP(blkpar_, j_, sl_, k_) { float cf_[16]; float am_ = 0.f; hvs[sl_] = *(const u32x2*)(H1B + PV_TOK(k_) * D + hoff); \
            _Pragma("unroll") for (int i = 0; i < 16; ++i) rg[i] = PV_REC(blkpar_, j_, (i >> 3), (i & 7)); \
            _Pragma("unroll") for (int i = 0; i < 16; ++i) { cf_[i] = __uint_as_float(rg[i] & 0xffff0000u); am_ = fmaxf(am_, fabsf(cf_[i])); } \
            am_ = fmaxf(am_, dpp_mov<0x128>(am_)); am_ = swap16_max(am_); am_ = swap32_max(am_); \
            const float iv_ = am_ > 0.f ? 127.f / am_ : 0.f; csc[sl_] = am_ * (1.f / 127.f); int cs_ = 0; \
            _Pragma("unroll") for (int m = 0; m < 4; ++m) { const int q0 = (int)rintf(cf_[4 * m] * iv_), q1 = (int)rintf(cf_[4 * m + 1] * iv_), q2 = (int)rintf(cf_[4 * m + 2] * iv_), q3 = (int)rintf(cf_[4 * m + 3] * iv_); \
                cqs[sl_][m] = (q0 & 0xFF) | ((q1 & 0xFF) << 8) | ((q2 & 0xFF) << 16) | ((q3 & 0xFF) << 24); cs_ = __builtin_amdgcn_sdot4(cqs[sl_][m], 0x01010101, cs_, false); } \
            float ct_ = (float)cs_; ct_ += dpp_mov<0x128>(ct_); ct_ = swap16_sum(ct_); ct_ = swap32_sum(ct_); cto[sl_] = -8.f * ct_; }
#define PV_T4(r0, r1, r2, r3, w, cqw) { const unsigned x0_ = __builtin_amdgcn_perm(r1[w], r0[w], 0x05010400u), x1_ = __builtin_amdgcn_perm(r1[w], r0[w], 0x07030602u), \
                y0_ = __builtin_amdgcn_perm(r3[w], r2[w], 0x05010400u), y1_ = __builtin_amdgcn_perm(r3[w], r2[w], 0x07030602u); \
            const unsigned t0_ = __builtin_amdgcn_perm(y0_, x0_, 0x05040100u), t1_ = __builtin_amdgcn_perm(y0_, x0_, 0x07060302u), t2_ = __builtin_amdgcn_perm(y1_, x1_, 0x05040100u), t3_ = __builtin_amdgcn_perm(y1_, x1_, 0x07060302u); \
            acci[8 * (w)] = __builtin_amdgcn_sdot4((int)(t0_ & 0x0F0F0F0Fu), cqw, acci[8 * (w)], false); acci[8 * (w) + 1] = __builtin_amdgcn_sdot4((int)(t0_ & 0xF0F0F0F0u), cqw, acci[8 * (w) + 1], false); \
            acci[8 * (w) + 2] = __builtin_amdgcn_sdot4((int)(t1_ & 0x0F0F0F0Fu), cqw, acci[8 * (w) + 2], false); acci[8 * (w) + 3] = __builtin_amdgcn_sdot4((int)(t1_ & 0xF0F0F0F0u), cqw, acci[8 * (w) + 3], false); \
            acci[8 * (w) + 4] = __builtin_amdgcn_sdot4((int)(t2_ & 0x0F0F0F0Fu), cqw, acci[8 * (w) + 4], false); acci[8 * (w) + 5] = __builtin_amdgcn_sdot4((int)(t2_ & 0xF0F0F0F0u), cqw, acci[8 * (w) + 5], false); \
            acci[8 * (w) + 6] = __builtin_amdgcn_sdot4((int)(t3_ & 0x0F0F0F0Fu), cqw, acci[8 * (w) + 6], false); acci[8 * (w) + 7] = __builtin_amdgcn_sdot4((int)(t3_ & 0xF0F0F0F0u), cqw, acci[8 * (w) + 7], false); }
#define PV_ACC8(vb, sl_, hf_) { _Pragma("unroll") for (int w = 0; w < 4; ++w) { PV_T4(vb[0], vb[1], vb[2], vb[3], w, cqs[sl_][2 * (hf_)]) PV_T4(vb[4], vb[5], vb[6], vb[7], w, cqs[sl_][2 * (hf_) + 1]) } }
#define PV_FIN(k_, sl_) { int r16[16], r8[8], r4[4]; \
            { const bool bt = lane & 8; _Pragma("unroll") for (int q = 0; q < 16; ++q) { const int keep = bt ? acci[q + 16] : acci[q], send = bt ? acci[q] : acci[q + 16]; r16[q] = keep + __builtin_amdgcn_update_dpp(0, send, 0x128, 0xF, 0xF, false); } } \
            _Pragma("unroll") for (int q = 0; q < 8; ++q) { int a_ = r16[q], b_ = r16[q + 8]; swap16i_(a_, b_); r8[q] = a_ + b_; } \
            _Pragma("unroll") for (int q = 0; q < 4; ++q) { int a_ = r8[q], b_ = r8[q + 4]; swap32i_(a_, b_); r4[q] = a_ + b_; } \
            _Pragma("unroll") for (int q = 0; q < 32; ++q) acci[q] = 0; \
            if ((k_) < K) { const u32x2 hw = hvs[sl_]; const float sc_ = csc[sl_], sh_ = sc_ * (1.f / 16.f), co_ = cto[sl_]; \
                *(u32x2*)(H1B + (size_t)(widx + nw * (k_)) * D + hoff) = (u32x2){pk2(bflo(hw.x) + ((float)r4[0] + co_) * sc_, bfhi(hw.x) + (float)r4[1] * sh_), pk2(bflo(hw.y) + ((float)r4[2] + co_) * sc_, bfhi(hw.y) + (float)r4[3] * sh_)}; } }
#define PV_STEP(vb, B_, j_, hf_) { PV_ACC8(vb, ((j_) & 3), hf_) if ((hf_) == 1) PV_FIN(4 * (B_) + (j_), ((j_) & 3)) \
            if ((hf_) == 0) PV_PREP((((j_) + 2) < 4) ? ((B_) & 1) : (((B_) + 1) & 1), (((j_) + 2) & 3), (((j_) + 2) & 3), 4 * (B_) + (j_) + 2) \
            PV_GATHER8(vb, rg, hf_) }
        u32x2 rq[4]; u32x4 v0[8], v1[8], v2[8], v3[8]; int acci[32]; int cqs[4][4]; float csc[4], cto[4]; unsigned rg[16]; u32x2 hvs[4];
        const int hoff = s * 256 + 32 * sub + 16 * (es & 1) + 8 * ((es >> 1) & 1) + 4 * (es >> 2);
#pragma unroll
        for (int q = 0; q < 32; ++q) acci[q] = 0;
        PV_RQLOAD(0) PV_RQSTORE(0) PV_RQLOAD(1) PV_RQSTORE(1)
        LDS_WAIT();
        PV_PREP(0, 0, 0, 0) PV_GATHER8(v0, rg, 0) PV_GATHER8(v1, rg, 1)
        PV_PREP(0, 1, 1, 1) PV_GATHER8(v2, rg, 0) PV_GATHER8(v3, rg, 1)
        for (int B = 0; B < NB4; ++B) {
            if (B > 0) { PV_RQSTORE(B + 1) LDS_WAIT(); }
            PV_STEP(v0, B, 0, 0) PV_STEP(v1, B, 0, 1)
            PV_STEP(v2, B, 1, 0) PV_STEP(v3, B, 1, 1)
            PV_RQLOAD(B + 2)
            PV_STEP(v0, B, 2, 0) PV_STEP(v1, B, 2, 1)
            PV_STEP(v2, B, 3, 0) PV_STEP(v3, B, 3, 1)
        }
    }
}
__device__ __forceinline__ void phase_final(const Params& p, int vcu, int G) {
    const int tid = threadIdx.x, lane = tid & 63, wave = __builtin_amdgcn_readfirstlane(tid >> 6);
    const bf16_t* H2B = (const bf16_t*)(p.ws + WS_H1B); float* Y = p.out; const float* fg = p.in[I_FG];
    const int w0 = vcu * NWAVES + wave, WS_ = G * NWAVES;
    const f32x4 g0 = ((const f32x4*)fg)[2 * lane], g1 = ((const f32x4*)fg)[2 * lane + 1], g2 = ((const f32x4*)fg)[128 + 2 * lane], g3 = ((const f32x4*)fg)[128 + 2 * lane + 1];
#define PF_LOAD(dst, t0_) { _Pragma("unroll") for (int u = 0; u < 4; ++u) { const int tok = ((t0_) + u * WS_) < T ? ((t0_) + u * WS_) : w0; \
            dst[u][0] = *(const u32x4*)(H2B + (size_t)tok * D + 8 * lane); dst[u][1] = *(const u32x4*)(H2B + (size_t)tok * D + 512 + 8 * lane); } }
#define PF_PROC(src, t0_) { _Pragma("unroll") for (int u = 0; u < 4; ++u) { const int tok = (t0_) + u * WS_; if (tok < T) { float f[16]; float ss = 0.f; \
            _Pragma("unroll") for (int k = 0; k < 4; ++k) { f[2 * k] = bflo(src[u][0][k]); f[2 * k + 1] = bfhi(src[u][0][k]); f[8 + 2 * k] = bflo(src[u][1][k]); f[8 + 2 * k + 1] = bfhi(src[u][1][k]); } \
            _Pragma("unroll") for (int k = 0; k < 16; ++k) ss += f[k] * f[k]; \
            const float rs = rsqrtf(wave_sum(ss) * (1.f / D) + EPS); f32x4* yr = (f32x4*)(Y + (size_t)tok * D); \
            yr[2 * lane] = (f32x4){f[0], f[1], f[2], f[3]} * rs * g0; yr[2 * lane + 1] = (f32x4){f[4], f[5], f[6], f[7]} * rs * g1; \
            yr[128 + 2 * lane] = (f32x4){f[8], f[9], f[10], f[11]} * rs * g2; yr[128 + 2 * lane + 1] = (f32x4){f[12], f[13], f[14], f[15]} * rs * g3; } } }
    u32x4 va[4][2], vb[4][2];
    PF_LOAD(va, w0)
    for (int t0 = w0; t0 < T; t0 += 8 * WS_) {
        if (t0 + 4 * WS_ < T) PF_LOAD(vb, t0 + 4 * WS_)
        PF_PROC(va, t0)
        if (t0 + 8 * WS_ < T) PF_LOAD(va, t0 + 8 * WS_)
        PF_PROC(vb, t0 + 4 * WS_)
    }
}
#define XB_TMO      128
#define XB_XCNT(j)  (256  + 64 * (j))
#define XB_XSUB(j)  (1280 + 64 * (j))
#define XB_XGEN(j)  (2304 + 64 * (j))
#define XB_TOP      3328
#define XB_TOPGEN   3392
#define XCD_BAR_WORDS 3456
#define XB_SPIN_CAP (1u << 18)

__device__ __forceinline__ unsigned xb_ld(unsigned* p)              { return __hip_atomic_load(p, __ATOMIC_RELAXED, __HIP_MEMORY_SCOPE_AGENT); }
__device__ __forceinline__ unsigned xb_add(unsigned* p, unsigned v) { return __hip_atomic_fetch_add(p, v, __ATOMIC_RELAXED, __HIP_MEMORY_SCOPE_AGENT); }
__device__ __forceinline__ unsigned xb_xcc_id() { return (unsigned)__builtin_amdgcn_s_getreg((3 << 11) | 20) & 0xFu; }
#define XB_SPIN(cond, bar) do { unsigned _sp = 0; while (cond) { __builtin_amdgcn_s_sleep(1); \
    if ((++_sp & 255u) == 0u) { if (xb_ld(&(bar)[XB_TMO])) break; if (_sp > XB_SPIN_CAP) { atomicAdd(&(bar)[XB_TMO], 1u); break; } } } } while (0)

struct XcdBarrier {
    unsigned* bar; unsigned x;
    volatile LAS unsigned* st;
};

__device__ __forceinline__ XcdBarrier xcd_barrier_post(unsigned* bar, volatile LAS unsigned* st) {
    XcdBarrier b; b.bar = bar; b.x = xb_xcc_id(); b.st = st;
    if (threadIdx.x == 0) (void)xb_add(&bar[XB_XCNT(b.x)], 1u);
    return b;
}
__device__ __forceinline__ void xcd_barrier_complete(unsigned* bar, unsigned x, unsigned& nloc, unsigned& nx) {
    const unsigned G = gridDim.x * gridDim.y * gridDim.z;
    unsigned sum, cnt, mine, sp = 0u;
    for (;;) {
        sum = 0u; cnt = 0u; mine = 0u;
#pragma unroll
        for (unsigned j = 0; j < 16; ++j) { const unsigned c = xb_ld(&bar[XB_XCNT(j)]); sum += c; cnt += (c > 0u) ? 1u : 0u; mine = (j == x) ? c : mine; }
        if (sum == G) break;
        __builtin_amdgcn_s_sleep(1);
        if ((++sp & 255u) == 0u) { if (xb_ld(&bar[XB_TMO])) break; if (sp > XB_SPIN_CAP) { atomicAdd(&bar[XB_TMO], 1u); break; } }
    }
    nloc = mine > 0u ? mine : 1u; nx = cnt > 0u ? cnt : 1u;
}

__device__ __forceinline__ void xcd_barrier(const XcdBarrier& b) {
    asm volatile("s_waitcnt vmcnt(0)" ::: "memory");
    __syncthreads();
    if (threadIdx.x == 0) {
        unsigned* bar = b.bar;
        __builtin_amdgcn_s_waitcnt(0);
        unsigned nloc = b.st[0], nx = b.st[1];
        if (nloc == 0u) { xcd_barrier_complete(bar, b.x, nloc, nx); b.st[0] = nloc; b.st[1] = nx; }
        const unsigned old = xb_add(&bar[XB_XSUB(b.x)], 1u);
        const unsigned gen = old / nloc;
        if (old + 1u == (gen + 1u) * nloc) {
            __builtin_amdgcn_fence(__ATOMIC_RELEASE, "agent");
            asm volatile("s_waitcnt vmcnt(0)" ::: "memory");
            const unsigned og = xb_add(&bar[XB_TOP], 1u);
            const unsigned tg = og / nx;
            if (og + 1u == (tg + 1u) * nx) xb_add(&bar[XB_TOPGEN], 1u);
            else XB_SPIN(xb_ld(&bar[XB_TOPGEN]) == tg, bar);
            __builtin_amdgcn_fence(__ATOMIC_ACQUIRE, "agent");
            xb_add(&bar[XB_XGEN(b.x)], 1u);
            asm volatile("s_waitcnt vmcnt(0)" ::: "memory");
        } else {
            XB_SPIN(xb_ld(&bar[XB_XGEN(b.x)]) == gen, bar);
            __builtin_amdgcn_fence(__ATOMIC_ACQUIRE, "agent");
            asm volatile("s_waitcnt vmcnt(0)" ::: "memory");
        }
    }
    __syncthreads();
}

constexpr int N_PHASES = 11;
__global__ void __launch_bounds__(NTHREADS, 2) hymba_fwd(Params p) {
    extern __shared__ __attribute__((aligned(16))) unsigned char lds_raw[];
    LAS unsigned char* lds = (LAS unsigned char*)lds_raw;
    cg::grid_group grid = cg::this_grid();
    const int G = gridDim.x; const int bx = blockIdx.x;
    const int vcu = (G % 8 == 0) ? (bx % 8) * (G / 8) + bx / 8 : bx;
    unsigned char* ws = p.ws;
    const int lo = p.ph_lo, hi = p.ph_hi;
    volatile LAS unsigned* MISC = (volatile LAS unsigned*)(lds + 131072 + 320);
    if (threadIdx.x < 32) MISC[threadIdx.x] = 0u;
    __syncthreads();
    XcdBarrier bar; bar.bar = (unsigned*)ws; bar.x = xb_xcc_id(); bar.st = MISC + 8;
    if (threadIdx.x == 0) { MISC[20] = xb_add(&bar.bar[XB_XCNT(bar.x)], 1u); MISC[21] = bar.x; MISC[22] = 0u; }
#define IN(k) (lo <= (k) && (k) < hi)
#define SEAM(k) do { if ((k) + 1 < hi) { if ((k) == 0) grid.sync(); else xcd_barrier(bar); } } while (0)
    if (IN(0)) { phase_prep(p, lds, vcu, G); SEAM(0); }
    {
        if (threadIdx.x == 0 && lo == 0 && hi > 1 && (G % 8) == 0) { bool ok = true; for (unsigned j = 0; j < 8; ++j) ok = ok && (xb_ld(&bar.bar[XB_XCNT(j)]) == (unsigned)(G / 8)); MISC[22] = ok ? 1u : 0u; }
        __syncthreads();
    }
    const bool xcc_ok = MISC[22] != 0u; const int xcc_x = xcc_ok ? (int)MISC[21] : (bx & 7), xcc_j = xcc_ok ? (int)MISC[20] : (bx >> 3);
    if (IN(1)) {
        { pg8::Gemm g{(const bf16_t*)(ws + WS_XN), (const bf16_t*)(ws + WS_WINT), T, 3584, D}; pg8::StaticOrder S; S.init(T, 3584, G, bx);
          EpiInProj E{(bf16_t*)(ws + WS_PROJ), (const float*)(ws + WS_SM)};
          pg8::gemm_phase<EpiInProj, pg8::StaticOrder, true, true>(lds, g, S, E); }
        { pg8::Gemm g{(const bf16_t*)(ws + WS_WINT) + (size_t)3584 * D, (const bf16_t*)(ws + WS_XN), 512, T, D}; pg8::StaticOrder S; S.init(512, T, G, bx);
          EpiStore E{(bf16_t*)(ws + WS_VT), T};
          pg8::gemm_phase<EpiStore, pg8::StaticOrder, true, true>(lds, g, S, E); }
        SEAM(1);
    }
    if (IN(2)) { phase_hgrn(p, lds, G); }
    if (IN(3)) { phase_attn(p, lds, G); SEAM(3); }
    if (IN(5)) {
        pg8::Gemm g{(const bf16_t*)(ws + WS_XN), (const bf16_t*)(ws + WS_WOT), T, D, D}; pg8::StaticOrder S; S.init(T, D, G, bx);
        EpiOutProj E{p.in[I_X], p.out, (bf16_t*)(ws + WS_H1B), (float*)(ws + WS_SS)};
        pg8::gemm_phase<EpiOutProj, pg8::StaticOrder, true, true>(lds, g, S, E);
        SEAM(5);
    }
    if (IN(6)) {
        phase_hquant(p, vcu, G);
        pg8::Gemm g{(const bf16_t*)(ws + WS_H1B), (const bf16_t*)(ws + WS_WQT), T, 2048, D}; pg8::StaticOrder S; S.init(T, 2048, G, bx);
        EpiQ E{(bf16_t*)(ws + WS_QP), (const float*)(ws + WS_SS), (float*)(ws + WS_GATE)};
        pg8::gemm_phase<EpiQ, pg8::StaticOrder, true, true>(lds, g, S, E);
        SEAM(6);
    }
    if (IN(7)) { phase_topk(p, lds, vcu, G); SEAM(7); }
    if (IN(8)) { phase_peer_u(p, lds, G, xcc_x, xcc_j); SEAM(8); }
    if (IN(9)) { phase_peer_v(p, lds, G, xcc_x, xcc_j); SEAM(9); }
    if (IN(10)) { phase_final(p, vcu, G); }
#undef IN
#undef SEAM
}

extern "C" void kernel_launch(void* const* d_in, const int* in_sizes, int n_in, void* d_out, int out_size, void* d_ws, size_t ws_size, hipStream_t stream) {
    static int grid = 0;
    if (grid == 0) {
        if (n_in != 19 || out_size != T * D || ws_size < WS_END) { fprintf(stderr, "kernel_launch: unexpected sizes (n_in %d out %d ws %zu)\n", n_in, out_size, ws_size); grid = -1; return; }
        int dev = 0, cus = 0, per_cu = 0;
        hipGetDevice(&dev); hipDeviceGetAttribute(&cus, hipDeviceAttributeMultiprocessorCount, dev);
        hipFuncSetAttribute((const void*)hymba_fwd, hipFuncAttributeMaxDynamicSharedMemorySize, LDS_BYTES);
        hipOccupancyMaxActiveBlocksPerMultiprocessor(&per_cu, (const void*)hymba_fwd, NTHREADS, LDS_BYTES);
        (void)hipGetLastError();
        if (per_cu < 1) { fprintf(stderr, "kernel_launch: occupancy query says %d blocks/CU\n", per_cu); per_cu = 1; }
        grid = cus;
    }
    if (grid < 0) return;
    if (hipMemsetAsync(d_ws, 0, 65536, stream) != hipSuccess) { fprintf(stderr, "kernel_launch: memset of the barrier words failed\n"); return; }
    Params p{};
    for (int i = 0; i < 19; ++i) p.in[i] = (const float*)d_in[i];
    p.out = (float*)d_out; p.ws = (unsigned char*)d_ws;
#if MK_ONE_LAUNCH
    p.ph_lo = 0; p.ph_hi = N_PHASES;
    void* args[] = {&p};
    hipError_t e = hipLaunchCooperativeKernel((const void*)hymba_fwd, dim3(grid), dim3(NTHREADS), args, LDS_BYTES, stream);
    if (e != hipSuccess) fprintf(stderr, "cooperative launch failed: %s (grid %d)\n", hipGetErrorString(e), grid);
#else
    for (int ph = 0; ph < N_PHASES; ++ph) { p.ph_lo = ph; p.ph_hi = ph + 1; hipLaunchKernelGGL(hymba_fwd, dim3(grid), dim3(NTHREADS), LDS_BYTES, stream, p); }
#endif
}
```

```cpp
#include <hip/hip_runtime.h>
#include <hip/hip_bf16.h>
#include <hip/hip_cooperative_groups.h>
#include <cstdio>
#include <cstdint>
#include <cmath>
namespace cg = cooperative_groups;
#ifndef MK_ONE_LAUNCH
#define MK_ONE_LAUNCH 1
#endif
namespace pg8 {
#define PG8_LAS __attribute__((address_space(3)))
typedef unsigned short bf16_t;
typedef short bf16x8 __attribute__((ext_vector_type(8)));
typedef float f32x4 __attribute__((ext_vector_type(4)));
typedef unsigned u32x4 __attribute__((ext_vector_type(4)));
constexpr int BM = 256, BK = 64, HALF = 128, HTB = HALF * BK * 2  , STAGE_BYTES = 8 * HTB, NXCD = 8, WGM = 8;

__host__ __device__ __forceinline__ int lds_byte(int r, int c) { const int st = (r >> 4) * 2 + (c >> 5), rr = r & 15, cc = c & 31, ob = rr * 64 + cc * 2; return st * 1024 + (ob ^ (((ob >> 9) & 1) << 5)); }
__host__ __device__ __forceinline__ void stage_rc(int b, int& R, int& C) { const int st = b / 1024, sb = b % 1024, swz = sb ^ (((sb >> 9) & 1) << 5); R = (st >> 1) * 16 + swz / 64; C = (st & 1) * 32 + (swz % 64) / 2; }
__host__ __device__ __forceinline__ int perm32(int rho) { const int n = rho >> 4, i = rho & 15; return 8 * (i >> 2) + 4 * n + (i & 3); }

struct Unit { int pm, pn; };
struct Gemm { const bf16_t* A; const bf16_t* Bt; int M, N, K; };

struct StaticOrder {
    int nM, nN, nwg, G, c;
    __host__ __device__ void init(int M, int N, int G_, int c_) { nM = M / BM; nN = N / BM; nwg = nM * nN; G = G_; c = c_; }
    __host__ __device__ bool next(int i, Unit& u) const {
        const long L = (long)i * G + c; if (L >= nwg) return false;
        int wgid = (int)L; { const int q = nwg / NXCD, r = nwg % NXCD, xcd = wgid % NXCD, off = wgid / NXCD; wgid = (xcd < r ? xcd * (q + 1) : r * (q + 1) + (xcd - r) * q) + off; }
        const int nig = WGM * nN, gid = wgid / nig, fm = gid * WGM, gsz = (nM - fm) < WGM ? (nM - fm) : WGM;
        u.pm = fm + ((wgid % nig) % gsz); u.pn = (wgid % nig) / gsz; return true;
    }
    __device__ __forceinline__ void a_ready(const Unit&) const {}
    __device__ __forceinline__ void done(const Unit&) const {}
};

__device__ __forceinline__ unsigned cvt_pk_bf16(float lo, float hi) { unsigned r; asm volatile("v_cvt_pk_bf16_f32 %0, %1, %2" : "=v"(r) : "v"(lo), "v"(hi)); return r; }
typedef float f32x2 __attribute__((ext_vector_type(2)));
template <class Epi, class Sched, bool ALIGN_EPI = false, bool SP2 = false>
__device__ __forceinline__ void gemm_phase(PG8_LAS unsigned char* lds, const Gemm g, const Sched& S, const Epi& E) {
    const int tid = threadIdx.x, wid = __builtin_amdgcn_readfirstlane(tid >> 6), lane = tid & 63, wr = wid >> 2, wc = wid & 3, fr = lane & 15, fq = lane >> 4;
    const int K = g.K, nt = K / BK;
    unsigned voffA[2], voffB[2];
#pragma unroll
    for (int i = 0; i < 2; ++i) { int R, C; stage_rc(tid * 16 + i * 8192, R, C); const int Rb = Epi::PERM ? ((R & ~31) + perm32(R & 31)) : R;
        voffA[i] = (unsigned)(R * K + C) * 2u; voffB[i] = (unsigned)(Rb * K + C) * 2u; }
    const size_t kstep = (size_t)(BK * 2);
    const size_t hstep = (size_t)HALF * K * 2;
    const size_t tstep = 2 * hstep;
    const unsigned ldsw = (unsigned)wid * 1024u;
    const int aoff = lds_byte(wr * 64 + fr, fq * 8), boff = lds_byte(wc * 32 + fr, fq * 8);
#define PG8_SA(b, h) (((b) * 2 + (h)) * HTB)
#define PG8_SB(b, h) ((4 + (b) * 2 + (h)) * HTB)
#define PG8_STAGE(bufoff, gbase, voff) do { _Pragma("unroll") for (int _i = 0; _i < 2; ++_i) \
        __builtin_amdgcn_global_load_lds((const unsigned*)((const char*)(gbase) + (voff)[_i]), (PG8_LAS unsigned*)(lds + (bufoff) + ldsw + _i * 8192), 16, 0, 0); } while (0)
#define PG8_LDA(dst, b, h) do { _Pragma("unroll") for (int m = 0; m < 4; ++m) _Pragma("unroll") for (int k = 0; k < 2; ++k) dst[m][k] = *(const PG8_LAS bf16x8*)(lds + PG8_SA(b, h) + aoff + m * 2048 + k * 1024); } while (0)
#define PG8_LDB(dst, b, h) do { _Pragma("unroll") for (int n = 0; n < 2; ++n) _Pragma("unroll") for (int k = 0; k < 2; ++k) dst[n][k] = *(const PG8_LAS bf16x8*)(lds + PG8_SB(b, h) + boff + n * 2048 + k * 1024); } while (0)
#define PG8_MMA(ai, bj, At, Bt) do { __builtin_amdgcn_s_setprio(1); _Pragma("unroll") for (int m = 0; m < 4; ++m) _Pragma("unroll") for (int n = 0; n < 2; ++n) _Pragma("unroll") for (int k = 0; k < 2; ++k) \
        acc[ai][bj][m][n] = __builtin_amdgcn_mfma_f32_16x16x32_bf16(Bt[n][k], At[m][k], acc[ai][bj][m][n], 0, 0, 0); __builtin_amdgcn_s_setprio(0); } while (0)
#define PG8_WAIT_V(n) asm volatile("s_waitcnt vmcnt(" #n ")" ::: "memory")
#define PG8_WAIT_L(n) asm volatile("s_waitcnt lgkmcnt(" #n ")" ::: "memory")
#define PG8_BAR __builtin_amdgcn_s_barrier()
#define PG8_SCHED __builtin_amdgcn_sched_barrier(0)
    Unit cur, nxt; int ui = 0;
    if (!S.next(0, cur)) return;
    f32x4 acc[2][2][4][2];
#pragma unroll
    for (int a = 0; a < 2; ++a)
#pragma unroll
        for (int b = 0; b < 2; ++b)
#pragma unroll
            for (int m = 0; m < 4; ++m)
#pragma unroll
                for (int n = 0; n < 2; ++n) acc[a][b][m][n] = (f32x4){0.f, 0.f, 0.f, 0.f};
    bf16x8 At[4][2], B0[2][2], B1[2][2];
    const char* cA = (const char*)g.A + (size_t)cur.pm * tstep; const char* cB = (const char*)g.Bt + (size_t)cur.pn * tstep;
    S.a_ready(cur);
    if constexpr (SP2) {
        PG8_STAGE(PG8_SB(0, 0), cB, voffB); PG8_STAGE(PG8_SB(0, 1), cB + hstep, voffB); PG8_STAGE(PG8_SA(0, 0), cA, voffA); PG8_STAGE(PG8_SA(0, 1), cA + hstep, voffA);
        if (wr == 1) PG8_BAR;
        PG8_WAIT_V(2); PG8_BAR;
        PG8_STAGE(PG8_SB(1, 0), cB + kstep, voffB); PG8_STAGE(PG8_SA(1, 0), cA + kstep, voffA); PG8_STAGE(PG8_SB(1, 1), cB + hstep + kstep, voffB);
        PG8_WAIT_V(6); PG8_BAR;
    } else {
        PG8_STAGE(PG8_SB(0, 0), cB, voffB); PG8_STAGE(PG8_SA(0, 0), cA, voffA); PG8_STAGE(PG8_SB(0, 1), cB + hstep, voffB); PG8_STAGE(PG8_SA(0, 1), cA + hstep, voffA);
        if (wr == 1) PG8_BAR;
        PG8_WAIT_V(4); PG8_BAR;
        PG8_STAGE(PG8_SB(1, 0), cB + kstep, voffB); PG8_STAGE(PG8_SA(1, 0), cA + kstep, voffA); PG8_STAGE(PG8_SB(1, 1), cB + hstep + kstep, voffB);
        PG8_WAIT_V(6); PG8_BAR;
    }
    for (;;) {
        const bool has_next = S.next(ui + 1, nxt);
        const char* nA = has_next ? (const char*)g.A + (size_t)nxt.pm * tstep : cA; const char* nB = has_next ? (const char*)g.Bt + (size_t)nxt.pn * tstep : cB;
        for (int t = 0; t < nt; t += 2) {
            const bool last = (t == nt - 2);
            const char* a1 = cA + (size_t)(t + 1) * kstep;
            const char* a2 = last ? nA : cA + (size_t)(t + 2) * kstep; const char* b2 = last ? nB : cB + (size_t)(t + 2) * kstep;
            const char* a3 = a2 + kstep; const char* b3 = b2 + kstep;
            if (last && has_next) S.a_ready(nxt);
            if constexpr (SP2) {
            PG8_LDB(B0, 0, 0); PG8_LDB(B1, 0, 1); PG8_SCHED; PG8_LDA(At, 0, 0); PG8_STAGE(PG8_SA(1, 1), a1 + hstep, voffA);
            PG8_WAIT_V(8); PG8_WAIT_L(0); PG8_BAR; PG8_MMA(0, 0, At, B0); PG8_MMA(0, 1, At, B1); PG8_BAR; PG8_SCHED;
            PG8_LDA(At, 0, 1); PG8_STAGE(PG8_SB(0, 0), b2, voffB); PG8_STAGE(PG8_SB(0, 1), b2 + hstep, voffB); PG8_STAGE(PG8_SA(0, 0), a2, voffA);
            PG8_WAIT_V(8); PG8_WAIT_L(0); PG8_BAR; PG8_MMA(1, 0, At, B0); PG8_MMA(1, 1, At, B1); PG8_BAR; PG8_SCHED;
            PG8_LDB(B0, 1, 0); PG8_LDB(B1, 1, 1); PG8_SCHED; PG8_LDA(At, 1, 0); PG8_STAGE(PG8_SA(0, 1), a2 + hstep, voffA);
            PG8_WAIT_V(8); PG8_WAIT_L(0); PG8_BAR; PG8_MMA(0, 0, At, B0); PG8_MMA(0, 1, At, B1); PG8_BAR; PG8_SCHED;
            PG8_LDA(At, 1, 1); PG8_STAGE(PG8_SB(1, 0), b3, voffB); PG8_STAGE(PG8_SB(1, 1), b3 + hstep, voffB); PG8_STAGE(PG8_SA(1, 0), a3, voffA);
            PG8_WAIT_V(8); PG8_WAIT_L(0); PG8_BAR; PG8_MMA(1, 0, At, B0); PG8_MMA(1, 1, At, B1); PG8_BAR; PG8_SCHED;
            } else {
            PG8_LDB(B0, 0, 0); PG8_SCHED; PG8_LDA(At, 0, 0); PG8_STAGE(PG8_SA(1, 1), a1 + hstep, voffA);
            PG8_WAIT_L(8); PG8_BAR; PG8_WAIT_L(0); PG8_MMA(0, 0, At, B0); PG8_BAR; PG8_SCHED;
            PG8_LDB(B1, 0, 1); PG8_STAGE(PG8_SB(0, 0), b2, voffB);
            PG8_BAR; PG8_WAIT_L(0); PG8_MMA(0, 1, At, B1); PG8_BAR;
            PG8_LDA(At, 0, 1); PG8_STAGE(PG8_SA(0, 0), a2, voffA);
            PG8_BAR; PG8_WAIT_L(0); PG8_MMA(1, 0, At, B0); PG8_BAR; PG8_SCHED;
            PG8_STAGE(PG8_SB(0, 1), b2 + hstep, voffB);
            PG8_WAIT_V(6); PG8_BAR; PG8_MMA(1, 1, At, B1); PG8_BAR;
            PG8_LDB(B0, 1, 0); PG8_SCHED; PG8_LDA(At, 1, 0); PG8_STAGE(PG8_SA(0, 1), a2 + hstep, voffA);
            PG8_WAIT_L(8); PG8_BAR; PG8_WAIT_L(0); PG8_MMA(0, 0, At, B0); PG8_BAR; PG8_SCHED;
            PG8_LDB(B1, 1, 1); PG8_STAGE(PG8_SB(1, 0), b3, voffB);
            PG8_BAR; PG8_WAIT_L(0); PG8_MMA(0, 1, At, B1); PG8_BAR;
            PG8_LDA(At, 1, 1); PG8_STAGE(PG8_SA(1, 0), a3, voffA);
            PG8_BAR; PG8_WAIT_L(0); PG8_MMA(1, 0, At, B0); PG8_BAR; PG8_SCHED;
            PG8_STAGE(PG8_SB(1, 1), b3 + hstep, voffB);
            PG8_WAIT_V(6); PG8_BAR; PG8_MMA(1, 1, At, B1); PG8_BAR;
            }
        }
        if constexpr (ALIGN_EPI) { if (wr == 0) PG8_BAR; }
        if constexpr (!Epi::AFTER_DRAIN) { E(acc, cur, wr, wc, fr, fq); S.done(cur); }
        if (!has_next) break;
#pragma unroll
        for (int a = 0; a < 2; ++a)
#pragma unroll
            for (int b = 0; b < 2; ++b)
#pragma unroll
                for (int m = 0; m < 4; ++m)
#pragma unroll
                    for (int n = 0; n < 2; ++n) acc[a][b][m][n] = (f32x4){0.f, 0.f, 0.f, 0.f};
        cur = nxt; cA = nA; cB = nB; ++ui;
        if constexpr (ALIGN_EPI) { if (wr == 1) PG8_BAR; }
    }
    PG8_WAIT_V(0);
    if constexpr (!ALIGN_EPI) { if (wr == 0) PG8_BAR; }
    PG8_BAR;
    if constexpr (Epi::AFTER_DRAIN) { E.fused(acc, cur, wr, wc, fr, fq, lds, wid, lane); S.done(cur); }
#undef PG8_SA
#undef PG8_SB
#undef PG8_STAGE
#undef PG8_LDA
#undef PG8_LDB
#undef PG8_MMA
#undef PG8_WAIT_V
#undef PG8_WAIT_L
#undef PG8_BAR
#undef PG8_SCHED
}
}

#define LAS __attribute__((address_space(3)))
typedef unsigned short bf16_t;
typedef short bf16x8 __attribute__((ext_vector_type(8)));
typedef short bf16x4 __attribute__((ext_vector_type(4)));
typedef float f32x4 __attribute__((ext_vector_type(4)));
typedef float f32x16 __attribute__((ext_vector_type(16)));
typedef unsigned u32x4 __attribute__((ext_vector_type(4)));
typedef unsigned u32x2 __attribute__((ext_vector_type(2)));
typedef __bf16 bf16x2_t __attribute__((ext_vector_type(2)));

constexpr int NB = 16, SEQ = 2048, T = NB * SEQ, D = 1024;
constexpr int PP = 4608;
constexpr int C_Q = 0, C_KF = 512, C_LFF = 1024, C_KB = 1536, C_LFB = 2048, C_V = 2560, C_G = 3072, C_DQ = 3584, C_DK = 4096;
constexpr float EPS = 1e-6f;
constexpr float LOG2E = 1.4426950408889634f;
constexpr int NWAVES = 8, NTHREADS = 512;
constexpr int NGRP = 4, GRP_SHIFT = 12, GRP_SIZE = 4096, VSL = 128, NVS = 4;
constexpr int LDS_BYTES = 147456;

constexpr size_t MiB = (size_t)1 << 20;
constexpr size_t WS_SM = 64 * 1024;
constexpr size_t WS_WINT = 2 * MiB, WS_WOT = 10 * MiB, WS_WQT = 12 * MiB, WS_KEYS = 16 * MiB;
constexpr size_t WS_UT = 32 * MiB, WS_USC = 48 * MiB, WS_VSC = 49 * MiB, WS_VE = 64 * MiB, WS_XN = 96 * MiB, WS_PROJ = 160 * MiB, WS_VT = 448 * MiB, WS_END = 480 * MiB;
constexpr size_t WS_H1B = 160 * MiB, WS_QP = 224 * MiB, WS_IDX = 360 * MiB, WS_GATE = 376 * MiB, WS_SS = 392 * MiB, WS_C = 394 * MiB;
constexpr int QPS = 2048 + 64;
constexpr size_t WS_UEX = 50 * MiB;
constexpr size_t WS_CQ = 410 * MiB, WS_CS = 414 * MiB;
constexpr size_t WS_PART = 224 * MiB;
constexpr size_t WS_H1Q = 96 * MiB, WS_HSC = 128 * MiB;
constexpr int SM_LBF = 0, SM_LBB = 512, SM_LAM = 1024, SM_BT = 2048, BT_STRIDE = 260;

struct Params { const float* in[19]; float* out; unsigned char* ws; int ph_lo, ph_hi; };
enum { I_X = 0, I_G1, I_WIN, I_LBF, I_LBB, I_HOG, I_LQ1, I_LK1, I_LQ2, I_LK2, I_DOG, I_RB, I_WOUT, I_G2, I_WQ, I_KEYS, I_U, I_V, I_FG };

#define LDS_WAIT() asm volatile("s_waitcnt lgkmcnt(0)" ::: "memory")
__device__ __forceinline__ unsigned f2bf(float f) { unsigned u = __builtin_bit_cast(unsigned, f); return (u + 0x7fffu + ((u >> 16) & 1u)) >> 16; }
typedef float f32x2v_ __attribute__((ext_vector_type(2)));
__device__ __forceinline__ unsigned pk2(float lo, float hi) { const f32x2v_ v = {lo, hi}; return __builtin_bit_cast(unsigned, __builtin_convertvector(v, bf16x2_t)); }
__device__ __forceinline__ float bflo(unsigned w) { return __uint_as_float(w << 16); }
__device__ __forceinline__ float bfhi(unsigned w) { return __uint_as_float(w & 0xffff0000u); }
template <int CTRL> __device__ __forceinline__ float dpp_mov(float v) { return __builtin_bit_cast(float, __builtin_amdgcn_update_dpp(0, __builtin_bit_cast(int, v), CTRL, 0xF, 0xF, false)); }
__device__ __forceinline__ void swap16_(float& a, float& b) { asm volatile("s_nop 1\n\tv_permlane16_swap_b32 %0, %1\n\ts_nop 1" : "+v"(a), "+v"(b)); }
__device__ __forceinline__ void swap32_(float& a, float& b) { asm volatile("s_nop 1\n\tv_permlane32_swap_b32 %0, %1\n\ts_nop 1" : "+v"(a), "+v"(b)); }
__device__ __forceinline__ void swap16i_(int& a, int& b) { asm volatile("s_nop 1\n\tv_permlane16_swap_b32 %0, %1\n\ts_nop 1" : "+v"(a), "+v"(b)); }
__device__ __forceinline__ void swap32i_(int& a, int& b) { asm volatile("s_nop 1\n\tv_permlane32_swap_b32 %0, %1\n\ts_nop 1" : "+v"(a), "+v"(b)); }
__device__ __forceinline__ float swap16_sum(float v) { float a = v, b = v; swap16_(a, b); return a + b; }
__device__ __forceinline__ float swap32_sum(float v) { float a = v, b = v; swap32_(a, b); return a + b; }
__device__ __forceinline__ float swap16_max(float v) { float a = v, b = v; swap16_(a, b); return fmaxf(a, b); }
__device__ __forceinline__ float swap32_max(float v) { float a = v, b = v; swap32_(a, b); return fmaxf(a, b); }
__device__ __forceinline__ float xchg16(float v, int lane) { float a = v, b = v; swap16_(a, b); return (lane & 16) ? a : b; }
__device__ __forceinline__ float xchg32(float v, int lane) { float a = v, b = v; swap32_(a, b); return (lane & 32) ? a : b; }
__device__ __forceinline__ float wave_sum(float v) {
    v += dpp_mov<0xB1>(v); v += dpp_mov<0x4E>(v); v += dpp_mov<0x141>(v); v += dpp_mov<0x140>(v);
    return swap32_sum(swap16_sum(v));
}
__device__ __forceinline__ float wave_max(float v) {
    v = fmaxf(v, dpp_mov<0xB1>(v)); v = fmaxf(v, dpp_mov<0x4E>(v)); v = fmaxf(v, dpp_mov<0x141>(v)); v = fmaxf(v, dpp_mov<0x140>(v));
    return swap32_max(swap16_max(v));
}
__device__ __forceinline__ float sigmoidf_(float z) { return __builtin_amdgcn_rcpf(1.0f + __expf(-z)); }

__device__ __forceinline__ void p0_transpose_item(const float* W, int K, int N, bf16_t* WT, const float* kscale, LAS float* scr, int item, int lane) {
    const int nblk = N / 32, kb = item / nblk, nb = item % nblk, k0 = 64 * kb, n0 = 32 * nb;
#pragma unroll 8
    for (int i = 0; i < 32; ++i) { const int kk = 2 * i + (lane >> 5); float w = W[(size_t)(k0 + kk) * N + n0 + (lane & 31)]; if (kscale) w *= kscale[k0 + kk]; scr[kk * 33 + (lane & 31)] = w; }
    LDS_WAIT(); asm volatile("" ::: "memory");
    const int c = lane & 7;
#pragma unroll
    for (int j = 0; j < 4; ++j) { const int n = (lane >> 3) + 8 * j; const LAS float* s = scr + (8 * c) * 33 + n;
        u32x4 o; o.x = pk2(s[0 * 33], s[1 * 33]); o.y = pk2(s[2 * 33], s[3 * 33]); o.z = pk2(s[4 * 33], s[5 * 33]); o.w = pk2(s[6 * 33], s[7 * 33]);
        *(u32x4*)(WT + (size_t)(n0 + n) * K + k0 + 8 * c) = o; }
    LDS_WAIT(); asm volatile("" ::: "memory");
}
__device__ __forceinline__ int t5_bucket(int rel) {
    const int n = rel < 0 ? -rel : rel;
    const int v = n < 8 ? n : n < 12 ? 8 : n < 16 ? 9 : n < 23 ? 10 : n < 32 ? 11 : n < 46 ? 12 : n < 64 ? 13 : n < 91 ? 14 : 15;
    return (rel > 0 ? 16 : 0) + v;
}
__device__ __forceinline__ void phase_prep(const Params& p, LAS unsigned char* lds, int vcu, int G) {
    const int tid = threadIdx.x, lane = tid & 63, wave = __builtin_amdgcn_readfirstlane(tid >> 6);
    unsigned char* ws = p.ws;
    LAS float* scr = (LAS float*)(lds + wave * 16384);
    const int gw = vcu * NWAVES + wave, NGW = G * NWAVES;
    constexpr int I_IN = (D / 64) * (4096 / 32), I_OUT = (D / 64) * (D / 32), I_QW = (D / 64) * (2048 / 32);
    for (int it = gw; it < I_IN + I_OUT + I_QW; it += NGW) {
        int r = it;
        if (r < I_IN) { p0_transpose_item(p.in[I_WIN], D, 4096, (bf16_t*)(ws + WS_WINT), nullptr, scr, r, lane); continue; } r -= I_IN;
        if (r < I_OUT) { p0_transpose_item(p.in[I_WOUT], D, D, (bf16_t*)(ws + WS_WOT), nullptr, scr, r, lane); continue; } r -= I_OUT;
        p0_transpose_item(p.in[I_WQ], D, 2048, (bf16_t*)(ws + WS_WQT), p.in[I_G2], scr, r, lane);
    }
    for (int i = blockIdx.x * NTHREADS + tid; i < 8 * 2 * 128 * 128 / 4; i += G * NTHREADS) {
        const f32x4 v = ((const f32x4*)p.in[I_KEYS])[i];
        ((u32x2*)(ws + WS_KEYS))[i] = (u32x2){pk2(v.x, v.y), pk2(v.z, v.w)};
    }
#define PX_LOAD(dst, m0_) { _Pragma("unroll") for (int u = 0; u < 4; ++u) { const int m = ((m0_) + u * NGW) < T ? ((m0_) + u * NGW) : gw; const f32x4* xr = (const f32x4*)(p.in[I_X] + (size_t)m * D) + lane; \
            _Pragma("unroll") for (int j = 0; j < 4; ++j) dst[u][j] = __builtin_nontemporal_load(xr + 64 * j); } }
#define PX_PROC(src, m0_) { _Pragma("unroll") for (int u = 0; u < 4; ++u) { const int m = (m0_) + u * NGW; if (m < T) { float ssq = 0.f; \
            _Pragma("unroll") for (int j = 0; j < 4; ++j) ssq += (src[u][j].x * src[u][j].x + src[u][j].y * src[u][j].y) + (src[u][j].z * src[u][j].z + src[u][j].w * src[u][j].w); \
            const float rs = rsqrtf(wave_sum(ssq) * (1.f / D) + EPS); unsigned long long* o8 = (unsigned long long*)((bf16_t*)(ws + WS_XN) + (size_t)m * D) + lane; \
            _Pragma("unroll") for (int j = 0; j < 4; ++j) { const f32x4 y = src[u][j] * rs * ((const f32x4*)p.in[I_G1])[64 * j + lane]; o8[64 * j] = (unsigned long long)pk2(y.x, y.y) | ((unsigned long long)pk2(y.z, y.w) << 32); } } } }
    {
        f32x4 va[4][4], vb[4][4];
        PX_LOAD(va, gw)
        for (int m0 = gw; m0 < T; m0 += 8 * NGW) {
            if (m0 + 4 * NGW < T) PX_LOAD(vb, m0 + 4 * NGW)
            PX_PROC(va, m0)
            if (m0 + 8 * NGW < T) PX_LOAD(va, m0 + 8 * NGW)
            PX_PROC(vb, m0 + 4 * NGW)
        }
    }
    if (blockIdx.x == 0) {
        float* sm = (float*)(ws + WS_SM);
        { const float* a = p.in[I_LBF]; sm[SM_LBF + tid] = 1.f / (1.f + __expf(a[512 + tid] - a[tid])); }
        { const float* a = p.in[I_LBB]; sm[SM_LBB + tid] = 1.f / (1.f + __expf(a[512 + tid] - a[tid])); }
        if (tid < 64) {
            float a = p.in[I_LQ1][tid] * p.in[I_LK1][tid], b = p.in[I_LQ2][tid] * p.in[I_LK2][tid];
            a = wave_sum(a); b = wave_sum(b);
            if (tid == 0) sm[SM_LAM] = __expf(a) - __expf(b) + 0.2f;
        }
        for (int i = tid; i < 4 * 257; i += NTHREADS) { const int h = i / 257, r = i % 257; sm[SM_BT + h * BT_STRIDE + r] = p.in[I_RB][t5_bucket(r - 128) * 4 + h] * LOG2E; }
    }
}

__device__ __forceinline__ float silu_(float x) { return x * __builtin_amdgcn_rcpf(1.0f + __expf(-x)); }
struct EpiInProj {
    static constexpr bool PERM = true, AFTER_DRAIN = false;
    bf16_t* P; const float* sm;
    __device__ __forceinline__ void st8(bf16_t* dst, const float (&y)[8]) const { u32x4 w; w.x = pk2(y[0], y[1]); w.y = pk2(y[2], y[3]); w.z = pk2(y[4], y[5]); w.w = pk2(y[6], y[7]); *(u32x4*)dst = w; }
    __device__ __forceinline__ void operator()(const f32x4 (&acc)[2][2][4][2], const pg8::Unit& u, int wr, int wc, int fr, int fq) const {
        const int seg = u.pn >> 1;
        const int row0 = u.pm * 256 + wr * 64 + fr;
        const int cs0 = (u.pn & 1) * 256 + wc * 32 + 8 * fq;
#pragma unroll
        for (int bj = 0; bj < 2; ++bj) {
            const int cs = cs0 + bj * 128;
            float lb[8] = {0.f, 0.f, 0.f, 0.f, 0.f, 0.f, 0.f, 0.f};
            if (seg == 1 || seg == 2) {
#pragma unroll
                for (int i = 0; i < 8; ++i) lb[i] = sm[(seg == 1 ? SM_LBF : SM_LBB) + cs + i];
            }
#pragma unroll
            for (int ai = 0; ai < 2; ++ai)
#pragma unroll
                for (int m = 0; m < 4; ++m) {
                    const size_t row = (size_t)(row0 + ai * 128 + m * 16);
                    bf16_t* rp = P + row * PP + cs;
                    float x[8];
#pragma unroll
                    for (int i = 0; i < 4; ++i) { x[i] = acc[ai][bj][m][0][i]; x[4 + i] = acc[ai][bj][m][1][i]; }
                    float y[8];
                    if (seg == 0 || seg == 4) {
#pragma unroll
                        for (int i = 0; i < 8; ++i) y[i] = silu_(x[i]);
                        st8(rp + (seg == 0 ? C_Q : C_G), y);
                    } else if (seg == 1 || seg == 2) {
                        float lf[8];
#pragma unroll
                        for (int i = 0; i < 8; ++i) { const float s = sigmoidf_(x[i]); const float k = (1.f - lb[i]) * (1.f - s); y[i] = k; lf[i] = __logf(1.f - k); }
                        st8(rp + (seg == 1 ? C_KF : C_KB), y);
                        st8(rp + (seg == 1 ? C_LFF : C_LFB), lf);
                    } else if (seg == 3) {
                        st8(rp + C_V, x);
                    } else if (seg == 5) {
#pragma unroll
                        for (int i = 0; i < 8; ++i) y[i] = x[i] * (0.125f * LOG2E);
                        st8(rp + C_DQ, y);
                    } else {
                        st8(rp + C_DK, x);
                    }
                }
        }
    }
};
struct EpiStore {
    static constexpr bool PERM = true, AFTER_DRAIN = false;
    bf16_t* O; int ldc;
    __device__ __forceinline__ void operator()(const f32x4 (&acc)[2][2][4][2], const pg8::Unit& u, int wr, int wc, int fr, int fq) const {
        const int row0 = u.pm * 256 + wr * 64 + fr, col0 = u.pn * 256 + wc * 32 + 8 * fq;
#pragma unroll
        for (int ai = 0; ai < 2; ++ai)
#pragma unroll
            for (int m = 0; m < 4; ++m)
#pragma unroll
                for (int bj = 0; bj < 2; ++bj) {
                    const f32x4 a = acc[ai][bj][m][0], b = acc[ai][bj][m][1];
                    u32x4 w; w.x = pk2(a[0], a[1]); w.y = pk2(a[2], a[3]); w.z = pk2(b[0], b[1]); w.w = pk2(b[2], b[3]);
                    *(u32x4*)(O + (size_t)(row0 + ai * 128 + m * 16) * ldc + col0 + bj * 128) = w;
                }
    }
};
struct EpiOutProj {
    static constexpr bool PERM = true, AFTER_DRAIN = false;
    const float* x; float* H1; bf16_t* H1B; float* SS;
    __device__ __forceinline__ void operator()(const f32x4 (&acc)[2][2][4][2], const pg8::Unit& u, int wr, int wc, int fr, int fq) const {
        const int row0 = u.pm * 256 + wr * 64 + fr, col0 = u.pn * 256 + wc * 32 + 8 * fq;
#pragma unroll
        for (int ai = 0; ai < 2; ++ai)
#pragma unroll
            for (int m = 0; m < 4; ++m) {
                const size_t row = (size_t)(row0 + ai * 128 + m * 16);
                float ss = 0.f;
#pragma unroll
                for (int bj = 0; bj < 2; ++bj) {
                    const size_t off = row * D + col0 + bj * 128;
                    const f32x4 a = *(const f32x4*)(x + off) + acc[ai][bj][m][0], b = *(const f32x4*)(x + off + 4) + acc[ai][bj][m][1];
                    u32x4 w; w.x = pk2(a[0], a[1]); w.y = pk2(a[2], a[3]); w.z = pk2(b[0], b[1]); w.w = pk2(b[2], b[3]);
                    *(u32x4*)(H1B + off) = w;
                    ss += (a[0] * a[0] + a[1] * a[1]) + (a[2] * a[2] + a[3] * a[3]) + (b[0] * b[0] + b[1] * b[1]) + (b[2] * b[2] + b[3] * b[3]);
                }
                ss += __shfl_xor(ss, 16); ss += __shfl_xor(ss, 32);
                if (fq == 0) SS[row * 16 + u.pn * 4 + wc] = ss;
            }
    }
};
__device__ __forceinline__ float row_rstd(const float* SS, size_t row) {
    const f32x4* s = (const f32x4*)(SS + row * 16);
    const f32x4 a = s[0], b = s[1], c = s[2], d = s[3];
    const float t = ((a[0] + a[1]) + (a[2] + a[3])) + ((b[0] + b[1]) + (b[2] + b[3])) + ((c[0] + c[1]) + (c[2] + c[3])) + ((d[0] + d[1]) + (d[2] + d[3]));
    return rsqrtf(t * (1.f / D) + EPS);
}
struct EpiQ {
    static constexpr bool PERM = true, AFTER_DRAIN = false;
    bf16_t* O; const float* SS; float* RSTD;
    __device__ __forceinline__ void operator()(const f32x4 (&acc)[2][2][4][2], const pg8::Unit& u, int wr, int wc, int fr, int fq) const {
        const int row0 = u.pm * 256 + wr * 64 + fr, col0 = u.pn * 256 + wc * 32 + 8 * fq;
#pragma unroll
        for (int ai = 0; ai < 2; ++ai)
#pragma unroll
            for (int m = 0; m < 4; ++m) {
                const size_t row = (size_t)(row0 + ai * 128 + m * 16);
                const float rs = row_rstd(SS, row);
                if (u.pn == 0 && wc == 0 && fq == 0) RSTD[row] = rs;
#pragma unroll
                for (int bj = 0; bj < 2; ++bj) {
                    const f32x4 a = acc[ai][bj][m][0] * rs, b = acc[ai][bj][m][1] * rs;
                    u32x4 w; w.x = pk2(a[0], a[1]); w.y = pk2(a[2], a[3]); w.z = pk2(b[0], b[1]); w.w = pk2(b[2], b[3]);
                    *(u32x4*)(O + row * QPS + col0 + bj * 128) = w;
                }
            }
    }
};

constexpr int HQ_STRIDE = 272, HT_STRIDE = 48;
constexpr int H_QA = 0, H_KD = 4352, H_KH = 8704, H_VT = 14848, H_DEC = 20992, H_OPER = 21504, H_RAW = 2 * H_OPER, H_RAWB = 16384;
constexpr size_t HG_DONE_OFF = 32768 + 256;
__device__ __forceinline__ void phase_hgrn(const Params& p, LAS unsigned char* lds, int G) {
    const int tid = threadIdx.x, lane = tid & 63, wave = __builtin_amdgcn_readfirstlane(tid >> 6), fr = lane & 15, g = lane >> 4;
    const bf16_t* PROJ = (const bf16_t*)(p.ws + WS_PROJ);
    const int NCH = SEQ / 16;
    for (int item = blockIdx.x; item < 128; item += G) {
        const int dir = item & 1, h = (item >> 1) & 3, b = item >> 3;
        bf16_t* O = (bf16_t*)p.out + (size_t)dir * T * 512;
        const int ck = dir ? C_KB : C_KF, cl = dir ? C_LFB : C_LFF;
        const bool isv = tid >= 256; const int arow = (tid & 255) >> 4, ac8 = (tid & 15) * 8;
        u32x4 rqA = (u32x4){0u, 0u, 0u, 0u}, rkA = rqA, rlA = rqA, rqB = rqA, rkB = rqA, rlB = rqA;
#define HG_GLOAD(S, ch) do { const int pos_ = (ch) * 16 + arow, tr_ = dir ? SEQ - 1 - pos_ : pos_; \
            const bf16_t* rp_ = PROJ + (size_t)(b * SEQ + tr_) * PP + h * 128 + ac8; \
            if (isv) { rq##S = *(const u32x4*)(rp_ + C_V); } else { rq##S = *(const u32x4*)(rp_ + C_Q); rk##S = *(const u32x4*)(rp_ + ck); rl##S = *(const u32x4*)(rp_ + cl); } } while (0)
#define HG_RAWSTORE(S, par) do { LAS unsigned char* R_ = lds + H_RAW + (par) * H_RAWB + arow * 256 + ac8 * 2; \
            if (isv) { *(LAS u32x4*)(R_ + 12288) = rq##S; } else { *(LAS u32x4*)R_ = rq##S; *(LAS u32x4*)(R_ + 4096) = rk##S; *(LAS u32x4*)(R_ + 8192) = rl##S; } } while (0)
        const int pc = tid & 127, part = tid >> 7;
        auto phaseB = [&](int par) {
            const LAS unsigned char* R = lds + H_RAW + par * H_RAWB; LAS unsigned char* OP = lds + par * H_OPER;
            float pre = 0.f, total = 0.f;
#pragma unroll
            for (int t = 0; t < 16; ++t) { const float v = __uint_as_float((unsigned)(*(const LAS unsigned short*)(R + 8192 + t * 256 + pc * 2)) << 16); total += v; pre += (t < 4 * part) ? v : 0.f; }
            float bb = pre; float kh[4], vv[4];
#pragma unroll
            for (int j = 0; j < 4; ++j) {
                const int t = 4 * part + j;
                const float lfv = __uint_as_float((unsigned)(*(const LAS unsigned short*)(R + 8192 + t * 256 + pc * 2)) << 16);
                const float qv = __uint_as_float((unsigned)(*(const LAS unsigned short*)(R + t * 256 + pc * 2)) << 16);
                const float kv = __uint_as_float((unsigned)(*(const LAS unsigned short*)(R + 4096 + t * 256 + pc * 2)) << 16);
                vv[j] = __uint_as_float((unsigned)(*(const LAS unsigned short*)(R + 12288 + t * 256 + pc * 2)) << 16);
                bb += lfv;
                *(LAS unsigned short*)(OP + H_QA + t * HQ_STRIDE + pc * 2) = (unsigned short)f2bf(qv * __expf(bb));
                *(LAS unsigned short*)(OP + H_KD + t * HQ_STRIDE + pc * 2) = (unsigned short)f2bf(kv * __expf(-bb));
                kh[j] = kv * __expf(total - bb);
            }
            *(LAS u32x2*)(OP + H_KH + pc * HT_STRIDE + part * 8) = (u32x2){pk2(kh[0], kh[1]), pk2(kh[2], kh[3])};
            *(LAS u32x2*)(OP + H_VT + pc * HT_STRIDE + part * 8) = (u32x2){pk2(vv[0], vv[1]), pk2(vv[2], vv[3])};
            if (part == 0) *(LAS float*)(OP + H_DEC + pc * 4) = __expf(total);
        };
        f32x4 S[8];
#pragma unroll
        for (int kt = 0; kt < 8; ++kt) S[kt] = (f32x4){0.f, 0.f, 0.f, 0.f};
        __syncthreads();
        HG_GLOAD(A, 0); HG_RAWSTORE(A, 0); HG_GLOAD(A, 1); HG_GLOAD(B, 2);
        __syncthreads();
        phaseB(0); HG_RAWSTORE(A, 1); HG_GLOAD(A, 3);
        __syncthreads();
#define HG_TAIL_ODD(i) { if ((i) + 2 < NCH) HG_RAWSTORE(A, 1); if ((i) + 4 < NCH) HG_GLOAD(A, (i) + 4); }
#define HG_TAIL_EVEN(i) { if ((i) + 2 < NCH) HG_RAWSTORE(B, 0); if ((i) + 4 < NCH) HG_GLOAD(B, (i) + 4); }
#define HG_STEP(i_, PAR) { const int i = (i_); \
            if (i + 1 < NCH) phaseB((i + 1) & 1); \
            { \
                const LAS unsigned char* OP = lds + (i & 1) * H_OPER; \
                f32x4 o = (f32x4){0.f, 0.f, 0.f, 0.f}; \
_Pragma("unroll") \
                for (int j = 0; j < 4; ++j) { \
                    u32x4 w; w.x = pk2(S[2 * j][0], S[2 * j][1]); w.y = pk2(S[2 * j][2], S[2 * j][3]); w.z = pk2(S[2 * j + 1][0], S[2 * j + 1][1]); w.w = pk2(S[2 * j + 1][2], S[2 * j + 1][3]); \
                    const u32x2 a0 = *(const LAS u32x2*)(OP + H_QA + fr * HQ_STRIDE + (32 * j + 4 * g) * 2), a1 = *(const LAS u32x2*)(OP + H_QA + fr * HQ_STRIDE + (32 * j + 16 + 4 * g) * 2); \
                    o = __builtin_amdgcn_mfma_f32_16x16x32_bf16(__builtin_bit_cast(bf16x8, (u32x4){a0.x, a0.y, a1.x, a1.y}), __builtin_bit_cast(bf16x8, w), o, 0, 0, 0); \
                } \
                f32x4 X = (f32x4){0.f, 0.f, 0.f, 0.f}; \
_Pragma("unroll") \
                for (int j = 0; j < 4; ++j) { \
                    const bf16x8 ak = *(const LAS bf16x8*)(OP + H_KD + fr * HQ_STRIDE + (32 * j + 8 * g) * 2), bq = *(const LAS bf16x8*)(OP + H_QA + fr * HQ_STRIDE + (32 * j + 8 * g) * 2); \
                    X = __builtin_amdgcn_mfma_f32_16x16x32_bf16(ak, bq, X, 0, 0, 0); \
                } \
_Pragma("unroll") \
                for (int r = 0; r < 4; ++r) X[r] = (4 * g + r > fr) ? 0.f : X[r]; \
                const u32x2 vlo = *(const LAS u32x2*)(OP + H_VT + (16 * wave + fr) * HT_STRIDE + g * 8); \
                const bf16x8 vb = __builtin_bit_cast(bf16x8, (u32x4){vlo.x, vlo.y, 0u, 0u}); \
                const bf16x8 pa = __builtin_bit_cast(bf16x8, (u32x4){pk2(X[0], X[1]), pk2(X[2], X[3]), 0u, 0u}); \
                o = __builtin_amdgcn_mfma_f32_16x16x32_bf16(pa, vb, o, 0, 0, 0); \
_Pragma("unroll") \
                for (int r = 0; r < 4; ++r) { const int pos = i * 16 + 4 * g + r, tr = dir ? SEQ - 1 - pos : pos; O[(size_t)(b * SEQ + tr) * 512 + h * 128 + 16 * wave + fr] = (bf16_t)f2bf(o[r]); } \
_Pragma("unroll") \
                for (int kt = 0; kt < 8; ++kt) { \
                    const f32x4 dc = *(const LAS f32x4*)(OP + H_DEC + (16 * kt + 4 * g) * 4); \
                    const u32x2 klo = *(const LAS u32x2*)(OP + H_KH + (16 * kt + fr) * HT_STRIDE + g * 8); \
                    S[kt] = __builtin_amdgcn_mfma_f32_16x16x32_bf16(__builtin_bit_cast(bf16x8, (u32x4){klo.x, klo.y, 0u, 0u}), vb, S[kt] * dc, 0, 0, 0); \
                } \
            } \
            HG_TAIL_##PAR(i) \
             \
            __syncthreads(); }
        for (int i2 = 0; i2 < NCH; i2 += 2) { HG_STEP(i2, EVEN) HG_STEP(i2 + 1, ODD) }
        asm volatile("s_waitcnt vmcnt(0)" ::: "memory");
        __syncthreads();
        if (tid == 0) { __builtin_amdgcn_fence(__ATOMIC_RELEASE, "agent"); asm volatile("s_waitcnt vmcnt(0)" ::: "memory");
            (void)__hip_atomic_fetch_add((unsigned*)(p.ws + HG_DONE_OFF), 1u, __ATOMIC_RELAXED, __HIP_MEMORY_SCOPE_AGENT); }
    }
}

constexpr int KT_STRIDE = 288, VT_STRIDE = 160;
constexpr int ATT_BUF = 64 * KT_STRIDE + 128 * VT_STRIDE;
constexpr int QUANT_ITEMS = 256;
__device__ __forceinline__ void quant_tables(const Params& p, int gw, int NGW, int lane) {
    unsigned char* ws = p.ws;
#define PQ_LOAD(dst, r0_) { _Pragma("unroll") for (int u = 0; u < 4; ++u) { const int r = ((r0_) + u * NGW) < 2 * 16384 ? ((r0_) + u * NGW) : gw; const bool isv = r >= 16384; const int e = isv ? r - 16384 : r; \
            const f32x4* xr = (const f32x4*)((isv ? p.in[I_V] : p.in[I_U]) + (size_t)e * D) + lane; _Pragma("unroll") for (int j = 0; j < 4; ++j) dst[u][j] = __builtin_nontemporal_load(xr + 64 * j); } }
#define PQ_PROC(src, r0_) { _Pragma("unroll") for (int u = 0; u < 4; ++u) { const int r = (r0_) + u * NGW; if (r < 2 * 16384) { \
            const bool isv = r >= 16384; const int e = isv ? r - 16384 : r; f32x4 v[4]; float am = 0.f; \
            _Pragma("unroll") for (int j = 0; j < 4; ++j) { v[j] = src[u][j]; if (!isv) v[j] = v[j] * ((const f32x4*)p.in[I_G2])[64 * j + lane]; \
                am = fmaxf(am, fmaxf(fmaxf(fabsf(v[j].x), fabsf(v[j].y)), fmaxf(fabsf(v[j].z), fabsf(v[j].w)))); } \
            am = wave_max(am); const float sc = am > 0.f ? am * (1.f / 7.f) : 1.f, inv = 1.f / sc; unsigned pk[4]; int qs = 0; \
            _Pragma("unroll") for (int j = 0; j < 4; ++j) { \
                const int q0 = (int)rintf(v[j].x * inv), q1 = (int)rintf(v[j].y * inv), q2 = (int)rintf(v[j].z * inv), q3 = (int)rintf(v[j].w * inv); qs += (q0 + q1) + (q2 + q3); \
                pk[j] = (unsigned)((q0 & 0xFF) | ((q1 & 0xFF) << 8) | ((q2 & 0xFF) << 16) | ((q3 & 0xFF) << 24)); } \
            if (isv) {   \
                _Pragma("unroll") for (int j = 0; j < 4; ++j) { const unsigned k_ = pk[j]; \
                    *(unsigned short*)(ws + WS_VE + ((size_t)j * 16384 + e) * VSL + 2 * lane) = (unsigned short)(((k_ & 0xFu) ^ 8u) | ((k_ >> 4) & 0xF0u) | ((((k_ >> 16) & 0xFu) ^ 8u) << 8) | ((k_ >> 12) & 0xF000u)); } \
                if (lane == 0) ((float*)(ws + WS_UEX))[4 * e + 1] = sc; } \
            else {   \
                _Pragma("unroll") for (int j = 0; j < 4; ++j) { const unsigned k_ = pk[j]; \
                    *(unsigned short*)(ws + WS_UT + ((size_t)j * 16384 + e) * 128 + 2 * lane) = (unsigned short)((k_ & 0xFu) | ((k_ >> 4) & 0xF0u) | (((k_ >> 16) & 0xFu) << 8) | ((k_ >> 12) & 0xF000u)); } \
                const float qt = wave_sum((float)qs); if (lane == 0) { ((float*)(ws + WS_UEX))[4 * e] = sc; ((float*)(ws + WS_UEX))[4 * e + 2] = 8.f * qt; } } } } }
    for (int r0 = gw; r0 < 2 * 16384; r0 += 4 * NGW) { f32x4 va[4][4]; PQ_LOAD(va, r0) PQ_PROC(va, r0) }
}
constexpr int MIX_ITEMS = 256;
__device__ __forceinline__ void mix_rows(const Params& p, int gw, int NGW, int lane) {
    const bf16_t* PROJ = (const bf16_t*)(p.ws + WS_PROJ);
    const bf16_t* OF = (const bf16_t*)p.out; const bf16_t* OB = OF + (size_t)T * 512;
    bf16_t* MIXED = (bf16_t*)(p.ws + WS_XN);
    const float* hog = p.in[I_HOG];
    const f32x4 g0 = *(const f32x4*)(hog + (lane & 15) * 8), g1 = *(const f32x4*)(hog + (lane & 15) * 8 + 4);
    for (int m0 = gw; m0 < T; m0 += 4 * NGW) {
        u32x4 av[4], bv[4], gv[4];
#pragma unroll
        for (int u = 0; u < 4; ++u) { const int m = (m0 + u * NGW) < T ? (m0 + u * NGW) : m0;
            av[u] = *(const u32x4*)(OF + (size_t)m * 512 + 8 * lane); bv[u] = *(const u32x4*)(OB + (size_t)m * 512 + 8 * lane); gv[u] = *(const u32x4*)(PROJ + (size_t)m * PP + C_G + 8 * lane); }
#pragma unroll
        for (int u = 0; u < 4; ++u) {
            const int m = m0 + u * NGW; if (m >= T) break;
            const u32x4 a = av[u], bb = bv[u], gg = gv[u];
            float o[8]; float ss = 0.f;
#pragma unroll
            for (int i = 0; i < 4; ++i) { o[2 * i] = bflo(a[i]) + bflo(bb[i]); o[2 * i + 1] = bfhi(a[i]) + bfhi(bb[i]); ss += o[2 * i] * o[2 * i] + o[2 * i + 1] * o[2 * i + 1]; }
            ss += dpp_mov<0xB1>(ss); ss += dpp_mov<0x4E>(ss); ss += dpp_mov<0x141>(ss); ss += dpp_mov<0x140>(ss);
            const float rs = rsqrtf(ss * (1.f / 128.f) + EPS);
            float y[8];
#pragma unroll
            for (int i = 0; i < 4; ++i) { y[2 * i] = o[2 * i] * rs * (i < 2 ? g0[2 * i] : g1[2 * i - 4]) * bflo(gg[i]); y[2 * i + 1] = o[2 * i + 1] * rs * (i < 2 ? g0[2 * i + 1] : g1[2 * i - 3]) * bfhi(gg[i]); }
            *(u32x4*)(MIXED + (size_t)m * D + 8 * lane) = (u32x4){pk2(y[0], y[1]), pk2(y[2], y[3]), pk2(y[4], y[5]), pk2(y[6], y[7])};
        }
    }
}

__device__ __forceinline__ float MAX3_(float a, float b, float c) { float r; asm("v_max3_f32 %0, %1, %2, %3" : "=v"(r) : "v"(a), "v"(b), "v"(c)); return r; }
__device__ __forceinline__ void phase_attn(const Params& p, LAS unsigned char* lds, int G) {
    const int tid = threadIdx.x, lane = tid & 63, wave = __builtin_amdgcn_readfirstlane(tid >> 6), fr = lane & 15, fq = lane >> 4;
    const bf16_t* PROJ = (const bf16_t*)(p.ws + WS_PROJ);
    const bf16_t* VT = (const bf16_t*)(p.ws + WS_VT);
    bf16_t* MIXED = (bf16_t*)(p.ws + WS_XN);
    const float* sm = (const float*)(p.ws + WS_SM);
    LAS unsigned char* LK = lds; LAS unsigned char* LV = lds + 64 * KT_STRIDE; LAS float* LB = (LAS float*)(lds + 2 * ATT_BUF);
    const float lam = sm[SM_LAM];
    float vinf = __builtin_inff(); asm volatile("" : "+v"(vinf));
    unsigned* qctr = (unsigned*)(p.ws + 32768);
    volatile LAS unsigned* qslot = (volatile LAS unsigned*)(lds + 131072 + 320 + 64);
    for (;;) {
        __syncthreads();
        if (tid == 0) qslot[0] = __hip_atomic_fetch_add(qctr, 1u, __ATOMIC_RELAXED, __HIP_MEMORY_SCOPE_AGENT);
        __syncthreads();
        const int item = (int)qslot[0];
        if (item >= 1024 + QUANT_ITEMS + MIX_ITEMS) break;
        if (item >= 1024 + QUANT_ITEMS) {
            if (tid == 0) { unsigned sp_ = 0; while (__hip_atomic_load((unsigned*)(p.ws + HG_DONE_OFF), __ATOMIC_RELAXED, __HIP_MEMORY_SCOPE_AGENT) < 128u && ++sp_ < (1u << 24)) __builtin_amdgcn_s_sleep(2);
                __builtin_amdgcn_fence(__ATOMIC_ACQUIRE, "agent"); asm volatile("s_waitcnt vmcnt(0)" ::: "memory"); }
            __syncthreads();
            mix_rows(p, (item - 1024 - QUANT_ITEMS) * NWAVES + wave, MIX_ITEMS * NWAVES, lane); continue;
        }
        if (item >= 1024) { quant_tables(p, (item - 1024) * NWAVES + wave, QUANT_ITEMS * NWAVES, lane); continue; }
        const int bh = item >> 4, qb = item & 15, b = bh >> 2, h = bh & 3;
        const int qabs = qb * 128 + wave * 16 + fr;
        const size_t qrow = (size_t)b * SEQ + qabs;
        __syncthreads();
        for (int i = tid; i < 257; i += NTHREADS) LB[i] = sm[SM_BT + h * BT_STRIDE + i];
        bf16x8 qf[2][2];
#pragma unroll
        for (int m = 0; m < 2; ++m)
#pragma unroll
            for (int kk = 0; kk < 2; ++kk) qf[m][kk] = *(const bf16x8*)(PROJ + qrow * PP + C_DQ + h * 128 + m * 64 + kk * 32 + fq * 8);
        float mrun[2] = {0.f, 0.f};
        f32x4 lacc[2] = {(f32x4){0.f, 0.f, 0.f, 0.f}, (f32x4){0.f, 0.f, 0.f, 0.f}};
        f32x4 o[2][8];
#pragma unroll
        for (int m = 0; m < 2; ++m)
#pragma unroll
            for (int dt = 0; dt < 8; ++dt) o[m][dt] = (f32x4){0.f, 0.f, 0.f, 0.f};
        u32x4 kreg[2], vreg[2];
        const bf16_t* kg[2]; const bf16_t* vg[2]; int koff[2], voff[2];
#pragma unroll
        for (int i = 0; i < 2; ++i) { const int c = tid + i * 512;
            const int kr = c >> 4, kc = (c & 15) * 8; kg[i] = PROJ + ((size_t)b * SEQ + kr) * PP + C_DK + h * 128 + kc; koff[i] = kr * KT_STRIDE + kc * 2;
            const int vr = c >> 3, vc = (c & 7) * 8; vg[i] = VT + (size_t)(h * 128 + vr) * T + (size_t)b * SEQ + vc; voff[i] = vr * VT_STRIDE + 64 * ((c & 7) >> 2) + 32 * (c & 1) + 8 * ((c & 3) >> 1); }
#pragma unroll
        for (int i = 0; i < 2; ++i) { kreg[i] = *(const u32x4*)kg[i]; vreg[i] = *(const u32x4*)vg[i]; }
#pragma unroll
        for (int i = 0; i < 2; ++i) { *(LAS u32x4*)(LK + koff[i]) = kreg[i]; *(LAS u32x2*)(LV + voff[i]) = (u32x2){vreg[i].x, vreg[i].y}; *(LAS u32x2*)(LV + voff[i] + 16) = (u32x2){vreg[i].z, vreg[i].w}; }
        __syncthreads();
        const int Qw = qb * 128 + wave * 16;
        for (int kt = 0; kt < SEQ / 64; ++kt) {
            const int pbuf = (kt & 1) * ATT_BUF;
            if (kt + 1 < SEQ / 64) {
#pragma unroll
                for (int i = 0; i < 2; ++i) { kreg[i] = *(const u32x4*)(kg[i] + (size_t)(kt + 1) * 64 * PP); vreg[i] = *(const u32x4*)(vg[i] + (kt + 1) * 64); }
            }
            const int k0 = kt * 64;
            const bool farl = (k0 + 63 - Qw) <= -91, farr = (k0 - (Qw + 15)) >= 91;
            const float binit = farl ? LB[0] : (farr ? LB[256] : 0.f);
            f32x4 s[2][4];
            {
                bf16x8 kf[16];
#define KF_LOAD(i_) kf[i_] = *(const LAS bf16x8*)(LK + pbuf + (16 * ((i_) & 3) + fr) * KT_STRIDE + ((((i_) >> 2) & 1) * 64 + ((i_) >> 3) * 32 + fq * 8) * 2)
#pragma unroll
                for (int i = 0; i < 6; ++i) KF_LOAD(i);
#pragma unroll
                for (int m = 0; m < 2; ++m) { const float ci = binit - mrun[m];
#pragma unroll
                    for (int ks = 0; ks < 4; ++ks) s[m][ks] = (f32x4){ci, ci, ci, ci}; }
                __builtin_amdgcn_sched_barrier(0);
#pragma unroll
                for (int i = 0; i < 16; ++i) {
                    s[(i >> 2) & 1][i & 3] = __builtin_amdgcn_mfma_f32_16x16x32_bf16(kf[i], qf[(i >> 2) & 1][i >> 3], s[(i >> 2) & 1][i & 3], 0, 0, 0);
                    if (i + 6 < 16) KF_LOAD(i + 6);
                    __builtin_amdgcn_sched_barrier(0);
                }
#undef KF_LOAD
            }
            if (!(farl || farr)) {
#pragma unroll
                for (int ks = 0; ks < 4; ++ks)
#pragma unroll
                    for (int r = 0; r < 4; ++r) {
                        int rel = k0 + 16 * ks + 4 * fq + r - qabs; rel = rel < -128 ? -128 : (rel > 128 ? 128 : rel);
                        const float bv = LB[rel + 128];
                        s[0][ks][r] += bv; s[1][ks][r] += bv;
                    }
            }
            bf16x8 pb[2][2];
#pragma unroll
            for (int m = 0; m < 2; ++m) {
                float mx = MAX3_(__builtin_amdgcn_fmed3f(s[m][0][0], s[m][1][0], vinf), __builtin_amdgcn_fmed3f(s[m][2][0], s[m][3][0], vinf), s[m][0][1]);
                mx = MAX3_(mx, s[m][0][2], s[m][0][3]); mx = MAX3_(mx, s[m][1][1], s[m][1][2]); mx = MAX3_(mx, s[m][1][3], s[m][2][1]);
                mx = MAX3_(mx, s[m][2][2], s[m][2][3]); mx = MAX3_(mx, s[m][3][1], s[m][3][2]); mx = MAX3_(mx, mx, s[m][3][3]);
                { float a_ = mx, b_ = mx; swap16_(a_, b_); mx = MAX3_(a_, b_, b_); }
                { float a_ = mx, b_ = mx; swap32_(a_, b_); mx = MAX3_(a_, b_, b_); }
                if (__any(fabsf(mx) > 8.0f)) {
                    const float dl = fabsf(mx) > 8.0f ? mx : 0.f, alpha = __builtin_amdgcn_exp2f(-dl);
                    mrun[m] += dl; lacc[m] *= alpha;
#pragma unroll
                    for (int ks = 0; ks < 4; ++ks) s[m][ks] = s[m][ks] - dl;
#pragma unroll
                    for (int dt = 0; dt < 8; ++dt) o[m][dt] *= alpha;
                }
#pragma unroll
                for (int ks = 0; ks < 4; ++ks)
#pragma unroll
                    for (int r = 0; r < 4; ++r) s[m][ks][r] = __builtin_amdgcn_exp2f(s[m][ks][r]);
#pragma unroll
                for (int k2 = 0; k2 < 2; ++k2) {
                    u32x4 w; w.x = pk2(s[m][2 * k2][0], s[m][2 * k2][1]); w.y = pk2(s[m][2 * k2][2], s[m][2 * k2][3]);
                    w.z = pk2(s[m][2 * k2 + 1][0], s[m][2 * k2 + 1][1]); w.w = pk2(s[m][2 * k2 + 1][2], s[m][2 * k2 + 1][3]);
                    pb[m][k2] = __builtin_bit_cast(bf16x8, w);
                }
            }
            const bf16x8 ones = __builtin_bit_cast(bf16x8, (u32x4){0x3F803F80u, 0x3F803F80u, 0x3F803F80u, 0x3F803F80u});
            bf16x8 vfa[8], vfb[8];
#pragma unroll
            for (int dt = 0; dt < 8; ++dt) vfa[dt] = *(const LAS bf16x8*)(LV + pbuf + (16 * dt + fr) * VT_STRIDE + (8 * fq) * 2);
            __builtin_amdgcn_sched_barrier(0);
            lacc[0] = __builtin_amdgcn_mfma_f32_16x16x32_bf16(ones, pb[0][0], lacc[0], 0, 0, 0);
            lacc[1] = __builtin_amdgcn_mfma_f32_16x16x32_bf16(ones, pb[1][0], lacc[1], 0, 0, 0);
#pragma unroll
            for (int dt = 0; dt < 8; ++dt) {
                o[0][dt] = __builtin_amdgcn_mfma_f32_16x16x32_bf16(vfa[dt], pb[0][0], o[0][dt], 0, 0, 0);
                o[1][dt] = __builtin_amdgcn_mfma_f32_16x16x32_bf16(vfa[dt], pb[1][0], o[1][dt], 0, 0, 0);
                vfb[dt] = *(const LAS bf16x8*)(LV + pbuf + (16 * dt + fr) * VT_STRIDE + (32 + 8 * fq) * 2);
            }
            __builtin_amdgcn_sched_barrier(0);
            lacc[0] = __builtin_amdgcn_mfma_f32_16x16x32_bf16(ones, pb[0][1], lacc[0], 0, 0, 0);
            lacc[1] = __builtin_amdgcn_mfma_f32_16x16x32_bf16(ones, pb[1][1], lacc[1], 0, 0, 0);
#pragma unroll
            for (int dt = 0; dt < 8; ++dt) {
                o[0][dt] = __builtin_amdgcn_mfma_f32_16x16x32_bf16(vfb[dt], pb[0][1], o[0][dt], 0, 0, 0);
                o[1][dt] = __builtin_amdgcn_mfma_f32_16x16x32_bf16(vfb[dt], pb[1][1], o[1][dt], 0, 0, 0);
            }
            if (kt + 1 < SEQ / 64) {
                const int nbuf = ((kt + 1) & 1) * ATT_BUF;
#pragma unroll
                for (int i = 0; i < 2; ++i) { *(LAS u32x4*)(LK + nbuf + koff[i]) = kreg[i]; *(LAS u32x2*)(LV + nbuf + voff[i]) = (u32x2){vreg[i].x, vreg[i].y}; *(LAS u32x2*)(LV + nbuf + voff[i] + 16) = (u32x2){vreg[i].z, vreg[i].w}; }
            }
            __syncthreads();
        }
        float inv[2];
#pragma unroll
        for (int m = 0; m < 2; ++m) inv[m] = __builtin_amdgcn_rcpf(lacc[m][0]);
        float ssq = 0.f;
#pragma unroll
        for (int dt = 0; dt < 8; ++dt)
#pragma unroll
            for (int r = 0; r < 4; ++r) { const float ov = o[0][dt][r] * inv[0] - lam * (o[1][dt][r] * inv[1]); o[0][dt][r] = ov; ssq += ov * ov; }
        ssq += __shfl_xor(ssq, 16); ssq += __shfl_xor(ssq, 32);
        const float rs = rsqrtf(ssq * (1.f / 128.f) + EPS) * 0.8f;
        const float* og = p.in[I_DOG];
#pragma unroll
        for (int dt = 0; dt < 8; ++dt) {
            const f32x4 g = *(const f32x4*)(og + 16 * dt + 4 * fq);
            const f32x4 y = o[0][dt] * rs * g;
            *(u32x2*)(MIXED + qrow * D + 512 + h * 128 + 16 * dt + 4 * fq) = (u32x2){pk2(y[0], y[1]), pk2(y[2], y[3])};
        }
    }
}

__device__ __forceinline__ void phase_hquant(const Params& p, int vcu, int G) {
    const int tid = threadIdx.x, lane = tid & 63, wave = __builtin_amdgcn_readfirstlane(tid >> 6);
    const bf16_t* H1B = (const bf16_t*)(p.ws + WS_H1B); const float* SS = (const float*)(p.ws + WS_SS);
    for (int t0 = vcu * NWAVES + wave; t0 < T; t0 += 4 * G * NWAVES) {
        u32x4 ha[4], hb[4];
#pragma unroll
        for (int u = 0; u < 4; ++u) { const int t = (t0 + u * G * NWAVES) < T ? (t0 + u * G * NWAVES) : t0; ha[u] = *(const u32x4*)(H1B + (size_t)t * D + 16 * lane); hb[u] = *(const u32x4*)(H1B + (size_t)t * D + 16 * lane + 8); }
#pragma unroll
        for (int u = 0; u < 4; ++u) {
            const int t = t0 + u * G * NWAVES; if (t >= T) break;
            const u32x4 h0 = ha[u], h1 = hb[u];
            float hf[16]; float am = 0.f;
#pragma unroll
            for (int k = 0; k < 4; ++k) { hf[2 * k] = bflo(h0[k]); hf[2 * k + 1] = bfhi(h0[k]); hf[8 + 2 * k] = bflo(h1[k]); hf[8 + 2 * k + 1] = bfhi(h1[k]); }
#pragma unroll
            for (int k = 0; k < 16; ++k) am = fmaxf(am, fabsf(hf[k]));
            am = wave_max(am);
            const float iv = am > 0.f ? 127.f / am : 0.f;
            u32x4 q;
#pragma unroll
            for (int w = 0; w < 4; ++w) { const int q0 = (int)rintf(hf[4 * w] * iv), q1 = (int)rintf(hf[4 * w + 1] * iv), q2 = (int)rintf(hf[4 * w + 2] * iv), q3 = (int)rintf(hf[4 * w + 3] * iv);
                q[w] = (unsigned)((q0 & 0xFF) | ((q1 & 0xFF) << 8) | ((q2 & 0xFF) << 16) | ((q3 & 0xFF) << 24)); }
            unsigned yh[4], yl[4];
#pragma unroll
            for (int w = 0; w < 4; ++w) { const unsigned xh = (q[w] >> 4) & 0x0F0F0F0Fu, xl = (q[w] & 0x0F0F0F0Fu) ^ 0x08080808u; yh[w] = xh | (xh >> 4); yl[w] = xl | (xl >> 4); }
            const u32x2 ph = {__builtin_amdgcn_perm(yh[1], yh[0], 0x06040200u), __builtin_amdgcn_perm(yh[3], yh[2], 0x06040200u)}, pl = {__builtin_amdgcn_perm(yl[1], yl[0], 0x06040200u), __builtin_amdgcn_perm(yl[3], yl[2], 0x06040200u)};
            unsigned char* hrow = p.ws + WS_H1Q + (size_t)t * D + (lane >> 4) * 256 + 8 * (lane & 15);
            *(u32x2*)hrow = ph; *(u32x2*)(hrow + 128) = pl;
            if (lane == 0) ((float*)(p.ws + WS_HSC))[t] = am * (1.f / 127.f) * row_rstd(SS, (size_t)t);
        }
    }
}
__device__ __forceinline__ unsigned ford(float f) { const unsigned u = __float_as_uint(f); return (u & 0x80000000u) ? ~u : (u | 0x80000000u); }
__device__ __forceinline__ float funord(unsigned u) { u = (u & 0x80000000u) ? (u & 0x7fffffffu) : ~u; return __uint_as_float(u); }
__device__ __forceinline__ unsigned kmax_(unsigned a, unsigned b) { unsigned r; asm("v_max_f32 %0, %1, %2" : "=v"(r) : "v"(a), "v"(b)); return r; }
__device__ __forceinline__ unsigned kmin_(unsigned a, unsigned b) { unsigned r; asm("v_min_f32 %0, %1, %2" : "=v"(r) : "v"(a), "v"(b)); return r; }
template <int N> __device__ __forceinline__ void bitonic_sort_desc(unsigned (&v)[N]) {
#pragma unroll
    for (int k = 2; k <= N; k <<= 1)
#pragma unroll
        for (int j = k >> 1; j > 0; j >>= 1)
#pragma unroll
            for (int i = 0; i < N; ++i) { const int l = i ^ j;
                if (l > i) { const unsigned a = v[i], b = v[l]; const unsigned mx = kmax_(a, b), mn = kmin_(a, b); if ((i & k) == 0) { v[i] = mx; v[l] = mn; } else { v[i] = mn; v[l] = mx; } } }
}
__device__ __forceinline__ void merge_top16(unsigned (&a)[16], const unsigned (&b)[16]) {
#pragma unroll
    for (int i = 0; i < 16; ++i) a[i] = kmax_(a[i], b[15 - i]);
#pragma unroll
    for (int j = 8; j > 0; j >>= 1)
#pragma unroll
        for (int i = 0; i < 16; ++i) { const int l = i ^ j; if (l > i) { const unsigned x = a[i], y = a[l]; a[i] = kmax_(x, y); a[l] = kmin_(x, y); } }
}
__device__ __forceinline__ void sort16_desc(unsigned (&v)[16]) {
#define CE_(a_, b_) { const unsigned x_ = v[a_], y_ = v[b_]; v[a_] = kmax_(x_, y_); v[b_] = kmin_(x_, y_); }
    CE_(0, 13) CE_(1, 12) CE_(2, 15) CE_(3, 14) CE_(4, 8) CE_(5, 6) CE_(7, 11) CE_(9, 10) CE_(0, 5) CE_(1, 7) CE_(2, 9) CE_(3, 4) CE_(6, 13) CE_(8, 14) CE_(10, 15) CE_(11, 12) CE_(0, 1) CE_(2, 3) CE_(4, 5) CE_(6, 8) CE_(7, 9) CE_(10, 11) CE_(12, 13) CE_(14, 15) CE_(0, 2) CE_(1, 3) CE_(4, 10) CE_(5, 11) CE_(6, 7) CE_(8, 9) CE_(12, 14) CE_(13, 15) CE_(1, 2) CE_(3, 12) CE_(4, 6) CE_(5, 7) CE_(8, 10) CE_(9, 11) CE_(13, 14) CE_(1, 4) CE_(2, 6) CE_(5, 8) CE_(7, 10) CE_(9, 13) CE_(11, 14) CE_(2, 4) CE_(3, 6) CE_(9, 12) CE_(11, 13) CE_(3, 5) CE_(6, 8) CE_(7, 9) CE_(10, 12) CE_(3, 4) CE_(5, 6) CE_(7, 8) CE_(9, 10) CE_(11, 12) CE_(6, 7) CE_(8, 9)
#undef CE_
}
__device__ __forceinline__ void bitonic_merge16(unsigned (&a)[16]) {
#pragma unroll
    for (int j = 8; j > 0; j >>= 1)
#pragma unroll
        for (int i = 0; i < 16; ++i) { const int l = i ^ j; if (l > i) { const unsigned x = a[i], y = a[l]; a[i] = kmax_(x, y); a[l] = kmin_(x, y); } }
}
__device__ __forceinline__ void top16_of64(const unsigned (&v)[64], unsigned (&out)[16]) {
    unsigned g1[16], g2[16], g3[16];
#pragma unroll
    for (int i = 0; i < 16; ++i) { out[i] = v[i]; g1[i] = v[16 + i]; g2[i] = v[32 + i]; g3[i] = v[48 + i]; }
    sort16_desc(out); sort16_desc(g1); sort16_desc(g2); sort16_desc(g3);
    merge_top16(out, g1); merge_top16(g2, g3); merge_top16(out, g2);
}
__device__ __forceinline__ unsigned xchg32u(unsigned v, int lane) { return __builtin_bit_cast(unsigned, xchg32(__builtin_bit_cast(float, v), lane)); }
constexpr int TK_KROW = 272, TK_TAB = 256 * TK_KROW;
__device__ __forceinline__ void phase_topk(const Params& p, LAS unsigned char* lds, int vcu, int G) {
    const int tid = threadIdx.x, lane = tid & 63, wave = __builtin_amdgcn_readfirstlane(tid >> 6), r32 = lane & 31, hi = lane >> 5;
    const bf16_t* QP = (const bf16_t*)(p.ws + WS_QP);
    const bf16_t* KEYS = (const bf16_t*)(p.ws + WS_KEYS);
    int* IDX = (int*)(p.ws + WS_IDX);
    LAS unsigned* tab = (LAS unsigned*)(lds + TK_TAB) + wave * 8 * 64 + lane;
    for (int item = blockIdx.x; item < (T / 256) * 2; item += G) {
        const int tg = item % (T / 256), hg = item / (T / 256);
        const size_t tok = (size_t)(tg * 8 + wave) * 32 + r32;
        for (int hh = 0; hh < 4; ++hh) {
            const int h = hg * 4 + hh;
            bf16x8 bqa[2][8];
#pragma unroll
            for (int pp = 0; pp < 2; ++pp)
#pragma unroll
                for (int s2 = 0; s2 < 8; ++s2) bqa[pp][s2] = __builtin_nontemporal_load((const bf16x8*)(QP + tok * QPS + h * 256 + pp * 128 + 8 * hi + 16 * s2));
            __syncthreads();
#pragma unroll
            for (int c8 = 0; c8 < 8; ++c8) { const int c = tid + c8 * NTHREADS, row = c >> 4, ch = c & 15;
                *(LAS u32x4*)(lds + row * TK_KROW + ch * 16) = *(const u32x4*)(KEYS + (size_t)(h * 256 + row) * 128 + ch * 8); }
            __syncthreads();
            unsigned lst[2][16];
#pragma unroll
            for (int pp = 0; pp < 2; ++pp) {
                f32x16 acc[4];
#pragma unroll
                for (int kt = 0; kt < 4; ++kt)
#pragma unroll
                    for (int r = 0; r < 16; ++r) acc[kt][r] = 0.f;
                const LAS unsigned char* kb = lds + (pp * 128 + r32) * TK_KROW + 16 * hi;
                {
                    bf16x8 akf[32];
#define AK_LOAD(i_) akf[i_] = *(const LAS bf16x8*)(kb + ((i_) & 3) * 32 * TK_KROW + 32 * ((i_) >> 2))
#pragma unroll
                    for (int i = 0; i < 8; ++i) AK_LOAD(i);
                    __builtin_amdgcn_sched_barrier(0);
#pragma unroll
                    for (int i = 0; i < 32; ++i) {
                        acc[i & 3] = __builtin_amdgcn_mfma_f32_32x32x16_bf16(akf[i], bqa[pp][i >> 2], acc[i & 3], 0, 0, 0);
                        if (i + 8 < 32) AK_LOAD(i + 8);
                        __builtin_amdgcn_sched_barrier(0);
                    }
#undef AK_LOAD
                }
                unsigned v[64];
#pragma unroll
                for (int kt = 0; kt < 4; ++kt)
#pragma unroll
                    for (int r = 0; r < 16; ++r) { const int n = 32 * kt + (r & 3) + 8 * (r >> 2) + 4 * hi; v[kt * 16 + r] = (__float_as_uint(acc[kt][r]) & ~0x7Fu) | (unsigned)(127 - n); }
                unsigned own[16];
                top16_of64(v, own);
#pragma unroll
                for (int j = 0; j < 16; ++j) lst[pp][j] = own[j];
            }
            {
                unsigned fin[16], par[16];
#pragma unroll
                for (int j = 0; j < 16; ++j) { int a_ = (int)lst[0][j], b_ = (int)lst[1][j]; swap32i_(a_, b_); fin[j] = (unsigned)a_; par[j] = (unsigned)b_; }
                merge_top16(fin, par);
#pragma unroll
                for (int j = 0; j < 16; ++j) { int x_ = (int)fin[j], y_ = (int)fin[j]; swap32i_(x_, y_); lst[0][j] = (unsigned)x_; lst[1][j] = (unsigned)y_; }
            }
            float a[16], bs[16];
#pragma unroll
            for (int j = 0; j < 16; ++j) { a[j] = __uint_as_float(lst[0][j] & ~0x7Fu); bs[j] = __uint_as_float(lst[1][j] & ~0x7Fu); }
#pragma unroll
            for (int m = 0; m < 4; ++m) {
                tab[m * 64] = (127u - (lst[0][4 * m] & 0x7Fu)) | ((127u - (lst[0][4 * m + 1] & 0x7Fu)) << 8) | ((127u - (lst[0][4 * m + 2] & 0x7Fu)) << 16) | ((127u - (lst[0][4 * m + 3] & 0x7Fu)) << 24);
                tab[(4 + m) * 64] = (127u - (lst[1][4 * m] & 0x7Fu)) | ((127u - (lst[1][4 * m + 1] & 0x7Fu)) << 8) | ((127u - (lst[1][4 * m + 2] & 0x7Fu)) << 16) | ((127u - (lst[1][4 * m + 3] & 0x7Fu)) << 24);
            }
            unsigned cand[50];
            {
                int c = 0;
#pragma unroll
                for (int i = 0; i < 16; ++i)
#pragma unroll
                    for (int j = 0; j < 16; ++j)
                        if ((i + 1) * (j + 1) <= 16) { cand[c] = (__float_as_uint(a[i] + bs[j]) & ~0xFFu) | (unsigned)(255 - (i * 16 + j)); ++c; }
            }
            unsigned best[16], m1[16], r2[16], eidx[16];
#pragma unroll
            for (int i = 0; i < 16; ++i) { best[i] = cand[i]; r2[i] = cand[24 + i]; }
#pragma unroll
            for (int i = 0; i < 8; ++i) { m1[i] = cand[16 + i]; m1[8 + i] = cand[49 - i]; }
            bitonic_merge16(m1); sort16_desc(r2);
            merge_top16(best, m1); merge_top16(best, r2);
            const unsigned e_hi = cand[40], e_lo = cand[41];
            const unsigned top_ = kmax_(best[0], e_hi);
            best[15] = kmax_(best[15], e_hi); best[14] = kmax_(best[14], e_lo);
            LDS_WAIT();
#pragma unroll
            for (int r = 0; r < 16; ++r) { const unsigned code = 255u - (best[r] & 0xFFu), ci = code >> 4, cj = code & 15u;
                const unsigned wi = tab[(ci >> 2) * 64], wj = tab[(4 + (cj >> 2)) * 64];
                eidx[r] = ((wi >> (8 * (ci & 3u))) & 0x7Fu) * 128u + ((wj >> (8 * (cj & 3u))) & 0x7Fu); }
            LDS_WAIT();
            if (hi == 0) {
                float g[16]; const float mx = __uint_as_float(top_ & ~0xFFu); float tot = 0.f;
#pragma unroll
                for (int r = 0; r < 16; ++r) { g[r] = __expf(__uint_as_float(best[r] & ~0xFFu) - mx); tot += g[r]; }
                const float it_ = 1.f / tot;
                unsigned* rp = (unsigned*)IDX + (tok * 8 + h) * 16;
#pragma unroll
                for (int q4 = 0; q4 < 4; ++q4)
                    *(u32x4*)(rp + 4 * q4) = (u32x4){eidx[4 * q4] | (f2bf(g[4 * q4] * it_) << 16), eidx[4 * q4 + 1] | (f2bf(g[4 * q4 + 1] * it_) << 16), eidx[4 * q4 + 2] | (f2bf(g[4 * q4 + 2] * it_) << 16), eidx[4 * q4 + 3] | (f2bf(g[4 * q4 + 3] * it_) << 16)};
            }
        }
    }
}

typedef float f32x2_ __attribute__((ext_vector_type(2)));
__device__ __forceinline__ float gelu_exact(float v) {
    const float av = fabsf(v), t = __builtin_amdgcn_rcpf(av * 0.2316418882f + 1.0f);
    float q = t * 0.5307027145f + (-0.7265760135f); q = q * t + 0.7107068705f; q = q * t + (-0.142248368f); q = q * t + 0.127414796f; q = q * t;
    const float e = __builtin_amdgcn_exp2f((v * v) * (-0.72134752044f));
    const float m = v * (q * e);
    return v < 0.f ? m : v - m;
}
__device__ __forceinline__ int dot8z_(unsigned a, unsigned b) { int r; asm("v_dot8_i32_i4 %0, %1, %2, 0" : "=v"(r) : "v"(a), "v"(b)); return r; }
__device__ __forceinline__ int dot4z_(unsigned a, int b) { int r; asm("v_dot4_i32_i8 %0, %1, %2, 0" : "=v"(r) : "v"(a), "v"(b)); return r; }
__device__ __forceinline__ void phase_peer_u(const Params& p, LAS unsigned char* lds, int G, int mx, int mj) {
    const int tid = threadIdx.x, lane = tid & 63, wave = __builtin_amdgcn_readfirstlane(tid >> 6), bx = blockIdx.x;
    const bool xl = (G % 8 == 0);
    const int x = xl ? (mx & 3) : 0, nx = xl ? 4 : 1, jb = xl ? (mx >> 2) * (G / 8) + mj : bx, nw = (xl ? G / 4 : G) * NWAVES, widx = jb * NWAVES + wave;
    const unsigned char* UQ = (const unsigned char*)(p.ws + WS_UT); const unsigned char* H1Q = (const unsigned char*)(p.ws + WS_H1Q);
    const unsigned* REC = (const unsigned*)(p.ws + WS_IDX); unsigned* PART = (unsigned*)(p.ws + WS_PART);
    const int sub = lane & 7, es = lane >> 3;
    const int K = (T - widx + nw - 1) / nw, NB4 = (K + 3) / 4;
    LAS unsigned* RL = (LAS unsigned*)(lds + wave * 4096);
    for (int s = x; s < 4; s += nx) {
        const unsigned char* UQs = UQ + (size_t)s * 16384 * 128; const unsigned sub16 = 16u * (unsigned)sub;
#define UK_TOK(k_) ((size_t)(widx + nw * ((k_) < K ? (k_) : K - 1)))
#define UK_RQLOAD(blk_) { _Pragma("unroll") for (int j = 0; j < 4; ++j) rq[j] = *(const u32x2*)(REC + UK_TOK(4 * (blk_) + j) * 128 + 2 * lane); }
#define UK_RQSTORE(blk_) { _Pragma("unroll") for (int j = 0; j < 4; ++j) *(LAS u32x2*)(RL + (((blk_) & 1) * 4 + j) * 128 + 2 * lane) = (u32x2){(rq[j].x & 0x3FFFu) << 7, (rq[j].y & 0x3FFFu) << 7}; }
#define UK_REC(blkpar_, j_, hf_, i_) RL[((blkpar_) * 4 + (j_)) * 128 + 64 * (hf_) + 8 * (i_) + es]
#define UK_GATHER8(vb, hf_) { _Pragma("unroll") for (int i = 0; i < 8; ++i) vb[i] = *(const u32x4*)(UQs + (rg[8 * (hf_) + i] + sub16)); }
#define UK_PREP(blkpar_, j_, sl_, k_) { const unsigned char* hp_ = H1Q + UK_TOK(k_) * D + s * 256 + 16 * sub; hh[sl_] = *(const u32x4*)hp_; hl[sl_] = *(const u32x4*)(hp_ + 128); \
            _Pragma("unroll") for (int i = 0; i < 16; ++i) rg[i] = UK_REC(blkpar_, j_, (i >> 3), (i & 7)); }
#define UK_ACC8(vb, sl_, hf_) { _Pragma("unroll") for (int i = 0; i < 8; ++i) { int a_ = dot8z_(vb[i][0], hh[sl_][0]); \
                _Pragma("unroll") for (int w = 1; w < 4; ++w) a_ = __builtin_amdgcn_sdot8((int)vb[i][w], (int)hh[sl_][w], a_, false); \
                a_ <<= 4;                                     \
                _Pragma("unroll") for (int w = 0; w < 4; ++w) a_ = __builtin_amdgcn_sdot8((int)vb[i][w], (int)hl[sl_][w], a_, false); \
                acc[8 * (hf_) + i] = a_; } }
#define UK_FIN(k_, sl_) { int r8[8], r4[4], r2[2]; \
            { const bool bt = lane & 1; _Pragma("unroll") for (int q = 0; q < 8; ++q) { const int keep = bt ? acc[q + 8] : acc[q], send = bt ? acc[q] : acc[q + 8]; r8[q] = keep + __builtin_amdgcn_update_dpp(0, send, 0xB1, 0xF, 0xF, false); } } \
            { const bool bt = lane & 2; _Pragma("unroll") for (int q = 0; q < 4; ++q) { const int keep = bt ? r8[q + 4] : r8[q], send = bt ? r8[q] : r8[q + 4]; r4[q] = keep + __builtin_amdgcn_update_dpp(0, send, 0x4E, 0xF, 0xF, false); } } \
            { const bool bt = lane & 4; _Pragma("unroll") for (int q = 0; q < 2; ++q) { const int keep = bt ? r4[q + 2] : r4[q], send = bt ? r4[q] : r4[q + 2]; \
                int x_ = __builtin_amdgcn_update_dpp(0, send, 0x104, 0xF, 0x5, false); x_ = __builtin_amdgcn_update_dpp(x_, send, 0x114, 0xF, 0xA, false); r2[q] = keep + x_; } }     \
              \
            if ((k_) < K) PART[((size_t)s * T + (size_t)(widx + nw * (k_))) * 64 + lane] = (unsigned)(((r2[0] + 4) >> 3) & 0xFFFF) | ((unsigned)((r2[1] + 4) >> 3) << 16); }
#define UK_STEP(vb, B_, j_, hf_) { UK_ACC8(vb, ((j_) & 3), hf_) if ((hf_) == 1) UK_FIN(4 * (B_) + (j_), ((j_) & 3)) \
            if ((hf_) == 0) UK_PREP((((j_) + 2) < 4) ? ((B_) & 1) : (((B_) + 1) & 1), (((j_) + 2) & 3), (((j_) + 2) & 3), 4 * (B_) + (j_) + 2) \
            UK_GATHER8(vb, hf_) }
        u32x2 rq[4]; u32x4 v0[8], v1[8], v2[8], v3[8]; int acc[16]; u32x4 hh[4], hl[4]; unsigned rg[16];
#pragma unroll
        for (int q = 0; q < 16; ++q) acc[q] = 0;
        __syncthreads();
        UK_RQLOAD(0) UK_RQSTORE(0) UK_RQLOAD(1) UK_RQSTORE(1)
        LDS_WAIT();
        UK_PREP(0, 0, 0, 0) UK_GATHER8(v0, 0) UK_GATHER8(v1, 1)
        UK_PREP(0, 1, 1, 1) UK_GATHER8(v2, 0) UK_GATHER8(v3, 1)
        for (int B = 0; B < NB4; ++B) {
            if (B > 0) { UK_RQSTORE(B + 1) LDS_WAIT(); }
            UK_STEP(v0, B, 0, 0) UK_STEP(v1, B, 0, 1)
            UK_STEP(v2, B, 1, 0) UK_STEP(v3, B, 1, 1)
            UK_RQLOAD(B + 2)
            UK_STEP(v0, B, 2, 0) UK_STEP(v1, B, 2, 1)
            UK_STEP(v2, B, 3, 0) UK_STEP(v3, B, 3, 1)
        }
    }
    __syncthreads();
}
__device__ __forceinline__ void phase_peer_c(const Params& p, int vcu, int G) {
    const int tid = threadIdx.x, lane = tid & 63, wave = __builtin_amdgcn_readfirstlane(tid >> 6);
    const unsigned* REC = (const unsigned*)(p.ws + WS_IDX); const unsigned* PART = (const unsigned*)(p.ws + WS_PART); const float* HSC = (const float*)(p.ws + WS_HSC);
    const f32x4* UEX = (const f32x4*)(p.ws + WS_UEX); unsigned* OFFS = (unsigned*)(p.ws + WS_C); unsigned char* CQ = p.ws + WS_CQ; float* CS = (float*)(p.ws + WS_CS);
    const int sub = lane & 7, es = lane >> 3, g0 = 8 * (sub & 1) + 4 * ((sub >> 1) & 1) + 2 * (sub >> 2), r0 = 8 * g0 + es;
    for (int t0 = vcu * NWAVES + wave; t0 < T; t0 += 2 * G * NWAVES) {
        unsigned pa[2][4]; unsigned ra[2][2]; float hs[2];
#pragma unroll
        for (int u = 0; u < 2; ++u) { const int t = (t0 + u * G * NWAVES) < T ? (t0 + u * G * NWAVES) : t0;
#pragma unroll
            for (int s = 0; s < 4; ++s) pa[u][s] = PART[((size_t)s * T + t) * 64 + lane];
            ra[u][0] = REC[(size_t)t * 128 + r0]; ra[u][1] = REC[(size_t)t * 128 + r0 + 8]; hs[u] = HSC[t]; }
#pragma unroll
        for (int u = 0; u < 2; ++u) { const int t = t0 + u * G * NWAVES; if (t >= T) break;
            float c[2]; unsigned e[2];
#pragma unroll
            for (int j = 0; j < 2; ++j) { const unsigned rec = ra[u][j]; e[j] = rec & 0x3FFFu; const f32x4 m = UEX[e[j]];
                const int tot = 8 * (j ? (((int)pa[u][0] >> 16) + ((int)pa[u][1] >> 16)) + (((int)pa[u][2] >> 16) + ((int)pa[u][3] >> 16))
                                       : ((int)(short)pa[u][0] + (int)(short)pa[u][1]) + ((int)(short)pa[u][2] + (int)(short)pa[u][3]));
                c[j] = __uint_as_float(rec & 0xffff0000u) * gelu_exact(((float)tot + m.z) * m.x * hs[u]) * m.y; }
            const float am = wave_max(fmaxf(fabsf(c[0]), fabsf(c[1]))), iv = am > 0.f ? 127.f * __builtin_amdgcn_rcpf(am) : 0.f;
            unsigned w = __builtin_amdgcn_cvt_pk_u8_f32(__builtin_fmaf(c[0], iv, 128.f), 0, 0u); w = __builtin_amdgcn_cvt_pk_u8_f32(__builtin_fmaf(c[1], iv, 128.f), 1, w); w ^= 0x8080u;
            const float csum = wave_sum((float)((int)(signed char)(w & 0xFFu) + (int)(signed char)(w >> 8)));
            OFFS[(size_t)t * 128 + r0] = e[0] << 7; OFFS[(size_t)t * 128 + r0 + 8] = e[1] << 7;
            *(unsigned short*)(CQ + (size_t)t * 128 + es * 16 + (g0 >> 2) * 4 + (g0 & 3)) = (unsigned short)w;
            if (lane == 0) *(f32x2_*)(CS + 2 * (size_t)t) = (f32x2_){am * (1.f / 127.f), -8.f * csum};
        }
    }
}
__device__ __forceinline__ void phase_peer_v(const Params& p, LAS unsigned char* lds, int G, int mx, int mj) {
    const int tid = threadIdx.x, lane = tid & 63, wave = __builtin_amdgcn_readfirstlane(tid >> 6), bx = blockIdx.x;
    const bool xl = (G % 8 == 0);
    const int x = xl ? (mx & 3) : 0, nx = xl ? 4 : 1, jb = xl ? (mx >> 2) * (G / 8) + mj : bx, nw = (xl ? G / 4 : G) * NWAVES, widx = jb * NWAVES + wave;
    const unsigned char* VQ = (const unsigned char*)(p.ws + WS_VE);
    const unsigned* CI = (const unsigned*)(p.ws + WS_C); const unsigned char* CQ = p.ws + WS_CQ; const float* CS = (const float*)(p.ws + WS_CS);
    bf16_t* H1B = (bf16_t*)(p.ws + WS_H1B);
    const int sub = lane & 7, es = lane >> 3;
    const int K = (T - widx + nw - 1) / nw, NB4 = (K + 3) / 4;
    LAS unsigned* RL = (LAS unsigned*)(lds + wave * 4096);
    for (int s = x; s < NVS; s += nx) {
        const unsigned char* VQs = VQ + (size_t)s * 16384 * VSL; const unsigned sub16 = 16u * (unsigned)sub;
#define PV_TOK(k_) ((size_t)(widx + nw * ((k_) < K ? (k_) : K - 1)))
#define PV_RQLOAD(blk_) { _Pragma("unroll") for (int j = 0; j < 4; ++j) rq[j] = *(const u32x2*)(CI + PV_TOK(4 * (blk_) + j) * 128 + 2 * lane); }
#define PV_RQSTORE(blk_) { _Pragma("unroll") for (int j = 0; j < 4; ++j) *(LAS u32x2*)(RL + (((blk_) & 1) * 4 + j) * 128 + 2 * lane) = rq[j]; }
#define PV_REC(blkpar_, j_, hf_, i_) RL[((blkpar_) * 4 + (j_)) * 128 + 64 * (hf_) + 8 * (i_) + es]
#define PV_GATHER8(vb, rg_, hf_) { _Pragma("unroll") for (int i = 0; i < 8; ++i) vb[i] = *(const u32x4*)(VQs + (rg_[8 * (hf_) + i] + sub16)); }
#define PV_PREP(blkpar_, j_, sl_, k_) { hvs[sl_] = *(const u32x2*)(H1B + PV_TOK(k_) * D + hoff); \
            _Pragma("unroll") for (int i = 0; i < 16; ++i) rg[i] = PV_REC(blkpar_, j_, (i >> 3), (i & 7)); \
            { const u32x4 cw_ = *(const u32x4*)(CQ + PV_TOK(k_) * 128 + es * 16); cqs[sl_][0] = (int)cw_.x; cqs[sl_][1] = (int)cw_.y; cqs[sl_][2] = (int)cw_.z; cqs[sl_][3] = (int)cw_.w; } \
            { const f32x2_ cs_ = *(const f32x2_*)(CS + 2 * PV_TOK(k_)); csc[sl_] = cs_.x; cto[sl_] = cs_.y; } }
#define PV_T4(r0, r1, r2, r3, w, cqw, Z) { const unsigned x0_ = __builtin_amdgcn_perm(r1[w], r0[w], 0x05010400u), x1_ = __builtin_amdgcn_perm(r1[w], r0[w], 0x07030602u), \
                y0_ = __builtin_amdgcn_perm(r3[w], r2[w], 0x05010400u), y1_ = __builtin_amdgcn_perm(r3[w], r2[w], 0x07030602u); \
            const unsigned t0_ = __builtin_amdgcn_perm(y0_, x0_, 0x05040100u), t1_ = __builtin_amdgcn_perm(y0_, x0_, 0x07060302u), t2_ = __builtin_amdgcn_perm(y1_, x1_, 0x05040100u), t3_ = __builtin_amdgcn_perm(y1_, x1_, 0x07060302u); \
            acci[8 * (w)] = (Z) ? dot4z_((unsigned)((int)(t0_ & 0x0F0F0F0Fu)), cqw) : __builtin_amdgcn_sdot4((int)(t0_ & 0x0F0F0F0Fu), cqw, acci[8 * (w)], false); acci[8 * (w) + 1] = (Z) ? dot4z_((unsigned)((int)t0_), cqw) : __builtin_amdgcn_sdot4((int)t0_, cqw, acci[8 * (w) + 1], false); \
            acci[8 * (w) + 2] = (Z) ? dot4z_((unsigned)((int)(t1_ & 0x0F0F0F0Fu)), cqw) : __builtin_amdgcn_sdot4((int)(t1_ & 0x0F0F0F0Fu), cqw, acci[8 * (w) + 2], false); acci[8 * (w) + 3] = (Z) ? dot4z_((unsigned)((int)t1_), cqw) : __builtin_amdgcn_sdot4((int)t1_, cqw, acci[8 * (w) + 3], false); \
            acci[8 * (w) + 4] = (Z) ? dot4z_((unsigned)((int)(t2_ & 0x0F0F0F0Fu)), cqw) : __builtin_amdgcn_sdot4((int)(t2_ & 0x0F0F0F0Fu), cqw, acci[8 * (w) + 4], false); acci[8 * (w) + 5] = (Z) ? dot4z_((unsigned)((int)t2_), cqw) : __builtin_amdgcn_sdot4((int)t2_, cqw, acci[8 * (w) + 5], false); \
            acci[8 * (w) + 6] = (Z) ? dot4z_((unsigned)((int)(t3_ & 0x0F0F0F0Fu)), cqw) : __builtin_amdgcn_sdot4((int)(t3_ & 0x0F0F0F0Fu), cqw, acci[8 * (w) + 6], false); acci[8 * (w) + 7] = (Z) ? dot4z_((unsigned)((int)t3_), cqw) : __builtin_amdgcn_sdot4((int)t3_, cqw, acci[8 * (w) + 7], false); }
#define PV_ACC8(vb, sl_, hf_) { _Pragma("unroll") for (int w = 0; w < 4; ++w) { PV_T4(vb[0], vb[1], vb[2], vb[3], w, cqs[sl_][2 * (hf_)], (hf_) == 0) PV_T4(vb[4], vb[5], vb[6], vb[7], w, cqs[sl_][2 * (hf_) + 1], false) } }
#define PV_FIN(k_, sl_) { int r16[16], r8[8], r4[4]; \
            { const bool bt = lane & 8; _Pragma("unroll") for (int q = 0; q < 16; ++q) { const int keep = bt ? acci[q + 16] : acci[q], send = bt ? acci[q] : acci[q + 16]; r16[q] = keep + __builtin_amdgcn_update_dpp(0, send, 0x128, 0xF, 0xF, false); } } \
            _Pragma("unroll") for (int q = 0; q < 8; ++q) { int a_ = r16[q], b_ = r16[q + 8]; swap16i_(a_, b_); r8[q] = a_ + b_; } \
            _Pragma("unroll") for (int q = 0; q < 4; ++q) { int a_ = r8[q], b_ = r8[q + 4]; swap32i_(a_, b_); r4[q] = a_ + b_; } \
            if ((k_) < K) { const u32x2 hw = hvs[sl_]; const float sc_ = csc[sl_], sh_ = sc_ * (1.f / 16.f), co_ = cto[sl_]; \
                *(u32x2*)(H1B + (size_t)(widx + nw * (k_)) * D + hoff) = (u32x2){pk2(bflo(hw.x) + ((float)r4[0] + co_) * sc_, bfhi(hw.x) + (float)(r4[1] - r4[0]) * sh_), pk2(bflo(hw.y) + ((float)r4[2] + co_) * sc_, bfhi(hw.y) + (float)(r4[3] - r4[2]) * sh_)}; } }
#define PV_STEP(vb, B_, j_, hf_) { PV_ACC8(vb, ((j_) & 3), hf_) if ((hf_) == 1) PV_FIN(4 * (B_) + (j_), ((j_) & 3)) \
            if ((hf_) == 0) PV_PREP((((j_) + 2) < 4) ? ((B_) & 1) : (((B_) + 1) & 1), (((j_) + 2) & 3), (((j_) + 2) & 3), 4 * (B_) + (j_) + 2) \
            PV_GATHER8(vb, rg, hf_) }
        u32x2 rq[4]; u32x4 v0[8], v1[8], v2[8], v3[8]; int acci[32]; int cqs[4][4]; float csc[4], cto[4]; unsigned rg[16]; u32x2 hvs[4];
        const int hoff = s * 256 + 32 * sub + 16 * (es & 1) + 8 * ((es >> 1) & 1) + 4 * (es >> 2);
#pragma unroll
        for (int q = 0; q < 32; ++q) acci[q] = 0;
        PV_RQLOAD(0) PV_RQSTORE(0) PV_RQLOAD(1) PV_RQSTORE(1)
        LDS_WAIT();
        PV_PREP(0, 0, 0, 0) PV_GATHER8(v0, rg, 0) PV_GATHER8(v1, rg, 1)
        PV_PREP(0, 1, 1, 1) PV_GATHER8(v2, rg, 0) PV_GATHER8(v3, rg, 1)
        for (int B = 0; B < NB4; ++B) {
            if (B > 0) { PV_RQSTORE(B + 1) LDS_WAIT(); }
            PV_STEP(v0, B, 0, 0) PV_STEP(v1, B, 0, 1)
            PV_STEP(v2, B, 1, 0) PV_STEP(v3, B, 1, 1)
            PV_RQLOAD(B + 2)
            PV_STEP(v0, B, 2, 0) PV_STEP(v1, B, 2, 1)
            PV_STEP(v2, B, 3, 0) PV_STEP(v3, B, 3, 1)
        }
    }
}
__device__ __forceinline__ void phase_final(const Params& p, int vcu, int G) {
    const int tid = threadIdx.x, lane = tid & 63, wave = __builtin_amdgcn_readfirstlane(tid >> 6);
    const bf16_t* H2B = (const bf16_t*)(p.ws + WS_H1B); float* Y = p.out; const float* fg = p.in[I_FG];
    const int w0 = vcu * NWAVES + wave, WS_ = G * NWAVES;
    const f32x4 g0 = ((const f32x4*)fg)[2 * lane], g1 = ((const f32x4*)fg)[2 * lane + 1], g2 = ((const f32x4*)fg)[128 + 2 * lane], g3 = ((const f32x4*)fg)[128 + 2 * lane + 1];
#define PF_LOAD(dst, t0_) { _Pragma("unroll") for (int u = 0; u < 4; ++u) { const int tok = ((t0_) + u * WS_) < T ? ((t0_) + u * WS_) : w0; \
            dst[u][0] = *(const u32x4*)(H2B + (size_t)tok * D + 8 * lane); dst[u][1] = *(const u32x4*)(H2B + (size_t)tok * D + 512 + 8 * lane); } }
#define PF_PROC(src, t0_) { _Pragma("unroll") for (int u = 0; u < 4; ++u) { const int tok = (t0_) + u * WS_; if (tok < T) { float f[16]; float ss = 0.f; \
            _Pragma("unroll") for (int k = 0; k < 4; ++k) { f[2 * k] = bflo(src[u][0][k]); f[2 * k + 1] = bfhi(src[u][0][k]); f[8 + 2 * k] = bflo(src[u][1][k]); f[8 + 2 * k + 1] = bfhi(src[u][1][k]); } \
            _Pragma("unroll") for (int k = 0; k < 16; ++k) ss += f[k] * f[k]; \
            const float rs = rsqrtf(wave_sum(ss) * (1.f / D) + EPS); f32x4* yr = (f32x4*)(Y + (size_t)tok * D); \
            yr[2 * lane] = (f32x4){f[0], f[1], f[2], f[3]} * rs * g0; yr[2 * lane + 1] = (f32x4){f[4], f[5], f[6], f[7]} * rs * g1; \
            yr[128 + 2 * lane] = (f32x4){f[8], f[9], f[10], f[11]} * rs * g2; yr[128 + 2 * lane + 1] = (f32x4){f[12], f[13], f[14], f[15]} * rs * g3; } } }
    u32x4 va[4][2], vb[4][2];
    PF_LOAD(va, w0)
    for (int t0 = w0; t0 < T; t0 += 8 * WS_) {
        if (t0 + 4 * WS_ < T) PF_LOAD(vb, t0 + 4 * WS_)
        PF_PROC(va, t0)
        if (t0 + 8 * WS_ < T) PF_LOAD(va, t0 + 8 * WS_)
        PF_PROC(vb, t0 + 4 * WS_)
    }
}
#define XB_TMO      128
#define XB_XCNT(j)  (256  + 64 * (j))
#define XB_XSUB(j)  (1280 + 64 * (j))
#define XB_XGEN(j)  (2304 + 64 * (j))
#define XB_TOP      3328
#define XB_TOPGEN   3392
#define XCD_BAR_WORDS 3456
#define XB_SPIN_CAP (1u << 18)

__device__ __forceinline__ unsigned xb_ld(unsigned* p)              { return __hip_atomic_load(p, __ATOMIC_RELAXED, __HIP_MEMORY_SCOPE_AGENT); }
__device__ __forceinline__ unsigned xb_add(unsigned* p, unsigned v) { return __hip_atomic_fetch_add(p, v, __ATOMIC_RELAXED, __HIP_MEMORY_SCOPE_AGENT); }
__device__ __forceinline__ unsigned xb_xcc_id() { return (unsigned)__builtin_amdgcn_s_getreg((3 << 11) | 20) & 0xFu; }
#define XB_SPIN(cond, bar) do { unsigned _sp = 0; while (cond) { __builtin_amdgcn_s_sleep(1); \
    if ((++_sp & 255u) == 0u) { if (xb_ld(&(bar)[XB_TMO])) break; if (_sp > XB_SPIN_CAP) { atomicAdd(&(bar)[XB_TMO], 1u); break; } } } } while (0)

struct XcdBarrier {
    unsigned* bar; unsigned x;
    volatile LAS unsigned* st;
};

__device__ __forceinline__ XcdBarrier xcd_barrier_post(unsigned* bar, volatile LAS unsigned* st) {
    XcdBarrier b; b.bar = bar; b.x = xb_xcc_id(); b.st = st;
    if (threadIdx.x == 0) (void)xb_add(&bar[XB_XCNT(b.x)], 1u);
    return b;
}
__device__ __forceinline__ void xcd_barrier_complete(unsigned* bar, unsigned x, unsigned& nloc, unsigned& nx) {
    const unsigned G = gridDim.x * gridDim.y * gridDim.z;
    unsigned sum, cnt, mine, sp = 0u;
    for (;;) {
        sum = 0u; cnt = 0u; mine = 0u;
#pragma unroll
        for (unsigned j = 0; j < 16; ++j) { const unsigned c = xb_ld(&bar[XB_XCNT(j)]); sum += c; cnt += (c > 0u) ? 1u : 0u; mine = (j == x) ? c : mine; }
        if (sum == G) break;
        __builtin_amdgcn_s_sleep(1);
        if ((++sp & 255u) == 0u) { if (xb_ld(&bar[XB_TMO])) break; if (sp > XB_SPIN_CAP) { atomicAdd(&bar[XB_TMO], 1u); break; } }
    }
    nloc = mine > 0u ? mine : 1u; nx = cnt > 0u ? cnt : 1u;
}

__device__ __forceinline__ void xcd_barrier(const XcdBarrier& b) {
    asm volatile("s_waitcnt vmcnt(0)" ::: "memory");
    __syncthreads();
    if (threadIdx.x == 0) {
        unsigned* bar = b.bar;
        __builtin_amdgcn_s_waitcnt(0);
        unsigned nloc = b.st[0], nx = b.st[1];
        if (nloc == 0u) { xcd_barrier_complete(bar, b.x, nloc, nx); b.st[0] = nloc; b.st[1] = nx; }
        const unsigned old = xb_add(&bar[XB_XSUB(b.x)], 1u);
        const unsigned gen = old / nloc;
        if (old + 1u == (gen + 1u) * nloc) {
            __builtin_amdgcn_fence(__ATOMIC_RELEASE, "agent");
            asm volatile("s_waitcnt vmcnt(0)" ::: "memory");
            const unsigned og = xb_add(&bar[XB_TOP], 1u);
            const unsigned tg = og / nx;
            if (og + 1u == (tg + 1u) * nx) xb_add(&bar[XB_TOPGEN], 1u);
            else XB_SPIN(xb_ld(&bar[XB_TOPGEN]) == tg, bar);
            __builtin_amdgcn_fence(__ATOMIC_ACQUIRE, "agent");
            xb_add(&bar[XB_XGEN(b.x)], 1u);
            asm volatile("s_waitcnt vmcnt(0)" ::: "memory");
        } else {
            XB_SPIN(xb_ld(&bar[XB_XGEN(b.x)]) == gen, bar);
            __builtin_amdgcn_fence(__ATOMIC_ACQUIRE, "agent");
            asm volatile("s_waitcnt vmcnt(0)" ::: "memory");
        }
    }
    __syncthreads();
}

constexpr int N_PHASES = 12;
__global__ void __launch_bounds__(NTHREADS, 2) hymba_fwd(Params p) {
    extern __shared__ __attribute__((aligned(16))) unsigned char lds_raw[];
    LAS unsigned char* lds = (LAS unsigned char*)lds_raw;
    cg::grid_group grid = cg::this_grid();
    const int G = gridDim.x; const int bx = blockIdx.x;
    const int vcu = (G % 8 == 0) ? (bx % 8) * (G / 8) + bx / 8 : bx;
    unsigned char* ws = p.ws;
    const int lo = p.ph_lo, hi = p.ph_hi;
    volatile LAS unsigned* MISC = (volatile LAS unsigned*)(lds + 131072 + 320);
    if (threadIdx.x < 32) MISC[threadIdx.x] = 0u;
    __syncthreads();
    XcdBarrier bar; bar.bar = (unsigned*)ws; bar.x = xb_xcc_id(); bar.st = MISC + 8;
    if (lo == 0 && bx == 0) { const u32x4 z_ = {0u, 0u, 0u, 0u}; for (int i = threadIdx.x; i < 65536 / 16; i += NTHREADS) ((u32x4*)ws)[i] = z_; }
#define IN(k) (lo <= (k) && (k) < hi)
#define SEAM(k) do { if ((k) + 1 < hi) { if ((k) == 0) grid.sync(); else xcd_barrier(bar); } } while (0)
    if (IN(0)) { phase_prep(p, lds, vcu, G); SEAM(0); }
    if (threadIdx.x == 0) { MISC[20] = xb_add(&bar.bar[XB_XCNT(bar.x)], 1u); MISC[21] = bar.x; MISC[22] = 0u; }
    if (IN(1)) {
        { pg8::Gemm g{(const bf16_t*)(ws + WS_XN), (const bf16_t*)(ws + WS_WINT), T, 3584, D}; pg8::StaticOrder S; S.init(T, 3584, G, bx);
          EpiInProj E{(bf16_t*)(ws + WS_PROJ), (const float*)(ws + WS_SM)};
          pg8::gemm_phase<EpiInProj, pg8::StaticOrder, true, true>(lds, g, S, E); }
        { pg8::Gemm g{(const bf16_t*)(ws + WS_WINT) + (size_t)3584 * D, (const bf16_t*)(ws + WS_XN), 512, T, D}; pg8::StaticOrder S; S.init(512, T, G, bx);
          EpiStore E{(bf16_t*)(ws + WS_VT), T};
          pg8::gemm_phase<EpiStore, pg8::StaticOrder, true, true>(lds, g, S, E); }
        SEAM(1);
    }
    if (IN(2)) { phase_hgrn(p, lds, G); }
    if (IN(3)) { phase_attn(p, lds, G); SEAM(3); }
    if (IN(5)) {
        pg8::Gemm g{(const bf16_t*)(ws + WS_XN), (const bf16_t*)(ws + WS_WOT), T, D, D}; pg8::StaticOrder S; S.init(T, D, G, bx);
        EpiOutProj E{p.in[I_X], p.out, (bf16_t*)(ws + WS_H1B), (float*)(ws + WS_SS)};
        pg8::gemm_phase<EpiOutProj, pg8::StaticOrder, true, true>(lds, g, S, E);
        SEAM(5);
    }
    if (IN(6)) {
        phase_hquant(p, vcu, G);
        pg8::Gemm g{(const bf16_t*)(ws + WS_H1B), (const bf16_t*)(ws + WS_WQT), T, 2048, D}; pg8::StaticOrder S; S.init(T, 2048, G, bx);
        EpiQ E{(bf16_t*)(ws + WS_QP), (const float*)(ws + WS_SS), (float*)(ws + WS_GATE)};
        pg8::gemm_phase<EpiQ, pg8::StaticOrder, true, true>(lds, g, S, E);
        SEAM(6);
    }
    if (IN(7)) { phase_topk(p, lds, vcu, G); SEAM(7); }
    {
        if (threadIdx.x == 0 && lo == 0 && hi > 2 && (G % 8) == 0) { bool ok = true; for (unsigned j = 0; j < 8; ++j) ok = ok && (xb_ld(&bar.bar[XB_XCNT(j)]) == (unsigned)(G / 8)); MISC[22] = ok ? 1u : 0u; }
        __syncthreads();
    }
    const bool xcc_ok = MISC[22] != 0u; const int xcc_x = __builtin_amdgcn_readfirstlane(xcc_ok ? (int)MISC[21] : (bx & 7)), xcc_j = __builtin_amdgcn_readfirstlane(xcc_ok ? (int)MISC[20] : (bx >> 3));
    if (IN(8)) { phase_peer_u(p, lds, G, xcc_x, xcc_j); SEAM(8); }
    if (IN(9)) { phase_peer_c(p, vcu, G); SEAM(9); }
    if (IN(10)) { phase_peer_v(p, lds, G, xcc_x, xcc_j); SEAM(10); }
    if (IN(11)) { phase_final(p, vcu, G); }
#undef IN
#undef SEAM
}

extern "C" void kernel_launch(void* const* d_in, const int* in_sizes, int n_in, void* d_out, int out_size, void* d_ws, size_t ws_size, hipStream_t stream) {
    static int grid = 0;
    if (grid == 0) {
        if (n_in != 19 || out_size != T * D || ws_size < WS_END) { fprintf(stderr, "kernel_launch: unexpected sizes (n_in %d out %d ws %zu)\n", n_in, out_size, ws_size); grid = -1; return; }
        int dev = 0, cus = 0, per_cu = 0;
        hipGetDevice(&dev); hipDeviceGetAttribute(&cus, hipDeviceAttributeMultiprocessorCount, dev);
        hipFuncSetAttribute((const void*)hymba_fwd, hipFuncAttributeMaxDynamicSharedMemorySize, LDS_BYTES);
        hipOccupancyMaxActiveBlocksPerMultiprocessor(&per_cu, (const void*)hymba_fwd, NTHREADS, LDS_BYTES);
        (void)hipGetLastError();
        if (per_cu < 1) { fprintf(stderr, "kernel_launch: occupancy query says %d blocks/CU\n", per_cu); per_cu = 1; }
        grid = cus;
    }
    if (grid < 0) return;
    Params p{};
    for (int i = 0; i < 19; ++i) p.in[i] = (const float*)d_in[i];
    p.out = (float*)d_out; p.ws = (unsigned char*)d_ws;
#if MK_ONE_LAUNCH
    p.ph_lo = 0; p.ph_hi = N_PHASES;
    void* args[] = {&p};
    hipError_t e = hipLaunchCooperativeKernel((const void*)hymba_fwd, dim3(grid), dim3(NTHREADS), args, LDS_BYTES, stream);
    if (e != hipSuccess) fprintf(stderr, "cooperative launch failed: %s (grid %d)\n", hipGetErrorString(e), grid);
#else
    for (int ph = 0; ph < N_PHASES; ++ph) { p.ph_lo = ph; p.ph_hi = ph + 1; hipLaunchKernelGGL(hymba_fwd, dim3(grid), dim3(NTHREADS), LDS_BYTES, stream, p); }
#endif
}
```
